# Optimizing an MI355X kernel written in HIP

```python
import math, functools
import jax, jax.numpy as jnp
from jax import lax
import numpy as np

D_MODEL = 1024
BATCH = 8
SEQ = 2048
DEPTH = 2
DEC_BATCH = 128
DEC_SEQ = 8
PAST_LEN = 2048
PAGE_SIZE = 128

D_MIX = D_MODEL
W_BRANCH = D_MIX // 4
A_HEADS = 4
A_QK = W_BRANCH // A_HEADS // 2
A_V = 2 * A_QK
Q_BLOCK = 128
LRU_BLOCKS = 4
LRU_BW = W_BRANCH // LRU_BLOCKS
CONV_W = 4
LRU_C = 8.0
RW_HEADS = 4
RW_HS = W_BRANCH // RW_HEADS
RW_LORA_W = 32
RW_LORA_A = 32
RW_NPROJ = 5
RW_GN_EPS = RW_HS * 1e-5
S5_CH = 16
S5_GROUPS = W_BRANCH // S5_CH
S5_STATE = 64
NORM_EPS = 1e-6
NEG_BIG = -1e30

OFF_AQ = 0
OFF_AK = OFF_AQ + W_BRANCH
OFF_AV = OFF_AK + W_BRANCH
OFF_B = OFF_AV + W_BRANCH
OFF_C = OFF_B + W_BRANCH
OFF_D = OFF_C + RW_NPROJ * W_BRANCH
OFF_G = OFF_D + W_BRANCH
D_IN = OFF_G + D_MIX

kernel_name = 'hymba_style_diffattn_rglru_rwkv7_s5_step'


def rms_norm(x, g):
    xf = x.astype(jnp.float32)
    y = xf * lax.rsqrt(jnp.mean(xf * xf, axis=-1, keepdims=True) + NORM_EPS)
    return (y * g.astype(jnp.float32)).astype(x.dtype)


def diff_attn_core(q, k, v, q_pos, k_pos, lam):
    s = jnp.einsum('bqhcd,bkhcd->bhcqk', q, k).astype(jnp.float32) * (A_QK ** -0.5)
    mask = k_pos[None, :] <= q_pos[:, None]
    p = jax.nn.softmax(jnp.where(mask, s, NEG_BIG), axis=-1)
    w = p[:, :, 0] - lam * p[:, :, 1]
    return jnp.einsum('bhqk,bkhd->bqhd', w.astype(v.dtype), v)


def diff_attn_prompt(q, k, v, lam):
    b, t = q.shape[0], q.shape[1]
    nblk = t // Q_BLOCK
    qb = jnp.swapaxes(q.reshape(b, nblk, Q_BLOCK, A_HEADS, 2, A_QK), 0, 1)
    k_pos = jnp.arange(t)

    def block(args):
        q_blk, i = args
        q_pos = i * Q_BLOCK + jnp.arange(Q_BLOCK)
        return diff_attn_core(q_blk, k, v, q_pos, k_pos, lam)

    o = lax.map(block, (qb, jnp.arange(nblk)))
    return jnp.swapaxes(o, 0, 1).reshape(b, t, A_HEADS, A_V)


def diff_attn_sample(q, k, v, lam, cache_k_l, cache_v_l, page_table):
    nb, tq = q.shape[0], q.shape[1]
    past = page_table.shape[1] * PAGE_SIZE
    k_past = cache_k_l[page_table].reshape(nb, past, A_HEADS, 2, A_QK).astype(k.dtype)
    v_past = cache_v_l[page_table].reshape(nb, past, A_HEADS, A_V).astype(v.dtype)
    k_all = jnp.concatenate([k_past, k], axis=1)
    v_all = jnp.concatenate([v_past, v], axis=1)
    q_pos = past + jnp.arange(tq)
    k_pos = jnp.arange(past + tq)
    return diff_attn_core(q, k_all, v_all, q_pos, k_pos, lam)


def causal_conv(xb, buf, w, bias):
    xp = jnp.concatenate([buf.astype(xb.dtype), xb], axis=1)
    t = xb.shape[1]
    y = bias + xp[:, 0:t] * w[0]
    for j in range(1, CONV_W):
        y = y + xp[:, j:j + t] * w[j]
    return y, xp[:, xp.shape[1] - (CONV_W - 1):]


def linear_scan(a, b, h0):
    b = b.at[:, 0].add(a[:, 0] * h0)

    def comb(l, r):
        return (l[0] * r[0], r[0] * l[1] + r[1])

    _, h = lax.associative_scan(comb, (a, b), axis=1)
    return h


def rglru(xc, h0, w_a, b_a, w_x, b_x, lam):
    bt, t, _ = xc.shape
    xf = xc.astype(jnp.float32)
    xblk = xf.reshape(bt, t, LRU_BLOCKS, LRU_BW)
    r = jax.nn.sigmoid(jnp.einsum('btnc,ncd->btnd', xblk, w_a).reshape(bt, t, W_BRANCH) + b_a)
    i = jax.nn.sigmoid(jnp.einsum('btnc,ncd->btnd', xblk, w_x).reshape(bt, t, W_BRANCH) + b_x)
    log_a = -LRU_C * r * jax.nn.softplus(-lam.astype(jnp.float32))
    a = jnp.exp(log_a)
    mult = jnp.sqrt(-jnp.expm1(2.0 * log_a))
    h = linear_scan(a, mult * (i * xf), h0.astype(jnp.float32))
    return h, h[:, -1]


def rwkv7_mix(pc, prev, S0, mu, w0, w1, w2, a0, a1, a2, k_k, k_a, r_k, gn_w, gn_b):
    bt, t, _ = pc.shape
    f32 = jnp.float32
    p = pc.astype(f32)
    p_prev = jnp.concatenate([prev.astype(f32)[:, None], p[:, :-1]], axis=1)
    xm = p + (p_prev - p) * mu.astype(f32)
    xr, xw, xk, xv, xa = jnp.split(xm, RW_NPROJ, axis=-1)
    w = -jax.nn.softplus(-(w0 + jnp.tanh(xw @ w1) @ w2)) - 0.5
    decay = jnp.exp(-jnp.exp(w))
    a = jax.nn.sigmoid(a0 + (xa @ a1) @ a2)

    def heads(z):
        return z.reshape(bt, t, RW_HEADS, RW_HS)

    kk = heads(xk * k_k)
    kk = kk / jnp.maximum(jnp.sqrt(jnp.sum(kk * kk, axis=-1, keepdims=True)), 1e-12)
    k = heads(xk * (1.0 + (a - 1.0) * k_a))
    r, v, a_h, dec_h = heads(xr), heads(xv), heads(a), heads(decay)

    def step(S, inp):
        r_t, w_t, k_t, v_t, kk_t, a_t = inp
        sa = jnp.einsum('bhij,bhj->bhi', S, -kk_t)
        S = (S * w_t[:, :, None, :] + sa[..., None] * (kk_t * a_t)[:, :, None, :]
             + v_t[..., None] * k_t[:, :, None, :])
        return S, jnp.einsum('bhij,bhj->bhi', S, r_t)

    seq = tuple(jnp.swapaxes(z, 0, 1) for z in (r, dec_h, k, v, kk, a_h))
    S, y = lax.scan(step, S0.astype(f32), seq)
    y = jnp.swapaxes(y, 0, 1)
    mean = jnp.mean(y, axis=-1, keepdims=True)
    var = jnp.mean(jnp.square(y - mean), axis=-1, keepdims=True)
    y = ((y - mean) * lax.rsqrt(var + RW_GN_EPS) * gn_w.reshape(RW_HEADS, RW_HS)
         + gn_b.reshape(RW_HEADS, RW_HS))
    y = y + jnp.sum(r * k * r_k, axis=-1, keepdims=True) * v
    return y.reshape(bt, t, W_BRANCH), pc[:, -1], S


def s5_mix(u, x0, lam_re, lam_im, log_dt, b_re, b_im, c_re, c_im, d, w_glu, b_glu):
    bt, t, _ = u.shape
    f32 = jnp.float32
    uf = u.astype(f32)
    ug = uf.reshape(bt, t, S5_GROUPS, S5_CH)
    lr, li = lam_re.astype(f32), lam_im.astype(f32)
    dt = jnp.exp(log_dt.astype(f32))[:, None]
    mag = jnp.exp(lr * dt)
    ab_re, ab_im = mag * jnp.cos(li * dt), mag * jnp.sin(li * dt)
    den = lr * lr + li * li
    pr = ab_re - 1.0
    f_re = (pr * lr + ab_im * li) / den
    f_im = (ab_im * lr - pr * li) / den
    bb_re = f_re[..., None] * b_re - f_im[..., None] * b_im
    bb_im = f_re[..., None] * b_im + f_im[..., None] * b_re
    bu_re = jnp.einsum('btgc,gnc->btgn', ug, bb_re)
    bu_im = jnp.einsum('btgc,gnc->btgn', ug, bb_im)
    h0_re, h0_im = x0[..., 0].astype(f32), x0[..., 1].astype(f32)
    bu_re = bu_re.at[:, 0].add(ab_re * h0_re - ab_im * h0_im)
    bu_im = bu_im.at[:, 0].add(ab_re * h0_im + ab_im * h0_re)
    a_re = jnp.broadcast_to(ab_re, bu_re.shape)
    a_im = jnp.broadcast_to(ab_im, bu_im.shape)

    def comb(l, r):
        lar, lai, lbr, lbi = l
        rar, rai, rbr, rbi = r
        return (rar * lar - rai * lai, rar * lai + rai * lar,
                rar * lbr - rai * lbi + rbr, rar * lbi + rai * lbr + rbi)

    _, _, h_re, h_im = lax.associative_scan(comb, (a_re, a_im, bu_re, bu_im), axis=1)
    y = jnp.einsum('btgn,gcn->btgc', h_re, c_re) - jnp.einsum('btgn,gcn->btgc', h_im, c_im)
    y = y.reshape(bt, t, W_BRANCH) + d * uf
    z = jax.nn.gelu(y)
    out = z * jax.nn.sigmoid(z @ w_glu + b_glu)
    return out, jnp.stack([h_re[:, -1], h_im[:, -1]], axis=-1)


def mixer_layer(x, attend, states, lam_init, norm_pre, norm_post, w_in, w_out,
                lam_q1, lam_k1, lam_q2, lam_k2, subln_w, conv_w, conv_b,
                lru_wa, lru_ba, lru_wx, lru_bx, lru_lam,
                rw_mu, rw_w0, rw_w1, rw_w2, rw_a0, rw_a1, rw_a2, rw_kk, rw_ka, rw_rk, rw_gnw, rw_gnb,
                s5_lre, s5_lim, s5_logdt, s5_bre, s5_bim, s5_cre, s5_cim, s5_d, s5_wglu, s5_bglu):
    conv_buf, lru_h, shift_prev, wkv_S, ssm_x = states
    b, t, _ = x.shape
    f32 = jnp.float32
    h = rms_norm(x, norm_pre)
    proj = jnp.einsum('btd,de->bte', h, w_in)
    q = proj[..., OFF_AQ:OFF_AK].reshape(b, t, A_HEADS, 2, A_QK)
    k = proj[..., OFF_AK:OFF_AV].reshape(b, t, A_HEADS, 2, A_QK)
    v = proj[..., OFF_AV:OFF_B].reshape(b, t, A_HEADS, A_V)
    xb = proj[..., OFF_B:OFF_C]
    pc = proj[..., OFF_C:OFF_D]
    u = proj[..., OFF_D:OFF_G]
    gate = proj[..., OFF_G:]
    lam = (jnp.exp(jnp.sum(lam_q1.astype(f32) * lam_k1.astype(f32)))
           - jnp.exp(jnp.sum(lam_q2.astype(f32) * lam_k2.astype(f32))) + lam_init)
    oa = attend(q, k, v, lam)
    oa = (rms_norm(oa, subln_w) * (1.0 - lam_init)).reshape(b, t, W_BRANCH)
    xc, new_conv = causal_conv(xb, conv_buf, conv_w, conv_b)
    ob, new_h = rglru(xc, lru_h, lru_wa, lru_ba, lru_wx, lru_bx, lru_lam)
    oc, new_shift, new_S = rwkv7_mix(pc, shift_prev, wkv_S, rw_mu, rw_w0, rw_w1, rw_w2,
                                     rw_a0, rw_a1, rw_a2, rw_kk, rw_ka, rw_rk, rw_gnw, rw_gnb)
    od, new_ssm = s5_mix(u, ssm_x, s5_lre, s5_lim, s5_logdt, s5_bre, s5_bim, s5_cre, s5_cim,
                         s5_d, s5_wglu, s5_bglu)
    o = jnp.concatenate([oa.astype(x.dtype), ob.astype(x.dtype), oc.astype(x.dtype),
                         od.astype(x.dtype)], axis=-1) * jax.nn.silu(gate)
    y = x + rms_norm(jnp.einsum('bte,ed->btd', o, w_out), norm_post)
    new_states = (k.reshape(b, t, A_HEADS, 2 * A_QK), v, new_conv, new_h, new_shift, new_S, new_ssm)
    return y, new_states


def setup_inputs(seed: int = 0) -> dict:
    key = jax.random.key(seed)
    keys = iter(jax.random.split(key, 64))
    f32 = jnp.float32

    def nrm(shape, scale):
        return jax.random.normal(next(keys), shape, f32) * scale

    def unif(shape, lo, hi):
        return jax.random.uniform(next(keys), shape, f32, lo, hi)

    W = W_BRANCH
    n_pages = PAST_LEN // PAGE_SIZE
    n_used = DEC_BATCH * n_pages
    n_pool = n_used + n_used // 4
    x_prompt = nrm((BATCH, SEQ, D_MODEL), 1.0)
    x_sample = nrm((DEC_BATCH, DEC_SEQ, D_MODEL), 1.0)
    cache_k = nrm((DEPTH, n_pool, PAGE_SIZE, A_HEADS, 2 * A_QK), 1.0)
    cache_v = nrm((DEPTH, n_pool, PAGE_SIZE, A_HEADS, A_V), 1.0)
    page_table = jax.random.permutation(next(keys), n_pool)[:n_used].reshape(DEC_BATCH, n_pages).astype(jnp.int32)
    state_conv = nrm((DEPTH, DEC_BATCH, CONV_W - 1, W), 1.0)
    state_lru = nrm((DEPTH, DEC_BATCH, W), 0.5)
    state_shift = nrm((DEPTH, DEC_BATCH, RW_NPROJ * W), 1.0)
    state_wkv = nrm((DEPTH, DEC_BATCH, RW_HEADS, RW_HS, RW_HS), 0.3)
    state_ssm = nrm((DEPTH, DEC_BATCH, S5_GROUPS, S5_STATE, 2), 0.1)
    norm_pre = 1.0 + nrm((DEPTH, D_MODEL), 0.05)
    norm_post = 1.0 + nrm((DEPTH, D_MODEL), 0.05)
    w_in = nrm((DEPTH, D_MODEL, D_IN), D_MODEL ** -0.5)
    w_out = nrm((DEPTH, D_MIX, D_MODEL), D_MIX ** -0.5)
    lam_q1 = nrm((DEPTH, A_QK), 0.1)
    lam_k1 = nrm((DEPTH, A_QK), 0.1)
    lam_q2 = nrm((DEPTH, A_QK), 0.1)
    lam_k2 = nrm((DEPTH, A_QK), 0.1)
    subln_w = 1.0 + nrm((DEPTH, A_V), 0.05)
    conv_w = nrm((DEPTH, CONV_W, W), CONV_W ** -0.5)
    conv_b = nrm((DEPTH, W), 0.01)
    lru_wa = nrm((DEPTH, LRU_BLOCKS, LRU_BW, LRU_BW), LRU_BW ** -0.5)
    lru_ba = nrm((DEPTH, W), 0.01)
    lru_wx = nrm((DEPTH, LRU_BLOCKS, LRU_BW, LRU_BW), LRU_BW ** -0.5)
    lru_bx = nrm((DEPTH, W), 0.01)
    a_init = unif((DEPTH, W), 0.9, 0.999)
    lru_lam = jnp.log(a_init) - jnp.log1p(-a_init)
    rw_mu = unif((DEPTH, RW_NPROJ * W), 0.0, 1.0)
    rw_w0 = unif((DEPTH, W), -5.0, 1.0)
    rw_w1 = nrm((DEPTH, W, RW_LORA_W), W ** -0.5)
    rw_w2 = nrm((DEPTH, RW_LORA_W, W), 0.1 * RW_LORA_W ** -0.5)
    rw_a0 = nrm((DEPTH, W), 0.1)
    rw_a1 = nrm((DEPTH, W, RW_LORA_A), W ** -0.5)
    rw_a2 = nrm((DEPTH, RW_LORA_A, W), 0.1 * RW_LORA_A ** -0.5)
    rw_kk = 0.85 + nrm((DEPTH, W), 0.05)
    rw_ka = 1.0 + nrm((DEPTH, W), 0.05)
    rw_rk = nrm((DEPTH, RW_HEADS, RW_HS), 0.1)
    rw_gnw = 1.0 + nrm((DEPTH, W), 0.05)
    rw_gnb = nrm((DEPTH, W), 0.01)
    s5_lre = -0.5 + nrm((DEPTH, S5_GROUPS, S5_STATE), 0.01)
    s5_lim = math.pi * jnp.arange(S5_STATE, dtype=f32) + nrm((DEPTH, S5_GROUPS, S5_STATE), 0.01)
    s5_logdt = unif((DEPTH, S5_GROUPS), math.log(0.001), math.log(0.1))
    s5_bre = nrm((DEPTH, S5_GROUPS, S5_STATE, S5_CH), (2 * S5_CH) ** -0.5)
    s5_bim = nrm((DEPTH, S5_GROUPS, S5_STATE, S5_CH), (2 * S5_CH) ** -0.5)
    s5_cre = nrm((DEPTH, S5_GROUPS, S5_CH, S5_STATE), (2 * S5_STATE) ** -0.5)
    s5_cim = nrm((DEPTH, S5_GROUPS, S5_CH, S5_STATE), (2 * S5_STATE) ** -0.5)
    s5_d = nrm((DEPTH, W), 0.5)
    s5_wglu = nrm((DEPTH, W, W), W ** -0.5)
    s5_bglu = nrm((DEPTH, W), 0.01)
    return {'x_prompt': x_prompt, 'x_sample': x_sample, 'cache_k': cache_k, 'cache_v': cache_v,
            'page_table': page_table, 'state_conv': state_conv, 'state_lru': state_lru,
            'state_shift': state_shift, 'state_wkv': state_wkv, 'state_ssm': state_ssm,
            'norm_pre': norm_pre, 'norm_post': norm_post, 'w_in': w_in, 'w_out': w_out,
            'lam_q1': lam_q1, 'lam_k1': lam_k1, 'lam_q2': lam_q2, 'lam_k2': lam_k2,
            'subln_w': subln_w, 'conv_w': conv_w, 'conv_b': conv_b,
            'lru_wa': lru_wa, 'lru_ba': lru_ba, 'lru_wx': lru_wx, 'lru_bx': lru_bx, 'lru_lam': lru_lam,
            'rw_mu': rw_mu, 'rw_w0': rw_w0, 'rw_w1': rw_w1, 'rw_w2': rw_w2, 'rw_a0': rw_a0,
            'rw_a1': rw_a1, 'rw_a2': rw_a2, 'rw_kk': rw_kk, 'rw_ka': rw_ka, 'rw_rk': rw_rk,
            'rw_gnw': rw_gnw, 'rw_gnb': rw_gnb,
            's5_lre': s5_lre, 's5_lim': s5_lim, 's5_logdt': s5_logdt, 's5_bre': s5_bre,
            's5_bim': s5_bim, 's5_cre': s5_cre, 's5_cim': s5_cim, 's5_d': s5_d,
            's5_wglu': s5_wglu, 's5_bglu': s5_bglu}


def reference(x_prompt, x_sample, cache_k, cache_v, page_table, state_conv, state_lru,
              state_shift, state_wkv, state_ssm, norm_pre, norm_post, w_in, w_out,
              lam_q1, lam_k1, lam_q2, lam_k2, subln_w, conv_w, conv_b,
              lru_wa, lru_ba, lru_wx, lru_bx, lru_lam,
              rw_mu, rw_w0, rw_w1, rw_w2, rw_a0, rw_a1, rw_a2, rw_kk, rw_ka, rw_rk, rw_gnw, rw_gnb,
              s5_lre, s5_lim, s5_logdt, s5_bre, s5_bim, s5_cre, s5_cim, s5_d, s5_wglu, s5_bglu):
    weights = (norm_pre, norm_post, w_in, w_out, lam_q1, lam_k1, lam_q2, lam_k2, subln_w,
               conv_w, conv_b, lru_wa, lru_ba, lru_wx, lru_bx, lru_lam,
               rw_mu, rw_w0, rw_w1, rw_w2, rw_a0, rw_a1, rw_a2, rw_kk, rw_ka, rw_rk, rw_gnw, rw_gnb,
               s5_lre, s5_lim, s5_logdt, s5_bre, s5_bim, s5_cre, s5_cim, s5_d, s5_wglu, s5_bglu)
    dt = x_prompt.dtype
    nbp = x_prompt.shape[0]
    zero_states = (jnp.zeros((nbp, CONV_W - 1, W_BRANCH), dt),
                   jnp.zeros((nbp, W_BRANCH), dt),
                   jnp.zeros((nbp, RW_NPROJ * W_BRANCH), dt),
                   jnp.zeros((nbp, RW_HEADS, RW_HS, RW_HS), dt),
                   jnp.zeros((nbp, S5_GROUPS, S5_STATE, 2), dt))
    xp, xs = x_prompt, x_sample
    outs_p = [[] for _ in range(7)]
    outs_s = [[] for _ in range(7)]
    for l in range(DEPTH):
        wl = tuple(w[l] for w in weights)
        lam_init = 0.8 - 0.6 * math.exp(-0.3 * l)
        xp, st_p = mixer_layer(xp, diff_attn_prompt, zero_states, lam_init, *wl)
        attend_s = functools.partial(diff_attn_sample, cache_k_l=cache_k[l],
                                     cache_v_l=cache_v[l], page_table=page_table)
        st_in = (state_conv[l], state_lru[l], state_shift[l], state_wkv[l], state_ssm[l])
        xs, st_s = mixer_layer(xs, attend_s, st_in, lam_init, *wl)
        for i in range(7):
            outs_p[i].append(st_p[i])
            outs_s[i].append(st_s[i])
    k_p, v_p, conv_p, lru_p, shift_p, wkv_p, ssm_p = [jnp.stack(z) for z in outs_p]
    k_s, v_s, conv_s, lru_s, shift_s, wkv_s, ssm_s = [jnp.stack(z) for z in outs_s]
    return (xp, xs, k_p, k_s, v_p, v_s, conv_p, conv_s, lru_p, lru_s,
            shift_p, shift_s, wkv_p, wkv_s, ssm_p, ssm_s)
```

```cpp
#include <hip/hip_runtime.h>
#include <cstdio>
#include <cstdint>
#ifndef MK_PER_PHASE
#define MK_PER_PHASE 0
#endif
namespace pg8 {
#define PG8_LAS __attribute__((address_space(3)))
typedef unsigned short bf16_t;
typedef short bf16x8 __attribute__((ext_vector_type(8)));
typedef float f32x4 __attribute__((ext_vector_type(4)));
typedef unsigned u32x4 __attribute__((ext_vector_type(4)));
constexpr int BM = 256, BK = 64, HALF = 128, HTB = HALF * BK * 2  , STAGE_BYTES = 8 * HTB, NXCD = 8, WGM = 8;

__host__ __device__ __forceinline__ int lds_byte(int r, int c) { const int st = (r >> 4) * 2 + (c >> 5), rr = r & 15, cc = c & 31, ob = rr * 64 + cc * 2; return st * 1024 + (ob ^ (((ob >> 9) & 1) << 5)); }
__host__ __device__ __forceinline__ void stage_rc(int b, int& R, int& C) { const int st = b / 1024, sb = b % 1024, swz = sb ^ (((sb >> 9) & 1) << 5); R = (st >> 1) * 16 + swz / 64; C = (st & 1) * 32 + (swz % 64) / 2; }
__host__ __device__ __forceinline__ int perm32(int rho) { const int n = rho >> 4, i = rho & 15; return 8 * (i >> 2) + 4 * n + (i & 3); }

struct Unit { int pm, pn; };
struct Gemm { const bf16_t* A; const bf16_t* Bt; int M, N, K; };

struct StaticOrder {
    int nM, nN, nwg, G, c;
    __host__ __device__ void init(int M, int N, int G_, int c_) { nM = M / BM; nN = N / BM; nwg = nM * nN; G = G_; c = c_; }
    __host__ __device__ bool next(int i, Unit& u) const {
        const long L = (long)i * G + c; if (L >= nwg) return false;
        int wgid = (int)L; { const int q = nwg / NXCD, r = nwg % NXCD, xcd = wgid % NXCD, off = wgid / NXCD; wgid = (xcd < r ? xcd * (q + 1) : r * (q + 1) + (xcd - r) * q) + off; }
        const int nig = WGM * nN, gid = wgid / nig, fm = gid * WGM, gsz = (nM - fm) < WGM ? (nM - fm) : WGM;
        u.pm = fm + ((wgid % nig) % gsz); u.pn = (wgid % nig) / gsz; return true;
    }
    __device__ __forceinline__ void a_ready(const Unit&) const {}
    __device__ __forceinline__ void done(const Unit&) const {}
};
template <class Epi, class Sched, bool STAMP = false>
__device__ __forceinline__ void gemm_phase(PG8_LAS unsigned char* lds, const Gemm g, const Sched& S, const Epi& E, unsigned long long* stamps) {
    int tid = threadIdx.x; asm volatile("" : "+v"(tid));
    const int wid = __builtin_amdgcn_readfirstlane(tid >> 6), lane = tid & 63, wr = wid >> 2, wc = wid & 3, fr = lane & 15, fq = lane >> 4;
    const int K = g.K, nt = K / BK;
    int ts_lo = 0, ts_hi = 0, nts = 0; const unsigned long long rt_entry = STAMP ? (unsigned long long)wall_clock64() : 0ull;
#define PG8_STAMP() do { if (STAMP && wid == 0 && nts < 64) { const unsigned long long _c = (unsigned long long)clock64(); \
        ts_lo = (lane == nts) ? (int)(unsigned)_c : ts_lo; ts_hi = (lane == nts) ? (int)(unsigned)(_c >> 32) : ts_hi; ++nts; } } while (0)
    PG8_STAMP();
    unsigned voffA[2], voffB[2];
#pragma unroll
    for (int i = 0; i < 2; ++i) { int R, C; stage_rc(tid * 16 + i * 8192, R, C); const int Rb = Epi::PERM ? ((R & ~31) + perm32(R & 31)) : R;
        voffA[i] = (unsigned)(R * K + C) * 2u; voffB[i] = (unsigned)(Rb * K + C) * 2u; }
    const size_t kstep = (size_t)(BK * 2);
    const size_t hstep = (size_t)HALF * K * 2;
    const size_t tstep = 2 * hstep;
    const unsigned ldsw = (unsigned)wid * 1024u;
    const int aoff = lds_byte(wr * 64 + fr, fq * 8), boff = lds_byte(wc * 32 + fr, fq * 8);
#define PG8_SA(b, h) (((b) * 2 + (h)) * HTB)
#define PG8_SB(b, h) ((4 + (b) * 2 + (h)) * HTB)
#define PG8_STAGE(bufoff, gbase, voff) do { _Pragma("unroll") for (int _i = 0; _i < 2; ++_i) \
        __builtin_amdgcn_global_load_lds((const unsigned*)((const char*)(gbase) + (voff)[_i]), (PG8_LAS unsigned*)(lds + (bufoff) + ldsw + _i * 8192), 16, 0, 0); } while (0)
#define PG8_LDA(dst, b, h) do { _Pragma("unroll") for (int m = 0; m < 4; ++m) _Pragma("unroll") for (int k = 0; k < 2; ++k) dst[m][k] = *(const PG8_LAS bf16x8*)(lds + PG8_SA(b, h) + aoff + m * 2048 + k * 1024); } while (0)
#define PG8_LDB(dst, b, h) do { _Pragma("unroll") for (int n = 0; n < 2; ++n) _Pragma("unroll") for (int k = 0; k < 2; ++k) dst[n][k] = *(const PG8_LAS bf16x8*)(lds + PG8_SB(b, h) + boff + n * 2048 + k * 1024); } while (0)
#define PG8_MMA(ai, bj, At, Bt) do { __builtin_amdgcn_s_setprio(1); _Pragma("unroll") for (int m = 0; m < 4; ++m) _Pragma("unroll") for (int n = 0; n < 2; ++n) _Pragma("unroll") for (int k = 0; k < 2; ++k) \
        acc[ai][bj][m][n] = __builtin_amdgcn_mfma_f32_16x16x32_bf16(Bt[n][k], At[m][k], acc[ai][bj][m][n], 0, 0, 0); __builtin_amdgcn_s_setprio(0); } while (0)
#define PG8_WAIT_V(n) asm volatile("s_waitcnt vmcnt(" #n ")" ::: "memory")
#define PG8_WAIT_L(n) asm volatile("s_waitcnt lgkmcnt(" #n ")" ::: "memory")
#define PG8_BAR __builtin_amdgcn_s_barrier()
#define PG8_SCHED __builtin_amdgcn_sched_barrier(0)
    Unit cur, nxt; int ui = 0;
    if (!S.next(0, cur)) return;
    f32x4 acc[2][2][4][2];
#pragma unroll
    for (int a = 0; a < 2; ++a)
#pragma unroll
        for (int b = 0; b < 2; ++b)
#pragma unroll
            for (int m = 0; m < 4; ++m)
#pragma unroll
                for (int n = 0; n < 2; ++n) acc[a][b][m][n] = (f32x4){0.f, 0.f, 0.f, 0.f};
    bf16x8 At[4][2], B0[2][2], B1[2][2];
    const char* cA = (const char*)g.A + (size_t)cur.pm * tstep; const char* cB = (const char*)g.Bt + (size_t)cur.pn * tstep;
    S.a_ready(cur);
    PG8_STAGE(PG8_SB(0, 0), cB, voffB); PG8_STAGE(PG8_SA(0, 0), cA, voffA); PG8_STAGE(PG8_SB(0, 1), cB + hstep, voffB); PG8_STAGE(PG8_SA(0, 1), cA + hstep, voffA);
    if (wr == 1) PG8_BAR;
    PG8_WAIT_V(4); PG8_BAR;
    PG8_STAGE(PG8_SB(1, 0), cB + kstep, voffB); PG8_STAGE(PG8_SA(1, 0), cA + kstep, voffA); PG8_STAGE(PG8_SB(1, 1), cB + hstep + kstep, voffB);
    PG8_WAIT_V(6); PG8_BAR;
    PG8_STAMP();
    for (;;) {
        const bool has_next = S.next(ui + 1, nxt);
        const char* nA = has_next ? (const char*)g.A + (size_t)nxt.pm * tstep : cA; const char* nB = has_next ? (const char*)g.Bt + (size_t)nxt.pn * tstep : cB;
        for (int t = 0; t < nt; t += 2) {
            const bool last = (t == nt - 2);
            const char* a1 = cA + (size_t)(t + 1) * kstep;
            const char* a2 = last ? nA : cA + (size_t)(t + 2) * kstep; const char* b2 = last ? nB : cB + (size_t)(t + 2) * kstep;
            const char* a3 = a2 + kstep; const char* b3 = b2 + kstep;
            if (last && has_next) S.a_ready(nxt);
            PG8_LDB(B0, 0, 0); PG8_SCHED; PG8_LDA(At, 0, 0); PG8_STAGE(PG8_SA(1, 1), a1 + hstep, voffA);
            PG8_WAIT_L(8); PG8_BAR; PG8_WAIT_L(0); PG8_MMA(0, 0, At, B0); PG8_BAR; PG8_SCHED;
            PG8_LDB(B1, 0, 1); PG8_STAGE(PG8_SB(0, 0), b2, voffB);
            PG8_BAR; PG8_WAIT_L(0); PG8_MMA(0, 1, At, B1); PG8_BAR;
            PG8_LDA(At, 0, 1); PG8_STAGE(PG8_SA(0, 0), a2, voffA);
            PG8_BAR; PG8_WAIT_L(0); PG8_MMA(1, 0, At, B0); PG8_BAR; PG8_SCHED;
            PG8_STAGE(PG8_SB(0, 1), b2 + hstep, voffB);
            PG8_WAIT_V(6); PG8_BAR; PG8_MMA(1, 1, At, B1); PG8_BAR;
            PG8_LDB(B0, 1, 0); PG8_SCHED; PG8_LDA(At, 1, 0); PG8_STAGE(PG8_SA(0, 1), a2 + hstep, voffA);
            PG8_WAIT_L(8); PG8_BAR; PG8_WAIT_L(0); PG8_MMA(0, 0, At, B0); PG8_BAR; PG8_SCHED;
            PG8_LDB(B1, 1, 1); PG8_STAGE(PG8_SB(1, 0), b3, voffB);
            PG8_BAR; PG8_WAIT_L(0); PG8_MMA(0, 1, At, B1); PG8_BAR;
            PG8_LDA(At, 1, 1); PG8_STAGE(PG8_SA(1, 0), a3, voffA);
            PG8_BAR; PG8_WAIT_L(0); PG8_MMA(1, 0, At, B0); PG8_BAR; PG8_SCHED;
            PG8_STAGE(PG8_SB(1, 1), b3 + hstep, voffB);
            PG8_WAIT_V(6); PG8_BAR; PG8_MMA(1, 1, At, B1); PG8_BAR;
        }
        PG8_STAMP();
        if constexpr (!Epi::AFTER_DRAIN) { E(acc, cur, wr, wc, fr, fq); S.done(cur); }
        PG8_STAMP();
        if (!has_next) break;
#pragma unroll
        for (int a = 0; a < 2; ++a)
#pragma unroll
            for (int b = 0; b < 2; ++b)
#pragma unroll
                for (int m = 0; m < 4; ++m)
#pragma unroll
                    for (int n = 0; n < 2; ++n) acc[a][b][m][n] = (f32x4){0.f, 0.f, 0.f, 0.f};
        cur = nxt; cA = nA; cB = nB; ++ui;
    }
    PG8_WAIT_V(0);
    if (wr == 0) PG8_BAR;
    PG8_BAR;
    if constexpr (Epi::AFTER_DRAIN) { E.fused(acc, cur, wr, wc, fr, fq, lds, wid, lane); S.done(cur); }
    PG8_STAMP();
    if (STAMP && wid == 0) { stamps[lane] = lane < nts ? (((unsigned long long)(unsigned)ts_hi << 32) | (unsigned)ts_lo) : 0ull;
        if (lane == 62) stamps[62] = rt_entry; if (lane == 63) stamps[63] = (unsigned long long)wall_clock64(); }
#undef PG8_STAMP
#undef PG8_SA
#undef PG8_SB
#undef PG8_STAGE
#undef PG8_LDA
#undef PG8_LDB
#undef PG8_MMA
#undef PG8_WAIT_V
#undef PG8_WAIT_L
#undef PG8_BAR
#undef PG8_SCHED
}
}

#define GAS __attribute__((address_space(1)))
#define LAS __attribute__((address_space(3)))
typedef unsigned short bf16;
typedef float f32x4 __attribute__((ext_vector_type(4)));
typedef float f32x2 __attribute__((ext_vector_type(2)));
typedef float f32x16 __attribute__((ext_vector_type(16)));
typedef short bf16x8 __attribute__((ext_vector_type(8)));
typedef unsigned u32x4 __attribute__((ext_vector_type(4)));
typedef unsigned u32x2 __attribute__((ext_vector_type(2)));

constexpr int NWAVES = 8, NTHREADS = 512;
constexpr int DM = 1024, NP = 16384, NSMP = 1024, MTOK = 17408, DIN = 3584, SEQ = 2048, DB = 128, DS = 8;
constexpr int OFF_AQ = 0, OFF_AK = 256, OFF_AV = 512, OFF_B = 768, OFF_C = 1024, OFF_D = 2304, OFF_G = 2560;
constexpr int NPOOL = 2560, NPAGES = 16;
constexpr float NORM_EPS = 1e-6f;
constexpr float QSCALE = 0.17677669529663687f * 1.4426950408889634f;
constexpr int NSPLIT = 9;
constexpr int PART_FLOATS = 16 + 16 + 1024;

constexpr size_t OUT_Y_P = 0, OUT_Y_S = 16777216, OUT_K_P = 17825792, OUT_K_S = 26214400, OUT_V_P = 26738688, OUT_V_S = 35127296,
    OUT_CONV_P = 35651584, OUT_CONV_S = 35663872, OUT_LRU_P = 35860480, OUT_LRU_S = 35864576, OUT_SHIFT_P = 35930112, OUT_SHIFT_S = 35950592,
    OUT_WKV_P = 36278272, OUT_WKV_S = 36540416, OUT_SSM_P = 40734720, OUT_SSM_S = 40767488, OUT_TOTAL = 41291776;

constexpr size_t MiB = 1u << 20;
constexpr size_t WS_CTL = 0, CTL_ZERO_BYTES = 1 * MiB;
constexpr size_t WS_WIN = 1 * MiB;
constexpr size_t WS_WOUT = WS_WIN + (size_t)2 * DIN * DM * 2;
constexpr size_t WS_H = WS_WOUT + (size_t)2 * DM * DM * 2;
constexpr size_t WS_PROJ = WS_H + (size_t)MTOK * DM * 2;
constexpr size_t WS_QB = WS_PROJ + (size_t)MTOK * DIN * 4;
constexpr size_t WS_KB = WS_QB + (size_t)NP * 256 * 2;
constexpr size_t WS_VT = WS_KB + (size_t)NP * 256 * 2;
constexpr size_t WS_LA = WS_VT + (size_t)NP * 256 * 2;
constexpr size_t WS_LB = WS_LA + (size_t)MTOK * 256 * 4;
constexpr size_t WS_LP = WS_LB + (size_t)MTOK * 256 * 4;
constexpr size_t WS_LE = WS_LP + (size_t)8 * 32 * 256 * 4;
constexpr size_t WS_RW = WS_LE + (size_t)8 * 32 * 256 * 4;
constexpr size_t WS_BON = WS_RW + (size_t)MTOK * 1536 * 4;
constexpr size_t WS_S5E = WS_BON + (size_t)MTOK * 4 * 4;
constexpr size_t WS_OMIX = WS_S5E + (size_t)8 * 16 * 16 * 64 * 2 * 4;
constexpr size_t WS_OB = WS_OMIX + (size_t)MTOK * DM * 4;
constexpr size_t WS_PART = WS_OB + (size_t)MTOK * DM * 2;
constexpr size_t WS_YP = WS_PART + (size_t)DB * 4 * NSPLIT * PART_FLOATS * 4;
constexpr size_t WS_X1 = WS_YP + (size_t)MTOK * DM * 4;
constexpr size_t WS_END = WS_X1 + (size_t)MTOK * DM * 4;
static_assert(WS_H % 256 == 0 && WS_PROJ % 256 == 0 && WS_QB % 256 == 0 && WS_VT % 256 == 0 && WS_RW % 256 == 0 && WS_OMIX % 256 == 0 && WS_PART % 256 == 0 && WS_YP % 256 == 0, "ws align");

constexpr int CW_BAR = 4096;
constexpr int CW_QUEUE = 8192;

constexpr int LDS_BYTES = 147456;
constexpr int MISC_OFF = 147456 - 256;

#define XB_TMO      128
#define XB_XCNT(j)  (256  + 64 * (j))
#define XB_XSUB(j)  (1280 + 64 * (j))
#define XB_XGEN(j)  (2304 + 64 * (j))
#define XB_TOP      3328
#define XB_TOPGEN   3392
#define XCD_BAR_WORDS 3456
#define XB_SPIN_CAP (1u << 18)

__device__ __forceinline__ unsigned xb_ld(unsigned* p)              { return __hip_atomic_load(p, __ATOMIC_RELAXED, __HIP_MEMORY_SCOPE_AGENT); }
__device__ __forceinline__ unsigned xb_add(unsigned* p, unsigned v) { return __hip_atomic_fetch_add(p, v, __ATOMIC_RELAXED, __HIP_MEMORY_SCOPE_AGENT); }
__device__ __forceinline__ unsigned xb_xcc_id() { return (unsigned)__builtin_amdgcn_s_getreg((3 << 11) | 20) & 0xFu; }
#define XB_SPIN(cond, bar) do { unsigned _sp = 0; while (cond) { __builtin_amdgcn_s_sleep(1); \
    if ((++_sp & 255u) == 0u) { if (xb_ld(&(bar)[XB_TMO])) break; if (_sp > XB_SPIN_CAP) { atomicAdd(&(bar)[XB_TMO], 1u); break; } } } } while (0)

struct XcdBarrier { unsigned* bar; unsigned x; volatile LAS unsigned* st; };

__device__ __forceinline__ XcdBarrier xcd_barrier_post(unsigned* bar, volatile LAS unsigned* st) {
    XcdBarrier b; b.bar = bar; b.x = xb_xcc_id(); b.st = st;
    if (threadIdx.x == 0) (void)xb_add(&bar[XB_XCNT(b.x)], 1u);
    return b;
}
__device__ __forceinline__ void xcd_barrier_complete(unsigned* bar, unsigned x, unsigned& nloc, unsigned& nx) {
    const unsigned G = gridDim.x * gridDim.y * gridDim.z;
    unsigned sum, cnt, mine, sp = 0u;
    for (;;) {
        sum = 0u; cnt = 0u; mine = 0u;
#pragma unroll
        for (unsigned j = 0; j < 16; ++j) { const unsigned c = xb_ld(&bar[XB_XCNT(j)]); sum += c; cnt += (c > 0u) ? 1u : 0u; mine = (j == x) ? c : mine; }
        if (sum == G) break;
        __builtin_amdgcn_s_sleep(1);
        if ((++sp & 255u) == 0u) { if (xb_ld(&bar[XB_TMO])) break; if (sp > XB_SPIN_CAP) { atomicAdd(&bar[XB_TMO], 1u); break; } }
    }
    nloc = mine > 0u ? mine : 1u; nx = cnt > 0u ? cnt : 1u;
}
__device__ __forceinline__ void xcd_barrier(const XcdBarrier& b) {
    asm volatile("s_waitcnt vmcnt(0)" ::: "memory");
    __syncthreads();
    if (threadIdx.x == 0) {
        unsigned* bar = b.bar;
        __builtin_amdgcn_s_waitcnt(0);
        unsigned nloc = b.st[0], nx = b.st[1];
        if (nloc == 0u) { xcd_barrier_complete(bar, b.x, nloc, nx); b.st[0] = nloc; b.st[1] = nx; }
        const unsigned old = xb_add(&bar[XB_XSUB(b.x)], 1u);
        const unsigned gen = old / nloc;
        if (old + 1u == (gen + 1u) * nloc) {
            __builtin_amdgcn_fence(__ATOMIC_RELEASE, "agent");
            asm volatile("s_waitcnt vmcnt(0)" ::: "memory");
            const unsigned og = xb_add(&bar[XB_TOP], 1u);
            const unsigned tg = og / nx;
            if (og + 1u == (tg + 1u) * nx) xb_add(&bar[XB_TOPGEN], 1u);
            else XB_SPIN(xb_ld(&bar[XB_TOPGEN]) == tg, bar);
            __builtin_amdgcn_fence(__ATOMIC_ACQUIRE, "agent");
            xb_add(&bar[XB_XGEN(b.x)], 1u);
            asm volatile("s_waitcnt vmcnt(0)" ::: "memory");
        } else {
            XB_SPIN(xb_ld(&bar[XB_XGEN(b.x)]) == gen, bar);
            __builtin_amdgcn_fence(__ATOMIC_ACQUIRE, "agent");
            asm volatile("s_waitcnt vmcnt(0)" ::: "memory");
        }
    }
    __syncthreads();
}

enum InIdx { I_XP = 0, I_XS, I_CK, I_CV, I_PT, I_SCONV, I_SLRU, I_SSHIFT, I_SWKV, I_SSSM, I_NPRE, I_NPOST, I_WIN, I_WOUT, I_LQ1, I_LK1, I_LQ2, I_LK2, I_SUBLN,
             I_CONVW, I_CONVB, I_LWA, I_LBA, I_LWX, I_LBX, I_LLAM, I_MU, I_W0, I_W1, I_W2, I_A0, I_A1, I_A2, I_KK, I_KA, I_RK, I_GNW, I_GNB,
             I_LRE, I_LIM, I_LOGDT, I_BRE, I_BIM, I_CRE, I_CIM, I_S5D, I_WGLU, I_BGLU, N_IN };
struct Args { const float* in[N_IN]; float* out; unsigned char* ws; int ph_lo, ph_hi; };
static_assert(sizeof(Args) == (N_IN + 2) * 8 + 8, "Args has no padding");

#define OPAQUE(x) asm volatile("" : "+v"(x))
__device__ __forceinline__ float wave_sum(float v) {
#pragma unroll
    for (int o = 1; o < 64; o <<= 1) v += __shfl_xor(v, o);
    return v;
}
__device__ __forceinline__ unsigned f2bf(float f) { unsigned u = __builtin_bit_cast(unsigned, f); return (u + 0x7fffu + ((u >> 16) & 1u)) >> 16; }
__device__ __forceinline__ unsigned pk2(float lo, float hi) { return f2bf(lo) | (f2bf(hi) << 16); }
__device__ __forceinline__ float sigmoidf_(float x) { return 1.0f / (1.0f + __expf(-x)); }
__device__ __forceinline__ float softplusf_(float x) { return fmaxf(x, 0.f) + log1pf(__expf(-fabsf(x))); }
__device__ __forceinline__ float lam_init_of(int l) { return l == 0 ? 0.2f : 0.35550907f; }
__device__ __forceinline__ float compute_lam(const Args& a, int l, int lane) {
    float v1 = 0.f, v2 = 0.f;
    if (lane < 32) { v1 = a.in[I_LQ1][l * 32 + lane] * a.in[I_LK1][l * 32 + lane]; v2 = a.in[I_LQ2][l * 32 + lane] * a.in[I_LK2][l * 32 + lane]; }
    v1 = wave_sum(v1); v2 = wave_sum(v2);
    return expf(v1) - expf(v2) + lam_init_of(l);
}

__device__ __forceinline__ void p0_transpose_item(const float* W, int K, int N, bf16* WT, LAS float* scr, int item, int lane) {
    const int nblk = N / 32, kb = item / nblk, nb = item % nblk, k0 = 64 * kb, n0 = 32 * nb;
#pragma unroll 8
    for (int i = 0; i < 32; ++i) { const int kk = 2 * i + (lane >> 5); scr[kk * 33 + (lane & 31)] = W[(size_t)(k0 + kk) * N + n0 + (lane & 31)]; }
    asm volatile("s_waitcnt lgkmcnt(0)" ::: "memory");
    const int c = lane & 7;
#pragma unroll
    for (int j = 0; j < 4; ++j) { const int n = (lane >> 3) + 8 * j; const LAS float* s = scr + (8 * c) * 33 + n;
        u32x4 o; o.x = pk2(s[0 * 33], s[1 * 33]); o.y = pk2(s[2 * 33], s[3 * 33]); o.z = pk2(s[4 * 33], s[5 * 33]); o.w = pk2(s[6 * 33], s[7 * 33]);
        *(u32x4*)(WT + (size_t)(n0 + n) * K + k0 + 8 * c) = o; }
    asm volatile("s_waitcnt lgkmcnt(0)" ::: "memory");
}
__device__ __forceinline__ void rms_row_to_bf16(const float* xrow, const float* g, bf16* orow, int lane) {
    const f32x4* xr = (const f32x4*)xrow + lane; const f32x4* gr = (const f32x4*)g + lane;
    f32x4 v[4]; float s = 0.f;
#pragma unroll
    for (int j = 0; j < 4; ++j) { v[j] = xr[64 * j]; s += (v[j].x * v[j].x + v[j].y * v[j].y) + (v[j].z * v[j].z + v[j].w * v[j].w); }
    const float r = rsqrtf(wave_sum(s) * (1.f / DM) + NORM_EPS);
    u32x2* o8 = (u32x2*)orow + lane;
#pragma unroll
    for (int j = 0; j < 4; ++j) { const f32x4 gg = gr[64 * j]; u32x2 o; o.x = pk2(v[j].x * r * gg.x, v[j].y * r * gg.y); o.y = pk2(v[j].z * r * gg.z, v[j].w * r * gg.w); o8[64 * j] = o; }
}
__device__ __forceinline__ void ph_prologue(const Args& a, LAS unsigned char* lds, int lane, int wave) {
    OPAQUE(lane);
    LAS float* scr = (LAS float*)(lds + wave * 16384);
    const int gw = blockIdx.x * NWAVES + wave, NGW = gridDim.x * NWAVES;
    constexpr int I_IN = (DM / 64) * (DIN / 32), I_OUT = (DM / 64) * (DM / 32), I_L = I_IN + I_OUT;
    for (int it = gw; it < 2 * I_L; it += NGW) {
        const int l = it / I_L, r = it % I_L;
        if (r < I_IN) p0_transpose_item(a.in[I_WIN] + (size_t)l * DM * DIN, DM, DIN, (bf16*)(a.ws + WS_WIN) + (size_t)l * DIN * DM, scr, r, lane);
        else p0_transpose_item(a.in[I_WOUT] + (size_t)l * DM * DM, DM, DM, (bf16*)(a.ws + WS_WOUT) + (size_t)l * DM * DM, scr, r - I_IN, lane);
    }
    bf16* H = (bf16*)(a.ws + WS_H);
    for (int m = gw; m < MTOK; m += NGW) {
        const float* row = m < NP ? a.in[I_XP] + (size_t)m * DM : a.in[I_XS] + (size_t)(m - NP) * DM;
        rms_row_to_bf16(row, a.in[I_NPRE], H + (size_t)m * DM, lane);
    }
}

struct EpiProj {
    static constexpr bool PERM = false, AFTER_DRAIN = false;
    float* P; float* out; int layer;
    __device__ __forceinline__ void operator()(const pg8::f32x4 (&acc)[2][2][4][2], const pg8::Unit& u, int wr, int wc, int fr, int fq) const {
        const int row0 = u.pm * 256 + wr * 64 + fr, col0 = u.pn * 256 + wc * 32 + 4 * fq;
#pragma unroll
        for (int ai = 0; ai < 2; ++ai)
#pragma unroll
            for (int m = 0; m < 4; ++m) { float* rowp = P + (size_t)(row0 + ai * 128 + m * 16) * DIN + col0;
#pragma unroll
                for (int bj = 0; bj < 2; ++bj)
#pragma unroll
                    for (int n = 0; n < 2; ++n) *(pg8::f32x4*)(rowp + bj * 128 + n * 16) = acc[ai][bj][m][n]; }
        if (u.pn == 1 || u.pn == 2) {
            const bool smp = (u.pm >= 64);
            float* base;
            if (u.pn == 1) base = smp ? out + OUT_K_S + (size_t)layer * NSMP * 256 : out + OUT_K_P + (size_t)layer * NP * 256;
            else           base = smp ? out + OUT_V_S + (size_t)layer * NSMP * 256 : out + OUT_V_P + (size_t)layer * NP * 256;
            const int r0 = row0 - (smp ? NP : 0), c0 = wc * 32 + 4 * fq;
#pragma unroll
            for (int ai = 0; ai < 2; ++ai)
#pragma unroll
                for (int m = 0; m < 4; ++m) { float* rowp = base + (size_t)(r0 + ai * 128 + m * 16) * 256 + c0;
#pragma unroll
                    for (int bj = 0; bj < 2; ++bj)
#pragma unroll
                        for (int n = 0; n < 2; ++n) *(pg8::f32x4*)(rowp + bj * 128 + n * 16) = acc[ai][bj][m][n]; }
        }
    }
};
struct EpiPlain {
    static constexpr bool PERM = false, AFTER_DRAIN = false;
    float* C; int ldc;
    __device__ __forceinline__ void operator()(const pg8::f32x4 (&acc)[2][2][4][2], const pg8::Unit& u, int wr, int wc, int fr, int fq) const {
        const int row0 = u.pm * 256 + wr * 64 + fr, col0 = u.pn * 256 + wc * 32 + 4 * fq;
#pragma unroll
        for (int ai = 0; ai < 2; ++ai)
#pragma unroll
            for (int m = 0; m < 4; ++m) { float* rowp = C + (size_t)(row0 + ai * 128 + m * 16) * ldc + col0;
#pragma unroll
                for (int bj = 0; bj < 2; ++bj)
#pragma unroll
                    for (int n = 0; n < 2; ++n) *(pg8::f32x4*)(rowp + bj * 128 + n * 16) = acc[ai][bj][m][n]; }
    }
};

__device__ __forceinline__ void lru_prep_item(const Args& a, int l, int item, LAS unsigned char* lds, int tid) {
    OPAQUE(tid);
    const float* PROJ = (const float*)(a.ws + WS_PROJ);
    float* LA = (float*)(a.ws + WS_LA); float* LB = (float*)(a.ws + WS_LB);
    LAS float* X = (LAS float*)lds;
    LAS float* XC = (LAS float*)(lds + 68608);
    const bool smp = item >= 256;
    int nseg, seglen, m0, s = 0, ch = 0, b0 = 0;
    if (!smp) { s = item >> 5; ch = item & 31; nseg = 1; seglen = 64; m0 = s * SEQ + ch * 64; }
    else { const int j = item - 256; nseg = 4; seglen = 8; m0 = NP + j * 32; b0 = j * 4; }
    const int rps = seglen + 3, L = nseg * seglen;
    for (int idx = tid; idx < nseg * rps * 64; idx += NTHREADS) {
        const int row = idx >> 6, c4 = idx & 63, seg = row / rps, i = row % rps;
        f32x4 v = (f32x4){0.f, 0.f, 0.f, 0.f};
        if (smp) { if (i >= 3) v = *(const f32x4*)(PROJ + (size_t)(m0 + seg * 8 + i - 3) * DIN + OFF_B + 4 * c4);
                   else v = *(const f32x4*)(a.in[I_SCONV] + ((size_t)(l * DB + b0 + seg) * 3 + i) * 256 + 4 * c4); }
        else { if (ch > 0 || i >= 3) v = *(const f32x4*)(PROJ + (size_t)(m0 + i - 3) * DIN + OFF_B + 4 * c4); }
        *(LAS f32x4*)(X + row * 256 + 4 * c4) = v;
    }
    __syncthreads();
    if (smp || ch == 31) {
        for (int idx = tid; idx < nseg * 3 * 256; idx += NTHREADS) {
            const int seg = idx / 768, j = (idx % 768) >> 8, c = idx & 255;
            const float v = X[(seg * rps + seglen + j) * 256 + c];
            if (smp) a.out[OUT_CONV_S + ((size_t)(l * DB + b0 + seg) * 3 + j) * 256 + c] = v;
            else a.out[OUT_CONV_P + ((size_t)(l * 8 + s) * 3 + j) * 256 + c] = v;
        }
    }
    {
        const float* cw = a.in[I_CONVW] + l * 1024; const float* cb = a.in[I_CONVB] + l * 256;
        for (int idx = tid; idx < L * 256; idx += NTHREADS) {
            const int t = idx >> 8, c = idx & 255, seg = t / seglen, i = t % seglen;
            const LAS float* bp = X + (seg * rps + i) * 256 + c;
            XC[t * 256 + c] = cb[c] + cw[c] * bp[0] + cw[256 + c] * bp[256] + cw[512 + c] * bp[512] + cw[768 + c] * bp[768];
        }
    }
    __syncthreads();
    {
        const int p = tid >> 8, o = tid & 255, n = o >> 6, d = o & 63;
        float wg[64];
        const float* wp = (p ? a.in[I_LWX] : a.in[I_LWA]) + ((size_t)(l * 4 + n) * 64) * 64 + d;
#pragma unroll
        for (int c = 0; c < 64; ++c) wg[c] = wp[c * 64];
        const float bias = (p ? a.in[I_LBX] : a.in[I_LBA])[l * 256 + o];
        LAS float* GX = X;
        const int LH = L >> 1;
        for (int hf = 0; hf < 2; ++hf) {
            for (int t = 0; t < LH; ++t) {
                const LAS float* xr = XC + (hf * LH + t) * 256 + n * 64;
                float r0 = bias, r1 = 0.f;
#pragma unroll
                for (int c4 = 0; c4 < 16; ++c4) { const f32x4 xv = *(const LAS f32x4*)(xr + 4 * c4);
                    r0 += xv.x * wg[4 * c4] + xv.y * wg[4 * c4 + 1]; r1 += xv.z * wg[4 * c4 + 2] + xv.w * wg[4 * c4 + 3]; }
                GX[(p * 32 + t) * 256 + o] = sigmoidf_(r0 + r1);
            }
            __syncthreads();
            for (int idx = tid; idx < LH * 256; idx += NTHREADS) {
                const int t = idx >> 8, oo = idx & 255;
                const float r = GX[t * 256 + oo], g = GX[(32 + t) * 256 + oo];
                const float spv = softplusf_(-a.in[I_LLAM][l * 256 + oo]);
                const float log_a = -8.0f * r * spv;
                const float av = expf(log_a);
                const float mult = sqrtf(-expm1f(2.0f * log_a));
                const float bv = mult * g * XC[(hf * LH + t) * 256 + oo];
                LA[(size_t)(m0 + hf * LH + t) * 256 + oo] = av; LB[(size_t)(m0 + hf * LH + t) * 256 + oo] = bv;
            }
            __syncthreads();
        }
    }
    __syncthreads();
    if (tid < 256) {
        const int o = tid;
        float* OMIX = (float*)(a.ws + WS_OMIX);
        for (int seg = 0; seg < nseg; ++seg) {
            float h = smp ? a.in[I_SLRU][(size_t)(l * DB + b0 + seg) * 256 + o] : 0.f, P = 1.f;
            for (int i = 0; i < seglen; ++i) { const size_t m = (size_t)(m0 + seg * seglen + i);
                const float av = LA[m * 256 + o], bv = LB[m * 256 + o];
                h = av * h + bv; P *= av;
                if (smp) OMIX[m * DM + 256 + o] = h; }
            if (smp) a.out[OUT_LRU_S + (size_t)(l * DB + b0 + seg) * 256 + o] = h;
            else { ((float*)(a.ws + WS_LP))[(size_t)(s * 32 + ch) * 256 + o] = P; ((float*)(a.ws + WS_LE))[(size_t)(s * 32 + ch) * 256 + o] = h; }
        }
    }
    __syncthreads();
}

__device__ __forceinline__ float rw_xm(const Args& a, const float* PROJ, int l, int m, int col) {
    const float p = PROJ[(size_t)m * DIN + OFF_C + col];
    float pp;
    if (m < NP) pp = (m & (SEQ - 1)) ? PROJ[(size_t)(m - 1) * DIN + OFF_C + col] : 0.f;
    else { const int q = m - NP; pp = (q & 7) ? PROJ[(size_t)(m - 1) * DIN + OFF_C + col] : a.in[I_SSHIFT][(size_t)(l * DB + (q >> 3)) * 1280 + col]; }
    return p + (pp - p) * a.in[I_MU][l * 1280 + col];
}
__device__ __forceinline__ void rwkv_prep_item(const Args& a, int l, int item, LAS unsigned char* lds, int tid) {
    OPAQUE(tid);
    const float* PROJ = (const float*)(a.ws + WS_PROJ);
    float* RW = (float*)(a.ws + WS_RW); float* BON = (float*)(a.ws + WS_BON);
    LAS float* XWA = (LAS float*)lds;
    LAS float* T1 = (LAS float*)(lds + 65536);
    const int m0 = item * 32;
    for (int idx = tid; idx < 32 * 512; idx += NTHREADS) {
        const int t = idx >> 9, c = idx & 511;
        const int col = c < 256 ? 256 + c : 1024 + (c - 256);
        XWA[idx] = rw_xm(a, PROJ, l, m0 + t, col);
    }
    __syncthreads();
    {
        const int jj = tid & 63, tg = tid >> 6, j = jj & 31;
        const float* W = (jj < 32 ? a.in[I_W1] : a.in[I_A1]) + (size_t)l * 256 * 32 + j;
        const LAS float* xb = XWA + (tg * 4) * 512 + (jj < 32 ? 0 : 256);
        float acc[4] = {0.f, 0.f, 0.f, 0.f};
#pragma unroll 8
        for (int c = 0; c < 256; ++c) { const float wv = W[c * 32];
#pragma unroll
            for (int k = 0; k < 4; ++k) acc[k] += xb[k * 512 + c] * wv; }
#pragma unroll
        for (int k = 0; k < 4; ++k) T1[(tg * 4 + k) * 64 + jj] = (jj < 32) ? tanhf(acc[k]) : acc[k];
    }
    __syncthreads();
    {
        const int o = tid & 255, half = tid >> 8, hd = o >> 6;
        float wr[32];
        const float* w2p = (half ? a.in[I_A2] : a.in[I_W2]) + (size_t)l * 32 * 256 + o;
#pragma unroll
        for (int j = 0; j < 32; ++j) wr[j] = w2p[(size_t)j * 256];
        const float b0 = (half ? a.in[I_A0] : a.in[I_W0])[l * 256 + o];
        const float kkw = a.in[I_KK][l * 256 + o], kaw = a.in[I_KA][l * 256 + o], rk = a.in[I_RK][l * 256 + o];
        for (int t = 0; t < 32; ++t) {
            float z0 = b0, z1 = 0.f;
            const LAS float* tp = T1 + t * 64 + half * 32;
#pragma unroll
            for (int j4 = 0; j4 < 8; ++j4) { const f32x4 tv = *(const LAS f32x4*)(tp + 4 * j4);
                z0 += tv.x * wr[4 * j4] + tv.y * wr[4 * j4 + 1]; z1 += tv.z * wr[4 * j4 + 2] + tv.w * wr[4 * j4 + 3]; }
            const float z = z0 + z1;
            const int m = m0 + t;
            float* rwp = RW + (size_t)m * 1536 + o;
            if (half == 0) {
                const float w = -softplusf_(-z) - 0.5f;
                rwp[256] = expf(-expf(w));
                rwp[0] = rw_xm(a, PROJ, l, m, o);
                rwp[768] = rw_xm(a, PROJ, l, m, 768 + o);
            } else {
                const float aa = sigmoidf_(z);
                const float xr = rw_xm(a, PROJ, l, m, o), xk = rw_xm(a, PROJ, l, m, 512 + o);
                const float kkv = xk * kkw;
                const float ss = wave_sum(kkv * kkv);
                const float kkn = kkv / fmaxf(sqrtf(ss), 1e-12f);
                const float kv = xk * (1.0f + (aa - 1.0f) * kaw);
                const float bon = wave_sum(xr * kv * rk);
                rwp[512] = kv; rwp[1024] = -kkn; rwp[1280] = kkn * aa;
                if ((o & 63) == 0) BON[(size_t)m * 4 + hd] = bon;
            }
        }
    }
    __syncthreads();
}

struct S5Par { float ab_re, ab_im; float bb_re[16], bb_im[16]; };
__device__ __forceinline__ void s5_params(const Args& a, int l, int g, int n, S5Par& P) {
    const float lr = a.in[I_LRE][(l * 16 + g) * 64 + n], li = a.in[I_LIM][(l * 16 + g) * 64 + n];
    const float dt = expf(a.in[I_LOGDT][l * 16 + g]);
    const float mag = expf(lr * dt);
    P.ab_re = mag * cosf(li * dt); P.ab_im = mag * sinf(li * dt);
    const float den = lr * lr + li * li, pr = P.ab_re - 1.0f;
    const float f_re = (pr * lr + P.ab_im * li) / den, f_im = (P.ab_im * lr - pr * li) / den;
    const f32x4* br = (const f32x4*)(a.in[I_BRE] + ((size_t)(l * 16 + g) * 64 + n) * 16); const f32x4* bi = (const f32x4*)(a.in[I_BIM] + ((size_t)(l * 16 + g) * 64 + n) * 16);
#pragma unroll
    for (int c4 = 0; c4 < 4; ++c4) { const f32x4 r = br[c4], i = bi[c4];
#pragma unroll
        for (int e = 0; e < 4; ++e) { P.bb_re[4 * c4 + e] = f_re * r[e] - f_im * i[e]; P.bb_im[4 * c4 + e] = f_re * i[e] + f_im * r[e]; } }
}
__device__ __forceinline__ void s5_step(const S5Par& P, const float* urow, float& hr, float& hi) {
    float br = 0.f, bi = 0.f;
#pragma unroll
    for (int c4 = 0; c4 < 4; ++c4) { const f32x4 u = *(const f32x4*)(urow + 4 * c4);
#pragma unroll
        for (int e = 0; e < 4; ++e) { br += u[e] * P.bb_re[4 * c4 + e]; bi += u[e] * P.bb_im[4 * c4 + e]; } }
    const float nr = P.ab_re * hr - P.ab_im * hi + br, ni = P.ab_re * hi + P.ab_im * hr + bi;
    hr = nr; hi = ni;
}
__device__ __forceinline__ void s5_pass1_wave(const Args& a, int l, int wi, int lane) {
    OPAQUE(lane);
    const int ck = wi & 15, g = (wi >> 4) & 15, s = wi >> 8;
    const float* PROJ = (const float*)(a.ws + WS_PROJ);
    S5Par P; s5_params(a, l, g, lane, P);
    float hr = 0.f, hi = 0.f;
    const float* up = PROJ + (size_t)(s * SEQ + ck * 128) * DIN + OFF_D + g * 16;
    for (int t = 0; t < 128; ++t) s5_step(P, up + (size_t)t * DIN, hr, hi);
    f32x2* E = (f32x2*)(a.ws + WS_S5E);
    E[((size_t)(s * 16 + g) * 16 + ck) * 64 + lane] = (f32x2){hr, hi};
}

__device__ __forceinline__ void attn_prep_rows_wave(const Args& a, int wi, int lane) {
    OPAQUE(lane);
    const float* PROJ = (const float*)(a.ws + WS_PROJ);
    bf16* QB = (bf16*)(a.ws + WS_QB); bf16* KB = (bf16*)(a.ws + WS_KB);
#pragma unroll
    for (int r = 0; r < 8; ++r) { const size_t m = (size_t)wi * 8 + r;
        const f32x4 q = *(const f32x4*)(PROJ + m * DIN + OFF_AQ + 4 * lane), k = *(const f32x4*)(PROJ + m * DIN + OFF_AK + 4 * lane);
        u32x2 qo, ko; qo.x = pk2(q.x * QSCALE, q.y * QSCALE); qo.y = pk2(q.z * QSCALE, q.w * QSCALE); ko.x = pk2(k.x, k.y); ko.y = pk2(k.z, k.w);
        *(u32x2*)(QB + m * 256 + 4 * lane) = qo; *(u32x2*)(KB + m * 256 + 4 * lane) = ko; }
}
__device__ __forceinline__ void attn_prep_vt_wave(const Args& a, int wi, int lane) {
    OPAQUE(lane);
    const float* PROJ = (const float*)(a.ws + WS_PROJ);
    bf16* VT = (bf16*)(a.ws + WS_VT);
    const int tt = wi & 31, h = (wi >> 5) & 3, b = wi >> 7;
    const int t = tt * 64 + lane;
    const f32x4* src = (const f32x4*)(PROJ + (size_t)(b * SEQ + t) * DIN + OFF_AV + h * 64);
    bf16* dst = VT + (size_t)((b * 4 + h) * 64) * SEQ + t;
#pragma unroll
    for (int d4 = 0; d4 < 16; ++d4) { const f32x4 v = src[d4];
        dst[(size_t)(4 * d4 + 0) * SEQ] = (bf16)f2bf(v.x); dst[(size_t)(4 * d4 + 1) * SEQ] = (bf16)f2bf(v.y);
        dst[(size_t)(4 * d4 + 2) * SEQ] = (bf16)f2bf(v.z); dst[(size_t)(4 * d4 + 3) * SEQ] = (bf16)f2bf(v.w); }
}

#ifndef MP_MASK
#define MP_MASK 0x1f
#endif
#ifndef MM_MASK
#define MM_MASK 0x7f
#endif
#define MPE(j) ((MP_MASK >> (j)) & 1)
#define MME(j) ((MM_MASK >> (j)) & 1)
constexpr int MP_LRU = 256 + 32, MP_RW = MTOK / 32, MP_S5 = 256  , MP_AR = 256  , MP_VT = 128  ;
constexpr int MP_TOTAL = MP_LRU + MP_RW + MP_S5 + MP_AR + MP_VT;
__device__ __forceinline__ void ph_mixprep(const Args& a, int l, LAS unsigned char* lds, int tid, int lane, int wave) {
    for (int it = blockIdx.x; it < MP_TOTAL; it += gridDim.x) {
        int r = it;
        if (r < MP_LRU) { if (MPE(0)) lru_prep_item(a, l, r, lds, tid); continue; } r -= MP_LRU;
        if (r < MP_RW) { if (MPE(1)) rwkv_prep_item(a, l, r, lds, tid); continue; } r -= MP_RW;
        if (r < MP_S5) { if (MPE(2)) s5_pass1_wave(a, l, r * 8 + wave, lane); continue; } r -= MP_S5;
        if (r < MP_AR) { if (MPE(3)) attn_prep_rows_wave(a, r * 8 + wave, lane); continue; } r -= MP_AR;
        if (MPE(4)) attn_prep_vt_wave(a, r * 8 + wave, lane);
    }
    {
        const float* PROJ = (const float*)(a.ws + WS_PROJ);
        const int gt = blockIdx.x * NTHREADS + tid, NGT = gridDim.x * NTHREADS;
        for (int idx = gt; idx < 136 * 1280; idx += NGT) {
            const int q = idx / 1280, c = idx % 1280;
            if (q < 8) a.out[OUT_SHIFT_P + (size_t)(l * 8 + q) * 1280 + c] = PROJ[(size_t)(q * SEQ + SEQ - 1) * DIN + OFF_C + c];
            else a.out[OUT_SHIFT_S + (size_t)(l * DB + (q - 8)) * 1280 + c] = PROJ[(size_t)(NP + (q - 8) * 8 + 7) * DIN + OFF_C + c];
        }
    }
}

__device__ __forceinline__ void rwkv_scan_unit(const Args& a, int l, bool smp, int sq, int h, LAS unsigned char* lds, int tid) {
    OPAQUE(tid);
    const float* RW = (const float*)(a.ws + WS_RW); const float* BON = (const float*)(a.ws + WS_BON);
    float* OMIX = (float*)(a.ws + WS_OMIX);
    LAS float* RWT = (LAS float*)lds;
    LAS float* Y = (LAS float*)(lds + 49152);
    const int T = smp ? DS : SEQ, TT = smp ? 8 : 32, mbase = smp ? NP + sq * DS : sq * SEQ;
    const int i = tid >> 3, jq = tid & 7;
    float S[8];
    if (smp) { const float* sp = a.in[I_SWKV] + (((size_t)(l * DB + sq) * 4 + h) * 64 + i) * 64 + 8 * jq;
        const f32x4 s0 = *(const f32x4*)sp, s1 = *(const f32x4*)(sp + 4);
        S[0] = s0.x; S[1] = s0.y; S[2] = s0.z; S[3] = s0.w; S[4] = s1.x; S[5] = s1.y; S[6] = s1.z; S[7] = s1.w; }
    else {
#pragma unroll
        for (int e = 0; e < 8; ++e) S[e] = 0.f; }
    const int nld = TT * 96 / NTHREADS;
    f32x4 pre[6];
#define RW_LOAD(tile) do { _Pragma("unroll") for (int k = 0; k < 6; ++k) { const int idx = tid + NTHREADS * k; \
        if (idx < TT * 96) { const int t = idx / 96, rem = idx % 96, sec = rem >> 4, c4 = rem & 15; \
            pre[k] = *(const f32x4*)(RW + (size_t)(mbase + (tile) * TT + t) * 1536 + sec * 256 + h * 64 + 4 * c4); } } } while (0)
#define RW_STORE() do { _Pragma("unroll") for (int k = 0; k < 6; ++k) { const int idx = tid + NTHREADS * k; \
        if (idx < TT * 96) *(LAS f32x4*)(RWT + idx * 4) = pre[k]; } } while (0)
    (void)nld;
    const int ntile = T / TT;
    RW_LOAD(0); RW_STORE();
    __syncthreads();
    for (int tile = 0; tile < ntile; ++tile) {
        if (tile + 1 < ntile) RW_LOAD(tile + 1);
        for (int t = 0; t < TT; ++t) {
            const LAS float* base = RWT + t * 384;
            const f32x4 r0 = *(const LAS f32x4*)(base + 0 + 8 * jq), r1 = *(const LAS f32x4*)(base + 4 + 8 * jq);
            const f32x4 w0 = *(const LAS f32x4*)(base + 64 + 8 * jq), w1 = *(const LAS f32x4*)(base + 68 + 8 * jq);
            const f32x4 k0 = *(const LAS f32x4*)(base + 128 + 8 * jq), k1 = *(const LAS f32x4*)(base + 132 + 8 * jq);
            const float vi = base[192 + i];
            const f32x4 a0 = *(const LAS f32x4*)(base + 256 + 8 * jq), a1 = *(const LAS f32x4*)(base + 260 + 8 * jq);
            const f32x4 b0 = *(const LAS f32x4*)(base + 320 + 8 * jq), b1 = *(const LAS f32x4*)(base + 324 + 8 * jq);
            float sa = (S[0] * a0.x + S[1] * a0.y) + (S[2] * a0.z + S[3] * a0.w) + (S[4] * a1.x + S[5] * a1.y) + (S[6] * a1.z + S[7] * a1.w);
            sa += __shfl_xor(sa, 1); sa += __shfl_xor(sa, 2); sa += __shfl_xor(sa, 4);
            S[0] = S[0] * w0.x + sa * b0.x + vi * k0.x; S[1] = S[1] * w0.y + sa * b0.y + vi * k0.y;
            S[2] = S[2] * w0.z + sa * b0.z + vi * k0.z; S[3] = S[3] * w0.w + sa * b0.w + vi * k0.w;
            S[4] = S[4] * w1.x + sa * b1.x + vi * k1.x; S[5] = S[5] * w1.y + sa * b1.y + vi * k1.y;
            S[6] = S[6] * w1.z + sa * b1.z + vi * k1.z; S[7] = S[7] * w1.w + sa * b1.w + vi * k1.w;
            float y = (S[0] * r0.x + S[1] * r0.y) + (S[2] * r0.z + S[3] * r0.w) + (S[4] * r1.x + S[5] * r1.y) + (S[6] * r1.z + S[7] * r1.w);
            y += __shfl_xor(y, 1); y += __shfl_xor(y, 2); y += __shfl_xor(y, 4);
            if (jq == 0) Y[t * 64 + i] = y;
        }
        __syncthreads();
        {
            const int t = tid >> 4, q = tid & 15;
            if (t < TT) {
                const f32x4 yv = *(const LAS f32x4*)(Y + t * 64 + 4 * q);
                float sm = (yv.x + yv.y) + (yv.z + yv.w);
                sm += __shfl_xor(sm, 1); sm += __shfl_xor(sm, 2); sm += __shfl_xor(sm, 4); sm += __shfl_xor(sm, 8);
                const float mean = sm * (1.f / 64.f);
                const f32x4 dv = yv - mean;
                float vs = (dv.x * dv.x + dv.y * dv.y) + (dv.z * dv.z + dv.w * dv.w);
                vs += __shfl_xor(vs, 1); vs += __shfl_xor(vs, 2); vs += __shfl_xor(vs, 4); vs += __shfl_xor(vs, 8);
                const float rs = rsqrtf(vs * (1.f / 64.f) + 64.0f * 1e-5f);
                const int m = mbase + tile * TT + t;
                const f32x4 gw = *(const f32x4*)(a.in[I_GNW] + l * 256 + h * 64 + 4 * q), gb = *(const f32x4*)(a.in[I_GNB] + l * 256 + h * 64 + 4 * q);
                const f32x4 vv = *(const LAS f32x4*)(RWT + t * 384 + 192 + 4 * q);
                const float bon = BON[(size_t)m * 4 + h];
                const f32x4 o = dv * rs * gw + gb + bon * vv;
                *(f32x4*)(OMIX + (size_t)m * DM + 512 + h * 64 + 4 * q) = o;
            }
        }
        __syncthreads();
        if (tile + 1 < ntile) { RW_STORE(); }
        __syncthreads();
    }
#undef RW_LOAD
#undef RW_STORE
    {
        float* dst = smp ? a.out + OUT_WKV_S + (((size_t)(l * DB + sq) * 4 + h) * 64 + i) * 64 + 8 * jq
                         : a.out + OUT_WKV_P + (((size_t)(l * 8 + sq) * 4 + h) * 64 + i) * 64 + 8 * jq;
        *(f32x4*)dst = (f32x4){S[0], S[1], S[2], S[3]}; *(f32x4*)(dst + 4) = (f32x4){S[4], S[5], S[6], S[7]};
    }
}

__device__ __forceinline__ void lru_pass2_wave(const Args& a, int l, int wi, int lane) {
    OPAQUE(lane);
    const int q = wi & 3, ch = (wi >> 2) & 31, s = wi >> 7;
    const int o = q * 64 + lane;
    const float* LA = (const float*)(a.ws + WS_LA); const float* LB = (const float*)(a.ws + WS_LB);
    const float* LP = (const float*)(a.ws + WS_LP); const float* LE = (const float*)(a.ws + WS_LE);
    float* OMIX = (float*)(a.ws + WS_OMIX);
    float h = 0.f;
    for (int c = 0; c < ch; ++c) h = LP[(size_t)(s * 32 + c) * 256 + o] * h + LE[(size_t)(s * 32 + c) * 256 + o];
    const size_t m0 = (size_t)s * SEQ + ch * 64;
#pragma unroll 8
    for (int i = 0; i < 64; ++i) { h = LA[(m0 + i) * 256 + o] * h + LB[(m0 + i) * 256 + o]; OMIX[(m0 + i) * DM + 256 + o] = h; }
    if (ch == 31) a.out[OUT_LRU_P + (size_t)(l * 8 + s) * 256 + o] = h;
}

__device__ __forceinline__ float gelu_tanh(float y) { return 0.5f * y * (1.0f + tanhf(0.7978845608028654f * (y + 0.044715f * y * y * y))); }
__device__ __forceinline__ void s5_pass2_wave(const Args& a, int l, bool smp, int wi, LAS unsigned char* wlds, int lane) {
    OPAQUE(lane);
    const float* PROJ = (const float*)(a.ws + WS_PROJ);
    float* OMIX = (float*)(a.ws + WS_OMIX);
    LAS float* HR = (LAS float*)wlds;
    LAS float* HI = HR + 32 * 68;
    int g, mbase, T, ck = 0, sq;
    if (smp) { g = wi & 15; sq = wi >> 4; mbase = NP + sq * DS; T = DS; }
    else { ck = wi & 15; g = (wi >> 4) & 15; sq = wi >> 8; mbase = sq * SEQ + ck * 128; T = 128; }
    S5Par P; s5_params(a, l, g, lane, P);
    float hr, hi;
    if (smp) { const f32x2 v = *(const f32x2*)(a.in[I_SSSM] + (((size_t)(l * DB + sq) * 16 + g) * 64 + lane) * 2); hr = v.x; hi = v.y; }
    else {
        float pr = P.ab_re, pi = P.ab_im;
#pragma unroll
        for (int k = 0; k < 7; ++k) { const float nr = pr * pr - pi * pi, ni = 2.0f * pr * pi; pr = nr; pi = ni; }
        hr = 0.f; hi = 0.f;
        const f32x2* E = (const f32x2*)(a.ws + WS_S5E) + ((size_t)(sq * 16 + g) * 16) * 64 + lane;
        for (int c = 0; c < ck; ++c) { const f32x2 e = E[(size_t)c * 64]; const float nr = pr * hr - pi * hi + e.x, ni = pr * hi + pi * hr + e.y; hr = nr; hi = ni; }
    }
    const int c = lane & 15, tq = lane >> 4;
    const float* crp = a.in[I_CRE] + ((size_t)(l * 16 + g) * 16 + c) * 64; const float* cip = a.in[I_CIM] + ((size_t)(l * 16 + g) * 16 + c) * 64;
    const float dd = a.in[I_S5D][l * 256 + g * 16 + c];
    for (int t0 = 0; t0 < T; t0 += 32) {
        const int nt = (T - t0) < 32 ? (T - t0) : 32;
        for (int t = 0; t < nt; ++t) {
            s5_step(P, PROJ + (size_t)(mbase + t0 + t) * DIN + OFF_D + g * 16, hr, hi);
            HR[t * 68 + lane] = hr; HI[t * 68 + lane] = hi;
        }
        asm volatile("s_waitcnt lgkmcnt(0)" ::: "memory");
        float acc[8];
#pragma unroll
        for (int i = 0; i < 8; ++i) acc[i] = 0.f;
        for (int n4 = 0; n4 < 16; ++n4) {
            const f32x4 cr = *(const f32x4*)(crp + 4 * n4), ci = *(const f32x4*)(cip + 4 * n4);
#pragma unroll
            for (int i = 0; i < 8; ++i) { const f32x4 h4 = *(const LAS f32x4*)(HR + (tq * 8 + i) * 68 + 4 * n4), g4 = *(const LAS f32x4*)(HI + (tq * 8 + i) * 68 + 4 * n4);
                acc[i] += (h4.x * cr.x + h4.y * cr.y) + (h4.z * cr.z + h4.w * cr.w) - ((g4.x * ci.x + g4.y * ci.y) + (g4.z * ci.z + g4.w * ci.w)); }
        }
#pragma unroll
        for (int i = 0; i < 8; ++i) { const int t = tq * 8 + i;
            if (t < nt) { const size_t m = (size_t)(mbase + t0 + t);
                const float u = PROJ[m * DIN + OFF_D + g * 16 + c];
                OMIX[m * DM + 768 + g * 16 + c] = gelu_tanh(acc[i] + dd * u); } }
        asm volatile("s_waitcnt lgkmcnt(0)" ::: "memory");
    }
    if (smp) *(f32x2*)(a.out + OUT_SSM_S + (((size_t)(l * DB + sq) * 16 + g) * 64 + lane) * 2) = (f32x2){hr, hi};
    else if (ck == 15) *(f32x2*)(a.out + OUT_SSM_P + (((size_t)(l * 8 + sq) * 16 + g) * 64 + lane) * 2) = (f32x2){hr, hi};
}

__device__ __forceinline__ bf16x8 pack8(const f32x16& p, int s) {
    u32x4 w; w.x = pk2(p[8 * s + 0], p[8 * s + 1]); w.y = pk2(p[8 * s + 2], p[8 * s + 3]); w.z = pk2(p[8 * s + 4], p[8 * s + 5]); w.w = pk2(p[8 * s + 6], p[8 * s + 7]);
    return __builtin_bit_cast(bf16x8, w);
}
__device__ __forceinline__ void attn_prompt_wave(const Args& a, int l, int b, int h, int qt, float lam, int lane) {
    OPAQUE(lane);
    const bf16* QB = (const bf16*)(a.ws + WS_QB); const bf16* KB = (const bf16*)(a.ws + WS_KB); const bf16* VT = (const bf16*)(a.ws + WS_VT);
    float* OMIX = (float*)(a.ws + WS_OMIX);
    const int r = lane & 31, hh = lane >> 5;
    const size_t mq = (size_t)b * SEQ + qt * 32 + r;
    bf16x8 qf[2][2];
#pragma unroll
    for (int c = 0; c < 2; ++c)
#pragma unroll
        for (int s = 0; s < 2; ++s) qf[c][s] = *(const bf16x8*)(QB + mq * 256 + h * 64 + c * 32 + 16 * s + 8 * hh);
    f32x16 o[2][2];
#pragma unroll
    for (int c = 0; c < 2; ++c)
#pragma unroll
        for (int tl = 0; tl < 2; ++tl)
#pragma unroll
            for (int e = 0; e < 16; ++e) o[c][tl][e] = 0.f;
    float mrun[2] = {-1e30f, -1e30f}, lrun[2] = {0.f, 0.f};
    const bf16* vbase = VT + (size_t)((b * 4 + h) * 64 + r) * SEQ + 4 * hh;
    for (int kt = 0; kt <= qt; ++kt) {
        const size_t mk = (size_t)b * SEQ + kt * 32 + r;
        bf16x8 kf[2][2];
#pragma unroll
        for (int c = 0; c < 2; ++c)
#pragma unroll
            for (int s = 0; s < 2; ++s) kf[c][s] = *(const bf16x8*)(KB + mk * 256 + h * 64 + c * 32 + 16 * s + 8 * hh);
        bf16x8 vf[2][2];
#pragma unroll
        for (int tl = 0; tl < 2; ++tl)
#pragma unroll
            for (int s = 0; s < 2; ++s) { const bf16* vp = vbase + (size_t)(32 * tl) * SEQ + kt * 32 + 16 * s;
                const u32x2 lo = *(const u32x2*)vp, hi = *(const u32x2*)(vp + 8);
                u32x4 w; w.x = lo.x; w.y = lo.y; w.z = hi.x; w.w = hi.y; vf[tl][s] = __builtin_bit_cast(bf16x8, w); }
        bf16x8 pf[2][2];
#pragma unroll
        for (int c = 0; c < 2; ++c) {
            f32x16 st;
#pragma unroll
            for (int e = 0; e < 16; ++e) st[e] = 0.f;
            st = __builtin_amdgcn_mfma_f32_32x32x16_bf16(kf[c][0], qf[c][0], st, 0, 0, 0);
            st = __builtin_amdgcn_mfma_f32_32x32x16_bf16(kf[c][1], qf[c][1], st, 0, 0, 0);
            if (kt == qt) {
#pragma unroll
                for (int e = 0; e < 16; ++e) { const int key = (e & 3) + 8 * (e >> 2) + 4 * hh; if (key > r) st[e] = -1e30f; }
            }
            float mx = st[0];
#pragma unroll
            for (int e = 1; e < 16; ++e) mx = fmaxf(mx, st[e]);
            mx = fmaxf(mx, __shfl_xor(mx, 32));
            const float mnew = fmaxf(mrun[c], mx);
            const float corr = exp2f(mrun[c] - mnew);
            float ps = 0.f;
#pragma unroll
            for (int e = 0; e < 16; ++e) { st[e] = exp2f(st[e] - mnew); ps += st[e]; }
            lrun[c] = lrun[c] * corr + ps; mrun[c] = mnew;
#pragma unroll
            for (int tl = 0; tl < 2; ++tl)
#pragma unroll
                for (int e = 0; e < 16; ++e) o[c][tl][e] *= corr;
            pf[c][0] = pack8(st, 0); pf[c][1] = pack8(st, 1);
        }
#pragma unroll
        for (int c = 0; c < 2; ++c)
#pragma unroll
            for (int tl = 0; tl < 2; ++tl) {
                o[c][tl] = __builtin_amdgcn_mfma_f32_32x32x16_bf16(vf[tl][0], pf[c][0], o[c][tl], 0, 0, 0);
                o[c][tl] = __builtin_amdgcn_mfma_f32_32x32x16_bf16(vf[tl][1], pf[c][1], o[c][tl], 0, 0, 0);
            }
    }
    const float l0 = lrun[0] + __shfl_xor(lrun[0], 32), l1 = lrun[1] + __shfl_xor(lrun[1], 32);
    const float i0 = 1.0f / l0, i1 = lam / l1;
    float ss = 0.f;
    f32x16 res[2];
#pragma unroll
    for (int tl = 0; tl < 2; ++tl)
#pragma unroll
        for (int e = 0; e < 16; ++e) { const float v = o[0][tl][e] * i0 - o[1][tl][e] * i1; res[tl][e] = v; ss += v * v; }
    ss += __shfl_xor(ss, 32);
    const float rs = rsqrtf(ss * (1.f / 64.f) + NORM_EPS) * (1.0f - lam_init_of(l));
    const float* sw = a.in[I_SUBLN] + l * 64;
#pragma unroll
    for (int tl = 0; tl < 2; ++tl)
#pragma unroll
        for (int g4 = 0; g4 < 4; ++g4) { const int vd = 32 * tl + 8 * g4 + 4 * hh;
            const f32x4 w4 = *(const f32x4*)(sw + vd);
            f32x4 ov; ov.x = res[tl][4 * g4 + 0] * rs * w4.x; ov.y = res[tl][4 * g4 + 1] * rs * w4.y; ov.z = res[tl][4 * g4 + 2] * rs * w4.z; ov.w = res[tl][4 * g4 + 3] * rs * w4.w;
            *(f32x4*)(OMIX + mq * DM + h * 64 + vd) = ov; }
}

__device__ __forceinline__ void attn_sample_wave(const Args& a, int l, int wi, int lane) {
    OPAQUE(lane);
    const int h = wi & 3, sp = (wi >> 2) % NSPLIT, b = (wi >> 2) / NSPLIT;
    const float* PROJ = (const float*)(a.ws + WS_PROJ);
    const int kk = lane >> 4, dq = lane & 15, g = lane & 7;
    f32x4 q[8];
#pragma unroll
    for (int i = 0; i < 8; ++i) { q[i] = *(const f32x4*)(PROJ + (size_t)(NP + b * 8 + i) * DIN + OFF_AQ + h * 64 + 4 * dq); q[i] *= QSCALE; }
    const bool isnew = (sp == NSPLIT - 1);
    const int nstep = isnew ? 2 : 16, nsub = isnew ? 1 : 4;
    const int qi = lane & 7;
    const int rowbase = lane & ~15;
    float M = -1e30f, Lsum = 0.f;
    f32x4 O[16];
#pragma unroll
    for (int j = 0; j < 16; ++j) O[j] = (f32x4){0.f, 0.f, 0.f, 0.f};
    for (int sub = 0; sub < nsub; ++sub) {
        const float* kp0; const float* vp0; size_t stepstride;
        if (isnew) { kp0 = PROJ + (size_t)(NP + b * 8 + kk) * DIN + OFF_AK + h * 64 + 4 * dq; vp0 = kp0 + (OFF_AV - OFF_AK); stepstride = (size_t)4 * DIN; }
        else { const int kg = sp * 256 + sub * 64 + kk; const int page = ((const int*)a.in[I_PT])[b * NPAGES + (kg >> 7)];
               const size_t off = ((((size_t)l * NPOOL + page) * 128 + (kg & 127)) * 4 + h) * 64 + 4 * dq;
               kp0 = a.in[I_CK] + off; vp0 = a.in[I_CV] + off; stepstride = (size_t)4 * 256; }
        float sc[16];
#pragma unroll
        for (int t = 0; t < 16; ++t) {
            if (t < nstep) {
                const f32x4 kv = *(const f32x4*)(kp0 + t * stepstride);
                float p[8];
#pragma unroll
                for (int i = 0; i < 8; ++i) p[i] = (kv.x * q[i].x + kv.y * q[i].y) + (kv.z * q[i].z + kv.w * q[i].w);
                float n4[4];
#pragma unroll
                for (int k = 0; k < 4; ++k) { const float keep = (g & 4) ? p[4 + k] : p[k], send = (g & 4) ? p[k] : p[4 + k]; n4[k] = keep + __shfl_xor(send, 4); }
                float n2[2];
#pragma unroll
                for (int k = 0; k < 2; ++k) { const float keep = (g & 2) ? n4[2 + k] : n4[k], send = (g & 2) ? n4[k] : n4[2 + k]; n2[k] = keep + __shfl_xor(send, 2); }
                const float keep = (g & 1) ? n2[1] : n2[0], send = (g & 1) ? n2[0] : n2[1];
                float sv = keep + __shfl_xor(send, 1);
                if (isnew && (4 * t + kk) > qi) sv = -1e30f;
                sc[t] = sv;
            } else sc[t] = -1e30f;
        }
        float mx = sc[0];
#pragma unroll
        for (int t = 1; t < 16; ++t) mx = fmaxf(mx, sc[t]);
        const float Mnew = fmaxf(M, mx);
        const float corr = exp2f(M - Mnew);
        float ps = 0.f;
#pragma unroll
        for (int t = 0; t < 16; ++t) { sc[t] = (t < nstep) ? exp2f(sc[t] - Mnew) : 0.f; ps += sc[t]; }
        Lsum = Lsum * corr + ps; M = Mnew;
        if (sub > 0) {
#pragma unroll
            for (int j = 0; j < 16; ++j) O[j] *= __shfl(corr, rowbase + j);
        }
        __builtin_amdgcn_sched_barrier(0);
#pragma unroll
        for (int t = 0; t < 16; ++t) {
            if (t < nstep) {
                const f32x4 vv = *(const f32x4*)(vp0 + t * stepstride);
#pragma unroll
                for (int j = 0; j < 16; ++j) { const float pj = __shfl(sc[t], rowbase + j); O[j] += pj * vv; }
            }
        }
        __builtin_amdgcn_sched_barrier(0);
    }
    float Mall = fmaxf(M, __shfl_xor(M, 16)); Mall = fmaxf(Mall, __shfl_xor(Mall, 32));
    const float scl = exp2f(M - Mall);
    float Lall = Lsum * scl; Lall += __shfl_xor(Lall, 16); Lall += __shfl_xor(Lall, 32);
#pragma unroll
    for (int j = 0; j < 16; ++j) { const float sj = __shfl(scl, rowbase + j);
        f32x4 v = O[j] * sj;
        v.x += __shfl_xor(v.x, 16); v.y += __shfl_xor(v.y, 16); v.z += __shfl_xor(v.z, 16); v.w += __shfl_xor(v.w, 16);
        v.x += __shfl_xor(v.x, 32); v.y += __shfl_xor(v.y, 32); v.z += __shfl_xor(v.z, 32); v.w += __shfl_xor(v.w, 32);
        O[j] = v; }
    float* part = (float*)(a.ws + WS_PART) + ((size_t)(b * 4 + h) * NSPLIT + sp) * PART_FLOATS;
    if (kk == 0) { part[dq] = Mall; part[16 + dq] = Lall;
#pragma unroll
        for (int j = 0; j < 16; ++j) *(f32x4*)(part + 32 + j * 64 + 4 * dq) = O[j]; }
}

constexpr int MM_RWP = 32;
constexpr int MM_AP = 256;
constexpr int MM_AS = (DB * NSPLIT * 4) / 8;
constexpr int MM_S5P = 256;
constexpr int MM_S5S = 256;
constexpr int MM_LRU = 128;
constexpr int MM_RWS = DB * 4;
constexpr int MM_TOTAL = MM_RWP + MM_AP + MM_AS + MM_S5P + MM_S5S + MM_LRU + MM_RWS;
__device__ __forceinline__ int grab_unit(unsigned* ctr, volatile LAS unsigned* MISC, int tid) {
    __syncthreads();
    if (tid == 0) MISC[4] = atomicAdd(ctr, 1u);
    __syncthreads();
    return (int)MISC[4];
}
__device__ __forceinline__ void ph_mixmain(const Args& a, int l, LAS unsigned char* lds, volatile LAS unsigned* MISC, int tid, int lane, int wave) {
    unsigned* qctr = (unsigned*)(a.ws + WS_CTL) + CW_QUEUE + 512 * l;
    const float lam = compute_lam(a, l, lane);
    int u;
    if (MME(0)) while ((u = grab_unit(qctr + 0 * 64, MISC, tid)) < MM_RWP) rwkv_scan_unit(a, l, false, u >> 2, u & 3, lds, tid);
    if (MME(1)) while ((u = grab_unit(qctr + 1 * 64, MISC, tid)) < MM_AP) { const int wi = u * 8 + wave; const int qt = 63 - (wi >> 5), bh = wi & 31; attn_prompt_wave(a, l, bh >> 2, bh & 3, qt, lam, lane); }
    if (MME(2)) while ((u = grab_unit(qctr + 2 * 64, MISC, tid)) < MM_AS) attn_sample_wave(a, l, u * 8 + wave, lane);
    if (MME(3)) while ((u = grab_unit(qctr + 3 * 64, MISC, tid)) < MM_S5P) s5_pass2_wave(a, l, false, u * 8 + wave, lds + wave * 17408, lane);
    if (MME(4)) while ((u = grab_unit(qctr + 4 * 64, MISC, tid)) < MM_S5S) s5_pass2_wave(a, l, true, u * 8 + wave, lds + wave * 17408, lane);
    if (MME(5)) while ((u = grab_unit(qctr + 5 * 64, MISC, tid)) < MM_LRU) lru_pass2_wave(a, l, u * 8 + wave, lane);
    if (MME(6)) while ((u = grab_unit(qctr + 6 * 64, MISC, tid)) < MM_RWS) rwkv_scan_unit(a, l, true, u >> 2, u & 3, lds, tid);
    __syncthreads();
}

__device__ __forceinline__ void combine_item(const Args& a, int l, int item, float lam, LAS unsigned char* lds, int tid, int lane, int wave) {
    OPAQUE(tid); OPAQUE(lane);
    const float* PROJ = (const float*)(a.ws + WS_PROJ);
    float* OMIX = (float*)(a.ws + WS_OMIX);
    bf16* OB = (bf16*)(a.ws + WS_OB);
    LAS float* ZT = (LAS float*)lds;
    const int m0 = item * 32;
    if (m0 >= NP) {
        const float* PART = (const float*)(a.ws + WS_PART);
        const float* sw = a.in[I_SUBLN] + l * 64;
        for (int task = wave; task < 128; task += NWAVES) {
            const int t = task >> 2, h = task & 3, m = m0 + t, q = m - NP, b = q >> 3, i = q & 7;
            const float* pb = PART + ((size_t)(b * 4 + h) * NSPLIT) * PART_FLOATS;
            float oc[2];
#pragma unroll
            for (int c = 0; c < 2; ++c) { const int j = c * 8 + i;
                float M = -1e30f;
#pragma unroll
                for (int s = 0; s < NSPLIT; ++s) M = fmaxf(M, pb[s * PART_FLOATS + j]);
                float L = 0.f, O = 0.f;
#pragma unroll
                for (int s = 0; s < NSPLIT; ++s) { const float w = exp2f(pb[s * PART_FLOATS + j] - M); L += pb[s * PART_FLOATS + 16 + j] * w; O += pb[s * PART_FLOATS + 32 + j * 64 + lane] * w; }
                oc[c] = O / L; }
            const float v = oc[0] - lam * oc[1];
            const float ss = wave_sum(v * v);
            OMIX[(size_t)m * DM + h * 64 + lane] = v * rsqrtf(ss * (1.f / 64.f) + NORM_EPS) * sw[lane] * (1.0f - lam_init_of(l));
        }
    }
    for (int idx = tid; idx < 32 * 256; idx += NTHREADS) { const int t = idx >> 8, c = idx & 255; ZT[c * 36 + t] = OMIX[(size_t)(m0 + t) * DM + 768 + c]; }
    __syncthreads();
    const int o = tid & 255, half = tid >> 8;
    float acc[16];
    const float bg = a.in[I_BGLU][l * 256 + o];
#pragma unroll
    for (int k = 0; k < 16; ++k) acc[k] = bg;
    const float* wg = a.in[I_WGLU] + (size_t)l * 65536 + o;
#pragma unroll 4
    for (int c = 0; c < 256; ++c) { const float wv = wg[(size_t)c * 256];
#pragma unroll
        for (int k4 = 0; k4 < 4; ++k4) { const f32x4 z4 = *(const LAS f32x4*)(ZT + c * 36 + half * 16 + 4 * k4);
            acc[4 * k4 + 0] += z4.x * wv; acc[4 * k4 + 1] += z4.y * wv; acc[4 * k4 + 2] += z4.z * wv; acc[4 * k4 + 3] += z4.w * wv; } }
#pragma unroll
    for (int k = 0; k < 16; ++k) { const int t = half * 16 + k; const size_t m = (size_t)(m0 + t);
        const float z = ZT[o * 36 + t];
        const float od = z * sigmoidf_(acc[k]);
#pragma unroll
        for (int sec = 0; sec < 4; ++sec) { const int col = sec * 256 + o;
            const float mix = (sec == 3) ? od : OMIX[m * DM + col];
            const float gt = PROJ[m * DIN + OFF_G + col];
            OB[m * DM + col] = (bf16)f2bf(mix * gt * sigmoidf_(gt)); } }
    __syncthreads();
}
__device__ __forceinline__ void ph_combine(const Args& a, int l, LAS unsigned char* lds, int tid, int lane, int wave) {
    const float lam = compute_lam(a, l, lane);
    for (int it = blockIdx.x; it < MTOK / 32; it += gridDim.x) combine_item(a, l, it, lam, lds, tid, lane, wave);
}

__device__ __forceinline__ void ph_postnorm(const Args& a, int l, int lane, int wave) {
    OPAQUE(lane);
    const float* YP = (const float*)(a.ws + WS_YP);
    const float* X1 = (const float*)(a.ws + WS_X1);
    const int gw = blockIdx.x * NWAVES + wave, NGW = gridDim.x * NWAVES;
    for (int m = gw; m < MTOK; m += NGW) {
        const float* xin = (l == 0) ? (m < NP ? a.in[I_XP] + (size_t)m * DM : a.in[I_XS] + (size_t)(m - NP) * DM) : X1 + (size_t)m * DM;
        float* yout = (l == 0) ? (float*)(a.ws + WS_X1) + (size_t)m * DM : (m < NP ? a.out + OUT_Y_P + (size_t)m * DM : a.out + OUT_Y_S + (size_t)(m - NP) * DM);
        const f32x4* yr = (const f32x4*)(YP + (size_t)m * DM) + lane; const f32x4* xr = (const f32x4*)xin + lane;
        const f32x4* gp = (const f32x4*)(a.in[I_NPOST] + l * DM) + lane;
        f32x4 v[4]; float s = 0.f;
#pragma unroll
        for (int j = 0; j < 4; ++j) { v[j] = yr[64 * j]; s += (v[j].x * v[j].x + v[j].y * v[j].y) + (v[j].z * v[j].z + v[j].w * v[j].w); }
        const float r = rsqrtf(wave_sum(s) * (1.f / DM) + NORM_EPS);
        float s2 = 0.f;
#pragma unroll
        for (int j = 0; j < 4; ++j) { v[j] = xr[64 * j] + v[j] * r * gp[64 * j]; ((f32x4*)yout + lane)[64 * j] = v[j];
            s2 += (v[j].x * v[j].x + v[j].y * v[j].y) + (v[j].z * v[j].z + v[j].w * v[j].w); }
        if (l == 0) {
            const float r2 = rsqrtf(wave_sum(s2) * (1.f / DM) + NORM_EPS);
            const f32x4* g2 = (const f32x4*)(a.in[I_NPRE] + DM) + lane;
            u32x2* o8 = (u32x2*)((bf16*)(a.ws + WS_H) + (size_t)m * DM) + lane;
#pragma unroll
            for (int j = 0; j < 4; ++j) { const f32x4 gg = g2[64 * j]; u32x2 ov; ov.x = pk2(v[j].x * r2 * gg.x, v[j].y * r2 * gg.y); ov.y = pk2(v[j].z * r2 * gg.z, v[j].w * r2 * gg.w); o8[64 * j] = ov; }
        }
    }
}

constexpr int N_PHASES = 13;
__global__ void __launch_bounds__(NTHREADS, 2) hymba_fwd(Args args) {
    extern __shared__ __attribute__((aligned(16))) unsigned char lds_raw[];
    LAS unsigned char* lds = (LAS unsigned char*)lds_raw;
    volatile LAS unsigned* MISC = (volatile LAS unsigned*)(lds + MISC_OFF);
    if (threadIdx.x < 64) MISC[threadIdx.x] = 0u;
#define TIDS() int tid = threadIdx.x; OPAQUE(tid); const int lane = tid & 63, wave = __builtin_amdgcn_readfirstlane(tid >> 6); (void)lane; (void)wave
    __syncthreads();
    unsigned* ctl = (unsigned*)(args.ws + WS_CTL);
#if MK_PER_PHASE
#define GRID_BAR() do { } while (0)
#else
    XcdBarrier bar = xcd_barrier_post(ctl + CW_BAR, MISC);
#define GRID_BAR() xcd_barrier(bar)
#endif
    const int lo = args.ph_lo, hi = args.ph_hi;
#ifndef PHASE_MASK
#define PHASE_MASK 0x7f
#endif
#define IN(k) (lo <= (k) && (k) < hi)
#define EN(j) ((PHASE_MASK >> (j)) & 1)
#define SEAM(k) do { if (IN(k) && IN((k) + 1)) GRID_BAR(); } while (0)

    if (EN(0) && IN(0)) { TIDS(); ph_prologue(args, lds, lane, wave); }
    SEAM(0);
    for (int l = 0; l < 2; ++l) {
        const int p0 = 1 + 6 * l;
        if (EN(1) && IN(p0)) {
            pg8::Gemm g{(const pg8::bf16_t*)(args.ws + WS_H), (const pg8::bf16_t*)(args.ws + WS_WIN) + (size_t)l * DIN * DM, MTOK, DIN, DM};
            pg8::StaticOrder S; S.init(MTOK, DIN, (int)gridDim.x, (int)blockIdx.x);
            EpiProj E{(float*)(args.ws + WS_PROJ), args.out, l};
            pg8::gemm_phase<EpiProj, pg8::StaticOrder, false>(lds, g, S, E, nullptr);
        }
        SEAM(p0);
        if (EN(2) && IN(p0 + 1)) { TIDS(); ph_mixprep(args, l, lds, tid, lane, wave); }
        SEAM(p0 + 1);
        if (EN(3) && IN(p0 + 2)) { TIDS(); ph_mixmain(args, l, lds, MISC, tid, lane, wave); }
        SEAM(p0 + 2);
        if (EN(4) && IN(p0 + 3)) { TIDS(); ph_combine(args, l, lds, tid, lane, wave); }
        SEAM(p0 + 3);
        if (EN(5) && IN(p0 + 4)) {
            pg8::Gemm g{(const pg8::bf16_t*)(args.ws + WS_OB), (const pg8::bf16_t*)(args.ws + WS_WOUT) + (size_t)l * DM * DM, MTOK, DM, DM};
            pg8::StaticOrder S; S.init(MTOK, DM, (int)gridDim.x, (int)blockIdx.x);
            EpiPlain E{(float*)(args.ws + WS_YP), DM};
            pg8::gemm_phase<EpiPlain, pg8::StaticOrder, false>(lds, g, S, E, nullptr);
        }
        SEAM(p0 + 4);
        if (EN(6) && IN(p0 + 5)) { TIDS(); ph_postnorm(args, l, lane, wave); }
        SEAM(p0 + 5);
    }
#undef IN
#undef SEAM
}

extern "C" void kernel_launch(void* const* d_in, const int* in_sizes, int n_in, void* d_out, int out_size, void* d_ws, size_t ws_size, hipStream_t stream) {
    static int grid = 0;
    if (grid == 0) {
        if (n_in != N_IN || out_size != (int)OUT_TOTAL || ws_size < WS_END) { fprintf(stderr, "kernel_launch: unexpected shapes: n_in %d out %d ws %zu (need %zu)\n", n_in, out_size, ws_size, (size_t)WS_END); grid = -1; return; }
        int dev = 0, cus = 0, per_cu = 0;
        if (hipGetDevice(&dev) != hipSuccess || hipDeviceGetAttribute(&cus, hipDeviceAttributeMultiprocessorCount, dev) != hipSuccess) { grid = -1; return; }
        if (hipFuncSetAttribute((const void*)hymba_fwd, hipFuncAttributeMaxDynamicSharedMemorySize, LDS_BYTES) != hipSuccess) { fprintf(stderr, "kernel_launch: hipFuncSetAttribute failed\n"); grid = -1; return; }
        if (hipOccupancyMaxActiveBlocksPerMultiprocessor(&per_cu, (const void*)hymba_fwd, NTHREADS, LDS_BYTES) != hipSuccess || per_cu < 1) { fprintf(stderr, "kernel_launch: occupancy query says %d\n", per_cu); }
        (void)hipGetLastError();
        grid = cus;
    }
    if (grid < 0) return;
    (void)hipMemsetAsync((char*)d_ws + WS_CTL, 0, CTL_ZERO_BYTES, stream);
    Args a{};
    for (int i = 0; i < N_IN; ++i) a.in[i] = (const float*)d_in[i];
    a.out = (float*)d_out; a.ws = (unsigned char*)d_ws;
#if MK_PER_PHASE
    for (int p = 0; p < N_PHASES; ++p) { a.ph_lo = p; a.ph_hi = p + 1; hipLaunchKernelGGL(hymba_fwd, dim3(grid), dim3(NTHREADS), LDS_BYTES, stream, a); }
#else
    a.ph_lo = 0; a.ph_hi = N_PHASES; hipLaunchKernelGGL(hymba_fwd, dim3(grid), dim3(NTHREADS), LDS_BYTES, stream, a);
#endif
}
```

```cpp
#include <hip/hip_runtime.h>
#include <cstdio>
#include <cstdint>
#ifndef MK_PER_PHASE
#define MK_PER_PHASE 0
#endif
namespace pg8 {
#define PG8_LAS __attribute__((address_space(3)))
typedef unsigned short bf16_t;
typedef short bf16x8 __attribute__((ext_vector_type(8)));
typedef float f32x4 __attribute__((ext_vector_type(4)));
typedef unsigned u32x4 __attribute__((ext_vector_type(4)));
constexpr int BM = 256, BK = 64, HALF = 128, HTB = HALF * BK * 2  , STAGE_BYTES = 8 * HTB, NXCD = 8, WGM = 8;

__host__ __device__ __forceinline__ int lds_byte(int r, int c) { const int st = (r >> 4) * 2 + (c >> 5), rr = r & 15, cc = c & 31, ob = rr * 64 + cc * 2; return st * 1024 + (ob ^ (((ob >> 9) & 1) << 5)); }
__host__ __device__ __forceinline__ void stage_rc(int b, int& R, int& C) { const int st = b / 1024, sb = b % 1024, swz = sb ^ (((sb >> 9) & 1) << 5); R = (st >> 1) * 16 + swz / 64; C = (st & 1) * 32 + (swz % 64) / 2; }
__host__ __device__ __forceinline__ int perm32(int rho) { const int n = rho >> 4, i = rho & 15; return 8 * (i >> 2) + 4 * n + (i & 3); }

struct Unit { int pm, pn; };
struct Gemm { const bf16_t* A; const bf16_t* Bt; int M, N, K; };

struct StaticOrder {
    int nM, nN, nwg, G, c;
    __host__ __device__ void init(int M, int N, int G_, int c_) { nM = M / BM; nN = N / BM; nwg = nM * nN; G = G_; c = c_; }
    __host__ __device__ bool next(int i, Unit& u) const {
        const long L = (long)i * G + c; if (L >= nwg) return false;
        int wgid = (int)L; { const int q = nwg / NXCD, r = nwg % NXCD, xcd = wgid % NXCD, off = wgid / NXCD; wgid = (xcd < r ? xcd * (q + 1) : r * (q + 1) + (xcd - r) * q) + off; }
        const int nig = WGM * nN, gid = wgid / nig, fm = gid * WGM, gsz = (nM - fm) < WGM ? (nM - fm) : WGM;
        u.pm = fm + ((wgid % nig) % gsz); u.pn = (wgid % nig) / gsz; return true;
    }
    __device__ __forceinline__ void a_ready(const Unit&) const {}
    __device__ __forceinline__ void done(const Unit&) const {}
};
template <class Epi, class Sched, bool STAMP = false>
__device__ __forceinline__ void gemm_phase(PG8_LAS unsigned char* lds, const Gemm g, const Sched& S, const Epi& E, unsigned long long* stamps, int tid_in) {
    int tid = tid_in; asm volatile("" : "+v"(tid));
    const int wid = __builtin_amdgcn_readfirstlane(tid >> 6), lane = tid & 63, wr = wid >> 2, wc = wid & 3, fr = lane & 15, fq = lane >> 4;
    const int K = g.K, nt = K / BK;
    int ts_lo = 0, ts_hi = 0, nts = 0; const unsigned long long rt_entry = STAMP ? (unsigned long long)wall_clock64() : 0ull;
#define PG8_STAMP() do { if (STAMP && wid == 0 && nts < 64) { const unsigned long long _c = (unsigned long long)clock64(); \
        ts_lo = (lane == nts) ? (int)(unsigned)_c : ts_lo; ts_hi = (lane == nts) ? (int)(unsigned)(_c >> 32) : ts_hi; ++nts; } } while (0)
    PG8_STAMP();
    unsigned voffA[2], voffB[2];
#pragma unroll
    for (int i = 0; i < 2; ++i) { int R, C; stage_rc(tid * 16 + i * 8192, R, C); const int Rb = Epi::PERM ? ((R & ~31) + perm32(R & 31)) : R;
        voffA[i] = (unsigned)(R * K + C) * 2u; voffB[i] = (unsigned)(Rb * K + C) * 2u; }
    const size_t kstep = (size_t)(BK * 2);
    const size_t hstep = (size_t)HALF * K * 2;
    const size_t tstep = 2 * hstep;
    const unsigned ldsw = (unsigned)wid * 1024u;
    const int aoff = lds_byte(wr * 64 + fr, fq * 8), boff = lds_byte(wc * 32 + fr, fq * 8);
#define PG8_SA(b, h) (((b) * 2 + (h)) * HTB)
#define PG8_SB(b, h) ((4 + (b) * 2 + (h)) * HTB)
#define PG8_STAGE(bufoff, gbase, voff) do { _Pragma("unroll") for (int _i = 0; _i < 2; ++_i) \
        __builtin_amdgcn_global_load_lds((const unsigned*)((const char*)(gbase) + (voff)[_i]), (PG8_LAS unsigned*)(lds + (bufoff) + ldsw + _i * 8192), 16, 0, 0); } while (0)
#define PG8_LDA(dst, b, h) do { _Pragma("unroll") for (int m = 0; m < 4; ++m) _Pragma("unroll") for (int k = 0; k < 2; ++k) dst[m][k] = *(const PG8_LAS bf16x8*)(lds + PG8_SA(b, h) + aoff + m * 2048 + k * 1024); } while (0)
#define PG8_LDB(dst, b, h) do { _Pragma("unroll") for (int n = 0; n < 2; ++n) _Pragma("unroll") for (int k = 0; k < 2; ++k) dst[n][k] = *(const PG8_LAS bf16x8*)(lds + PG8_SB(b, h) + boff + n * 2048 + k * 1024); } while (0)
#define PG8_MMA(ai, bj, At, Bt) do { __builtin_amdgcn_s_setprio(1); _Pragma("unroll") for (int m = 0; m < 4; ++m) _Pragma("unroll") for (int n = 0; n < 2; ++n) _Pragma("unroll") for (int k = 0; k < 2; ++k) \
        acc[ai][bj][m][n] = __builtin_amdgcn_mfma_f32_16x16x32_bf16(Bt[n][k], At[m][k], acc[ai][bj][m][n], 0, 0, 0); __builtin_amdgcn_s_setprio(0); } while (0)
#define PG8_WAIT_V(n) asm volatile("s_waitcnt vmcnt(" #n ")" ::: "memory")
#define PG8_WAIT_L(n) asm volatile("s_waitcnt lgkmcnt(" #n ")" ::: "memory")
#define PG8_BAR __builtin_amdgcn_s_barrier()
#define PG8_SCHED __builtin_amdgcn_sched_barrier(0)
    Unit cur, nxt; int ui = 0;
    if (!S.next(0, cur)) return;
    f32x4 acc[2][2][4][2];
#pragma unroll
    for (int a = 0; a < 2; ++a)
#pragma unroll
        for (int b = 0; b < 2; ++b)
#pragma unroll
            for (int m = 0; m < 4; ++m)
#pragma unroll
                for (int n = 0; n < 2; ++n) acc[a][b][m][n] = (f32x4){0.f, 0.f, 0.f, 0.f};
    bf16x8 At[4][2], B0[2][2], B1[2][2];
    const char* cA = (const char*)g.A + (size_t)cur.pm * tstep; const char* cB = (const char*)g.Bt + (size_t)cur.pn * tstep;
    S.a_ready(cur);
    PG8_STAGE(PG8_SB(0, 0), cB, voffB); PG8_STAGE(PG8_SA(0, 0), cA, voffA); PG8_STAGE(PG8_SB(0, 1), cB + hstep, voffB); PG8_STAGE(PG8_SA(0, 1), cA + hstep, voffA);
    if (wr == 1) PG8_BAR;
    PG8_WAIT_V(4); PG8_BAR;
    PG8_STAGE(PG8_SB(1, 0), cB + kstep, voffB); PG8_STAGE(PG8_SA(1, 0), cA + kstep, voffA); PG8_STAGE(PG8_SB(1, 1), cB + hstep + kstep, voffB);
    PG8_WAIT_V(6); PG8_BAR;
    PG8_STAMP();
    for (;;) {
        const bool has_next = S.next(ui + 1, nxt);
        const char* nA = has_next ? (const char*)g.A + (size_t)nxt.pm * tstep : cA; const char* nB = has_next ? (const char*)g.Bt + (size_t)nxt.pn * tstep : cB;
        for (int t = 0; t < nt; t += 2) {
            const bool last = (t == nt - 2);
            const char* a1 = cA + (size_t)(t + 1) * kstep;
            const char* a2 = last ? nA : cA + (size_t)(t + 2) * kstep; const char* b2 = last ? nB : cB + (size_t)(t + 2) * kstep;
            const char* a3 = a2 + kstep; const char* b3 = b2 + kstep;
            if (last && has_next) S.a_ready(nxt);
            PG8_LDB(B0, 0, 0); PG8_SCHED; PG8_LDA(At, 0, 0); PG8_STAGE(PG8_SA(1, 1), a1 + hstep, voffA);
            PG8_WAIT_L(8); PG8_BAR; PG8_WAIT_L(0); PG8_MMA(0, 0, At, B0); PG8_BAR; PG8_SCHED;
            PG8_LDB(B1, 0, 1); PG8_STAGE(PG8_SB(0, 0), b2, voffB);
            PG8_BAR; PG8_WAIT_L(0); PG8_MMA(0, 1, At, B1); PG8_BAR;
            PG8_LDA(At, 0, 1); PG8_STAGE(PG8_SA(0, 0), a2, voffA);
            PG8_BAR; PG8_WAIT_L(0); PG8_MMA(1, 0, At, B0); PG8_BAR; PG8_SCHED;
            PG8_STAGE(PG8_SB(0, 1), b2 + hstep, voffB);
            PG8_WAIT_V(6); PG8_BAR; PG8_MMA(1, 1, At, B1); PG8_BAR;
            PG8_LDB(B0, 1, 0); PG8_SCHED; PG8_LDA(At, 1, 0); PG8_STAGE(PG8_SA(0, 1), a2 + hstep, voffA);
            PG8_WAIT_L(8); PG8_BAR; PG8_WAIT_L(0); PG8_MMA(0, 0, At, B0); PG8_BAR; PG8_SCHED;
            PG8_LDB(B1, 1, 1); PG8_STAGE(PG8_SB(1, 0), b3, voffB);
            PG8_BAR; PG8_WAIT_L(0); PG8_MMA(0, 1, At, B1); PG8_BAR;
            PG8_LDA(At, 1, 1); PG8_STAGE(PG8_SA(1, 0), a3, voffA);
            PG8_BAR; PG8_WAIT_L(0); PG8_MMA(1, 0, At, B0); PG8_BAR; PG8_SCHED;
            PG8_STAGE(PG8_SB(1, 1), b3 + hstep, voffB);
            PG8_WAIT_V(6); PG8_BAR; PG8_MMA(1, 1, At, B1); PG8_BAR;
        }
        PG8_STAMP();
        if constexpr (!Epi::AFTER_DRAIN) { int l2; asm volatile("v_mbcnt_lo_u32_b32 %0, -1, 0\n\tv_mbcnt_hi_u32_b32 %0, -1, %0" : "=v"(l2)); E(acc, cur, wr, wc, l2 & 15, l2 >> 4); S.done(cur); }
        PG8_STAMP();
        if (!has_next) break;
#pragma unroll
        for (int a = 0; a < 2; ++a)
#pragma unroll
            for (int b = 0; b < 2; ++b)
#pragma unroll
                for (int m = 0; m < 4; ++m)
#pragma unroll
                    for (int n = 0; n < 2; ++n) acc[a][b][m][n] = (f32x4){0.f, 0.f, 0.f, 0.f};
        cur = nxt; cA = nA; cB = nB; ++ui;
    }
    PG8_WAIT_V(0);
    if (wr == 0) PG8_BAR;
    PG8_BAR;
    if constexpr (Epi::AFTER_DRAIN) { E.fused(acc, cur, wr, wc, fr, fq, lds, wid, lane); S.done(cur); }
    PG8_STAMP();
    if (STAMP && wid == 0) { stamps[lane] = lane < nts ? (((unsigned long long)(unsigned)ts_hi << 32) | (unsigned)ts_lo) : 0ull;
        if (lane == 62) stamps[62] = rt_entry; if (lane == 63) stamps[63] = (unsigned long long)wall_clock64(); }
#undef PG8_STAMP
#undef PG8_SA
#undef PG8_SB
#undef PG8_STAGE
#undef PG8_LDA
#undef PG8_LDB
#undef PG8_MMA
#undef PG8_WAIT_V
#undef PG8_WAIT_L
#undef PG8_BAR
#undef PG8_SCHED
}
}

#define GAS __attribute__((address_space(1)))
#define LAS __attribute__((address_space(3)))
typedef unsigned short bf16;
typedef float f32x4 __attribute__((ext_vector_type(4)));
typedef float f32x2 __attribute__((ext_vector_type(2)));
typedef float f32x16 __attribute__((ext_vector_type(16)));
typedef short bf16x8 __attribute__((ext_vector_type(8)));
typedef unsigned u32x4 __attribute__((ext_vector_type(4)));
typedef unsigned u32x2 __attribute__((ext_vector_type(2)));

constexpr int NWAVES = 8, NTHREADS = 512;
constexpr int DM = 1024, NP = 16384, NSMP = 1024, MTOK = 17408, DIN = 3584, SEQ = 2048, DB = 128, DS = 8;
constexpr int OFF_AQ = 0, OFF_AK = 256, OFF_AV = 512, OFF_B = 768, OFF_C = 1024, OFF_D = 2304, OFF_G = 2560;
constexpr int NPOOL = 2560, NPAGES = 16;
constexpr float NORM_EPS = 1e-6f;
constexpr float QSCALE = 0.17677669529663687f * 1.4426950408889634f;
constexpr int NSPLIT = 9;
constexpr int PART_FLOATS = 16 + 16 + 1024;

constexpr size_t OUT_Y_P = 0, OUT_Y_S = 16777216, OUT_K_P = 17825792, OUT_K_S = 26214400, OUT_V_P = 26738688, OUT_V_S = 35127296,
    OUT_CONV_P = 35651584, OUT_CONV_S = 35663872, OUT_LRU_P = 35860480, OUT_LRU_S = 35864576, OUT_SHIFT_P = 35930112, OUT_SHIFT_S = 35950592,
    OUT_WKV_P = 36278272, OUT_WKV_S = 36540416, OUT_SSM_P = 40734720, OUT_SSM_S = 40767488, OUT_TOTAL = 41291776;

constexpr size_t MiB = 1u << 20;
constexpr size_t WS_CTL = 0, CTL_ZERO_BYTES = 1 * MiB;
constexpr size_t WS_WIN = 1 * MiB;
constexpr size_t WS_WOUT = WS_WIN + (size_t)2 * DIN * DM * 2;
constexpr size_t WS_H = WS_WOUT + (size_t)2 * DM * DM * 2;
constexpr size_t WS_PROJ = WS_H + (size_t)MTOK * DM * 2;
constexpr size_t WS_QB = WS_PROJ + (size_t)MTOK * DIN * 4;
constexpr size_t WS_KB = WS_QB + (size_t)NP * 256 * 2;
constexpr size_t WS_VT = WS_KB + (size_t)NP * 256 * 2;
constexpr size_t WS_LA = WS_VT + (size_t)NP * 256 * 2;
constexpr size_t WS_LB = WS_LA + (size_t)MTOK * 256 * 4;
constexpr size_t WS_LP = WS_LB + (size_t)MTOK * 256 * 4;
constexpr size_t WS_LE = WS_LP + (size_t)8 * 32 * 256 * 4;
constexpr size_t WS_RW = WS_LE + (size_t)8 * 32 * 256 * 4;
constexpr size_t WS_BON = WS_RW + (size_t)MTOK * 1536 * 4;
constexpr size_t WS_S5E = WS_BON + (size_t)MTOK * 4 * 4;
constexpr size_t WS_OMIX = WS_S5E + (size_t)8 * 16 * 16 * 64 * 2 * 4;
constexpr size_t WS_ZB = WS_OMIX, WS_WGLU = WS_OMIX + 16 * MiB, WS_LWT = WS_OMIX + 17 * MiB, WS_W1T = WS_OMIX + 18 * MiB, WS_S5T = WS_OMIX + 19 * MiB;
constexpr size_t WS_OB = WS_OMIX + (size_t)MTOK * DM * 4;
constexpr size_t WS_PART = WS_OB + (size_t)MTOK * DM * 2;
constexpr size_t WS_YP = WS_PART + (size_t)DB * 4 * NSPLIT * PART_FLOATS * 4;
constexpr size_t WS_X1 = WS_YP + (size_t)MTOK * DM * 4;
constexpr size_t WS_PZ = WS_X1 + (size_t)MTOK * DM * 4;
constexpr size_t WS_END = WS_PZ + (size_t)8 * 4 * 8 * 2 * 4096 * 4;
static_assert(WS_H % 256 == 0 && WS_PROJ % 256 == 0 && WS_QB % 256 == 0 && WS_VT % 256 == 0 && WS_RW % 256 == 0 && WS_OMIX % 256 == 0 && WS_PART % 256 == 0 && WS_YP % 256 == 0, "ws align");

constexpr int CW_BAR = 4096;
constexpr int CW_QUEUE = 8192;

constexpr int LDS_BYTES = 147456;
constexpr int MISC_OFF = 147456 - 256;

#define XB_TMO      128
#define XB_XCNT(j)  (256  + 64 * (j))
#define XB_XSUB(j)  (1280 + 64 * (j))
#define XB_XGEN(j)  (2304 + 64 * (j))
#define XB_TOP      3328
#define XB_TOPGEN   3392
#define XCD_BAR_WORDS 3456
#define XB_SPIN_CAP (1u << 18)

__device__ __forceinline__ unsigned xb_ld(unsigned* p)              { return __hip_atomic_load(p, __ATOMIC_RELAXED, __HIP_MEMORY_SCOPE_AGENT); }
__device__ __forceinline__ unsigned xb_add(unsigned* p, unsigned v) { return __hip_atomic_fetch_add(p, v, __ATOMIC_RELAXED, __HIP_MEMORY_SCOPE_AGENT); }
__device__ __forceinline__ unsigned xb_xcc_id() { return (unsigned)__builtin_amdgcn_s_getreg((3 << 11) | 20) & 0xFu; }
#define XB_SPIN(cond, bar) do { unsigned _sp = 0; while (cond) { __builtin_amdgcn_s_sleep(1); \
    if ((++_sp & 255u) == 0u) { if (xb_ld(&(bar)[XB_TMO])) break; if (_sp > XB_SPIN_CAP) { atomicAdd(&(bar)[XB_TMO], 1u); break; } } } } while (0)

struct XcdBarrier { unsigned* bar; unsigned x; volatile LAS unsigned* st; };

__device__ __forceinline__ XcdBarrier xcd_barrier_post(unsigned* bar, volatile LAS unsigned* st) {
    XcdBarrier b; b.bar = bar; b.x = xb_xcc_id(); b.st = st;
    if (threadIdx.x == 0) (void)xb_add(&bar[XB_XCNT(b.x)], 1u);
    return b;
}
__device__ __forceinline__ void xcd_barrier_complete(unsigned* bar, unsigned x, unsigned& nloc, unsigned& nx) {
    const unsigned G = gridDim.x * gridDim.y * gridDim.z;
    unsigned sum, cnt, mine, sp = 0u;
    for (;;) {
        sum = 0u; cnt = 0u; mine = 0u;
#pragma unroll
        for (unsigned j = 0; j < 16; ++j) { const unsigned c = xb_ld(&bar[XB_XCNT(j)]); sum += c; cnt += (c > 0u) ? 1u : 0u; mine = (j == x) ? c : mine; }
        if (sum == G) break;
        __builtin_amdgcn_s_sleep(1);
        if ((++sp & 255u) == 0u) { if (xb_ld(&bar[XB_TMO])) break; if (sp > XB_SPIN_CAP) { atomicAdd(&bar[XB_TMO], 1u); break; } }
    }
    nloc = mine > 0u ? mine : 1u; nx = cnt > 0u ? cnt : 1u;
}
__device__ __forceinline__ void xcd_barrier(const XcdBarrier& b, bool leader) {
    asm volatile("s_waitcnt vmcnt(0)" ::: "memory");
    __syncthreads();
    if (leader) {
        unsigned* bar = b.bar;
        __builtin_amdgcn_s_waitcnt(0);
        unsigned nloc = b.st[0], nx = b.st[1];
        if (nloc == 0u) { xcd_barrier_complete(bar, b.x, nloc, nx); b.st[0] = nloc; b.st[1] = nx; }
        const unsigned old = xb_add(&bar[XB_XSUB(b.x)], 1u);
        const unsigned gen = old / nloc;
        if (old + 1u == (gen + 1u) * nloc) {
            __builtin_amdgcn_fence(__ATOMIC_RELEASE, "agent");
            asm volatile("s_waitcnt vmcnt(0)" ::: "memory");
            const unsigned og = xb_add(&bar[XB_TOP], 1u);
            const unsigned tg = og / nx;
            if (og + 1u == (tg + 1u) * nx) xb_add(&bar[XB_TOPGEN], 1u);
            else XB_SPIN(xb_ld(&bar[XB_TOPGEN]) == tg, bar);
            __builtin_amdgcn_fence(__ATOMIC_ACQUIRE, "agent");
            xb_add(&bar[XB_XGEN(b.x)], 1u);
            asm volatile("s_waitcnt vmcnt(0)" ::: "memory");
        } else {
            XB_SPIN(xb_ld(&bar[XB_XGEN(b.x)]) == gen, bar);
            __builtin_amdgcn_fence(__ATOMIC_ACQUIRE, "agent");
            asm volatile("s_waitcnt vmcnt(0)" ::: "memory");
        }
    }
    __syncthreads();
}

enum InIdx { I_XP = 0, I_XS, I_CK, I_CV, I_PT, I_SCONV, I_SLRU, I_SSHIFT, I_SWKV, I_SSSM, I_NPRE, I_NPOST, I_WIN, I_WOUT, I_LQ1, I_LK1, I_LQ2, I_LK2, I_SUBLN,
             I_CONVW, I_CONVB, I_LWA, I_LBA, I_LWX, I_LBX, I_LLAM, I_MU, I_W0, I_W1, I_W2, I_A0, I_A1, I_A2, I_KK, I_KA, I_RK, I_GNW, I_GNB,
             I_LRE, I_LIM, I_LOGDT, I_BRE, I_BIM, I_CRE, I_CIM, I_S5D, I_WGLU, I_BGLU, N_IN };
struct Args { const float* in[N_IN]; float* out; unsigned char* ws; int ph_lo, ph_hi; };
static_assert(sizeof(Args) == (N_IN + 2) * 8 + 8, "Args has no padding");
constexpr int TAB_OFF = 147456 - 1024;
struct Ctx {
    float* out; unsigned char* ws; const LAS unsigned* tab;
    __device__ __forceinline__ const float* inp(int i) const {
        const unsigned lo = tab[2 * i], hi = tab[2 * i + 1];
        return (const float*)(const GAS float*)(((unsigned long long)(unsigned)__builtin_amdgcn_readfirstlane((int)hi) << 32) | (unsigned long long)(unsigned)__builtin_amdgcn_readfirstlane((int)lo));
    }
};

__device__ __forceinline__ int lane_id_asm() { int l; asm volatile("v_mbcnt_lo_u32_b32 %0, -1, 0\n\tv_mbcnt_hi_u32_b32 %0, -1, %0" : "=v"(l)); return l; }
#define OPAQUE(x) asm volatile("" : "+v"(x))
__device__ __forceinline__ float wave_sum(float v) {
#pragma unroll
    for (int o = 1; o < 64; o <<= 1) v += __shfl_xor(v, o);
    return v;
}
template <int CTRL> __device__ __forceinline__ float dpp_mov(float v) { return __builtin_bit_cast(float, __builtin_amdgcn_update_dpp(0, __builtin_bit_cast(int, v), CTRL, 0xF, 0xF, true)); }
__device__ __forceinline__ float red8(float v) { v += dpp_mov<0xB1>(v); v += dpp_mov<0x4E>(v); v += dpp_mov<0x141>(v); return v; }
__device__ __forceinline__ float red16(float v) { v = red8(v); v += dpp_mov<0x140>(v); return v; }
__device__ __forceinline__ unsigned f2bf(float f) { unsigned u = __builtin_bit_cast(unsigned, f); return (u + 0x7fffu + ((u >> 16) & 1u)) >> 16; }
typedef __bf16 bf16x2_t __attribute__((ext_vector_type(2)));
__device__ __forceinline__ unsigned pk2(float lo, float hi) { const f32x2 v = {lo, hi}; return __builtin_bit_cast(unsigned, __builtin_convertvector(v, bf16x2_t)); }
__device__ __forceinline__ f32x4 ldp4(const bf16* p) { const u32x2 w = *(const u32x2*)p; return (f32x4){__builtin_bit_cast(float, w.x << 16), __builtin_bit_cast(float, w.x & 0xffff0000u), __builtin_bit_cast(float, w.y << 16), __builtin_bit_cast(float, w.y & 0xffff0000u)}; }
__device__ __forceinline__ float ldp1(const bf16* p) { return __builtin_bit_cast(float, (unsigned)(*p) << 16); }
__device__ __forceinline__ float sigmoidf_(float x) { return __builtin_amdgcn_rcpf(1.0f + __builtin_amdgcn_exp2f(-1.4426950408889634f * x)); }
__device__ __forceinline__ float siluf_(float x) { return x * sigmoidf_(x); }
__device__ __forceinline__ float tanhf_(float x) { return 1.0f - 2.0f * __builtin_amdgcn_rcpf(1.0f + __builtin_amdgcn_exp2f(2.8853900817779268f * x)); }
__device__ __forceinline__ float wave_sum_fast(float v) { v = red16(v); v += __shfl_xor(v, 16); v += __shfl_xor(v, 32); return v; }
__device__ __forceinline__ float softplusf_(float x) { return fmaxf(x, 0.f) + log1pf(__expf(-fabsf(x))); }
__device__ __forceinline__ float lam_init_of(int l) { return l == 0 ? 0.2f : 0.35550907f; }
__device__ __forceinline__ float compute_lam(const Ctx& a, int l, int lane) {
    float v1 = 0.f, v2 = 0.f;
    if (lane < 32) { v1 = a.inp(I_LQ1)[l * 32 + lane] * a.inp(I_LK1)[l * 32 + lane]; v2 = a.inp(I_LQ2)[l * 32 + lane] * a.inp(I_LK2)[l * 32 + lane]; }
    v1 = wave_sum(v1); v2 = wave_sum(v2);
    return expf(v1) - expf(v2) + lam_init_of(l);
}

__device__ __forceinline__ void s5_disc_compute(const Ctx& a, int l, int g, int n, float& ab_re, float& ab_im, float& f_re, float& f_im);
__device__ __forceinline__ void p0_transpose_item(const float* W, int K, int N, bf16* WT, LAS float* scr, int item, int lane) {
    const int nblk = N / 32, kb = item / nblk, nb = item % nblk, k0 = 64 * kb, n0 = 32 * nb;
    float wv[32];
#pragma unroll
    for (int i = 0; i < 32; ++i) wv[i] = W[(size_t)(k0 + 2 * i + (lane >> 5)) * N + n0 + (lane & 31)];
#pragma unroll
    for (int i = 0; i < 32; ++i) scr[(2 * i + (lane >> 5)) * 33 + (lane & 31)] = wv[i];
    asm volatile("s_waitcnt lgkmcnt(0)" ::: "memory");
    const int c = lane & 7;
#pragma unroll
    for (int j = 0; j < 4; ++j) { const int n = (lane >> 3) + 8 * j; const LAS float* s = scr + (8 * c) * 33 + n;
        u32x4 o; o.x = pk2(s[0 * 33], s[1 * 33]); o.y = pk2(s[2 * 33], s[3 * 33]); o.z = pk2(s[4 * 33], s[5 * 33]); o.w = pk2(s[6 * 33], s[7 * 33]);
        *(u32x4*)(WT + (size_t)(n0 + n) * K + k0 + 8 * c) = o; }
    asm volatile("s_waitcnt lgkmcnt(0)" ::: "memory");
}
__device__ __forceinline__ void rms_row_to_bf16(const float* xrow, const float* g, bf16* orow, int lane) {
    const f32x4* xr = (const f32x4*)xrow + lane; const f32x4* gr = (const f32x4*)g + lane;
    f32x4 v[4]; float s = 0.f;
#pragma unroll
    for (int j = 0; j < 4; ++j) { v[j] = xr[64 * j]; s += (v[j].x * v[j].x + v[j].y * v[j].y) + (v[j].z * v[j].z + v[j].w * v[j].w); }
    const float r = rsqrtf(wave_sum(s) * (1.f / DM) + NORM_EPS);
    u32x2* o8 = (u32x2*)orow + lane;
#pragma unroll
    for (int j = 0; j < 4; ++j) { const f32x4 gg = gr[64 * j]; u32x2 o; o.x = pk2(v[j].x * r * gg.x, v[j].y * r * gg.y); o.y = pk2(v[j].z * r * gg.z, v[j].w * r * gg.w); o8[64 * j] = o; }
}
__device__ __forceinline__ void ph_prologue(const Ctx& a, LAS unsigned char* lds, int lane, int wave) {
    OPAQUE(lane);
    LAS float* scr = (LAS float*)(lds + wave * 16384);
    const int gw = blockIdx.x * NWAVES + wave, NGW = gridDim.x * NWAVES;
    constexpr int I_IN = (DM / 64) * (DIN / 32), I_OUT = (DM / 64) * (DM / 32), I_GLU = (256 / 64) * (256 / 32), I_L = I_IN + I_OUT + I_GLU;
    for (int it = gw; it < 2 * I_L; it += NGW) {
        const int l = it / I_L, r = it % I_L;
        if (r < I_IN) p0_transpose_item(a.inp(I_WIN) + (size_t)l * DM * DIN, DM, DIN, (bf16*)(a.ws + WS_WIN) + (size_t)l * DIN * DM, scr, r, lane);
        else if (r < I_IN + I_OUT) p0_transpose_item(a.inp(I_WOUT) + (size_t)l * DM * DM, DM, DM, (bf16*)(a.ws + WS_WOUT) + (size_t)l * DM * DM, scr, r - I_IN, lane);
        else p0_transpose_item(a.inp(I_WGLU) + (size_t)l * 65536, 256, 256, (bf16*)(a.ws + WS_WGLU) + (size_t)l * 65536, scr, r - I_IN - I_OUT, lane);
    }
    {
        bf16* LWT = (bf16*)(a.ws + WS_LWT);
        const float* wa = a.inp(I_LWA); const float* wx = a.inp(I_LWX);
        for (int idx = gw * 64 + lane; idx < 2 * 2 * 4 * 64 * 64; idx += NGW * 64) {
            const int c = idx & 63, d = (idx >> 6) & 63, n = (idx >> 12) & 3, p = (idx >> 14) & 1, l = idx >> 15;
            LWT[idx] = (bf16)f2bf((p ? wx : wa)[((size_t)(l * 4 + n) * 64 + c) * 64 + d]);
        }
    }
    {
        float* T = (float*)(a.ws + WS_S5T);
        for (int idx = gw * 64 + lane; idx < 2 * 16 * 64; idx += NGW * 64) {
            float ar, ai, fr, fi; s5_disc_compute(a, idx >> 10, (idx >> 6) & 15, idx & 63, ar, ai, fr, fi);
            *(f32x4*)(T + (size_t)idx * 4) = (f32x4){ar, ai, fr, fi};
        }
    }
    {
        bf16* W1T = (bf16*)(a.ws + WS_W1T);
        const float* w1 = a.inp(I_W1); const float* a1 = a.inp(I_A1);
        for (int idx = gw * 64 + lane; idx < 2 * 2 * 32 * 256; idx += NGW * 64) {
            const int k = idx & 255, n = (idx >> 8) & 31, p = (idx >> 13) & 1, l = idx >> 14;
            W1T[idx] = (bf16)f2bf((p ? a1 : w1)[((size_t)l * 256 + k) * 32 + n]);
        }
    }
    bf16* H = (bf16*)(a.ws + WS_H);
    {
        const float* xp = a.inp(I_XP); const float* xs = a.inp(I_XS) - (size_t)NP * DM;
        f32x4 gg[4];
#pragma unroll
        for (int j = 0; j < 4; ++j) gg[j] = ((const f32x4*)a.inp(I_NPRE) + lane)[64 * j];
        for (int m0 = gw; m0 < MTOK; m0 += 2 * NGW) {
            const int m1 = m0 + NGW; const bool has1 = m1 < MTOK; const int mb = has1 ? m1 : m0;
            const f32x4* xa = (const f32x4*)((m0 < NP ? xp : xs) + (size_t)m0 * DM) + lane; const f32x4* xb = (const f32x4*)((mb < NP ? xp : xs) + (size_t)mb * DM) + lane;
            f32x4 va[4], vb[4]; float sa = 0.f, sb = 0.f;
#pragma unroll
            for (int j = 0; j < 4; ++j) { va[j] = xa[64 * j]; vb[j] = xb[64 * j]; }
#pragma unroll
            for (int j = 0; j < 4; ++j) { sa += (va[j].x * va[j].x + va[j].y * va[j].y) + (va[j].z * va[j].z + va[j].w * va[j].w); sb += (vb[j].x * vb[j].x + vb[j].y * vb[j].y) + (vb[j].z * vb[j].z + vb[j].w * vb[j].w); }
            const float ra = rsqrtf(wave_sum_fast(sa) * (1.f / DM) + NORM_EPS), rb = rsqrtf(wave_sum_fast(sb) * (1.f / DM) + NORM_EPS);
            u32x2* ha = (u32x2*)(H + (size_t)m0 * DM) + lane; u32x2* hb = (u32x2*)(H + (size_t)mb * DM) + lane;
#pragma unroll
            for (int j = 0; j < 4; ++j) { u32x2 o; o.x = pk2(va[j].x * ra * gg[j].x, va[j].y * ra * gg[j].y); o.y = pk2(va[j].z * ra * gg[j].z, va[j].w * ra * gg[j].w); ha[64 * j] = o;
                if (has1) { u32x2 p; p.x = pk2(vb[j].x * rb * gg[j].x, vb[j].y * rb * gg[j].y); p.y = pk2(vb[j].z * rb * gg[j].z, vb[j].w * rb * gg[j].w); hb[64 * j] = p; } }
        }
    }
}

struct EpiProj {
    static constexpr bool PERM = true, AFTER_DRAIN = false;
    bf16* P; float* out; int layer;
    __device__ __forceinline__ void operator()(const pg8::f32x4 (&acc)[2][2][4][2], const pg8::Unit& u, int wr, int wc, int fr, int fq) const {
        const int row0 = u.pm * 256 + wr * 64 + fr, col0 = u.pn * 256 + wc * 32 + 8 * fq;
#pragma unroll
        for (int ai = 0; ai < 2; ++ai)
#pragma unroll
            for (int m = 0; m < 4; ++m) { bf16* rowp = P + (size_t)(row0 + ai * 128 + m * 16) * DIN + col0;
#pragma unroll
                for (int bj = 0; bj < 2; ++bj) { const pg8::f32x4 v0 = acc[ai][bj][m][0], v1 = acc[ai][bj][m][1];
                    u32x4 w; w.x = pk2(v0[0], v0[1]); w.y = pk2(v0[2], v0[3]); w.z = pk2(v1[0], v1[1]); w.w = pk2(v1[2], v1[3]);
                    *(u32x4*)(rowp + bj * 128) = w; } }
        if (u.pn == 1 || u.pn == 2) {
            const bool smp = (u.pm >= 64);
            float* base;
            if (u.pn == 1) base = smp ? out + OUT_K_S + (size_t)layer * NSMP * 256 : out + OUT_K_P + (size_t)layer * NP * 256;
            else           base = smp ? out + OUT_V_S + (size_t)layer * NSMP * 256 : out + OUT_V_P + (size_t)layer * NP * 256;
            const int r0 = row0 - (smp ? NP : 0), c0 = wc * 32 + 8 * fq;
#pragma unroll
            for (int ai = 0; ai < 2; ++ai)
#pragma unroll
                for (int m = 0; m < 4; ++m) { float* rowp = base + (size_t)(r0 + ai * 128 + m * 16) * 256 + c0;
#pragma unroll
                    for (int bj = 0; bj < 2; ++bj) { __builtin_nontemporal_store(acc[ai][bj][m][0], (pg8::f32x4*)(rowp + bj * 128)); __builtin_nontemporal_store(acc[ai][bj][m][1], (pg8::f32x4*)(rowp + bj * 128 + 4)); } }
        }
    }
};
struct EpiPlain {
    static constexpr bool PERM = true, AFTER_DRAIN = false;
    bf16* C; int ldc;
    __device__ __forceinline__ void operator()(const pg8::f32x4 (&acc)[2][2][4][2], const pg8::Unit& u, int wr, int wc, int fr, int fq) const {
        const int row0 = u.pm * 256 + wr * 64 + fr, col0 = u.pn * 256 + wc * 32 + 8 * fq;
#pragma unroll
        for (int ai = 0; ai < 2; ++ai)
#pragma unroll
            for (int m = 0; m < 4; ++m) { bf16* rowp = C + (size_t)(row0 + ai * 128 + m * 16) * ldc + col0;
#pragma unroll
                for (int bj = 0; bj < 2; ++bj) { const pg8::f32x4 v0 = acc[ai][bj][m][0], v1 = acc[ai][bj][m][1];
                    u32x4 w; w.x = pk2(v0[0], v0[1]); w.y = pk2(v0[2], v0[3]); w.z = pk2(v1[0], v1[1]); w.w = pk2(v1[2], v1[3]);
                    *(u32x4*)(rowp + bj * 128) = w; } }
    }
};

__device__ __forceinline__ void lru_prep_item(const Ctx& a, int l, int item, LAS unsigned char* lds, int tid) {
    OPAQUE(tid);
    const bf16* PROJ = (const bf16*)(a.ws + WS_PROJ);
    float* LA = (float*)(a.ws + WS_LA); float* LB = (float*)(a.ws + WS_LB);
    LAS float* X = (LAS float*)lds;
    LAS float* XC = (LAS float*)(lds + 68608);
    const bool smp = item >= 256;
    int nseg, seglen, m0, s = 0, ch = 0, b0 = 0;
    if (!smp) { s = item >> 5; ch = item & 31; nseg = 1; seglen = 64; m0 = s * SEQ + ch * 64; }
    else { const int j = item - 256; nseg = 4; seglen = 8; m0 = NP + j * 32; b0 = j * 4; }
    const int rps = seglen + 3, L = nseg * seglen;
    {
        const float* sconv = a.inp(I_SCONV);
#pragma unroll 4
        for (int idx = tid; idx < nseg * rps * 64; idx += NTHREADS) {
            const int row = idx >> 6, c4 = idx & 63, seg = row / rps, i = row % rps;
            const bool halo = i < 3;
            const bool fromstate = smp && halo;
            f32x4 v = ldp4(PROJ + (size_t)(m0 + seg * seglen + (halo && (smp || ch == 0) ? 3 : i) - 3) * DIN + OFF_B + 4 * c4);
            const f32x4 vs = *(const f32x4*)(sconv + (fromstate ? ((size_t)(l * DB + b0 + seg) * 3 + i) * 256 : (size_t)0) + 4 * c4);
            if (fromstate) v = vs;
            if (!smp && ch == 0 && halo) v = (f32x4){0.f, 0.f, 0.f, 0.f};
            *(LAS f32x4*)(X + row * 256 + 4 * c4) = v;
        }
    }
    __syncthreads();
    if (smp || ch == 31) {
        for (int idx = tid; idx < nseg * 3 * 256; idx += NTHREADS) {
            const int seg = idx / 768, j = (idx % 768) >> 8, c = idx & 255;
            const float v = X[(seg * rps + seglen + j) * 256 + c];
            if (smp) a.out[OUT_CONV_S + ((size_t)(l * DB + b0 + seg) * 3 + j) * 256 + c] = v;
            else a.out[OUT_CONV_P + ((size_t)(l * 8 + s) * 3 + j) * 256 + c] = v;
        }
    }
    {
        const float* cw = a.inp(I_CONVW) + l * 1024; const float* cb = a.inp(I_CONVB) + l * 256;
        for (int idx = tid; idx < L * 256; idx += NTHREADS) {
            const int t = idx >> 8, c = idx & 255, seg = t / seglen, i = t % seglen;
            const LAS float* bp = X + (seg * rps + i) * 256 + c;
            XC[t * 256 + c] = cb[c] + cw[c] * bp[0] + cw[256 + c] * bp[256] + cw[512 + c] * bp[512] + cw[768 + c] * bp[768];
        }
    }
    __syncthreads();
    {
        const int lane = tid & 63, wv = tid >> 6, p = wv >> 2, n = wv & 3, r = lane & 31, hh = lane >> 5, o = tid & 255;
        const bf16* WT = (const bf16*)(a.ws + WS_LWT) + ((size_t)((l * 2 + p) * 4 + n) * 64) * 64;
        bf16x8 wf[2][4];
#pragma unroll
        for (int dt = 0; dt < 2; ++dt)
#pragma unroll
            for (int sx = 0; sx < 4; ++sx) wf[dt][sx] = *(const bf16x8*)(WT + (dt * 32 + r) * 64 + 16 * sx + 8 * hh);
        const float* bp = (p ? a.inp(I_LBX) : a.inp(I_LBA)) + l * 256 + n * 64 + 4 * hh;
        LAS float* GX = X;
        const int LH = L >> 1;
        bf16* OB = (bf16*)(a.ws + WS_OB);
        const float spv = softplusf_(-a.inp(I_LLAM)[l * 256 + o]) * 1.4426950408889634f;
        const float* slru = a.inp(I_SLRU);
        float hs = 0.f, Ps = 1.f;
        for (int hf = 0; hf < 2; ++hf) {
            {
                const LAS float* xr = XC + (hf * LH + r) * 256 + n * 64 + 8 * hh;
                bf16x8 xb[4];
#pragma unroll
                for (int sx = 0; sx < 4; ++sx) { const f32x4 x0 = *(const LAS f32x4*)(xr + 16 * sx), x1 = *(const LAS f32x4*)(xr + 16 * sx + 4);
                    u32x4 w; w.x = pk2(x0.x, x0.y); w.y = pk2(x0.z, x0.w); w.z = pk2(x1.x, x1.y); w.w = pk2(x1.z, x1.w); xb[sx] = __builtin_bit_cast(bf16x8, w); }
#pragma unroll
                for (int dt = 0; dt < 2; ++dt) {
                    f32x16 acc;
#pragma unroll
                    for (int e = 0; e < 16; ++e) acc[e] = 0.f;
#pragma unroll
                    for (int sx = 0; sx < 4; ++sx) acc = __builtin_amdgcn_mfma_f32_32x32x16_bf16(wf[dt][sx], xb[sx], acc, 0, 0, 0);
#pragma unroll
                    for (int g4 = 0; g4 < 4; ++g4) { const f32x4 bb = *(const f32x4*)(bp + dt * 32 + 8 * g4);
                        f32x4 gv; gv.x = sigmoidf_(acc[4 * g4] + bb.x); gv.y = sigmoidf_(acc[4 * g4 + 1] + bb.y); gv.z = sigmoidf_(acc[4 * g4 + 2] + bb.z); gv.w = sigmoidf_(acc[4 * g4 + 3] + bb.w);
                        *(LAS f32x4*)(GX + (p * 32 + r) * 256 + n * 64 + dt * 32 + 8 * g4 + 4 * hh) = gv; }
                }
            }
            __syncthreads();
            if (p == 0) {
              for (int t0 = 0; t0 < LH; t0 += 8) {
                float gts[8];
                if (smp) {
#pragma unroll
                    for (int t = 0; t < 8; ++t) gts[t] = ldp1(PROJ + (size_t)(m0 + hf * LH + t0 + t) * DIN + OFF_G + 256 + o); }
#pragma unroll
                for (int t8 = 0; t8 < 8; ++t8) {
                    const int t = t0 + t8;
                    const int tt = hf * LH + t, seg = tt / seglen, i = tt % seglen;
                    if (i == 0) { hs = smp ? slru[(size_t)(l * DB + b0 + seg) * 256 + o] : 0.f; Ps = 1.f; }
                    const float rg = GX[t * 256 + o], g = GX[(32 + t) * 256 + o];
                    const float av = __builtin_amdgcn_exp2f(-8.0f * rg * spv);
                    const float mult = __builtin_amdgcn_sqrtf(fmaxf(1.0f - av * av, 0.f));
                    const float bv = mult * g * XC[tt * 256 + o];
                    const size_t m = (size_t)(m0 + tt);
                    hs = av * hs + bv; Ps *= av;
                    if (smp) { OB[m * DM + 256 + o] = (bf16)f2bf(hs * siluf_(gts[t8])); if (i == seglen - 1) a.out[OUT_LRU_S + (size_t)(l * DB + b0 + seg) * 256 + o] = hs; }
                    else { LA[m * 256 + o] = av; LB[m * 256 + o] = bv; }
                }
              }
            }
            __syncthreads();
        }
        if (!smp && p == 0) { ((float*)(a.ws + WS_LP))[(size_t)(s * 32 + ch) * 256 + o] = Ps; ((float*)(a.ws + WS_LE))[(size_t)(s * 32 + ch) * 256 + o] = hs; }
    }
    __syncthreads();
}

__device__ __forceinline__ void rwkv_prep_item(const Ctx& a, int l, int item, LAS unsigned char* lds, int tid) {
    OPAQUE(tid);
    const bf16* PROJ = (const bf16*)(a.ws + WS_PROJ);
    float* RW = (float*)(a.ws + WS_RW);
    const float* mu = a.inp(I_MU) + l * 1280; const float* sshift = a.inp(I_SSHIFT) + (size_t)l * DB * 1280;
    LAS float* XWA = (LAS float*)lds;
    LAS float* T1 = (LAS float*)(lds + 65536);
    const int m0 = item * 32;
#pragma unroll
    for (int kb = 0; kb < 20; kb += 10) {
        f32x4 pv[10], ppv[10], psv[10];
#pragma unroll
        for (int k = 0; k < 10; ++k) {
            const int idx = tid + NTHREADS * (kb + k), t = idx / 320, c4 = idx % 320, col = 4 * c4, m = m0 + t;
            const bool first = (m < NP) ? ((m & (SEQ - 1)) == 0) : (((m - NP) & 7) == 0);
            const bool fromstate = first && m >= NP;
            pv[k] = ldp4(PROJ + (size_t)m * DIN + OFF_C + col);
            ppv[k] = ldp4(PROJ + (size_t)(first ? m : m - 1) * DIN + OFF_C + col);
            psv[k] = *(const f32x4*)(sshift + (fromstate ? (size_t)((m - NP) >> 3) * 1280 : (size_t)0) + col);
        }
#pragma unroll
        for (int k = 0; k < 10; ++k) {
            const int idx = tid + NTHREADS * (kb + k), t = idx / 320, c4 = idx % 320, col = 4 * c4, m = m0 + t;
            const bool first = (m < NP) ? ((m & (SEQ - 1)) == 0) : (((m - NP) & 7) == 0);
            f32x4 pp = ppv[k];
            if (first && m >= NP) pp = psv[k];
            if (first && m < NP) pp = (f32x4){0.f, 0.f, 0.f, 0.f};
            const f32x4 xm = pv[k] + (pp - pv[k]) * *(const f32x4*)(mu + col);
            const int sec = c4 >> 6, cc = col & 255;
            if (sec == 1) *(LAS f32x4*)(XWA + t * 512 + cc) = xm;
            else if (sec == 4) *(LAS f32x4*)(XWA + t * 512 + 256 + cc) = xm;
            else *(f32x4*)(RW + (size_t)m * 1536 + (sec == 0 ? 0 : (sec == 2 ? 512 : 768)) + cc) = xm;
        }
    }
    __syncthreads();
    if (tid < 128) {
        const int lane = tid & 63, p = tid >> 6, r = lane & 31, hh = lane >> 5;
        const bf16* wt = (const bf16*)(a.ws + WS_W1T) + ((size_t)(l * 2 + p) * 32 + r) * 256 + 8 * hh;
        const LAS float* xr = XWA + r * 512 + p * 256 + 8 * hh;
        f32x16 acc;
#pragma unroll
        for (int e = 0; e < 16; ++e) acc[e] = 0.f;
#pragma unroll
        for (int sx = 0; sx < 16; ++sx) {
            const bf16x8 af = *(const bf16x8*)(wt + 16 * sx);
            const f32x4 x0 = *(const LAS f32x4*)(xr + 16 * sx), x1 = *(const LAS f32x4*)(xr + 16 * sx + 4);
            u32x4 w; w.x = pk2(x0.x, x0.y); w.y = pk2(x0.z, x0.w); w.z = pk2(x1.x, x1.y); w.w = pk2(x1.z, x1.w);
            acc = __builtin_amdgcn_mfma_f32_32x32x16_bf16(af, __builtin_bit_cast(bf16x8, w), acc, 0, 0, 0);
        }
#pragma unroll
        for (int g4 = 0; g4 < 4; ++g4) { f32x4 v = (f32x4){acc[4 * g4], acc[4 * g4 + 1], acc[4 * g4 + 2], acc[4 * g4 + 3]};
            if (p == 0) { v.x = tanhf_(v.x); v.y = tanhf_(v.y); v.z = tanhf_(v.z); v.w = tanhf_(v.w); }
            *(LAS f32x4*)(T1 + r * 64 + p * 32 + 8 * g4 + 4 * hh) = v; }
    }
    __syncthreads();
    {
        const int o = tid & 255, half = tid >> 8;
        float wr[32];
        const float* w2p = (half ? a.inp(I_A2) : a.inp(I_W2)) + (size_t)l * 32 * 256 + o;
#pragma unroll
        for (int j = 0; j < 32; ++j) wr[j] = w2p[(size_t)j * 256];
        const float b0 = (half ? a.inp(I_A0) : a.inp(I_W0))[l * 256 + o];
        const float kkw = a.inp(I_KK)[l * 256 + o], kaw = a.inp(I_KA)[l * 256 + o];
#pragma unroll
        for (int t0 = 0; t0 < 32; t0 += 8) {
            float xk_[8];
            if (half) {
#pragma unroll
                for (int t = 0; t < 8; ++t) xk_[t] = RW[(size_t)(m0 + t0 + t) * 1536 + 512 + o]; }
#pragma unroll
            for (int t8 = 0; t8 < 8; ++t8) {
                const int t = t0 + t8;
                float z0 = b0, z1 = 0.f;
                const LAS float* tp = T1 + t * 64 + half * 32;
#pragma unroll
                for (int j4 = 0; j4 < 8; ++j4) { const f32x4 tv = *(const LAS f32x4*)(tp + 4 * j4);
                    z0 += tv.x * wr[4 * j4] + tv.y * wr[4 * j4 + 1]; z1 += tv.z * wr[4 * j4 + 2] + tv.w * wr[4 * j4 + 3]; }
                const float z = z0 + z1;
                float* rwp = RW + (size_t)(m0 + t) * 1536 + o;
                if (half == 0) {
                    rwp[256] = __builtin_amdgcn_exp2f(-0.8750566294f * sigmoidf_(z));
                } else {
                    const float aa = sigmoidf_(z);
                    const float xk = xk_[t8];
                    const float kkv = xk * kkw;
                    const float ss = wave_sum_fast(kkv * kkv);
                    const float kkn = kkv * __builtin_amdgcn_rsqf(fmaxf(ss, 1e-24f));
                    rwp[512] = xk * (1.0f + (aa - 1.0f) * kaw); rwp[1024] = -kkn; rwp[1280] = kkn * aa;
                }
            }
        }
    }
    __syncthreads();
}

__device__ __forceinline__ void s5_disc(const Ctx& a, int l, int g, int n, float& ab_re, float& ab_im, float& f_re, float& f_im) {
    const f32x4 t = *(const f32x4*)((const float*)(a.ws + WS_S5T) + ((size_t)(l * 16 + g) * 64 + n) * 4);
    ab_re = t.x; ab_im = t.y; f_re = t.z; f_im = t.w;
}
__device__ __forceinline__ void s5_disc_compute(const Ctx& a, int l, int g, int n, float& ab_re, float& ab_im, float& f_re, float& f_im) {
    const float lr = a.inp(I_LRE)[(l * 16 + g) * 64 + n], li = a.inp(I_LIM)[(l * 16 + g) * 64 + n];
    const float dt = expf(a.inp(I_LOGDT)[l * 16 + g]);
    const float mag = expf(lr * dt);
    ab_re = mag * cosf(li * dt); ab_im = mag * sinf(li * dt);
    const float den = lr * lr + li * li, pr = ab_re - 1.0f;
    f_re = (pr * lr + ab_im * li) / den; f_im = (ab_im * lr - pr * li) / den;
}
struct S5Par { float ab_re, ab_im; bf16x8 bf[4]; };
__device__ __forceinline__ void s5_params(const Ctx& a, int l, int g, int lane, S5Par& P) {
    float fr, fi;
    s5_disc(a, l, g, lane, P.ab_re, P.ab_im, fr, fi);
    const int r = lane & 31, hh = lane >> 5;
#pragma unroll
    for (int nh = 0; nh < 2; ++nh) {
        float xr, xi, f_re, f_im;
        s5_disc(a, l, g, 32 * nh + r, xr, xi, f_re, f_im);
        const float* brp = a.inp(I_BRE) + ((size_t)(l * 16 + g) * 64 + 32 * nh + r) * 16 + 8 * hh; const float* bip = a.inp(I_BIM) + ((size_t)(l * 16 + g) * 64 + 32 * nh + r) * 16 + 8 * hh;
        const f32x4 r0 = *(const f32x4*)brp, r1 = *(const f32x4*)(brp + 4), i0 = *(const f32x4*)bip, i1 = *(const f32x4*)(bip + 4);
        u32x4 wr, wi;
        wr.x = pk2(f_re * r0.x - f_im * i0.x, f_re * r0.y - f_im * i0.y); wr.y = pk2(f_re * r0.z - f_im * i0.z, f_re * r0.w - f_im * i0.w);
        wr.z = pk2(f_re * r1.x - f_im * i1.x, f_re * r1.y - f_im * i1.y); wr.w = pk2(f_re * r1.z - f_im * i1.z, f_re * r1.w - f_im * i1.w);
        wi.x = pk2(f_re * i0.x + f_im * r0.x, f_re * i0.y + f_im * r0.y); wi.y = pk2(f_re * i0.z + f_im * r0.z, f_re * i0.w + f_im * r0.w);
        wi.z = pk2(f_re * i1.x + f_im * r1.x, f_re * i1.y + f_im * r1.y); wi.w = pk2(f_re * i1.z + f_im * r1.z, f_re * i1.w + f_im * r1.w);
        P.bf[nh] = __builtin_bit_cast(bf16x8, wr); P.bf[2 + nh] = __builtin_bit_cast(bf16x8, wi);
    }
}
__device__ __forceinline__ void s5_bu_block(const S5Par& P, const bf16* PROJ, size_t m0, int nvalid, int g, LAS float* HR, LAS float* HI, int lane) {
    const int r = lane & 31, hh = lane >> 5;
    const int tr = r < nvalid ? r : nvalid - 1;
    const bf16x8 uf = *(const bf16x8*)(PROJ + (m0 + tr) * DIN + OFF_D + g * 16 + 8 * hh);
#pragma unroll
    for (int tile = 0; tile < 4; ++tile) {
        f32x16 acc;
#pragma unroll
        for (int e = 0; e < 16; ++e) acc[e] = 0.f;
        acc = __builtin_amdgcn_mfma_f32_32x32x16_bf16(P.bf[tile], uf, acc, 0, 0, 0);
        LAS float* dst = ((tile >> 1) ? HI : HR) + r * 68 + 32 * (tile & 1) + 4 * hh;
#pragma unroll
        for (int g4 = 0; g4 < 4; ++g4) *(LAS f32x4*)(dst + 8 * g4) = (f32x4){acc[4 * g4], acc[4 * g4 + 1], acc[4 * g4 + 2], acc[4 * g4 + 3]};
    }
    asm volatile("s_waitcnt lgkmcnt(0)" ::: "memory");
}
__device__ __forceinline__ void s5_pass1_wave(const Ctx& a, int l, int wi, LAS unsigned char* wlds, int lane) {
    OPAQUE(lane);
    const int ck = wi & 15, g = (wi >> 4) & 15, s = wi >> 8;
    const bf16* PROJ = (const bf16*)(a.ws + WS_PROJ);
    LAS float* HR = (LAS float*)wlds; LAS float* HI = HR + 32 * 68;
    S5Par P; s5_params(a, l, g, lane, P);
    float hr = 0.f, hi = 0.f;
    for (int t0 = 0; t0 < 128; t0 += 32) {
        s5_bu_block(P, PROJ, (size_t)(s * SEQ + ck * 128 + t0), 32, g, HR, HI, lane);
#pragma unroll 8
        for (int t = 0; t < 32; ++t) { const float br = HR[t * 68 + lane], bi = HI[t * 68 + lane];
            const float nr = P.ab_re * hr - P.ab_im * hi + br, ni = P.ab_re * hi + P.ab_im * hr + bi; hr = nr; hi = ni; }
        asm volatile("s_waitcnt lgkmcnt(0)" ::: "memory");
    }
    f32x2* E = (f32x2*)(a.ws + WS_S5E);
    E[((size_t)(s * 16 + g) * 16 + ck) * 64 + lane] = (f32x2){hr, hi};
}

__device__ __forceinline__ void attn_prep_rows_wave(const Ctx& a, int wi, int lane) {
    OPAQUE(lane);
    const bf16* PROJ = (const bf16*)(a.ws + WS_PROJ);
    bf16* QB = (bf16*)(a.ws + WS_QB);
#pragma unroll
    for (int r = 0; r < 8; ++r) { const size_t m = (size_t)wi * 8 + r;
        const f32x4 q = ldp4(PROJ + m * DIN + OFF_AQ + 4 * lane);
        u32x2 qo; qo.x = pk2(q.x * QSCALE, q.y * QSCALE); qo.y = pk2(q.z * QSCALE, q.w * QSCALE);
        *(u32x2*)(QB + m * 256 + 4 * lane) = qo; }
}
__device__ __forceinline__ void attn_prep_kv_wave(const Ctx& a, int wi, int lane) {
    OPAQUE(lane);
    const bf16* PROJ = (const bf16*)(a.ws + WS_PROJ);
    bf16* KF = (bf16*)(a.ws + WS_KB); bf16* VF = (bf16*)(a.ws + WS_VT);
    const int kt = wi & 63, b = wi >> 6, r = lane & 31, hh = lane >> 5;
    const bf16* krow = PROJ + (size_t)(b * SEQ + kt * 32 + r) * DIN + OFF_AK + 8 * hh;
    const bf16* vcol = PROJ + (size_t)(b * SEQ + kt * 32 + 4 * hh) * DIN + OFF_AV + r;
#pragma unroll
    for (int h = 0; h < 4; ++h) {
#pragma unroll
        for (int cs = 0; cs < 4; ++cs) {
            const u32x4 ko = *(const u32x4*)(krow + h * 64 + cs * 16);
            const size_t frag = ((size_t)((b * 4 + h) * 64 + kt) * 4 + cs) * 512 + lane * 8;
            *(u32x4*)(KF + frag) = ko;
            const int tl = cs >> 1, s2 = cs & 1;
            const bf16* vp = vcol + (size_t)(16 * s2) * DIN + h * 64 + 32 * tl;
            unsigned v[8];
#pragma unroll
            for (int jj = 0; jj < 8; ++jj) v[jj] = (unsigned)vp[(size_t)(8 * (jj >> 2) + (jj & 3)) * DIN];
            u32x4 vo; vo.x = v[0] | (v[1] << 16); vo.y = v[2] | (v[3] << 16); vo.z = v[4] | (v[5] << 16); vo.w = v[6] | (v[7] << 16);
            *(u32x4*)(VF + frag) = vo;
        }
    }
}

#ifndef MP_MASK
#define MP_MASK 0x1f
#endif
#ifndef MM_MASK
#define MM_MASK 0x7f
#endif
#define MPE(j) ((MP_MASK >> (j)) & 1)
#define MME(j) ((MM_MASK >> (j)) & 1)
constexpr int MP_LRU = 256 + 32, MP_RW = MTOK / 32, MP_S5 = 256  , MP_AR = 256  , MP_VT = 64  ;
constexpr int MP_TOTAL = MP_LRU + MP_RW + MP_S5 + MP_AR + MP_VT;
__device__ __forceinline__ int grab_unit(unsigned* ctr, volatile LAS unsigned* MISC, int tid) {
    __syncthreads();
    if (tid == 0) MISC[4] = atomicAdd(ctr, 1u);
    __syncthreads();
    return (int)MISC[4];
}
__device__ __forceinline__ void ph_mixprep(const Ctx& a, int lq, int MMSK, LAS unsigned char* lds, volatile LAS unsigned* MISC, int tid, int lane, int wave) {
    const int l = lq & 1;
    unsigned* qctr = (unsigned*)(a.ws + WS_CTL) + CW_QUEUE + 4096 + 512 * lq;
    int u;
    if (MMSK & 1) while ((u = grab_unit(qctr + 0 * 64, MISC, tid)) < MP_LRU) lru_prep_item(a, l, u, lds, tid);
    if (MMSK & 2) while ((u = grab_unit(qctr + 1 * 64, MISC, tid)) < MP_RW) rwkv_prep_item(a, l, u, lds, tid);
    if (MMSK & 4) while ((u = grab_unit(qctr + 2 * 64, MISC, tid)) < MP_S5) s5_pass1_wave(a, l, u * 8 + wave, lds + wave * 17408, lane);
    if (MMSK & 8) while ((u = grab_unit(qctr + 3 * 64, MISC, tid)) < MP_AR) attn_prep_rows_wave(a, u * 8 + wave, lane);
    if (MMSK & 16) while ((u = grab_unit(qctr + 4 * 64, MISC, tid)) < MP_VT) attn_prep_kv_wave(a, u * 8 + wave, lane);
    {
        const bf16* PROJ = (const bf16*)(a.ws + WS_PROJ);
        const int gt = blockIdx.x * NTHREADS + tid, NGT = gridDim.x * NTHREADS;
        for (int idx = gt; idx < 136 * 1280; idx += NGT) {
            const int q = idx / 1280, c = idx % 1280;
            if (q < 8) a.out[OUT_SHIFT_P + (size_t)(l * 8 + q) * 1280 + c] = ldp1(PROJ + (size_t)(q * SEQ + SEQ - 1) * DIN + OFF_C + c);
            else a.out[OUT_SHIFT_S + (size_t)(l * DB + (q - 8)) * 1280 + c] = ldp1(PROJ + (size_t)(NP + (q - 8) * 8 + 7) * DIN + OFF_C + c);
        }
    }
}

struct RwOps { f32x2 w[4], k[4], a[4], b[4], r[4]; float vi; };
__device__ __forceinline__ void rw_ld4(f32x2 (&d)[4], const LAS float* p) { const f32x4 x = *(const LAS f32x4*)p, y = *(const LAS f32x4*)(p + 4);
    d[0] = (f32x2){x.x, x.y}; d[1] = (f32x2){x.z, x.w}; d[2] = (f32x2){y.x, y.y}; d[3] = (f32x2){y.z, y.w}; }
template <int MODE> __device__ __forceinline__ void rw_load_ops(RwOps& o, const LAS float* base, int i, int jq) {
    rw_ld4(o.w, base + 64 + 8 * jq); rw_ld4(o.k, base + 128 + 8 * jq);
    o.vi = base[192 + i];
    rw_ld4(o.a, base + 256 + 8 * jq); rw_ld4(o.b, base + 320 + 8 * jq);
    if (MODE == 0) rw_ld4(o.r, base + 8 * jq);
}
__device__ __forceinline__ float rw_dot(const f32x2 (&S)[4], const f32x2 (&v)[4]) {
    const f32x2 d0 = S[0] * v[0] + S[1] * v[1], d1 = S[2] * v[2] + S[3] * v[3];
    const f32x2 d = d0 + d1;
    return d.x + d.y;
}
template <int MODE> __device__ __forceinline__ void rw_step(const RwOps& o, f32x2 (&S)[4], f32x2 (&Pm)[4], LAS float* yslot, int jq) {
    const float sa = red8(rw_dot(S, o.a));
    const f32x2 sa2 = (f32x2){sa, sa}, vi2 = (f32x2){o.vi, o.vi};
#pragma unroll
    for (int k = 0; k < 4; ++k) S[k] = (S[k] * o.w[k] + vi2 * o.k[k]) + sa2 * o.b[k];
    if (MODE == 0) {
        const float y = red8(rw_dot(S, o.r));
        if (jq == 0) *yslot = y;
    } else {
        const float sp = red8(rw_dot(Pm, o.a));
        const f32x2 sp2 = (f32x2){sp, sp};
#pragma unroll
        for (int k = 0; k < 4; ++k) Pm[k] = Pm[k] * o.w[k] + sp2 * o.b[k];
    }
}
template <int MODE, int TT>
__device__ __forceinline__ void rwkv_core(const Ctx& a, int l, int h, int mbase, int T, float (&S8)[8], float (&P8)[8], LAS unsigned char* lds, int tid) {
    f32x2 S[4], Pm[4];
#pragma unroll
    for (int k = 0; k < 4; ++k) { S[k] = (f32x2){S8[2 * k], S8[2 * k + 1]}; Pm[k] = (f32x2){P8[2 * k], P8[2 * k + 1]}; }
    const float* RW = (const float*)(a.ws + WS_RW);
    const f32x4 rk4 = *(const f32x4*)(a.inp(I_RK) + l * 256 + h * 64 + 4 * (tid & 15));
    bf16* OB = (bf16*)(a.ws + WS_OB); const bf16* PROJ = (const bf16*)(a.ws + WS_PROJ);
    LAS float* RWT = (LAS float*)lds;
    LAS float* Y = (LAS float*)(lds + 49152);
    const int i = tid >> 3, jq = tid & 7;
    f32x4 pre[6];
#define RW_LOAD(tile) do { _Pragma("unroll") for (int k = 0; k < 6; ++k) { const int idx = tid + NTHREADS * k; \
        if (idx < TT * 96) { const int t = idx / 96, rem = idx % 96, sec = rem >> 4, c4 = rem & 15; \
            pre[k] = *(const f32x4*)(RW + (size_t)(mbase + (tile) * TT + t) * 1536 + sec * 256 + h * 64 + 4 * c4); } } } while (0)
#define RW_STORE() do { _Pragma("unroll") for (int k = 0; k < 6; ++k) { const int idx = tid + NTHREADS * k; \
        if (idx < TT * 96) *(LAS f32x4*)(RWT + idx * 4) = pre[k]; } } while (0)
    const int ntile = T / TT;
    const int gt_t = tid >> 4, gt_q = tid & 15;
    f32x4 gn_w = (f32x4){0.f, 0.f, 0.f, 0.f}, gn_b = gn_w, gpre = gn_w;
    if (MODE == 0) { gn_w = *(const f32x4*)(a.inp(I_GNW) + l * 256 + h * 64 + 4 * gt_q); gn_b = *(const f32x4*)(a.inp(I_GNB) + l * 256 + h * 64 + 4 * gt_q); }
    RW_LOAD(0);
    __syncthreads();
    RW_STORE();
    __syncthreads();
    for (int tile = 0; tile < ntile; ++tile) {
        if (tile + 1 < ntile) RW_LOAD(tile + 1);
        if (MODE == 0 && gt_t < TT) gpre = ldp4(PROJ + (size_t)(mbase + tile * TT + gt_t) * DIN + OFF_G + 512 + h * 64 + 4 * gt_q);
        {
            RwOps oa, ob;
            rw_load_ops<MODE>(oa, RWT, i, jq);
            for (int t = 0; t < TT; t += 2) {
                rw_load_ops<MODE>(ob, RWT + (t + 1) * 384, i, jq);
                rw_step<MODE>(oa, S, Pm, Y + t * 64 + i, jq);
                rw_load_ops<MODE>(oa, RWT + (t + 2) * 384, i, jq);
                rw_step<MODE>(ob, S, Pm, Y + (t + 1) * 64 + i, jq);
            }
        }
        __syncthreads();
        if (MODE == 0) {
            const int t = tid >> 4, q = tid & 15;
            if (t < TT) {
                const f32x4 yv = *(const LAS f32x4*)(Y + t * 64 + 4 * q);
                const float mean = red16((yv.x + yv.y) + (yv.z + yv.w)) * (1.f / 64.f);
                const f32x4 dv = yv - mean;
                const float rs = rsqrtf(red16((dv.x * dv.x + dv.y * dv.y) + (dv.z * dv.z + dv.w * dv.w)) * (1.f / 64.f) + 64.0f * 1e-5f);
                const int m = mbase + tile * TT + t;
                const f32x4 gw = gn_w, gb = gn_b;
                const f32x4 vv = *(const LAS f32x4*)(RWT + t * 384 + 192 + 4 * q);
                const f32x4 r4 = *(const LAS f32x4*)(RWT + t * 384 + 4 * q), k4 = *(const LAS f32x4*)(RWT + t * 384 + 128 + 4 * q);
                const float bon = red16((r4.x * k4.x * rk4.x + r4.y * k4.y * rk4.y) + (r4.z * k4.z * rk4.z + r4.w * k4.w * rk4.w));
                const f32x4 o = dv * rs * gw + gb + bon * vv;
                const f32x4 gt = gpre;
                u32x2 ow; ow.x = pk2(o.x * siluf_(gt.x), o.y * siluf_(gt.y)); ow.y = pk2(o.z * siluf_(gt.z), o.w * siluf_(gt.w));
                *(u32x2*)(OB + (size_t)m * DM + 512 + h * 64 + 4 * q) = ow;
            }
            __syncthreads();
        }
        if (tile + 1 < ntile) { RW_STORE(); }
        __syncthreads();
    }
#undef RW_LOAD
#undef RW_STORE
#pragma unroll
    for (int k = 0; k < 4; ++k) { S8[2 * k] = S[k].x; S8[2 * k + 1] = S[k].y; P8[2 * k] = Pm[k].x; P8[2 * k + 1] = Pm[k].y; }
}
__device__ __forceinline__ void st8(float* dst, const float (&S)[8]) { *(f32x4*)dst = (f32x4){S[0], S[1], S[2], S[3]}; *(f32x4*)(dst + 4) = (f32x4){S[4], S[5], S[6], S[7]}; }
__device__ __forceinline__ void ld8(const float* src, float (&S)[8]) { const f32x4 s0 = *(const f32x4*)src, s1 = *(const f32x4*)(src + 4);
    S[0] = s0.x; S[1] = s0.y; S[2] = s0.z; S[3] = s0.w; S[4] = s1.x; S[5] = s1.y; S[6] = s1.z; S[7] = s1.w; }
__device__ __forceinline__ void rwkv_sample_unit(const Ctx& a, int l, int b, int h, LAS unsigned char* lds, int tid) {
    OPAQUE(tid);
    const int i = tid >> 3, jq = tid & 7;
    float S[8], D[8];
    ld8(a.inp(I_SWKV) + (((size_t)(l * DB + b) * 4 + h) * 64 + i) * 64 + 8 * jq, S);
    rwkv_core<0, 8>(a, l, h, NP + b * DS, DS, S, D, lds, tid);
    st8(a.out + OUT_WKV_S + (((size_t)(l * DB + b) * 4 + h) * 64 + i) * 64 + 8 * jq, S);
}
__device__ __forceinline__ void rwkv_prompt_unitA(const Ctx& a, int l, int u, LAS unsigned char* lds, int tid) {
    OPAQUE(tid);
    const int c = u & 7, h = (u >> 3) & 3, s = u >> 5;
    if (c == 7) return;
    const int i = tid >> 3, jq = tid & 7;
    float* pz = (float*)(a.ws + WS_PZ) + ((size_t)((s * 4 + h) * 8 + c) * 2) * 4096 + i * 64 + 8 * jq;
    float S[8], Pm[8];
#pragma unroll
    for (int e = 0; e < 8; ++e) { S[e] = 0.f; Pm[e] = (8 * jq + e == i) ? 1.f : 0.f; }
    if (c == 0) { rwkv_core<0, 32>(a, l, h, s * SEQ, 256, S, Pm, lds, tid); st8(pz + 4096, S); }
    else { rwkv_core<1, 32>(a, l, h, s * SEQ + c * 256, 256, S, Pm, lds, tid); st8(pz, Pm); st8(pz + 4096, S); }
}
__device__ __forceinline__ void rwkv_prompt_unitB(const Ctx& a, int l, int u, LAS unsigned char* lds, int tid) {
    OPAQUE(tid);
    const int c = 7 - (u >> 5), sh = u & 31, s = sh >> 2, h = sh & 3;
    const int i = tid >> 3, jq = tid & 7;
    const float* pzb = (const float*)(a.ws + WS_PZ) + ((size_t)(sh * 8) * 2) * 4096;
    LAS float* SL = (LAS float*)lds;
    LAS float* PL = (LAS float*)(lds + 17408);
    float S[8], Z[8];
    ld8(pzb + 4096 + i * 64 + 8 * jq, S);
    {
        f32x4 pp[6][2]; float ZZ[6][8];
#pragma unroll
        for (int cp = 1; cp <= 6; ++cp) if (cp < c) { const float* pg = pzb + (size_t)cp * 8192;
            pp[cp - 1][0] = *(const f32x4*)(pg + tid * 4); pp[cp - 1][1] = *(const f32x4*)(pg + (tid + NTHREADS) * 4); ld8(pg + 4096 + i * 64 + 8 * jq, ZZ[cp - 1]); }
        __syncthreads();
#pragma unroll
        for (int cp = 1; cp <= 6; ++cp) if (cp < c) { *(LAS f32x4*)(PL + (cp - 1) * 4096 + tid * 4) = pp[cp - 1][0]; *(LAS f32x4*)(PL + (cp - 1) * 4096 + (tid + NTHREADS) * 4) = pp[cp - 1][1]; }
#pragma unroll
        for (int cp = 1; cp <= 6; ++cp) if (cp < c) {
            __syncthreads();
            *(LAS f32x4*)(SL + i * 68 + 8 * jq) = (f32x4){S[0], S[1], S[2], S[3]}; *(LAS f32x4*)(SL + i * 68 + 8 * jq + 4) = (f32x4){S[4], S[5], S[6], S[7]};
            __syncthreads();
            const LAS float* PLc = PL + (cp - 1) * 4096;
#pragma unroll
            for (int e = 0; e < 8; ++e) Z[e] = ZZ[cp - 1][e];
#pragma unroll 4
            for (int k4 = 0; k4 < 16; ++k4) {
                const f32x4 sv = *(const LAS f32x4*)(SL + i * 68 + 4 * k4);
#pragma unroll
                for (int kk = 0; kk < 4; ++kk) { const f32x4 q0 = *(const LAS f32x4*)(PLc + (4 * k4 + kk) * 64 + 8 * jq), q1 = *(const LAS f32x4*)(PLc + (4 * k4 + kk) * 64 + 8 * jq + 4);
                    const float x = sv[kk];
                    Z[0] += x * q0.x; Z[1] += x * q0.y; Z[2] += x * q0.z; Z[3] += x * q0.w; Z[4] += x * q1.x; Z[5] += x * q1.y; Z[6] += x * q1.z; Z[7] += x * q1.w; }
            }
#pragma unroll
            for (int e = 0; e < 8; ++e) S[e] = Z[e];
        }
    }
    rwkv_core<0, 32>(a, l, h, s * SEQ + c * 256, 256, S, Z, lds, tid);
    if (c == 7) st8(a.out + OUT_WKV_P + (((size_t)(l * 8 + s) * 4 + h) * 64 + i) * 64 + 8 * jq, S);
}

__device__ __forceinline__ void lru_pass2_wave(const Ctx& a, int l, int wi, int lane) {
    OPAQUE(lane);
    const int q = wi & 3, ch = (wi >> 2) & 31, s = wi >> 7;
    const int o = q * 64 + lane;
    const float* LA = (const float*)(a.ws + WS_LA); const float* LB = (const float*)(a.ws + WS_LB);
    const float* LP = (const float*)(a.ws + WS_LP); const float* LE = (const float*)(a.ws + WS_LE);
    bf16* OB = (bf16*)(a.ws + WS_OB); const bf16* PROJ = (const bf16*)(a.ws + WS_PROJ);
    float h = 0.f;
#pragma unroll 8
    for (int c = 0; c < ch; ++c) h = LP[(size_t)(s * 32 + c) * 256 + o] * h + LE[(size_t)(s * 32 + c) * 256 + o];
    const size_t m0 = (size_t)s * SEQ + ch * 64;
#pragma unroll
    for (int i0 = 0; i0 < 64; i0 += 32) {
        float av[32], bv[32], gv[32];
#pragma unroll
        for (int i = 0; i < 32; ++i) { av[i] = LA[(m0 + i0 + i) * 256 + o]; bv[i] = LB[(m0 + i0 + i) * 256 + o]; gv[i] = ldp1(PROJ + (m0 + i0 + i) * DIN + OFF_G + 256 + o); }
#pragma unroll
        for (int i = 0; i < 32; ++i) { h = av[i] * h + bv[i]; OB[(m0 + i0 + i) * DM + 256 + o] = (bf16)f2bf(h * siluf_(gv[i])); }
    }
    if (ch == 31) a.out[OUT_LRU_P + (size_t)(l * 8 + s) * 256 + o] = h;
}

__device__ __forceinline__ float gelu_tanh(float y) { return 0.5f * y * (1.0f + tanhf_(0.7978845608028654f * (y + 0.044715f * y * y * y))); }
__device__ __forceinline__ void s5_pass2_wave(const Ctx& a, int l, bool smp, int wi, LAS unsigned char* wlds, int lane) {
    OPAQUE(lane);
    const bf16* PROJ = (const bf16*)(a.ws + WS_PROJ);
    bf16* ZB = (bf16*)(a.ws + WS_ZB);
    LAS float* HR = (LAS float*)wlds;
    LAS float* HI = HR + 32 * 68;
    int g, mbase, T, ck = 0, sq;
    if (smp) { g = wi & 15; sq = wi >> 4; mbase = NP + sq * DS; T = DS; }
    else { ck = wi & 15; g = (wi >> 4) & 15; sq = wi >> 8; mbase = sq * SEQ + ck * 128; T = 128; }
    S5Par P; s5_params(a, l, g, lane, P);
    float hr, hi;
    if (smp) { const f32x2 v = *(const f32x2*)(a.inp(I_SSSM) + (((size_t)(l * DB + sq) * 16 + g) * 64 + lane) * 2); hr = v.x; hi = v.y; }
    else {
        float pr = P.ab_re, pi = P.ab_im;
#pragma unroll
        for (int k = 0; k < 7; ++k) { const float nr = pr * pr - pi * pi, ni = 2.0f * pr * pi; pr = nr; pi = ni; }
        hr = 0.f; hi = 0.f;
        const f32x2* E = (const f32x2*)(a.ws + WS_S5E) + ((size_t)(sq * 16 + g) * 16) * 64 + lane;
        for (int c = 0; c < ck; ++c) { const f32x2 e = E[(size_t)c * 64]; const float nr = pr * hr - pi * hi + e.x, ni = pr * hi + pi * hr + e.y; hr = nr; hi = ni; }
    }
    const int cc = lane & 15, kq = lane >> 4;
    bf16x8 cf[4];
    {
        const float* crp = a.inp(I_CRE) + ((size_t)(l * 16 + g) * 16 + cc) * 64 + 8 * kq; const float* cip = a.inp(I_CIM) + ((size_t)(l * 16 + g) * 16 + cc) * 64 + 8 * kq;
#pragma unroll
        for (int ks = 0; ks < 4; ++ks) { const float* p = (ks < 2 ? crp : cip) + 32 * (ks & 1); const float sg = ks < 2 ? 1.f : -1.f;
            const f32x4 x0 = *(const f32x4*)p, x1 = *(const f32x4*)(p + 4);
            u32x4 w; w.x = pk2(sg * x0.x, sg * x0.y); w.y = pk2(sg * x0.z, sg * x0.w); w.z = pk2(sg * x1.x, sg * x1.y); w.w = pk2(sg * x1.z, sg * x1.w); cf[ks] = __builtin_bit_cast(bf16x8, w); }
    }
    const f32x4 dd4 = *(const f32x4*)(a.inp(I_S5D) + l * 256 + g * 16 + 4 * kq);
    for (int t0 = 0; t0 < T; t0 += 32) {
        const int nt = (T - t0) < 32 ? (T - t0) : 32;
        s5_bu_block(P, PROJ, (size_t)(mbase + t0), nt, g, HR, HI, lane);
        for (int t = 0; t < nt; ++t) { const float br = HR[t * 68 + lane], bi = HI[t * 68 + lane];
            const float nr = P.ab_re * hr - P.ab_im * hi + br, ni = P.ab_re * hi + P.ab_im * hr + bi; hr = nr; hi = ni;
            HR[t * 68 + lane] = hr; HI[t * 68 + lane] = hi; }
        asm volatile("s_waitcnt lgkmcnt(0)" ::: "memory");
#pragma unroll
        for (int tt = 0; tt < 2; ++tt) {
            if (tt * 16 < nt) {
                f32x4 acc = (f32x4){0.f, 0.f, 0.f, 0.f};
#pragma unroll
                for (int ks = 0; ks < 4; ++ks) { const LAS float* hp = (ks < 2 ? HR : HI) + (tt * 16 + cc) * 68 + 32 * (ks & 1) + 8 * kq;
                    const f32x4 x0 = *(const LAS f32x4*)hp, x1 = *(const LAS f32x4*)(hp + 4);
                    u32x4 w; w.x = pk2(x0.x, x0.y); w.y = pk2(x0.z, x0.w); w.z = pk2(x1.x, x1.y); w.w = pk2(x1.z, x1.w);
                    acc = __builtin_amdgcn_mfma_f32_16x16x32_bf16(cf[ks], __builtin_bit_cast(bf16x8, w), acc, 0, 0, 0); }
                const int t = tt * 16 + cc;
                if (t < nt) { const size_t m = (size_t)(mbase + t0 + t);
                    const f32x4 u4 = ldp4(PROJ + m * DIN + OFF_D + g * 16 + 4 * kq);
                    u32x2 zz; zz.x = pk2(gelu_tanh(acc.x + dd4.x * u4.x), gelu_tanh(acc.y + dd4.y * u4.y)); zz.y = pk2(gelu_tanh(acc.z + dd4.z * u4.z), gelu_tanh(acc.w + dd4.w * u4.w));
                    *(u32x2*)(ZB + m * 256 + g * 16 + 4 * kq) = zz; }
            }
        }
        asm volatile("s_waitcnt lgkmcnt(0)" ::: "memory");
    }
    if (smp) *(f32x2*)(a.out + OUT_SSM_S + (((size_t)(l * DB + sq) * 16 + g) * 64 + lane) * 2) = (f32x2){hr, hi};
    else if (ck == 15) *(f32x2*)(a.out + OUT_SSM_P + (((size_t)(l * 8 + sq) * 16 + g) * 64 + lane) * 2) = (f32x2){hr, hi};
}

__device__ __forceinline__ bf16x8 pack8(const f32x16& p, int s) {
    u32x4 w; w.x = pk2(p[8 * s + 0], p[8 * s + 1]); w.y = pk2(p[8 * s + 2], p[8 * s + 3]); w.z = pk2(p[8 * s + 4], p[8 * s + 5]); w.w = pk2(p[8 * s + 6], p[8 * s + 7]);
    return __builtin_bit_cast(bf16x8, w);
}
__device__ __forceinline__ void attn_load4(const bf16* F, size_t fragbase, bf16x8 (&f)[4]) {
#pragma unroll
    for (int cs = 0; cs < 4; ++cs) f[cs] = *(const bf16x8*)(F + fragbase + cs * 512);
}
__device__ __forceinline__ void attn_tile(const bf16x8 (&qf)[2][2], const bf16x8 (&kf)[4], const bf16x8 (&vf)[4], f32x16 (&o)[2][2], float (&mrun)[2], float (&lrun)[2], bool diag, int r, int hh) {
    bf16x8 pf[2][2];
#pragma unroll
    for (int c = 0; c < 2; ++c) {
        f32x16 st;
#pragma unroll
        for (int e = 0; e < 16; ++e) st[e] = 0.f;
        __builtin_amdgcn_s_setprio(1);
        st = __builtin_amdgcn_mfma_f32_32x32x16_bf16(kf[c * 2 + 0], qf[c][0], st, 0, 0, 0);
        st = __builtin_amdgcn_mfma_f32_32x32x16_bf16(kf[c * 2 + 1], qf[c][1], st, 0, 0, 0);
        __builtin_amdgcn_s_setprio(0);
        if (diag) {
#pragma unroll
            for (int e = 0; e < 16; ++e) { const int key = (e & 3) + 8 * (e >> 2) + 4 * hh; if (key > r) st[e] = -1e30f; }
        }
        float mx = st[0];
#pragma unroll
        for (int e = 1; e < 16; ++e) mx = fmaxf(mx, st[e]);
        mx = fmaxf(mx, __shfl_xor(mx, 32));
        const bool upd = mx > mrun[c] + 8.0f;
        if (__any(upd)) {
            const float mnew = upd ? mx : mrun[c];
            const float corr = __builtin_amdgcn_exp2f(mrun[c] - mnew);
            lrun[c] *= corr; mrun[c] = mnew;
#pragma unroll
            for (int tl = 0; tl < 2; ++tl)
#pragma unroll
                for (int e = 0; e < 16; ++e) o[c][tl][e] *= corr;
        }
        float ps = 0.f;
        const float mcur = mrun[c];
#pragma unroll
        for (int e = 0; e < 16; ++e) { st[e] = __builtin_amdgcn_exp2f(st[e] - mcur); ps += st[e]; }
        lrun[c] += ps;
        pf[c][0] = pack8(st, 0); pf[c][1] = pack8(st, 1);
    }
    __builtin_amdgcn_s_setprio(1);
#pragma unroll
    for (int c = 0; c < 2; ++c)
#pragma unroll
        for (int tl = 0; tl < 2; ++tl) {
            o[c][tl] = __builtin_amdgcn_mfma_f32_32x32x16_bf16(vf[tl * 2 + 0], pf[c][0], o[c][tl], 0, 0, 0);
            o[c][tl] = __builtin_amdgcn_mfma_f32_32x32x16_bf16(vf[tl * 2 + 1], pf[c][1], o[c][tl], 0, 0, 0);
        }
    __builtin_amdgcn_s_setprio(0);
}
__device__ __forceinline__ void attn_prompt_wave(const Ctx& a, int l, int b, int h, int qt, float lam, int lane) {
    OPAQUE(lane);
    const bf16* QB = (const bf16*)(a.ws + WS_QB); const bf16* KF = (const bf16*)(a.ws + WS_KB); const bf16* VF = (const bf16*)(a.ws + WS_VT);
    bf16* OB = (bf16*)(a.ws + WS_OB); const bf16* PROJ = (const bf16*)(a.ws + WS_PROJ);
    const int r = lane & 31, hh = lane >> 5;
    const size_t mq = (size_t)b * SEQ + qt * 32 + r;
    bf16x8 qf[2][2];
#pragma unroll
    for (int c = 0; c < 2; ++c)
#pragma unroll
        for (int s = 0; s < 2; ++s) qf[c][s] = *(const bf16x8*)(QB + mq * 256 + h * 64 + c * 32 + 16 * s + 8 * hh);
    f32x16 o[2][2];
#pragma unroll
    for (int c = 0; c < 2; ++c)
#pragma unroll
        for (int tl = 0; tl < 2; ++tl)
#pragma unroll
            for (int e = 0; e < 16; ++e) o[c][tl][e] = 0.f;
    float mrun[2] = {-1e30f, -1e30f}, lrun[2] = {0.f, 0.f};
    const size_t fb0 = ((size_t)((b * 4 + h) * 64) * 4) * 512 + lane * 8;
    bf16x8 kA[4], kB[4], vv[4];
    attn_load4(KF, fb0, kA);
    int kt = 0;
    for (; kt + 1 <= qt; kt += 2) {
        attn_load4(VF, fb0 + (size_t)kt * 2048, vv);
        attn_load4(KF, fb0 + (size_t)(kt + 1) * 2048, kB);
        attn_tile(qf, kA, vv, o, mrun, lrun, false, r, hh);
        attn_load4(VF, fb0 + (size_t)(kt + 1) * 2048, vv);
        if (kt + 2 <= qt) attn_load4(KF, fb0 + (size_t)(kt + 2) * 2048, kA);
        attn_tile(qf, kB, vv, o, mrun, lrun, kt + 1 == qt, r, hh);
    }
    if (kt == qt) { attn_load4(VF, fb0 + (size_t)kt * 2048, vv); attn_tile(qf, kA, vv, o, mrun, lrun, true, r, hh); }
    const float l0 = lrun[0] + __shfl_xor(lrun[0], 32), l1 = lrun[1] + __shfl_xor(lrun[1], 32);
    const float i0 = 1.0f / l0, i1 = lam / l1;
    float ss = 0.f;
    f32x16 res[2];
#pragma unroll
    for (int tl = 0; tl < 2; ++tl)
#pragma unroll
        for (int e = 0; e < 16; ++e) { const float v = o[0][tl][e] * i0 - o[1][tl][e] * i1; res[tl][e] = v; ss += v * v; }
    ss += __shfl_xor(ss, 32);
    const float rs = rsqrtf(ss * (1.f / 64.f) + NORM_EPS) * (1.0f - lam_init_of(l));
    const float* sw = a.inp(I_SUBLN) + l * 64;
#pragma unroll
    for (int tl = 0; tl < 2; ++tl)
#pragma unroll
        for (int g4 = 0; g4 < 4; ++g4) { const int vd = 32 * tl + 8 * g4 + 4 * hh;
            const f32x4 w4 = *(const f32x4*)(sw + vd);
            f32x4 ov; ov.x = res[tl][4 * g4 + 0] * rs * w4.x; ov.y = res[tl][4 * g4 + 1] * rs * w4.y; ov.z = res[tl][4 * g4 + 2] * rs * w4.z; ov.w = res[tl][4 * g4 + 3] * rs * w4.w;
            const f32x4 gt = ldp4(PROJ + mq * DIN + OFF_G + h * 64 + vd);
            u32x2 ow; ow.x = pk2(ov.x * siluf_(gt.x), ov.y * siluf_(gt.y)); ow.y = pk2(ov.z * siluf_(gt.z), ov.w * siluf_(gt.w));
            *(u32x2*)(OB + mq * DM + h * 64 + vd) = ow; }
}

struct SmpK { f32x4 k[8]; };
__device__ __forceinline__ void smp_load(SmpK& d, const float* kp) {
#pragma unroll
    for (int t = 0; t < 8; ++t) d.k[t] = __builtin_nontemporal_load((const f32x4*)(kp + (size_t)t * 1024));
}
__device__ __forceinline__ void smp_group(const SmpK& d, const SmpK& dv, const f32x4 (&q)[8], f32x4 (&O)[4], float& M, float& Lsum, int nstep, bool isnew, int kk, int g, int lane) {
    float sc[8];
#pragma unroll
    for (int t = 0; t < 8; ++t) {
        float p[8];
#pragma unroll
        for (int i = 0; i < 8; ++i) p[i] = (d.k[t].x * q[i].x + d.k[t].y * q[i].y) + (d.k[t].z * q[i].z + d.k[t].w * q[i].w);
        float n4[4];
#pragma unroll
        for (int k = 0; k < 4; ++k) { const float keep = (g & 4) ? p[4 + k] : p[k], send = (g & 4) ? p[k] : p[4 + k]; n4[k] = keep + dpp_mov<0x141>(send); }
        float n2[2];
#pragma unroll
        for (int k = 0; k < 2; ++k) { const float keep = (g & 2) ? n4[2 + k] : n4[k], send = (g & 2) ? n4[k] : n4[2 + k]; n2[k] = keep + dpp_mov<0x4E>(send); }
        const float keep = (g & 1) ? n2[1] : n2[0], send = (g & 1) ? n2[0] : n2[1];
        float sv = keep + dpp_mov<0xB1>(send);
        if (t >= nstep || (isnew && (4 * t + kk) > g)) sv = -1e30f;
        sc[t] = sv;
    }
    float mx = fmaxf(fmaxf(fmaxf(sc[0], sc[1]), fmaxf(sc[2], sc[3])), fmaxf(fmaxf(sc[4], sc[5]), fmaxf(sc[6], sc[7])));
    mx = fmaxf(mx, __shfl_xor(mx, 16)); mx = fmaxf(mx, __shfl_xor(mx, 32));
    const float Mnew = fmaxf(M, mx);
    const float corr = __builtin_amdgcn_exp2f(M - Mnew);
    float ps = 0.f;
#pragma unroll
    for (int t = 0; t < 8; ++t) { sc[t] = __builtin_amdgcn_exp2f(sc[t] - Mnew); ps += sc[t]; }
    Lsum = Lsum * corr + ps; M = Mnew;
#pragma unroll
    for (int rg = 0; rg < 4; ++rg) { const float cr = __shfl(corr, (lane & 48) | (4 * kk + rg));
        O[0][rg] *= cr; O[1][rg] *= cr; O[2][rg] *= cr; O[3][rg] *= cr; }
    u32x4 pw; pw.x = pk2(sc[0], sc[1]); pw.y = pk2(sc[2], sc[3]); pw.z = pk2(sc[4], sc[5]); pw.w = pk2(sc[6], sc[7]);
    const bf16x8 pa = __builtin_bit_cast(bf16x8, pw);
#pragma unroll
    for (int e = 0; e < 4; ++e) {
        u32x4 vw; vw.x = pk2(dv.k[0][e], dv.k[1][e]); vw.y = pk2(dv.k[2][e], dv.k[3][e]); vw.z = pk2(dv.k[4][e], dv.k[5][e]); vw.w = pk2(dv.k[6][e], dv.k[7][e]);
        O[e] = __builtin_amdgcn_mfma_f32_16x16x32_bf16(pa, __builtin_bit_cast(bf16x8, vw), O[e], 0, 0, 0);
    }
}
__device__ __forceinline__ void attn_sample_wave(const Ctx& a, int l, int wi, int lane) {
    OPAQUE(lane);
    const int h = wi & 3, sp = (wi >> 2) % NSPLIT, b = (wi >> 2) / NSPLIT;
    const bf16* PROJ = (const bf16*)(a.ws + WS_PROJ);
    const int kk = lane >> 4, dq = lane & 15, g = lane & 7;
    f32x4 q[8];
#pragma unroll
    for (int i = 0; i < 8; ++i) { q[i] = ldp4(PROJ + (size_t)(NP + b * 8 + i) * DIN + OFF_AQ + h * 64 + 4 * dq); q[i] *= QSCALE; }
    const bool isnew = (sp == NSPLIT - 1);
    float M = -1e30f, Lsum = 0.f;
    f32x4 O[4];
#pragma unroll
    for (int e = 0; e < 4; ++e) O[e] = (f32x4){0.f, 0.f, 0.f, 0.f};
    if (isnew) {
        SmpK d, dv;
        const bf16* kp = PROJ + (size_t)(NP + b * 8 + kk) * DIN + OFF_AK + h * 64 + 4 * dq;
#pragma unroll
        for (int t = 0; t < 8; ++t) { if (t < 2) { d.k[t] = ldp4(kp + (size_t)t * 4 * DIN); dv.k[t] = ldp4(kp + (size_t)t * 4 * DIN + (OFF_AV - OFF_AK)); }
            else { d.k[t] = (f32x4){0.f, 0.f, 0.f, 0.f}; dv.k[t] = (f32x4){0.f, 0.f, 0.f, 0.f}; } }
        smp_group(d, dv, q, O, M, Lsum, 2, true, kk, g, lane);
    } else {
        const int* pt = (const int*)a.inp(I_PT) + b * NPAGES + sp * 2;
        const int pg0 = pt[0], pg1 = pt[1];
        const size_t lo = (size_t)(kk * 4 + h) * 64 + 4 * dq;
        const float* kb0 = a.inp(I_CK) + ((size_t)l * NPOOL + pg0) * 32768 + lo; const float* kb1 = a.inp(I_CK) + ((size_t)l * NPOOL + pg1) * 32768 + lo;
        const float* vb0 = a.inp(I_CV) + ((size_t)l * NPOOL + pg0) * 32768 + lo; const float* vb1 = a.inp(I_CV) + ((size_t)l * NPOOL + pg1) * 32768 + lo;
        SmpK dA, dB, dV;
        smp_load(dA, kb0);
#pragma unroll
        for (int gi = 0; gi < 8; gi += 2) {
            smp_load(dV, ((gi >> 2) ? vb1 : vb0) + (size_t)(gi & 3) * 8192);
            { const int gn = gi + 1; smp_load(dB, ((gn >> 2) ? kb1 : kb0) + (size_t)(gn & 3) * 8192); }
            smp_group(dA, dV, q, O, M, Lsum, 8, false, kk, g, lane);
            { const int gn = gi + 1; smp_load(dV, ((gn >> 2) ? vb1 : vb0) + (size_t)(gn & 3) * 8192); }
            if (gi + 2 < 8) { const int gn = gi + 2; smp_load(dA, ((gn >> 2) ? kb1 : kb0) + (size_t)(gn & 3) * 8192); }
            smp_group(dB, dV, q, O, M, Lsum, 8, false, kk, g, lane);
        }
    }
    float Lall = Lsum + __shfl_xor(Lsum, 16); Lall += __shfl_xor(Lall, 32);
    float* part = (float*)(a.ws + WS_PART) + ((size_t)(b * 4 + h) * NSPLIT + sp) * PART_FLOATS;
    if (kk == 0) { part[dq] = M; part[16 + dq] = Lall; }
#pragma unroll
    for (int rg = 0; rg < 4; ++rg) *(f32x4*)(part + 32 + (4 * kk + rg) * 64 + 4 * dq) = (f32x4){O[0][rg], O[1][rg], O[2][rg], O[3][rg]};
}

__device__ __forceinline__ void attn_sample_merge_wave(const Ctx& a, int l, int wi, float lam, int lane) {
    OPAQUE(lane);
    const int h = wi & 3, q = wi >> 2, b = q >> 3, i = q & 7;
    const size_t m = (size_t)NP + q;
    const float* pb = (const float*)(a.ws + WS_PART) + ((size_t)(b * 4 + h) * NSPLIT) * PART_FLOATS;
    float oc[2];
#pragma unroll
    for (int c = 0; c < 2; ++c) { const int j = c * 8 + i;
        float ms[NSPLIT], M = -1e30f;
#pragma unroll
        for (int s = 0; s < NSPLIT; ++s) { ms[s] = pb[s * PART_FLOATS + j]; M = fmaxf(M, ms[s]); }
        float L = 0.f, O = 0.f;
#pragma unroll
        for (int s = 0; s < NSPLIT; ++s) { const float w = __builtin_amdgcn_exp2f(ms[s] - M); L += pb[s * PART_FLOATS + 16 + j] * w; O += pb[s * PART_FLOATS + 32 + j * 64 + lane] * w; }
        oc[c] = O / L; }
    const float v = oc[0] - lam * oc[1];
    const float ss = wave_sum(v * v);
    const float ov = v * rsqrtf(ss * (1.f / 64.f) + NORM_EPS) * a.inp(I_SUBLN)[l * 64 + lane] * (1.0f - lam_init_of(l));
    const float gt = ldp1((const bf16*)(a.ws + WS_PROJ) + m * DIN + OFF_G + h * 64 + lane);
    ((bf16*)(a.ws + WS_OB))[m * DM + h * 64 + lane] = (bf16)f2bf(ov * siluf_(gt));
}

__device__ __forceinline__ void glu_wave(const Ctx& a, int l, int unit, int wave, int lane) {
    OPAQUE(lane);
    const bf16* ZB = (const bf16*)(a.ws + WS_ZB); const bf16* WT = (const bf16*)(a.ws + WS_WGLU) + (size_t)l * 65536;
    const bf16* PROJ = (const bf16*)(a.ws + WS_PROJ); bf16* OB = (bf16*)(a.ws + WS_OB);
    const int r = lane & 31, hh = lane >> 5, n0 = wave * 32;
    const size_t m = (size_t)unit * 32 + r;
    const bf16* zp = ZB + m * 256 + 8 * hh; const bf16* wp = WT + (size_t)(n0 + r) * 256 + 8 * hh;
    f32x16 acc;
#pragma unroll
    for (int e = 0; e < 16; ++e) acc[e] = 0.f;
#pragma unroll
    for (int s0 = 0; s0 < 16; s0 += 8) {
        bf16x8 wa[8], zb[8];
#pragma unroll
        for (int s1 = 0; s1 < 8; ++s1) { wa[s1] = *(const bf16x8*)(wp + 16 * (s0 + s1)); zb[s1] = *(const bf16x8*)(zp + 16 * (s0 + s1)); }
#pragma unroll
        for (int s1 = 0; s1 < 8; ++s1) acc = __builtin_amdgcn_mfma_f32_32x32x16_bf16(wa[s1], zb[s1], acc, 0, 0, 0);
    }
    const float* bg = a.inp(I_BGLU) + l * 256;
#pragma unroll
    for (int g4 = 0; g4 < 4; ++g4) { const int n = n0 + 8 * g4 + 4 * hh;
        const f32x4 bb = *(const f32x4*)(bg + n), gt = ldp4(PROJ + m * DIN + OFF_G + 768 + n);
        const u32x2 zz = *(const u32x2*)(ZB + m * 256 + n);
        const float z0 = __builtin_bit_cast(float, zz.x << 16), z1 = __builtin_bit_cast(float, zz.x & 0xffff0000u), z2 = __builtin_bit_cast(float, zz.y << 16), z3 = __builtin_bit_cast(float, zz.y & 0xffff0000u);
        u32x2 o; o.x = pk2(z0 * sigmoidf_(acc[4 * g4 + 0] + bb.x) * siluf_(gt.x), z1 * sigmoidf_(acc[4 * g4 + 1] + bb.y) * siluf_(gt.y));
        o.y = pk2(z2 * sigmoidf_(acc[4 * g4 + 2] + bb.z) * siluf_(gt.z), z3 * sigmoidf_(acc[4 * g4 + 3] + bb.w) * siluf_(gt.w));
        *(u32x2*)(OB + m * DM + 768 + n) = o; }
}

constexpr int MM_RWA = 256;
constexpr int MM_RWB = 224;
constexpr int MM_AP = 256;
constexpr int MM_AS = (DB * NSPLIT * 4) / 8;
constexpr int MM_S5P = 256;
constexpr int MM_S5S = 256;
constexpr int MM_LRU = 128;
constexpr int MM_RWS = DB * 4;
constexpr int MM_MRG = 512;
constexpr int MM_GLU = MTOK / 32;
__device__ __forceinline__ void ph_mixA(const Ctx& a, int lq, int MMSK, LAS unsigned char* lds, volatile LAS unsigned* MISC, int tid, int lane, int wave) {
    const int l = lq & 1;
    unsigned* qctr = (unsigned*)(a.ws + WS_CTL) + CW_QUEUE + 1024 * lq;
    const float lam = compute_lam(a, l, lane);
    int u;
    const bool even = ((blockIdx.x >> 3) & 1) == 0;
#pragma unroll 1
    for (int pass = 0; pass < 2; ++pass) {
        if ((pass == 0) == even) { if ((MMSK >> 0) & 1) while ((u = grab_unit(qctr + 0 * 64, MISC, tid)) < MM_RWA) rwkv_prompt_unitA(a, l, u, lds, tid); }
        else { if ((MMSK >> 2) & 1) while ((u = grab_unit(qctr + 2 * 64, MISC, tid)) < MM_AS) attn_sample_wave(a, l, u * 8 + wave, lane); }
    }
    if ((MMSK >> 1) & 1) while ((u = grab_unit(qctr + 1 * 64, MISC, tid)) < MM_AP) { const int bh = u & 31, qt = 8 * (7 - (u >> 5)) + wave; attn_prompt_wave(a, l, bh >> 2, bh & 3, qt, lam, lane); }
    if ((MMSK >> 3) & 1) while ((u = grab_unit(qctr + 3 * 64, MISC, tid)) < MM_S5P) s5_pass2_wave(a, l, false, u * 8 + wave, lds + wave * 17408, lane);
    if ((MMSK >> 4) & 1) while ((u = grab_unit(qctr + 4 * 64, MISC, tid)) < MM_S5S) s5_pass2_wave(a, l, true, u * 8 + wave, lds + wave * 17408, lane);
    if ((MMSK >> 5) & 1) while ((u = grab_unit(qctr + 5 * 64, MISC, tid)) < MM_LRU) lru_pass2_wave(a, l, u * 8 + wave, lane);
    __syncthreads();
}
__device__ __forceinline__ void ph_mixB(const Ctx& a, int lq, int MMSK, LAS unsigned char* lds, volatile LAS unsigned* MISC, int tid, int lane, int wave) {
    const int l = lq & 1;
    unsigned* qctr = (unsigned*)(a.ws + WS_CTL) + CW_QUEUE + 1024 * lq + 512;
    int u;
    if ((MMSK >> 0) & 1) while ((u = grab_unit(qctr + 0 * 64, MISC, tid)) < MM_RWB) rwkv_prompt_unitB(a, l, u, lds, tid);
    if ((MMSK >> 1) & 1) while ((u = grab_unit(qctr + 1 * 64, MISC, tid)) < MM_RWS) rwkv_sample_unit(a, l, u >> 2, u & 3, lds, tid);
    if ((MMSK >> 2) & 1) while ((u = grab_unit(qctr + 2 * 64, MISC, tid)) < MM_GLU) glu_wave(a, l, u, wave, lane);
    if ((MMSK >> 3) & 1) { const float lam = compute_lam(a, l, lane); while ((u = grab_unit(qctr + 3 * 64, MISC, tid)) < MM_MRG) attn_sample_merge_wave(a, l, u * 8 + wave, lam, lane); }
    __syncthreads();
}

__device__ __forceinline__ void ph_postnorm(const Ctx& a, int l, int lane, int wave) {
    OPAQUE(lane);
    const bf16* YP = (const bf16*)(a.ws + WS_YP);
    const float* xp = a.inp(I_XP);
    const float* xs = a.inp(I_XS) - (size_t)NP * DM;
    bf16* X1b = (bf16*)(a.ws + WS_X1);
    float* yp = a.out + OUT_Y_P;
    float* ys = a.out + OUT_Y_S - (size_t)NP * DM;
    bf16* H = (bf16*)(a.ws + WS_H);
    f32x4 gp[4], g2[4];
#pragma unroll
    for (int j = 0; j < 4; ++j) { gp[j] = ((const f32x4*)(a.inp(I_NPOST) + l * DM) + lane)[64 * j]; g2[j] = ((const f32x4*)(a.inp(I_NPRE) + DM) + lane)[64 * j]; }
    const int gw = blockIdx.x * NWAVES + wave, NGW = gridDim.x * NWAVES;
    for (int m0 = gw; m0 < MTOK; m0 += 2 * NGW) {
        const int m1 = m0 + NGW; const bool has1 = m1 < MTOK; const int mb = has1 ? m1 : m0;
        const bf16* ya = YP + (size_t)m0 * DM + 4 * lane; const bf16* yb = YP + (size_t)mb * DM + 4 * lane;
        const f32x4* xa = (const f32x4*)((m0 < NP ? xp : xs) + (size_t)m0 * DM) + lane; const f32x4* xb = (const f32x4*)((mb < NP ? xp : xs) + (size_t)mb * DM) + lane;
        f32x4 va[4], vb[4], wa[4], wb[4];
#pragma unroll
        for (int j = 0; j < 4; ++j) { va[j] = ldp4(ya + 256 * j); vb[j] = ldp4(yb + 256 * j);
            if (l == 0) { wa[j] = xa[64 * j]; wb[j] = xb[64 * j]; }
            else { wa[j] = ldp4(X1b + (size_t)m0 * DM + 4 * lane + 256 * j); wb[j] = ldp4(X1b + (size_t)mb * DM + 4 * lane + 256 * j); } }
        float sa = 0.f, sb = 0.f;
#pragma unroll
        for (int j = 0; j < 4; ++j) { sa += (va[j].x * va[j].x + va[j].y * va[j].y) + (va[j].z * va[j].z + va[j].w * va[j].w); sb += (vb[j].x * vb[j].x + vb[j].y * vb[j].y) + (vb[j].z * vb[j].z + vb[j].w * vb[j].w); }
        const float ra = rsqrtf(wave_sum_fast(sa) * (1.f / DM) + NORM_EPS), rb = rsqrtf(wave_sum_fast(sb) * (1.f / DM) + NORM_EPS);
        f32x4* oa = (f32x4*)((m0 < NP ? yp : ys) + (size_t)m0 * DM) + lane; f32x4* ob = (f32x4*)((mb < NP ? yp : ys) + (size_t)mb * DM) + lane;
        float ta = 0.f, tb = 0.f;
#pragma unroll
        for (int j = 0; j < 4; ++j) { va[j] = wa[j] + va[j] * ra * gp[j]; vb[j] = wb[j] + vb[j] * rb * gp[j];
            if (l == 0) { u32x2 o; o.x = pk2(va[j].x, va[j].y); o.y = pk2(va[j].z, va[j].w); *(u32x2*)(X1b + (size_t)m0 * DM + 4 * lane + 256 * j) = o;
                if (has1) { u32x2 p; p.x = pk2(vb[j].x, vb[j].y); p.y = pk2(vb[j].z, vb[j].w); *(u32x2*)(X1b + (size_t)mb * DM + 4 * lane + 256 * j) = p; } }
            else { __builtin_nontemporal_store(va[j], oa + 64 * j); if (has1) __builtin_nontemporal_store(vb[j], ob + 64 * j); }
            ta += (va[j].x * va[j].x + va[j].y * va[j].y) + (va[j].z * va[j].z + va[j].w * va[j].w); tb += (vb[j].x * vb[j].x + vb[j].y * vb[j].y) + (vb[j].z * vb[j].z + vb[j].w * vb[j].w); }
        if (l == 0) {
            const float qa = rsqrtf(wave_sum_fast(ta) * (1.f / DM) + NORM_EPS), qb = rsqrtf(wave_sum_fast(tb) * (1.f / DM) + NORM_EPS);
            u32x2* ha = (u32x2*)(H + (size_t)m0 * DM) + lane; u32x2* hb = (u32x2*)(H + (size_t)mb * DM) + lane;
#pragma unroll
            for (int j = 0; j < 4; ++j) { u32x2 o; o.x = pk2(va[j].x * qa * g2[j].x, va[j].y * qa * g2[j].y); o.y = pk2(va[j].z * qa * g2[j].z, va[j].w * qa * g2[j].w); ha[64 * j] = o;
                if (has1) { u32x2 p; p.x = pk2(vb[j].x * qb * g2[j].x, vb[j].y * qb * g2[j].y); p.y = pk2(vb[j].z * qb * g2[j].z, vb[j].w * qb * g2[j].w); hb[64 * j] = p; } }
        }
    }
}

constexpr int N_PHASES = 13;
#ifndef DUP_PHASE
#define DUP_PHASE -1
#endif
#ifndef DUP_MASK
#define DUP_MASK 0x7f
#endif
__global__ void __launch_bounds__(NTHREADS, 2) hymba_fwd(Args args) {
    extern __shared__ __attribute__((aligned(16))) unsigned char lds_raw[];
    LAS unsigned char* lds = (LAS unsigned char*)lds_raw;
    volatile LAS unsigned* MISC = (volatile LAS unsigned*)(lds + MISC_OFF);
    if (threadIdx.x < 64) MISC[threadIdx.x] = 0u;
    if (threadIdx.x < N_IN) *(LAS unsigned long long*)(lds + TAB_OFF + 8 * threadIdx.x) = (unsigned long long)args.in[threadIdx.x];
    Ctx ctx; ctx.out = args.out; ctx.ws = args.ws; ctx.tab = (const LAS unsigned*)(lds + TAB_OFF);
    const int wave_s = __builtin_amdgcn_readfirstlane(threadIdx.x >> 6);
#define TIDS() int tid = wave_s * 64 + lane_id_asm(); const int lane = tid & 63, wave = wave_s; (void)lane; (void)wave; Ctx cx = ctx; { GAS unsigned char* w_ = (GAS unsigned char*)ctx.ws; GAS float* o_ = (GAS float*)ctx.out; asm volatile("" : "+s"(w_), "+s"(o_)); cx.ws = (unsigned char*)w_; cx.out = (float*)o_; }
    __syncthreads();
    unsigned* ctl = (unsigned*)(args.ws + WS_CTL);
#if MK_PER_PHASE
#define GRID_BAR() do { } while (0)
#else
    XcdBarrier bar = xcd_barrier_post(ctl + CW_BAR, MISC);
#define GRID_BAR() xcd_barrier(bar, wave_s == 0 && lane_id_asm() == 0)
#endif
    const int lo = args.ph_lo, hi = args.ph_hi;
#define IN(k) (lo <= (k) && (k) < hi)
#define SEAM(k) do { if (IN(k) && IN((k) + 1)) GRID_BAR(); } while (0)
#define NREP(j) ((DUP_PHASE == (j)) ? 2 : 1)

    if (IN(0)) { TIDS(); ph_prologue(cx, lds, lane, wave); }
    SEAM(0);
    for (int l = 0; l < 2; ++l) {
        const int p0 = 1 + 6 * l;
        if (IN(p0))
#pragma unroll 1
          for (int rp = 0; rp < NREP(1); ++rp) {
            if (rp) GRID_BAR();
            TIDS();
            pg8::Gemm g{(const pg8::bf16_t*)(cx.ws + WS_H), (const pg8::bf16_t*)(cx.ws + WS_WIN) + (size_t)l * DIN * DM, MTOK, DIN, DM};
            pg8::StaticOrder S; S.init(MTOK, DIN, (int)gridDim.x, (int)blockIdx.x);
            EpiProj E{(bf16*)(cx.ws + WS_PROJ), cx.out, l};
            pg8::gemm_phase<EpiProj, pg8::StaticOrder, false>(lds, g, S, E, nullptr, tid);
        }
        SEAM(p0);
        if (IN(p0 + 1)) {
#pragma unroll 1
            for (int rp = 0; rp < NREP(2); ++rp) { if (rp) GRID_BAR(); TIDS(); ph_mixprep(cx, l + 2 * rp, rp ? (DUP_MASK) : 0x1f, lds, MISC, tid, lane, wave); } }
        SEAM(p0 + 1);
        if (IN(p0 + 2)) {
#pragma unroll 1
            for (int rp = 0; rp < NREP(3); ++rp) { if (rp) GRID_BAR(); TIDS(); ph_mixA(cx, l + 2 * rp, rp ? (DUP_MASK) : 0x3f, lds, MISC, tid, lane, wave); } }
        SEAM(p0 + 2);
        if (IN(p0 + 3)) {
#pragma unroll 1
            for (int rp = 0; rp < NREP(4); ++rp) { if (rp) GRID_BAR(); TIDS(); ph_mixB(cx, l + 2 * rp, rp ? (DUP_MASK) : 0xf, lds, MISC, tid, lane, wave); } }
        SEAM(p0 + 3);
        if (IN(p0 + 4))
#pragma unroll 1
          for (int rp = 0; rp < NREP(5); ++rp) {
            if (rp) GRID_BAR();
            TIDS();
            pg8::Gemm g{(const pg8::bf16_t*)(cx.ws + WS_OB), (const pg8::bf16_t*)(cx.ws + WS_WOUT) + (size_t)l * DM * DM, MTOK, DM, DM};
            pg8::StaticOrder S; S.init(MTOK, DM, (int)gridDim.x, (int)blockIdx.x);
            EpiPlain E{(bf16*)(cx.ws + WS_YP), DM};
            pg8::gemm_phase<EpiPlain, pg8::StaticOrder, false>(lds, g, S, E, nullptr, tid);
        }
        SEAM(p0 + 4);
        if (IN(p0 + 5)) {
#pragma unroll 1
            for (int rp = 0; rp < NREP(6); ++rp) { if (rp) GRID_BAR(); TIDS(); ph_postnorm(cx, l, lane, wave); } }
        SEAM(p0 + 5);
    }
#undef IN
#undef SEAM
}

extern "C" void kernel_launch(void* const* d_in, const int* in_sizes, int n_in, void* d_out, int out_size, void* d_ws, size_t ws_size, hipStream_t stream) {
    static int grid = 0;
    if (grid == 0) {
        if (n_in != N_IN || out_size != (int)OUT_TOTAL || ws_size < WS_END) { fprintf(stderr, "kernel_launch: unexpected shapes: n_in %d out %d ws %zu (need %zu)\n", n_in, out_size, ws_size, (size_t)WS_END); grid = -1; return; }
        int dev = 0, cus = 0, per_cu = 0;
        if (hipGetDevice(&dev) != hipSuccess || hipDeviceGetAttribute(&cus, hipDeviceAttributeMultiprocessorCount, dev) != hipSuccess) { grid = -1; return; }
        if (hipFuncSetAttribute((const void*)hymba_fwd, hipFuncAttributeMaxDynamicSharedMemorySize, LDS_BYTES) != hipSuccess) { fprintf(stderr, "kernel_launch: hipFuncSetAttribute failed\n"); grid = -1; return; }
        if (hipOccupancyMaxActiveBlocksPerMultiprocessor(&per_cu, (const void*)hymba_fwd, NTHREADS, LDS_BYTES) != hipSuccess || per_cu < 1) { fprintf(stderr, "kernel_launch: occupancy query says %d\n", per_cu); }
        (void)hipGetLastError();
        grid = cus;
    }
    if (grid < 0) return;
    (void)hipMemsetAsync((char*)d_ws + WS_CTL, 0, CTL_ZERO_BYTES, stream);
    Args a{};
    for (int i = 0; i < N_IN; ++i) a.in[i] = (const float*)d_in[i];
    a.out = (float*)d_out; a.ws = (unsigned char*)d_ws;
#if MK_PER_PHASE
    for (int p = 0; p < N_PHASES; ++p) { a.ph_lo = p; a.ph_hi = p + 1; hipLaunchKernelGGL(hymba_fwd, dim3(grid), dim3(NTHREADS), LDS_BYTES, stream, a); }
#else
    a.ph_lo = 0; a.ph_hi = N_PHASES; hipLaunchKernelGGL(hymba_fwd, dim3(grid), dim3(NTHREADS), LDS_BYTES, stream, a);
#endif
}
```

```cpp
#include <hip/hip_runtime.h>
#include <cstdio>
#include <cstdint>
#ifndef MK_PER_PHASE
#define MK_PER_PHASE 0
#endif
namespace pg8 {
#define PG8_LAS __attribute__((address_space(3)))
typedef unsigned short bf16_t;
typedef short bf16x8 __attribute__((ext_vector_type(8)));
typedef float f32x4 __attribute__((ext_vector_type(4)));
typedef unsigned u32x4 __attribute__((ext_vector_type(4)));
constexpr int BM = 256, BK = 64, HALF = 128, HTB = HALF * BK * 2  , STAGE_BYTES = 8 * HTB, NXCD = 8, WGM = 8;

__host__ __device__ __forceinline__ int lds_byte(int r, int c) { const int st = (r >> 4) * 2 + (c >> 5), rr = r & 15, cc = c & 31, ob = rr * 64 + cc * 2; return st * 1024 + (ob ^ (((ob >> 9) & 1) << 5)); }
__host__ __device__ __forceinline__ void stage_rc(int b, int& R, int& C) { const int st = b / 1024, sb = b % 1024, swz = sb ^ (((sb >> 9) & 1) << 5); R = (st >> 1) * 16 + swz / 64; C = (st & 1) * 32 + (swz % 64) / 2; }
__host__ __device__ __forceinline__ int perm32(int rho) { const int n = rho >> 4, i = rho & 15; return 8 * (i >> 2) + 4 * n + (i & 3); }

struct Unit { int pm, pn; };
struct Gemm { const bf16_t* A; const bf16_t* Bt; int M, N, K; };

struct StaticOrder {
    int nM, nN, nwg, G, c;
    __host__ __device__ void init(int M, int N, int G_, int c_) { nM = M / BM; nN = N / BM; nwg = nM * nN; G = G_; c = c_; }
    __host__ __device__ bool next(int i, Unit& u) const {
        const long L = (long)i * G + c; if (L >= nwg) return false;
        int wgid = (int)L; { const int q = nwg / NXCD, r = nwg % NXCD, xcd = wgid % NXCD, off = wgid / NXCD; wgid = (xcd < r ? xcd * (q + 1) : r * (q + 1) + (xcd - r) * q) + off; }
        const int nig = WGM * nN, gid = wgid / nig, fm = gid * WGM, gsz = (nM - fm) < WGM ? (nM - fm) : WGM;
        u.pm = fm + ((wgid % nig) % gsz); u.pn = (wgid % nig) / gsz; return true;
    }
    __device__ __forceinline__ void a_ready(const Unit&) const {}
    __device__ __forceinline__ void done(const Unit&) const {}
};
template <class Epi, class Sched, bool STAMP = false>
__device__ __forceinline__ void gemm_phase(PG8_LAS unsigned char* lds, const Gemm g, const Sched& S, const Epi& E, unsigned long long* stamps, int tid_in) {
    int tid = tid_in; asm volatile("" : "+v"(tid));
    const int wid = __builtin_amdgcn_readfirstlane(tid >> 6), lane = tid & 63, wr = wid >> 2, wc = wid & 3, fr = lane & 15, fq = lane >> 4;
    const int K = g.K, nt = K / BK;
    int ts_lo = 0, ts_hi = 0, nts = 0; const unsigned long long rt_entry = STAMP ? (unsigned long long)wall_clock64() : 0ull;
#define PG8_STAMP() do { if (STAMP && wid == 0 && nts < 64) { const unsigned long long _c = (unsigned long long)clock64(); \
        ts_lo = (lane == nts) ? (int)(unsigned)_c : ts_lo; ts_hi = (lane == nts) ? (int)(unsigned)(_c >> 32) : ts_hi; ++nts; } } while (0)
    PG8_STAMP();
    unsigned voffA[2], voffB[2];
#pragma unroll
    for (int i = 0; i < 2; ++i) { int R, C; stage_rc(tid * 16 + i * 8192, R, C); const int Rb = Epi::PERM ? ((R & ~31) + perm32(R & 31)) : R;
        voffA[i] = (unsigned)(R * K + C) * 2u; voffB[i] = (unsigned)(Rb * K + C) * 2u; }
    const size_t kstep = (size_t)(BK * 2);
    const size_t hstep = (size_t)HALF * K * 2;
    const size_t tstep = 2 * hstep;
    const unsigned ldsw = (unsigned)wid * 1024u;
    const int aoff = lds_byte(wr * 64 + fr, fq * 8), boff = lds_byte(wc * 32 + fr, fq * 8);
#define PG8_SA(b, h) (((b) * 2 + (h)) * HTB)
#define PG8_SB(b, h) ((4 + (b) * 2 + (h)) * HTB)
#define PG8_STAGE(bufoff, gbase, voff) do { _Pragma("unroll") for (int _i = 0; _i < 2; ++_i) \
        __builtin_amdgcn_global_load_lds((const unsigned*)((const char*)(gbase) + (voff)[_i]), (PG8_LAS unsigned*)(lds + (bufoff) + ldsw + _i * 8192), 16, 0, 0); } while (0)
#define PG8_LDA(dst, b, h) do { _Pragma("unroll") for (int m = 0; m < 4; ++m) _Pragma("unroll") for (int k = 0; k < 2; ++k) dst[m][k] = *(const PG8_LAS bf16x8*)(lds + PG8_SA(b, h) + aoff + m * 2048 + k * 1024); } while (0)
#define PG8_LDB(dst, b, h) do { _Pragma("unroll") for (int n = 0; n < 2; ++n) _Pragma("unroll") for (int k = 0; k < 2; ++k) dst[n][k] = *(const PG8_LAS bf16x8*)(lds + PG8_SB(b, h) + boff + n * 2048 + k * 1024); } while (0)
#define PG8_MMA(ai, bj, At, Bt) do { __builtin_amdgcn_s_setprio(1); _Pragma("unroll") for (int m = 0; m < 4; ++m) _Pragma("unroll") for (int n = 0; n < 2; ++n) _Pragma("unroll") for (int k = 0; k < 2; ++k) \
        acc[ai][bj][m][n] = __builtin_amdgcn_mfma_f32_16x16x32_bf16(Bt[n][k], At[m][k], acc[ai][bj][m][n], 0, 0, 0); __builtin_amdgcn_s_setprio(0); } while (0)
#define PG8_WAIT_V(n) asm volatile("s_waitcnt vmcnt(" #n ")" ::: "memory")
#define PG8_WAIT_L(n) asm volatile("s_waitcnt lgkmcnt(" #n ")" ::: "memory")
#define PG8_BAR __builtin_amdgcn_s_barrier()
#define PG8_SCHED __builtin_amdgcn_sched_barrier(0)
    Unit cur, nxt; int ui = 0;
    if (!S.next(0, cur)) return;
    f32x4 acc[2][2][4][2];
#pragma unroll
    for (int a = 0; a < 2; ++a)
#pragma unroll
        for (int b = 0; b < 2; ++b)
#pragma unroll
            for (int m = 0; m < 4; ++m)
#pragma unroll
                for (int n = 0; n < 2; ++n) acc[a][b][m][n] = (f32x4){0.f, 0.f, 0.f, 0.f};
    bf16x8 At[4][2], B0[2][2], B1[2][2];
    const char* cA = (const char*)g.A + (size_t)cur.pm * tstep; const char* cB = (const char*)g.Bt + (size_t)cur.pn * tstep;
    S.a_ready(cur);
    PG8_STAGE(PG8_SB(0, 0), cB, voffB); PG8_STAGE(PG8_SA(0, 0), cA, voffA); PG8_STAGE(PG8_SB(0, 1), cB + hstep, voffB); PG8_STAGE(PG8_SA(0, 1), cA + hstep, voffA);
    if (wr == 1) PG8_BAR;
    PG8_WAIT_V(4); PG8_BAR;
    PG8_STAGE(PG8_SB(1, 0), cB + kstep, voffB); PG8_STAGE(PG8_SA(1, 0), cA + kstep, voffA); PG8_STAGE(PG8_SB(1, 1), cB + hstep + kstep, voffB);
    PG8_WAIT_V(6); PG8_BAR;
    PG8_STAMP();
    for (;;) {
        const bool has_next = S.next(ui + 1, nxt);
        const char* nA = has_next ? (const char*)g.A + (size_t)nxt.pm * tstep : cA; const char* nB = has_next ? (const char*)g.Bt + (size_t)nxt.pn * tstep : cB;
        for (int t = 0; t < nt; t += 2) {
            const bool last = (t == nt - 2);
            const char* a1 = cA + (size_t)(t + 1) * kstep;
            const char* a2 = last ? nA : cA + (size_t)(t + 2) * kstep; const char* b2 = last ? nB : cB + (size_t)(t + 2) * kstep;
            const char* a3 = a2 + kstep; const char* b3 = b2 + kstep;
            if (last && has_next) S.a_ready(nxt);
            PG8_LDB(B0, 0, 0); PG8_SCHED; PG8_LDA(At, 0, 0); PG8_STAGE(PG8_SA(1, 1), a1 + hstep, voffA);
            PG8_WAIT_L(8); PG8_BAR; PG8_WAIT_L(0); PG8_MMA(0, 0, At, B0); PG8_BAR; PG8_SCHED;
            PG8_LDB(B1, 0, 1); PG8_STAGE(PG8_SB(0, 0), b2, voffB);
            PG8_BAR; PG8_WAIT_L(0); PG8_MMA(0, 1, At, B1); PG8_BAR;
            PG8_LDA(At, 0, 1); PG8_STAGE(PG8_SA(0, 0), a2, voffA);
            PG8_BAR; PG8_WAIT_L(0); PG8_MMA(1, 0, At, B0); PG8_BAR; PG8_SCHED;
            PG8_STAGE(PG8_SB(0, 1), b2 + hstep, voffB);
            PG8_WAIT_V(6); PG8_BAR; PG8_MMA(1, 1, At, B1); PG8_BAR;
            PG8_LDB(B0, 1, 0); PG8_SCHED; PG8_LDA(At, 1, 0); PG8_STAGE(PG8_SA(0, 1), a2 + hstep, voffA);
            PG8_WAIT_L(8); PG8_BAR; PG8_WAIT_L(0); PG8_MMA(0, 0, At, B0); PG8_BAR; PG8_SCHED;
            PG8_LDB(B1, 1, 1); PG8_STAGE(PG8_SB(1, 0), b3, voffB);
            PG8_BAR; PG8_WAIT_L(0); PG8_MMA(0, 1, At, B1); PG8_BAR;
            PG8_LDA(At, 1, 1); PG8_STAGE(PG8_SA(1, 0), a3, voffA);
            PG8_BAR; PG8_WAIT_L(0); PG8_MMA(1, 0, At, B0); PG8_BAR; PG8_SCHED;
            PG8_STAGE(PG8_SB(1, 1), b3 + hstep, voffB);
            PG8_WAIT_V(6); PG8_BAR; PG8_MMA(1, 1, At, B1); PG8_BAR;
        }
        PG8_STAMP();
        if constexpr (!Epi::AFTER_DRAIN) { int l2; asm volatile("v_mbcnt_lo_u32_b32 %0, -1, 0\n\tv_mbcnt_hi_u32_b32 %0, -1, %0" : "=v"(l2)); E(acc, cur, wr, wc, l2 & 15, l2 >> 4); S.done(cur); }
        PG8_STAMP();
        if (!has_next) break;
#pragma unroll
        for (int a = 0; a < 2; ++a)
#pragma unroll
            for (int b = 0; b < 2; ++b)
#pragma unroll
                for (int m = 0; m < 4; ++m)
#pragma unroll
                    for (int n = 0; n < 2; ++n) acc[a][b][m][n] = (f32x4){0.f, 0.f, 0.f, 0.f};
        cur = nxt; cA = nA; cB = nB; ++ui;
    }
    PG8_WAIT_V(0);
    if (wr == 0) PG8_BAR;
    PG8_BAR;
    if constexpr (Epi::AFTER_DRAIN) { E.fused(acc, cur, wr, wc, fr, fq, lds, wid, lane); S.done(cur); }
    PG8_STAMP();
    if (STAMP && wid == 0) { stamps[lane] = lane < nts ? (((unsigned long long)(unsigned)ts_hi << 32) | (unsigned)ts_lo) : 0ull;
        if (lane == 62) stamps[62] = rt_entry; if (lane == 63) stamps[63] = (unsigned long long)wall_clock64(); }
#undef PG8_STAMP
#undef PG8_SA
#undef PG8_SB
#undef PG8_STAGE
#undef PG8_LDA
#undef PG8_LDB
#undef PG8_MMA
#undef PG8_WAIT_V
#undef PG8_WAIT_L
#undef PG8_BAR
#undef PG8_SCHED
}
}

#define GAS __attribute__((address_space(1)))
#define LAS __attribute__((address_space(3)))
typedef unsigned short bf16;
typedef float f32x4 __attribute__((ext_vector_type(4)));
typedef float f32x2 __attribute__((ext_vector_type(2)));
typedef float f32x16 __attribute__((ext_vector_type(16)));
typedef short bf16x8 __attribute__((ext_vector_type(8)));
typedef unsigned u32x4 __attribute__((ext_vector_type(4)));
typedef unsigned u32x2 __attribute__((ext_vector_type(2)));

constexpr int NWAVES = 8, NTHREADS = 512;
constexpr int DM = 1024, NP = 16384, NSMP = 1024, MTOK = 17408, DIN = 3584, SEQ = 2048, DB = 128, DS = 8;
constexpr int OFF_AQ = 0, OFF_AK = 256, OFF_AV = 512, OFF_B = 768, OFF_C = 1024, OFF_D = 2304, OFF_G = 2560;
constexpr int NPOOL = 2560, NPAGES = 16;
constexpr float NORM_EPS = 1e-6f;
constexpr float QSCALE = 0.17677669529663687f * 1.4426950408889634f;
constexpr int NSPLIT = 9;
constexpr int PART_FLOATS = 16 + 16 + 1024;

constexpr size_t OUT_Y_P = 0, OUT_Y_S = 16777216, OUT_K_P = 17825792, OUT_K_S = 26214400, OUT_V_P = 26738688, OUT_V_S = 35127296,
    OUT_CONV_P = 35651584, OUT_CONV_S = 35663872, OUT_LRU_P = 35860480, OUT_LRU_S = 35864576, OUT_SHIFT_P = 35930112, OUT_SHIFT_S = 35950592,
    OUT_WKV_P = 36278272, OUT_WKV_S = 36540416, OUT_SSM_P = 40734720, OUT_SSM_S = 40767488, OUT_TOTAL = 41291776;

constexpr size_t MiB = 1u << 20;
constexpr size_t WS_CTL = 0, CTL_ZERO_BYTES = 1 * MiB;
constexpr size_t WS_WIN = 1 * MiB;
constexpr size_t WS_WOUT = WS_WIN + (size_t)2 * DIN * DM * 2;
constexpr size_t WS_H = WS_WOUT + (size_t)2 * DM * DM * 2;
constexpr size_t WS_PROJ = WS_H + (size_t)MTOK * DM * 2;
constexpr size_t WS_QB = WS_PROJ + (size_t)MTOK * DIN * 4;
constexpr size_t WS_KB = WS_QB + (size_t)NP * 256 * 2;
constexpr size_t WS_VT = WS_KB + (size_t)NP * 256 * 2;
constexpr size_t WS_LA = WS_VT + (size_t)NP * 256 * 2;
constexpr size_t WS_LB = WS_LA + (size_t)MTOK * 256 * 4;
constexpr size_t WS_LP = WS_LB + (size_t)MTOK * 256 * 4;
constexpr size_t WS_LE = WS_LP + (size_t)8 * 32 * 256 * 4;
constexpr size_t WS_RW = WS_LE + (size_t)8 * 32 * 256 * 4;
constexpr size_t WS_BON = WS_RW + (size_t)MTOK * 1536 * 4;
constexpr size_t WS_S5E = WS_BON + (size_t)MTOK * 4 * 4;
constexpr size_t WS_OMIX = WS_S5E + (size_t)8 * 16 * 16 * 64 * 2 * 4;
constexpr size_t WS_ZB = WS_OMIX, WS_WGLU = WS_OMIX + 16 * MiB, WS_LWT = WS_OMIX + 17 * MiB, WS_W1T = WS_OMIX + 18 * MiB, WS_S5T = WS_OMIX + 19 * MiB;
constexpr size_t WS_OB = WS_OMIX + (size_t)MTOK * DM * 4;
constexpr size_t WS_PART = WS_OB + (size_t)MTOK * DM * 2;
constexpr size_t WS_YP = WS_PART + (size_t)DB * 4 * NSPLIT * PART_FLOATS * 4;
constexpr size_t WS_X1 = WS_YP + (size_t)MTOK * DM * 4;
constexpr size_t WS_PZ = WS_X1 + (size_t)MTOK * DM * 4;
constexpr size_t WS_END = WS_PZ + (size_t)8 * 4 * 8 * 2 * 4096 * 4;
static_assert(WS_H % 256 == 0 && WS_PROJ % 256 == 0 && WS_QB % 256 == 0 && WS_VT % 256 == 0 && WS_RW % 256 == 0 && WS_OMIX % 256 == 0 && WS_PART % 256 == 0 && WS_YP % 256 == 0, "ws align");

constexpr int CW_BAR = 4096;
constexpr int CW_QUEUE = 8192;

constexpr int LDS_BYTES = 147456;
constexpr int MISC_OFF = 147456 - 256;

#define XB_TMO      128
#define XB_XCNT(j)  (256  + 64 * (j))
#define XB_XSUB(j)  (1280 + 64 * (j))
#define XB_XGEN(j)  (2304 + 64 * (j))
#define XB_TOP      3328
#define XB_TOPGEN   3392
#define XCD_BAR_WORDS 3456
#define XB_SPIN_CAP (1u << 18)

__device__ __forceinline__ unsigned xb_ld(unsigned* p)              { return __hip_atomic_load(p, __ATOMIC_RELAXED, __HIP_MEMORY_SCOPE_AGENT); }
__device__ __forceinline__ unsigned xb_add(unsigned* p, unsigned v) { return __hip_atomic_fetch_add(p, v, __ATOMIC_RELAXED, __HIP_MEMORY_SCOPE_AGENT); }
__device__ __forceinline__ unsigned xb_xcc_id() { return (unsigned)__builtin_amdgcn_s_getreg((3 << 11) | 20) & 0xFu; }
#define XB_SPIN(cond, bar) do { unsigned _sp = 0; while (cond) { __builtin_amdgcn_s_sleep(1); \
    if ((++_sp & 255u) == 0u) { if (xb_ld(&(bar)[XB_TMO])) break; if (_sp > XB_SPIN_CAP) { atomicAdd(&(bar)[XB_TMO], 1u); break; } } } } while (0)

struct XcdBarrier { unsigned* bar; unsigned x; volatile LAS unsigned* st; };

__device__ __forceinline__ XcdBarrier xcd_barrier_post(unsigned* bar, volatile LAS unsigned* st) {
    XcdBarrier b; b.bar = bar; b.x = xb_xcc_id(); b.st = st;
    if (threadIdx.x == 0) (void)xb_add(&bar[XB_XCNT(b.x)], 1u);
    return b;
}
__device__ __forceinline__ void xcd_barrier_complete(unsigned* bar, unsigned x, unsigned& nloc, unsigned& nx) {
    const unsigned G = gridDim.x * gridDim.y * gridDim.z;
    unsigned sum, cnt, mine, sp = 0u;
    for (;;) {
        sum = 0u; cnt = 0u; mine = 0u;
#pragma unroll
        for (unsigned j = 0; j < 16; ++j) { const unsigned c = xb_ld(&bar[XB_XCNT(j)]); sum += c; cnt += (c > 0u) ? 1u : 0u; mine = (j == x) ? c : mine; }
        if (sum == G) break;
        __builtin_amdgcn_s_sleep(1);
        if ((++sp & 255u) == 0u) { if (xb_ld(&bar[XB_TMO])) break; if (sp > XB_SPIN_CAP) { atomicAdd(&bar[XB_TMO], 1u); break; } }
    }
    nloc = mine > 0u ? mine : 1u; nx = cnt > 0u ? cnt : 1u;
}
__device__ __forceinline__ void xcd_barrier(const XcdBarrier& b, bool leader) {
    asm volatile("s_waitcnt vmcnt(0)" ::: "memory");
    __syncthreads();
    if (leader) {
        unsigned* bar = b.bar;
        __builtin_amdgcn_s_waitcnt(0);
        unsigned nloc = b.st[0], nx = b.st[1];
        if (nloc == 0u) { xcd_barrier_complete(bar, b.x, nloc, nx); b.st[0] = nloc; b.st[1] = nx; }
        const unsigned old = xb_add(&bar[XB_XSUB(b.x)], 1u);
        const unsigned gen = old / nloc;
        if (old + 1u == (gen + 1u) * nloc) {
            __builtin_amdgcn_fence(__ATOMIC_RELEASE, "agent");
            asm volatile("s_waitcnt vmcnt(0)" ::: "memory");
            const unsigned og = xb_add(&bar[XB_TOP], 1u);
            const unsigned tg = og / nx;
            if (og + 1u == (tg + 1u) * nx) xb_add(&bar[XB_TOPGEN], 1u);
            else XB_SPIN(xb_ld(&bar[XB_TOPGEN]) == tg, bar);
            __builtin_amdgcn_fence(__ATOMIC_ACQUIRE, "agent");
            xb_add(&bar[XB_XGEN(b.x)], 1u);
            asm volatile("s_waitcnt vmcnt(0)" ::: "memory");
        } else {
            XB_SPIN(xb_ld(&bar[XB_XGEN(b.x)]) == gen, bar);
            __builtin_amdgcn_fence(__ATOMIC_ACQUIRE, "agent");
            asm volatile("s_waitcnt vmcnt(0)" ::: "memory");
        }
    }
    __syncthreads();
}

enum InIdx { I_XP = 0, I_XS, I_CK, I_CV, I_PT, I_SCONV, I_SLRU, I_SSHIFT, I_SWKV, I_SSSM, I_NPRE, I_NPOST, I_WIN, I_WOUT, I_LQ1, I_LK1, I_LQ2, I_LK2, I_SUBLN,
             I_CONVW, I_CONVB, I_LWA, I_LBA, I_LWX, I_LBX, I_LLAM, I_MU, I_W0, I_W1, I_W2, I_A0, I_A1, I_A2, I_KK, I_KA, I_RK, I_GNW, I_GNB,
             I_LRE, I_LIM, I_LOGDT, I_BRE, I_BIM, I_CRE, I_CIM, I_S5D, I_WGLU, I_BGLU, N_IN };
struct Args { const float* in[N_IN]; float* out; unsigned char* ws; int ph_lo, ph_hi; };
static_assert(sizeof(Args) == (N_IN + 2) * 8 + 8, "Args has no padding");
constexpr int TAB_OFF = 147456 - 1024;
struct Ctx {
    float* out; unsigned char* ws; const LAS unsigned* tab;
    __device__ __forceinline__ const float* inp(int i) const {
        const unsigned lo = tab[2 * i], hi = tab[2 * i + 1];
        return (const float*)(const GAS float*)(((unsigned long long)(unsigned)__builtin_amdgcn_readfirstlane((int)hi) << 32) | (unsigned long long)(unsigned)__builtin_amdgcn_readfirstlane((int)lo));
    }
};

__device__ __forceinline__ int lane_id_asm() { int l; asm volatile("v_mbcnt_lo_u32_b32 %0, -1, 0\n\tv_mbcnt_hi_u32_b32 %0, -1, %0" : "=v"(l)); return l; }
#define OPAQUE(x) asm volatile("" : "+v"(x))
__device__ __forceinline__ float wave_sum(float v) {
#pragma unroll
    for (int o = 1; o < 64; o <<= 1) v += __shfl_xor(v, o);
    return v;
}
template <int CTRL> __device__ __forceinline__ float dpp_mov(float v) { return __builtin_bit_cast(float, __builtin_amdgcn_update_dpp(0, __builtin_bit_cast(int, v), CTRL, 0xF, 0xF, true)); }
__device__ __forceinline__ float red8(float v) { v += dpp_mov<0xB1>(v); v += dpp_mov<0x4E>(v); v += dpp_mov<0x141>(v); return v; }
__device__ __forceinline__ float red16(float v) { v = red8(v); v += dpp_mov<0x140>(v); return v; }
__device__ __forceinline__ unsigned f2bf(float f) { unsigned u = __builtin_bit_cast(unsigned, f); return (u + 0x7fffu + ((u >> 16) & 1u)) >> 16; }
typedef __bf16 bf16x2_t __attribute__((ext_vector_type(2)));
__device__ __forceinline__ unsigned pk2(float lo, float hi) { const f32x2 v = {lo, hi}; return __builtin_bit_cast(unsigned, __builtin_convertvector(v, bf16x2_t)); }
__device__ __forceinline__ f32x4 ldp4(const bf16* p) { const u32x2 w = *(const u32x2*)p; return (f32x4){__builtin_bit_cast(float, w.x << 16), __builtin_bit_cast(float, w.x & 0xffff0000u), __builtin_bit_cast(float, w.y << 16), __builtin_bit_cast(float, w.y & 0xffff0000u)}; }
__device__ __forceinline__ float ldp1(const bf16* p) { return __builtin_bit_cast(float, (unsigned)(*p) << 16); }
__device__ __forceinline__ float sigmoidf_(float x) { return __builtin_amdgcn_rcpf(1.0f + __builtin_amdgcn_exp2f(-1.4426950408889634f * x)); }
__device__ __forceinline__ float siluf_(float x) { return x * sigmoidf_(x); }
__device__ __forceinline__ float tanhf_(float x) { return 1.0f - 2.0f * __builtin_amdgcn_rcpf(1.0f + __builtin_amdgcn_exp2f(2.8853900817779268f * x)); }
__device__ __forceinline__ float wave_sum_fast(float v) { v = red16(v); v += __shfl_xor(v, 16); v += __shfl_xor(v, 32); return v; }
__device__ __forceinline__ float softplusf_(float x) { return fmaxf(x, 0.f) + log1pf(__expf(-fabsf(x))); }
__device__ __forceinline__ float lam_init_of(int l) { return l == 0 ? 0.2f : 0.35550907f; }
__device__ __forceinline__ float compute_lam(const Ctx& a, int l, int lane) {
    float v1 = 0.f, v2 = 0.f;
    if (lane < 32) { v1 = a.inp(I_LQ1)[l * 32 + lane] * a.inp(I_LK1)[l * 32 + lane]; v2 = a.inp(I_LQ2)[l * 32 + lane] * a.inp(I_LK2)[l * 32 + lane]; }
    v1 = wave_sum(v1); v2 = wave_sum(v2);
    return expf(v1) - expf(v2) + lam_init_of(l);
}

__device__ __forceinline__ void s5_disc_compute(const Ctx& a, int l, int g, int n, float& ab_re, float& ab_im, float& f_re, float& f_im);
__device__ __forceinline__ void p0_transpose_item(const float* W, int K, int N, bf16* WT, LAS float* scr, int item, int lane) {
    const int nblk = N / 32, kb = item / nblk, nb = item % nblk, k0 = 64 * kb, n0 = 32 * nb;
    float wv[32];
#pragma unroll
    for (int i = 0; i < 32; ++i) wv[i] = W[(size_t)(k0 + 2 * i + (lane >> 5)) * N + n0 + (lane & 31)];
#pragma unroll
    for (int i = 0; i < 32; ++i) scr[(2 * i + (lane >> 5)) * 33 + (lane & 31)] = wv[i];
    asm volatile("s_waitcnt lgkmcnt(0)" ::: "memory");
    const int c = lane & 7;
#pragma unroll
    for (int j = 0; j < 4; ++j) { const int n = (lane >> 3) + 8 * j; const LAS float* s = scr + (8 * c) * 33 + n;
        u32x4 o; o.x = pk2(s[0 * 33], s[1 * 33]); o.y = pk2(s[2 * 33], s[3 * 33]); o.z = pk2(s[4 * 33], s[5 * 33]); o.w = pk2(s[6 * 33], s[7 * 33]);
        *(u32x4*)(WT + (size_t)(n0 + n) * K + k0 + 8 * c) = o; }
    asm volatile("s_waitcnt lgkmcnt(0)" ::: "memory");
}
__device__ __forceinline__ void rms_row_to_bf16(const float* xrow, const float* g, bf16* orow, int lane) {
    const f32x4* xr = (const f32x4*)xrow + lane; const f32x4* gr = (const f32x4*)g + lane;
    f32x4 v[4]; float s = 0.f;
#pragma unroll
    for (int j = 0; j < 4; ++j) { v[j] = xr[64 * j]; s += (v[j].x * v[j].x + v[j].y * v[j].y) + (v[j].z * v[j].z + v[j].w * v[j].w); }
    const float r = rsqrtf(wave_sum(s) * (1.f / DM) + NORM_EPS);
    u32x2* o8 = (u32x2*)orow + lane;
#pragma unroll
    for (int j = 0; j < 4; ++j) { const f32x4 gg = gr[64 * j]; u32x2 o; o.x = pk2(v[j].x * r * gg.x, v[j].y * r * gg.y); o.y = pk2(v[j].z * r * gg.z, v[j].w * r * gg.w); o8[64 * j] = o; }
}
__device__ __forceinline__ void ph_prologue(const Ctx& a, LAS unsigned char* lds, int lane, int wave) {
    OPAQUE(lane);
    LAS float* scr = (LAS float*)(lds + wave * 16384);
    const int gw = blockIdx.x * NWAVES + wave, NGW = gridDim.x * NWAVES;
    constexpr int I_IN = (DM / 64) * (DIN / 32), I_OUT = (DM / 64) * (DM / 32), I_GLU = (256 / 64) * (256 / 32), I_L = I_IN + I_OUT + I_GLU;
    for (int it = gw; it < 2 * I_L; it += NGW) {
        const int l = it / I_L, r = it % I_L;
        if (r < I_IN) p0_transpose_item(a.inp(I_WIN) + (size_t)l * DM * DIN, DM, DIN, (bf16*)(a.ws + WS_WIN) + (size_t)l * DIN * DM, scr, r, lane);
        else if (r < I_IN + I_OUT) p0_transpose_item(a.inp(I_WOUT) + (size_t)l * DM * DM, DM, DM, (bf16*)(a.ws + WS_WOUT) + (size_t)l * DM * DM, scr, r - I_IN, lane);
        else p0_transpose_item(a.inp(I_WGLU) + (size_t)l * 65536, 256, 256, (bf16*)(a.ws + WS_WGLU) + (size_t)l * 65536, scr, r - I_IN - I_OUT, lane);
    }
    {
        bf16* LWT = (bf16*)(a.ws + WS_LWT);
        const float* wa = a.inp(I_LWA); const float* wx = a.inp(I_LWX);
        for (int idx = gw * 64 + lane; idx < 2 * 2 * 4 * 64 * 64; idx += NGW * 64) {
            const int c = idx & 63, d = (idx >> 6) & 63, n = (idx >> 12) & 3, p = (idx >> 14) & 1, l = idx >> 15;
            LWT[idx] = (bf16)f2bf((p ? wx : wa)[((size_t)(l * 4 + n) * 64 + c) * 64 + d]);
        }
    }
    {
        float* T = (float*)(a.ws + WS_S5T);
        for (int idx = gw * 64 + lane; idx < 2 * 16 * 64; idx += NGW * 64) {
            float ar, ai, fr, fi; s5_disc_compute(a, idx >> 10, (idx >> 6) & 15, idx & 63, ar, ai, fr, fi);
            *(f32x4*)(T + (size_t)idx * 4) = (f32x4){ar, ai, fr, fi};
        }
    }
    {
        bf16* W1T = (bf16*)(a.ws + WS_W1T);
        const float* w1 = a.inp(I_W1); const float* a1 = a.inp(I_A1);
        for (int idx = gw * 64 + lane; idx < 2 * 2 * 32 * 256; idx += NGW * 64) {
            const int k = idx & 255, n = (idx >> 8) & 31, p = (idx >> 13) & 1, l = idx >> 14;
            W1T[idx] = (bf16)f2bf((p ? a1 : w1)[((size_t)l * 256 + k) * 32 + n]);
        }
    }
    bf16* H = (bf16*)(a.ws + WS_H);
    {
        const float* xp = a.inp(I_XP); const float* xs = a.inp(I_XS) - (size_t)NP * DM;
        f32x4 gg[4];
#pragma unroll
        for (int j = 0; j < 4; ++j) gg[j] = ((const f32x4*)a.inp(I_NPRE) + lane)[64 * j];
        for (int m0 = gw; m0 < MTOK; m0 += 2 * NGW) {
            const int m1 = m0 + NGW; const bool has1 = m1 < MTOK; const int mb = has1 ? m1 : m0;
            const f32x4* xa = (const f32x4*)((m0 < NP ? xp : xs) + (size_t)m0 * DM) + lane; const f32x4* xb = (const f32x4*)((mb < NP ? xp : xs) + (size_t)mb * DM) + lane;
            f32x4 va[4], vb[4]; float sa = 0.f, sb = 0.f;
#pragma unroll
            for (int j = 0; j < 4; ++j) { va[j] = xa[64 * j]; vb[j] = xb[64 * j]; }
#pragma unroll
            for (int j = 0; j < 4; ++j) { sa += (va[j].x * va[j].x + va[j].y * va[j].y) + (va[j].z * va[j].z + va[j].w * va[j].w); sb += (vb[j].x * vb[j].x + vb[j].y * vb[j].y) + (vb[j].z * vb[j].z + vb[j].w * vb[j].w); }
            const float ra = rsqrtf(wave_sum_fast(sa) * (1.f / DM) + NORM_EPS), rb = rsqrtf(wave_sum_fast(sb) * (1.f / DM) + NORM_EPS);
            u32x2* ha = (u32x2*)(H + (size_t)m0 * DM) + lane; u32x2* hb = (u32x2*)(H + (size_t)mb * DM) + lane;
#pragma unroll
            for (int j = 0; j < 4; ++j) { u32x2 o; o.x = pk2(va[j].x * ra * gg[j].x, va[j].y * ra * gg[j].y); o.y = pk2(va[j].z * ra * gg[j].z, va[j].w * ra * gg[j].w); ha[64 * j] = o;
                if (has1) { u32x2 p; p.x = pk2(vb[j].x * rb * gg[j].x, vb[j].y * rb * gg[j].y); p.y = pk2(vb[j].z * rb * gg[j].z, vb[j].w * rb * gg[j].w); hb[64 * j] = p; } }
        }
    }
}

struct EpiProj {
    static constexpr bool PERM = true, AFTER_DRAIN = false;
    bf16* P; float* out; int layer;
    __device__ __forceinline__ void operator()(const pg8::f32x4 (&acc)[2][2][4][2], const pg8::Unit& u, int wr, int wc, int fr, int fq) const {
        const int row0 = u.pm * 256 + wr * 64 + fr, col0 = u.pn * 256 + wc * 32 + 8 * fq;
#pragma unroll
        for (int ai = 0; ai < 2; ++ai)
#pragma unroll
            for (int m = 0; m < 4; ++m) { bf16* rowp = P + (size_t)(row0 + ai * 128 + m * 16) * DIN + col0;
#pragma unroll
                for (int bj = 0; bj < 2; ++bj) { const pg8::f32x4 v0 = acc[ai][bj][m][0], v1 = acc[ai][bj][m][1];
                    u32x4 w; w.x = pk2(v0[0], v0[1]); w.y = pk2(v0[2], v0[3]); w.z = pk2(v1[0], v1[1]); w.w = pk2(v1[2], v1[3]);
                    *(u32x4*)(rowp + bj * 128) = w; } }
        if (u.pn == 1 || u.pn == 2) {
            const bool smp = (u.pm >= 64);
            float* base;
            if (u.pn == 1) base = smp ? out + OUT_K_S + (size_t)layer * NSMP * 256 : out + OUT_K_P + (size_t)layer * NP * 256;
            else           base = smp ? out + OUT_V_S + (size_t)layer * NSMP * 256 : out + OUT_V_P + (size_t)layer * NP * 256;
            const int r0 = row0 - (smp ? NP : 0), c0 = wc * 32 + 8 * fq;
#pragma unroll
            for (int ai = 0; ai < 2; ++ai)
#pragma unroll
                for (int m = 0; m < 4; ++m) { float* rowp = base + (size_t)(r0 + ai * 128 + m * 16) * 256 + c0;
#pragma unroll
                    for (int bj = 0; bj < 2; ++bj) { __builtin_nontemporal_store(acc[ai][bj][m][0], (pg8::f32x4*)(rowp + bj * 128)); __builtin_nontemporal_store(acc[ai][bj][m][1], (pg8::f32x4*)(rowp + bj * 128 + 4)); } }
        }
    }
};
struct EpiPlain {
    static constexpr bool PERM = true, AFTER_DRAIN = false;
    bf16* C; int ldc;
    __device__ __forceinline__ void operator()(const pg8::f32x4 (&acc)[2][2][4][2], const pg8::Unit& u, int wr, int wc, int fr, int fq) const {
        const int row0 = u.pm * 256 + wr * 64 + fr, col0 = u.pn * 256 + wc * 32 + 8 * fq;
#pragma unroll
        for (int ai = 0; ai < 2; ++ai)
#pragma unroll
            for (int m = 0; m < 4; ++m) { bf16* rowp = C + (size_t)(row0 + ai * 128 + m * 16) * ldc + col0;
#pragma unroll
                for (int bj = 0; bj < 2; ++bj) { const pg8::f32x4 v0 = acc[ai][bj][m][0], v1 = acc[ai][bj][m][1];
                    u32x4 w; w.x = pk2(v0[0], v0[1]); w.y = pk2(v0[2], v0[3]); w.z = pk2(v1[0], v1[1]); w.w = pk2(v1[2], v1[3]);
                    *(u32x4*)(rowp + bj * 128) = w; } }
    }
};

__device__ __forceinline__ void lru_prep_item(const Ctx& a, int l, int item, LAS unsigned char* lds, int tid) {
    OPAQUE(tid);
    const bf16* PROJ = (const bf16*)(a.ws + WS_PROJ);
    float* LA = (float*)(a.ws + WS_LA); float* LB = (float*)(a.ws + WS_LB);
    LAS float* X = (LAS float*)lds;
    LAS float* XC = (LAS float*)(lds + 68608);
    const bool smp = item >= 256;
    int nseg, seglen, m0, s = 0, ch = 0, b0 = 0;
    if (!smp) { s = item >> 5; ch = item & 31; nseg = 1; seglen = 64; m0 = s * SEQ + ch * 64; }
    else { const int j = item - 256; nseg = 4; seglen = 8; m0 = NP + j * 32; b0 = j * 4; }
    const int rps = seglen + 3, L = nseg * seglen;
    {
        const float* sconv = a.inp(I_SCONV);
#pragma unroll 4
        for (int idx = tid; idx < nseg * rps * 64; idx += NTHREADS) {
            const int row = idx >> 6, c4 = idx & 63, seg = row / rps, i = row % rps;
            const bool halo = i < 3;
            const bool fromstate = smp && halo;
            f32x4 v = ldp4(PROJ + (size_t)(m0 + seg * seglen + (halo && (smp || ch == 0) ? 3 : i) - 3) * DIN + OFF_B + 4 * c4);
            const f32x4 vs = *(const f32x4*)(sconv + (fromstate ? ((size_t)(l * DB + b0 + seg) * 3 + i) * 256 : (size_t)0) + 4 * c4);
            if (fromstate) v = vs;
            if (!smp && ch == 0 && halo) v = (f32x4){0.f, 0.f, 0.f, 0.f};
            *(LAS f32x4*)(X + row * 256 + 4 * c4) = v;
        }
    }
    __syncthreads();
    if (smp || ch == 31) {
        for (int idx = tid; idx < nseg * 3 * 256; idx += NTHREADS) {
            const int seg = idx / 768, j = (idx % 768) >> 8, c = idx & 255;
            const float v = X[(seg * rps + seglen + j) * 256 + c];
            if (smp) a.out[OUT_CONV_S + ((size_t)(l * DB + b0 + seg) * 3 + j) * 256 + c] = v;
            else a.out[OUT_CONV_P + ((size_t)(l * 8 + s) * 3 + j) * 256 + c] = v;
        }
    }
    {
        const float* cw = a.inp(I_CONVW) + l * 1024; const float* cb = a.inp(I_CONVB) + l * 256;
        for (int idx = tid; idx < L * 256; idx += NTHREADS) {
            const int t = idx >> 8, c = idx & 255, seg = t / seglen, i = t % seglen;
            const LAS float* bp = X + (seg * rps + i) * 256 + c;
            XC[t * 256 + c] = cb[c] + cw[c] * bp[0] + cw[256 + c] * bp[256] + cw[512 + c] * bp[512] + cw[768 + c] * bp[768];
        }
    }
    __syncthreads();
    {
        const int lane = tid & 63, wv = tid >> 6, p = wv >> 2, n = wv & 3, r = lane & 31, hh = lane >> 5, o = tid & 255;
        const bf16* WT = (const bf16*)(a.ws + WS_LWT) + ((size_t)((l * 2 + p) * 4 + n) * 64) * 64;
        bf16x8 wf[2][4];
#pragma unroll
        for (int dt = 0; dt < 2; ++dt)
#pragma unroll
            for (int sx = 0; sx < 4; ++sx) wf[dt][sx] = *(const bf16x8*)(WT + (dt * 32 + r) * 64 + 16 * sx + 8 * hh);
        const float* bp = (p ? a.inp(I_LBX) : a.inp(I_LBA)) + l * 256 + n * 64 + 4 * hh;
        LAS float* GX = X;
        const int LH = L >> 1;
        bf16* OB = (bf16*)(a.ws + WS_OB);
        const float spv = softplusf_(-a.inp(I_LLAM)[l * 256 + o]) * 1.4426950408889634f;
        const float* slru = a.inp(I_SLRU);
        float hs = 0.f, Ps = 1.f;
        for (int hf = 0; hf < 2; ++hf) {
            {
                const LAS float* xr = XC + (hf * LH + r) * 256 + n * 64 + 8 * hh;
                bf16x8 xb[4];
#pragma unroll
                for (int sx = 0; sx < 4; ++sx) { const f32x4 x0 = *(const LAS f32x4*)(xr + 16 * sx), x1 = *(const LAS f32x4*)(xr + 16 * sx + 4);
                    u32x4 w; w.x = pk2(x0.x, x0.y); w.y = pk2(x0.z, x0.w); w.z = pk2(x1.x, x1.y); w.w = pk2(x1.z, x1.w); xb[sx] = __builtin_bit_cast(bf16x8, w); }
#pragma unroll
                for (int dt = 0; dt < 2; ++dt) {
                    f32x16 acc;
#pragma unroll
                    for (int e = 0; e < 16; ++e) acc[e] = 0.f;
#pragma unroll
                    for (int sx = 0; sx < 4; ++sx) acc = __builtin_amdgcn_mfma_f32_32x32x16_bf16(wf[dt][sx], xb[sx], acc, 0, 0, 0);
#pragma unroll
                    for (int g4 = 0; g4 < 4; ++g4) { const f32x4 bb = *(const f32x4*)(bp + dt * 32 + 8 * g4);
                        f32x4 gv; gv.x = sigmoidf_(acc[4 * g4] + bb.x); gv.y = sigmoidf_(acc[4 * g4 + 1] + bb.y); gv.z = sigmoidf_(acc[4 * g4 + 2] + bb.z); gv.w = sigmoidf_(acc[4 * g4 + 3] + bb.w);
                        *(LAS f32x4*)(GX + (p * 32 + r) * 256 + n * 64 + dt * 32 + 8 * g4 + 4 * hh) = gv; }
                }
            }
            __syncthreads();
            if (p == 0) {
              for (int t0 = 0; t0 < LH; t0 += 8) {
                float gts[8];
                if (smp) {
#pragma unroll
                    for (int t = 0; t < 8; ++t) gts[t] = ldp1(PROJ + (size_t)(m0 + hf * LH + t0 + t) * DIN + OFF_G + 256 + o); }
#pragma unroll
                for (int t8 = 0; t8 < 8; ++t8) {
                    const int t = t0 + t8;
                    const int tt = hf * LH + t, seg = tt / seglen, i = tt % seglen;
                    if (i == 0) { hs = smp ? slru[(size_t)(l * DB + b0 + seg) * 256 + o] : 0.f; Ps = 1.f; }
                    const float rg = GX[t * 256 + o], g = GX[(32 + t) * 256 + o];
                    const float av = __builtin_amdgcn_exp2f(-8.0f * rg * spv);
                    const float mult = __builtin_amdgcn_sqrtf(fmaxf(1.0f - av * av, 0.f));
                    const float bv = mult * g * XC[tt * 256 + o];
                    const size_t m = (size_t)(m0 + tt);
                    hs = av * hs + bv; Ps *= av;
                    if (smp) { OB[m * DM + 256 + o] = (bf16)f2bf(hs * siluf_(gts[t8])); if (i == seglen - 1) a.out[OUT_LRU_S + (size_t)(l * DB + b0 + seg) * 256 + o] = hs; }
                    else { LA[m * 256 + o] = av; LB[m * 256 + o] = bv; }
                }
              }
            }
            __syncthreads();
        }
        if (!smp && p == 0) { ((float*)(a.ws + WS_LP))[(size_t)(s * 32 + ch) * 256 + o] = Ps; ((float*)(a.ws + WS_LE))[(size_t)(s * 32 + ch) * 256 + o] = hs; }
    }
    __syncthreads();
}

__device__ __forceinline__ void rwkv_prep_item(const Ctx& a, int l, int item, LAS unsigned char* lds, int tid) {
    OPAQUE(tid);
    const bf16* PROJ = (const bf16*)(a.ws + WS_PROJ);
    float* RW = (float*)(a.ws + WS_RW);
    const float* mu = a.inp(I_MU) + l * 1280; const float* sshift = a.inp(I_SSHIFT) + (size_t)l * DB * 1280;
    LAS float* XWA = (LAS float*)lds;
    LAS float* T1 = (LAS float*)(lds + 65536);
    const int m0 = item * 32;
#pragma unroll
    for (int kb = 0; kb < 20; kb += 10) {
        f32x4 pv[10], ppv[10], psv[10];
#pragma unroll
        for (int k = 0; k < 10; ++k) {
            const int idx = tid + NTHREADS * (kb + k), t = idx / 320, c4 = idx % 320, col = 4 * c4, m = m0 + t;
            const bool first = (m < NP) ? ((m & (SEQ - 1)) == 0) : (((m - NP) & 7) == 0);
            const bool fromstate = first && m >= NP;
            pv[k] = ldp4(PROJ + (size_t)m * DIN + OFF_C + col);
            ppv[k] = ldp4(PROJ + (size_t)(first ? m : m - 1) * DIN + OFF_C + col);
            psv[k] = *(const f32x4*)(sshift + (fromstate ? (size_t)((m - NP) >> 3) * 1280 : (size_t)0) + col);
        }
#pragma unroll
        for (int k = 0; k < 10; ++k) {
            const int idx = tid + NTHREADS * (kb + k), t = idx / 320, c4 = idx % 320, col = 4 * c4, m = m0 + t;
            const bool first = (m < NP) ? ((m & (SEQ - 1)) == 0) : (((m - NP) & 7) == 0);
            f32x4 pp = ppv[k];
            if (first && m >= NP) pp = psv[k];
            if (first && m < NP) pp = (f32x4){0.f, 0.f, 0.f, 0.f};
            const f32x4 xm = pv[k] + (pp - pv[k]) * *(const f32x4*)(mu + col);
            const int sec = c4 >> 6, cc = col & 255;
            if (sec == 1) *(LAS f32x4*)(XWA + t * 512 + cc) = xm;
            else if (sec == 4) *(LAS f32x4*)(XWA + t * 512 + 256 + cc) = xm;
            else *(f32x4*)(RW + (size_t)m * 1536 + (sec == 0 ? 0 : (sec == 2 ? 512 : 768)) + cc) = xm;
        }
    }
    __syncthreads();
    if (tid < 128) {
        const int lane = tid & 63, p = tid >> 6, r = lane & 31, hh = lane >> 5;
        const bf16* wt = (const bf16*)(a.ws + WS_W1T) + ((size_t)(l * 2 + p) * 32 + r) * 256 + 8 * hh;
        const LAS float* xr = XWA + r * 512 + p * 256 + 8 * hh;
        f32x16 acc;
#pragma unroll
        for (int e = 0; e < 16; ++e) acc[e] = 0.f;
#pragma unroll
        for (int sx = 0; sx < 16; ++sx) {
            const bf16x8 af = *(const bf16x8*)(wt + 16 * sx);
            const f32x4 x0 = *(const LAS f32x4*)(xr + 16 * sx), x1 = *(const LAS f32x4*)(xr + 16 * sx + 4);
            u32x4 w; w.x = pk2(x0.x, x0.y); w.y = pk2(x0.z, x0.w); w.z = pk2(x1.x, x1.y); w.w = pk2(x1.z, x1.w);
            acc = __builtin_amdgcn_mfma_f32_32x32x16_bf16(af, __builtin_bit_cast(bf16x8, w), acc, 0, 0, 0);
        }
#pragma unroll
        for (int g4 = 0; g4 < 4; ++g4) { f32x4 v = (f32x4){acc[4 * g4], acc[4 * g4 + 1], acc[4 * g4 + 2], acc[4 * g4 + 3]};
            if (p == 0) { v.x = tanhf_(v.x); v.y = tanhf_(v.y); v.z = tanhf_(v.z); v.w = tanhf_(v.w); }
            *(LAS f32x4*)(T1 + r * 64 + p * 32 + 8 * g4 + 4 * hh) = v; }
    }
    __syncthreads();
    {
        const int o = tid & 255, half = tid >> 8;
        float wr[32];
        const float* w2p = (half ? a.inp(I_A2) : a.inp(I_W2)) + (size_t)l * 32 * 256 + o;
#pragma unroll
        for (int j = 0; j < 32; ++j) wr[j] = w2p[(size_t)j * 256];
        const float b0 = (half ? a.inp(I_A0) : a.inp(I_W0))[l * 256 + o];
        const float kkw = a.inp(I_KK)[l * 256 + o], kaw = a.inp(I_KA)[l * 256 + o];
#pragma unroll
        for (int t0 = 0; t0 < 32; t0 += 8) {
            float xk_[8];
            if (half) {
#pragma unroll
                for (int t = 0; t < 8; ++t) xk_[t] = RW[(size_t)(m0 + t0 + t) * 1536 + 512 + o]; }
#pragma unroll
            for (int t8 = 0; t8 < 8; ++t8) {
                const int t = t0 + t8;
                float z0 = b0, z1 = 0.f;
                const LAS float* tp = T1 + t * 64 + half * 32;
#pragma unroll
                for (int j4 = 0; j4 < 8; ++j4) { const f32x4 tv = *(const LAS f32x4*)(tp + 4 * j4);
                    z0 += tv.x * wr[4 * j4] + tv.y * wr[4 * j4 + 1]; z1 += tv.z * wr[4 * j4 + 2] + tv.w * wr[4 * j4 + 3]; }
                const float z = z0 + z1;
                float* rwp = RW + (size_t)(m0 + t) * 1536 + o;
                if (half == 0) {
                    rwp[256] = __builtin_amdgcn_exp2f(-0.8750566294f * sigmoidf_(z));
                } else {
                    const float aa = sigmoidf_(z);
                    const float xk = xk_[t8];
                    const float kkv = xk * kkw;
                    const float ss = wave_sum_fast(kkv * kkv);
                    const float kkn = kkv * __builtin_amdgcn_rsqf(fmaxf(ss, 1e-24f));
                    rwp[512] = xk * (1.0f + (aa - 1.0f) * kaw); rwp[1024] = -kkn; rwp[1280] = kkn * aa;
                }
            }
        }
    }
    __syncthreads();
}

__device__ __forceinline__ void s5_disc(const Ctx& a, int l, int g, int n, float& ab_re, float& ab_im, float& f_re, float& f_im) {
    const f32x4 t = *(const f32x4*)((const float*)(a.ws + WS_S5T) + ((size_t)(l * 16 + g) * 64 + n) * 4);
    ab_re = t.x; ab_im = t.y; f_re = t.z; f_im = t.w;
}
__device__ __forceinline__ void s5_disc_compute(const Ctx& a, int l, int g, int n, float& ab_re, float& ab_im, float& f_re, float& f_im) {
    const float lr = a.inp(I_LRE)[(l * 16 + g) * 64 + n], li = a.inp(I_LIM)[(l * 16 + g) * 64 + n];
    const float dt = expf(a.inp(I_LOGDT)[l * 16 + g]);
    const float mag = expf(lr * dt);
    ab_re = mag * cosf(li * dt); ab_im = mag * sinf(li * dt);
    const float den = lr * lr + li * li, pr = ab_re - 1.0f;
    f_re = (pr * lr + ab_im * li) / den; f_im = (ab_im * lr - pr * li) / den;
}
struct S5Par { float ab_re, ab_im; bf16x8 bf[4]; };
__device__ __forceinline__ void s5_params(const Ctx& a, int l, int g, int lane, S5Par& P) {
    float fr, fi;
    s5_disc(a, l, g, lane, P.ab_re, P.ab_im, fr, fi);
    const int r = lane & 31, hh = lane >> 5;
#pragma unroll
    for (int nh = 0; nh < 2; ++nh) {
        float xr, xi, f_re, f_im;
        s5_disc(a, l, g, 32 * nh + r, xr, xi, f_re, f_im);
        const float* brp = a.inp(I_BRE) + ((size_t)(l * 16 + g) * 64 + 32 * nh + r) * 16 + 8 * hh; const float* bip = a.inp(I_BIM) + ((size_t)(l * 16 + g) * 64 + 32 * nh + r) * 16 + 8 * hh;
        const f32x4 r0 = *(const f32x4*)brp, r1 = *(const f32x4*)(brp + 4), i0 = *(const f32x4*)bip, i1 = *(const f32x4*)(bip + 4);
        u32x4 wr, wi;
        wr.x = pk2(f_re * r0.x - f_im * i0.x, f_re * r0.y - f_im * i0.y); wr.y = pk2(f_re * r0.z - f_im * i0.z, f_re * r0.w - f_im * i0.w);
        wr.z = pk2(f_re * r1.x - f_im * i1.x, f_re * r1.y - f_im * i1.y); wr.w = pk2(f_re * r1.z - f_im * i1.z, f_re * r1.w - f_im * i1.w);
        wi.x = pk2(f_re * i0.x + f_im * r0.x, f_re * i0.y + f_im * r0.y); wi.y = pk2(f_re * i0.z + f_im * r0.z, f_re * i0.w + f_im * r0.w);
        wi.z = pk2(f_re * i1.x + f_im * r1.x, f_re * i1.y + f_im * r1.y); wi.w = pk2(f_re * i1.z + f_im * r1.z, f_re * i1.w + f_im * r1.w);
        P.bf[nh] = __builtin_bit_cast(bf16x8, wr); P.bf[2 + nh] = __builtin_bit_cast(bf16x8, wi);
    }
}
__device__ __forceinline__ void s5_bu_block(const S5Par& P, const bf16* PROJ, size_t m0, int nvalid, int g, LAS float* HR, LAS float* HI, int lane) {
    const int r = lane & 31, hh = lane >> 5;
    const int tr = r < nvalid ? r : nvalid - 1;
    const bf16x8 uf = *(const bf16x8*)(PROJ + (m0 + tr) * DIN + OFF_D + g * 16 + 8 * hh);
#pragma unroll
    for (int tile = 0; tile < 4; ++tile) {
        f32x16 acc;
#pragma unroll
        for (int e = 0; e < 16; ++e) acc[e] = 0.f;
        acc = __builtin_amdgcn_mfma_f32_32x32x16_bf16(P.bf[tile], uf, acc, 0, 0, 0);
        LAS float* dst = ((tile >> 1) ? HI : HR) + r * 68 + 32 * (tile & 1) + 4 * hh;
#pragma unroll
        for (int g4 = 0; g4 < 4; ++g4) *(LAS f32x4*)(dst + 8 * g4) = (f32x4){acc[4 * g4], acc[4 * g4 + 1], acc[4 * g4 + 2], acc[4 * g4 + 3]};
    }
    asm volatile("s_waitcnt lgkmcnt(0)" ::: "memory");
}
__device__ __forceinline__ void s5_pass1_wave(const Ctx& a, int l, int wi, LAS unsigned char* wlds, int lane) {
    OPAQUE(lane);
    const int ck = wi & 15, g = (wi >> 4) & 15, s = wi >> 8;
    const bf16* PROJ = (const bf16*)(a.ws + WS_PROJ);
    LAS float* HR = (LAS float*)wlds; LAS float* HI = HR + 32 * 68;
    S5Par P; s5_params(a, l, g, lane, P);
    float hr = 0.f, hi = 0.f;
    for (int t0 = 0; t0 < 128; t0 += 32) {
        s5_bu_block(P, PROJ, (size_t)(s * SEQ + ck * 128 + t0), 32, g, HR, HI, lane);
#pragma unroll 8
        for (int t = 0; t < 32; ++t) { const float br = HR[t * 68 + lane], bi = HI[t * 68 + lane];
            const float nr = P.ab_re * hr - P.ab_im * hi + br, ni = P.ab_re * hi + P.ab_im * hr + bi; hr = nr; hi = ni; }
        asm volatile("s_waitcnt lgkmcnt(0)" ::: "memory");
    }
    f32x2* E = (f32x2*)(a.ws + WS_S5E);
    E[((size_t)(s * 16 + g) * 16 + ck) * 64 + lane] = (f32x2){hr, hi};
}

__device__ __forceinline__ void attn_prep_rows_wave(const Ctx& a, int wi, int lane) {
    OPAQUE(lane);
    const bf16* PROJ = (const bf16*)(a.ws + WS_PROJ);
    bf16* QB = (bf16*)(a.ws + WS_QB);
#pragma unroll
    for (int r = 0; r < 8; ++r) { const size_t m = (size_t)wi * 8 + r;
        const f32x4 q = ldp4(PROJ + m * DIN + OFF_AQ + 4 * lane);
        u32x2 qo; qo.x = pk2(q.x * QSCALE, q.y * QSCALE); qo.y = pk2(q.z * QSCALE, q.w * QSCALE);
        *(u32x2*)(QB + m * 256 + 4 * lane) = qo; }
}
__device__ __forceinline__ void attn_prep_kv_wave(const Ctx& a, int wi, int lane) {
    OPAQUE(lane);
    const bf16* PROJ = (const bf16*)(a.ws + WS_PROJ);
    bf16* KF = (bf16*)(a.ws + WS_KB); bf16* VF = (bf16*)(a.ws + WS_VT);
    const int kt = wi & 63, b = wi >> 6, r = lane & 31, hh = lane >> 5;
    const bf16* krow = PROJ + (size_t)(b * SEQ + kt * 32 + r) * DIN + OFF_AK + 8 * hh;
    const bf16* vcol = PROJ + (size_t)(b * SEQ + kt * 32 + 4 * hh) * DIN + OFF_AV + r;
#pragma unroll
    for (int h = 0; h < 4; ++h) {
#pragma unroll
        for (int cs = 0; cs < 4; ++cs) {
            const u32x4 ko = *(const u32x4*)(krow + h * 64 + cs * 16);
            const size_t frag = ((size_t)((b * 4 + h) * 64 + kt) * 4 + cs) * 512 + lane * 8;
            *(u32x4*)(KF + frag) = ko;
            const int tl = cs >> 1, s2 = cs & 1;
            const bf16* vp = vcol + (size_t)(16 * s2) * DIN + h * 64 + 32 * tl;
            unsigned v[8];
#pragma unroll
            for (int jj = 0; jj < 8; ++jj) v[jj] = (unsigned)vp[(size_t)(8 * (jj >> 2) + (jj & 3)) * DIN];
            u32x4 vo; vo.x = v[0] | (v[1] << 16); vo.y = v[2] | (v[3] << 16); vo.z = v[4] | (v[5] << 16); vo.w = v[6] | (v[7] << 16);
            *(u32x4*)(VF + frag) = vo;
        }
    }
}

#ifndef MP_MASK
#define MP_MASK 0x1f
#endif
#ifndef MM_MASK
#define MM_MASK 0x7f
#endif
#define MPE(j) ((MP_MASK >> (j)) & 1)
#define MME(j) ((MM_MASK >> (j)) & 1)
constexpr int MP_LRU = 256 + 32, MP_RW = MTOK / 32, MP_S5 = 256  , MP_AR = 256  , MP_VT = 64  ;
constexpr int MP_TOTAL = MP_LRU + MP_RW + MP_S5 + MP_AR + MP_VT;
__device__ __forceinline__ int grab_unit(unsigned* ctr, volatile LAS unsigned* MISC, int tid) {
    __syncthreads();
    if (tid == 0) MISC[4] = atomicAdd(ctr, 1u);
    __syncthreads();
    return (int)MISC[4];
}
__device__ __forceinline__ void ph_mixprep(const Ctx& a, int lq, int MMSK, LAS unsigned char* lds, volatile LAS unsigned* MISC, int tid, int lane, int wave) {
    const int l = lq & 1;
    unsigned* qctr = (unsigned*)(a.ws + WS_CTL) + CW_QUEUE + 4096 + 512 * lq;
    int u;
    if (MMSK & 1) while ((u = grab_unit(qctr + 0 * 64, MISC, tid)) < MP_LRU) lru_prep_item(a, l, u, lds, tid);
    if (MMSK & 2) while ((u = grab_unit(qctr + 1 * 64, MISC, tid)) < MP_RW) rwkv_prep_item(a, l, u, lds, tid);
    if (MMSK & 4) while ((u = grab_unit(qctr + 2 * 64, MISC, tid)) < MP_S5) s5_pass1_wave(a, l, u * 8 + wave, lds + wave * 17408, lane);
    if (MMSK & 8) while ((u = grab_unit(qctr + 3 * 64, MISC, tid)) < MP_AR) attn_prep_rows_wave(a, u * 8 + wave, lane);
    if (MMSK & 16) while ((u = grab_unit(qctr + 4 * 64, MISC, tid)) < MP_VT) attn_prep_kv_wave(a, u * 8 + wave, lane);
    {
        const bf16* PROJ = (const bf16*)(a.ws + WS_PROJ);
        const int gt = blockIdx.x * NTHREADS + tid, NGT = gridDim.x * NTHREADS;
        for (int idx = gt; idx < 136 * 1280; idx += NGT) {
            const int q = idx / 1280, c = idx % 1280;
            if (q < 8) a.out[OUT_SHIFT_P + (size_t)(l * 8 + q) * 1280 + c] = ldp1(PROJ + (size_t)(q * SEQ + SEQ - 1) * DIN + OFF_C + c);
            else a.out[OUT_SHIFT_S + (size_t)(l * DB + (q - 8)) * 1280 + c] = ldp1(PROJ + (size_t)(NP + (q - 8) * 8 + 7) * DIN + OFF_C + c);
        }
    }
}

struct RwOps { f32x2 w[4], k[4], a[4], b[4], r[4]; float vi; };
__device__ __forceinline__ void rw_ld4(f32x2 (&d)[4], const LAS float* p) { const f32x4 x = *(const LAS f32x4*)p, y = *(const LAS f32x4*)(p + 4);
    d[0] = (f32x2){x.x, x.y}; d[1] = (f32x2){x.z, x.w}; d[2] = (f32x2){y.x, y.y}; d[3] = (f32x2){y.z, y.w}; }
template <int MODE> __device__ __forceinline__ void rw_load_ops(RwOps& o, const LAS float* base, int i, int jq) {
    rw_ld4(o.w, base + 64 + 8 * jq); rw_ld4(o.k, base + 128 + 8 * jq);
    o.vi = base[192 + i];
    rw_ld4(o.a, base + 256 + 8 * jq); rw_ld4(o.b, base + 320 + 8 * jq);
    if (MODE == 0) rw_ld4(o.r, base + 8 * jq);
}
__device__ __forceinline__ float rw_dot(const f32x2 (&S)[4], const f32x2 (&v)[4]) {
    const f32x2 d0 = S[0] * v[0] + S[1] * v[1], d1 = S[2] * v[2] + S[3] * v[3];
    const f32x2 d = d0 + d1;
    return d.x + d.y;
}
template <int MODE> __device__ __forceinline__ void rw_step(const RwOps& o, f32x2 (&S)[4], f32x2 (&Pm)[4], LAS float* yslot, int jq) {
    const float sa = red8(rw_dot(S, o.a));
    const f32x2 sa2 = (f32x2){sa, sa}, vi2 = (f32x2){o.vi, o.vi};
#pragma unroll
    for (int k = 0; k < 4; ++k) S[k] = (S[k] * o.w[k] + vi2 * o.k[k]) + sa2 * o.b[k];
    if (MODE == 0) {
        const float y = red8(rw_dot(S, o.r));
        if (jq == 0) *yslot = y;
    } else {
        const float sp = red8(rw_dot(Pm, o.a));
        const f32x2 sp2 = (f32x2){sp, sp};
#pragma unroll
        for (int k = 0; k < 4; ++k) Pm[k] = Pm[k] * o.w[k] + sp2 * o.b[k];
    }
}
template <int MODE, int TT>
__device__ __forceinline__ void rwkv_core(const Ctx& a, int l, int h, int mbase, int T, float (&S8)[8], float (&P8)[8], LAS unsigned char* lds, int tid) {
    f32x2 S[4], Pm[4];
#pragma unroll
    for (int k = 0; k < 4; ++k) { S[k] = (f32x2){S8[2 * k], S8[2 * k + 1]}; Pm[k] = (f32x2){P8[2 * k], P8[2 * k + 1]}; }
    const float* RW = (const float*)(a.ws + WS_RW);
    const f32x4 rk4 = *(const f32x4*)(a.inp(I_RK) + l * 256 + h * 64 + 4 * (tid & 15));
    bf16* OB = (bf16*)(a.ws + WS_OB); const bf16* PROJ = (const bf16*)(a.ws + WS_PROJ);
    LAS float* RWT = (LAS float*)lds;
    LAS float* Y = (LAS float*)(lds + 49152);
    const int i = tid >> 3, jq = tid & 7;
    f32x4 pre[6];
#define RW_LOAD(tile) do { _Pragma("unroll") for (int k = 0; k < 6; ++k) { const int idx = tid + NTHREADS * k; \
        if (idx < TT * 96) { const int t = idx / 96, rem = idx % 96, sec = rem >> 4, c4 = rem & 15; \
            pre[k] = *(const f32x4*)(RW + (size_t)(mbase + (tile) * TT + t) * 1536 + sec * 256 + h * 64 + 4 * c4); } } } while (0)
#define RW_STORE() do { _Pragma("unroll") for (int k = 0; k < 6; ++k) { const int idx = tid + NTHREADS * k; \
        if (idx < TT * 96) *(LAS f32x4*)(RWT + idx * 4) = pre[k]; } } while (0)
    const int ntile = T / TT;
    const int gt_t = tid >> 4, gt_q = tid & 15;
    f32x4 gn_w = (f32x4){0.f, 0.f, 0.f, 0.f}, gn_b = gn_w, gpre = gn_w;
    if (MODE == 0) { gn_w = *(const f32x4*)(a.inp(I_GNW) + l * 256 + h * 64 + 4 * gt_q); gn_b = *(const f32x4*)(a.inp(I_GNB) + l * 256 + h * 64 + 4 * gt_q); }
    RW_LOAD(0);
    __syncthreads();
    RW_STORE();
    __syncthreads();
    for (int tile = 0; tile < ntile; ++tile) {
        if (tile + 1 < ntile) RW_LOAD(tile + 1);
        if (MODE == 0 && gt_t < TT) gpre = ldp4(PROJ + (size_t)(mbase + tile * TT + gt_t) * DIN + OFF_G + 512 + h * 64 + 4 * gt_q);
        {
            RwOps oa, ob;
            rw_load_ops<MODE>(oa, RWT, i, jq);
            for (int t = 0; t < TT; t += 2) {
                rw_load_ops<MODE>(ob, RWT + (t + 1) * 384, i, jq);
                rw_step<MODE>(oa, S, Pm, Y + t * 64 + i, jq);
                rw_load_ops<MODE>(oa, RWT + (t + 2) * 384, i, jq);
                rw_step<MODE>(ob, S, Pm, Y + (t + 1) * 64 + i, jq);
            }
        }
        __syncthreads();
        if (MODE == 0) {
            const int t = tid >> 4, q = tid & 15;
            if (t < TT) {
                const f32x4 yv = *(const LAS f32x4*)(Y + t * 64 + 4 * q);
                const float mean = red16((yv.x + yv.y) + (yv.z + yv.w)) * (1.f / 64.f);
                const f32x4 dv = yv - mean;
                const float rs = rsqrtf(red16((dv.x * dv.x + dv.y * dv.y) + (dv.z * dv.z + dv.w * dv.w)) * (1.f / 64.f) + 64.0f * 1e-5f);
                const int m = mbase + tile * TT + t;
                const f32x4 gw = gn_w, gb = gn_b;
                const f32x4 vv = *(const LAS f32x4*)(RWT + t * 384 + 192 + 4 * q);
                const f32x4 r4 = *(const LAS f32x4*)(RWT + t * 384 + 4 * q), k4 = *(const LAS f32x4*)(RWT + t * 384 + 128 + 4 * q);
                const float bon = red16((r4.x * k4.x * rk4.x + r4.y * k4.y * rk4.y) + (r4.z * k4.z * rk4.z + r4.w * k4.w * rk4.w));
                const f32x4 o = dv * rs * gw + gb + bon * vv;
                const f32x4 gt = gpre;
                u32x2 ow; ow.x = pk2(o.x * siluf_(gt.x), o.y * siluf_(gt.y)); ow.y = pk2(o.z * siluf_(gt.z), o.w * siluf_(gt.w));
                *(u32x2*)(OB + (size_t)m * DM + 512 + h * 64 + 4 * q) = ow;
            }
            __syncthreads();
        }
        if (tile + 1 < ntile) { RW_STORE(); }
        __syncthreads();
    }
#undef RW_LOAD
#undef RW_STORE
#pragma unroll
    for (int k = 0; k < 4; ++k) { S8[2 * k] = S[k].x; S8[2 * k + 1] = S[k].y; P8[2 * k] = Pm[k].x; P8[2 * k + 1] = Pm[k].y; }
}
__device__ __forceinline__ void st8(float* dst, const float (&S)[8]) { *(f32x4*)dst = (f32x4){S[0], S[1], S[2], S[3]}; *(f32x4*)(dst + 4) = (f32x4){S[4], S[5], S[6], S[7]}; }
__device__ __forceinline__ void ld8(const float* src, float (&S)[8]) { const f32x4 s0 = *(const f32x4*)src, s1 = *(const f32x4*)(src + 4);
    S[0] = s0.x; S[1] = s0.y; S[2] = s0.z; S[3] = s0.w; S[4] = s1.x; S[5] = s1.y; S[6] = s1.z; S[7] = s1.w; }
__device__ __forceinline__ void rwkv_sample_unit(const Ctx& a, int l, int b, int h, LAS unsigned char* lds, int tid) {
    OPAQUE(tid);
    const int i = tid >> 3, jq = tid & 7;
    float S[8], D[8];
    ld8(a.inp(I_SWKV) + (((size_t)(l * DB + b) * 4 + h) * 64 + i) * 64 + 8 * jq, S);
    rwkv_core<0, 8>(a, l, h, NP + b * DS, DS, S, D, lds, tid);
    st8(a.out + OUT_WKV_S + (((size_t)(l * DB + b) * 4 + h) * 64 + i) * 64 + 8 * jq, S);
}
__device__ __forceinline__ void rwkv_prompt_unitA(const Ctx& a, int l, int u, LAS unsigned char* lds, int tid) {
    OPAQUE(tid);
    const int c = u & 7, h = (u >> 3) & 3, s = u >> 5;
    if (c == 7) return;
    const int i = tid >> 3, jq = tid & 7;
    float* pz = (float*)(a.ws + WS_PZ) + ((size_t)((s * 4 + h) * 8 + c) * 2) * 4096 + i * 64 + 8 * jq;
    float S[8], Pm[8];
#pragma unroll
    for (int e = 0; e < 8; ++e) { S[e] = 0.f; Pm[e] = (8 * jq + e == i) ? 1.f : 0.f; }
    if (c == 0) { rwkv_core<0, 32>(a, l, h, s * SEQ, 256, S, Pm, lds, tid); st8(pz + 4096, S); }
    else { rwkv_core<1, 32>(a, l, h, s * SEQ + c * 256, 256, S, Pm, lds, tid); st8(pz, Pm); st8(pz + 4096, S); }
}
__device__ __forceinline__ void rwkv_prompt_unitB(const Ctx& a, int l, int u, LAS unsigned char* lds, int tid) {
    OPAQUE(tid);
    const int c = 7 - (u >> 5), sh = u & 31, s = sh >> 2, h = sh & 3;
    const int i = tid >> 3, jq = tid & 7;
    const float* pzb = (const float*)(a.ws + WS_PZ) + ((size_t)(sh * 8) * 2) * 4096;
    LAS float* SL = (LAS float*)lds;
    LAS float* PL = (LAS float*)(lds + 17408);
    float S[8], Z[8];
    ld8(pzb + 4096 + i * 64 + 8 * jq, S);
    {
        f32x4 pp[6][2]; float ZZ[6][8];
#pragma unroll
        for (int cp = 1; cp <= 6; ++cp) if (cp < c) { const float* pg = pzb + (size_t)cp * 8192;
            pp[cp - 1][0] = *(const f32x4*)(pg + tid * 4); pp[cp - 1][1] = *(const f32x4*)(pg + (tid + NTHREADS) * 4); ld8(pg + 4096 + i * 64 + 8 * jq, ZZ[cp - 1]); }
        __syncthreads();
#pragma unroll
        for (int cp = 1; cp <= 6; ++cp) if (cp < c) { *(LAS f32x4*)(PL + (cp - 1) * 4096 + tid * 4) = pp[cp - 1][0]; *(LAS f32x4*)(PL + (cp - 1) * 4096 + (tid + NTHREADS) * 4) = pp[cp - 1][1]; }
#pragma unroll
        for (int cp = 1; cp <= 6; ++cp) if (cp < c) {
            __syncthreads();
            *(LAS f32x4*)(SL + i * 68 + 8 * jq) = (f32x4){S[0], S[1], S[2], S[3]}; *(LAS f32x4*)(SL + i * 68 + 8 * jq + 4) = (f32x4){S[4], S[5], S[6], S[7]};
            __syncthreads();
            const LAS float* PLc = PL + (cp - 1) * 4096;
#pragma unroll
            for (int e = 0; e < 8; ++e) Z[e] = ZZ[cp - 1][e];
#pragma unroll 4
            for (int k4 = 0; k4 < 16; ++k4) {
                const f32x4 sv = *(const LAS f32x4*)(SL + i * 68 + 4 * k4);
#pragma unroll
                for (int kk = 0; kk < 4; ++kk) { const f32x4 q0 = *(const LAS f32x4*)(PLc + (4 * k4 + kk) * 64 + 8 * jq), q1 = *(const LAS f32x4*)(PLc + (4 * k4 + kk) * 64 + 8 * jq + 4);
                    const float x = sv[kk];
                    Z[0] += x * q0.x; Z[1] += x * q0.y; Z[2] += x * q0.z; Z[3] += x * q0.w; Z[4] += x * q1.x; Z[5] += x * q1.y; Z[6] += x * q1.z; Z[7] += x * q1.w; }
            }
#pragma unroll
            for (int e = 0; e < 8; ++e) S[e] = Z[e];
        }
    }
    rwkv_core<0, 32>(a, l, h, s * SEQ + c * 256, 256, S, Z, lds, tid);
    if (c == 7) st8(a.out + OUT_WKV_P + (((size_t)(l * 8 + s) * 4 + h) * 64 + i) * 64 + 8 * jq, S);
}

__device__ __forceinline__ void lru_pass2_wave(const Ctx& a, int l, int wi, int lane) {
    OPAQUE(lane);
    const int q = wi & 3, ch = (wi >> 2) & 31, s = wi >> 7;
    const int o = q * 64 + lane;
    const float* LA = (const float*)(a.ws + WS_LA); const float* LB = (const float*)(a.ws + WS_LB);
    const float* LP = (const float*)(a.ws + WS_LP); const float* LE = (const float*)(a.ws + WS_LE);
    bf16* OB = (bf16*)(a.ws + WS_OB); const bf16* PROJ = (const bf16*)(a.ws + WS_PROJ);
    float h = 0.f;
#pragma unroll 8
    for (int c = 0; c < ch; ++c) h = LP[(size_t)(s * 32 + c) * 256 + o] * h + LE[(size_t)(s * 32 + c) * 256 + o];
    const size_t m0 = (size_t)s * SEQ + ch * 64;
#pragma unroll
    for (int i0 = 0; i0 < 64; i0 += 32) {
        float av[32], bv[32], gv[32];
#pragma unroll
        for (int i = 0; i < 32; ++i) { av[i] = LA[(m0 + i0 + i) * 256 + o]; bv[i] = LB[(m0 + i0 + i) * 256 + o]; gv[i] = ldp1(PROJ + (m0 + i0 + i) * DIN + OFF_G + 256 + o); }
#pragma unroll
        for (int i = 0; i < 32; ++i) { h = av[i] * h + bv[i]; OB[(m0 + i0 + i) * DM + 256 + o] = (bf16)f2bf(h * siluf_(gv[i])); }
    }
    if (ch == 31) a.out[OUT_LRU_P + (size_t)(l * 8 + s) * 256 + o] = h;
}

__device__ __forceinline__ float gelu_tanh(float y) { return 0.5f * y * (1.0f + tanhf_(0.7978845608028654f * (y + 0.044715f * y * y * y))); }
__device__ __forceinline__ void s5_pass2_wave(const Ctx& a, int l, bool smp, int wi, LAS unsigned char* wlds, int lane) {
    OPAQUE(lane);
    const bf16* PROJ = (const bf16*)(a.ws + WS_PROJ);
    bf16* ZB = (bf16*)(a.ws + WS_ZB);
    LAS float* HR = (LAS float*)wlds;
    LAS float* HI = HR + 32 * 68;
    int g, mbase, T, ck = 0, sq;
    if (smp) { g = wi & 15; sq = wi >> 4; mbase = NP + sq * DS; T = DS; }
    else { ck = wi & 15; g = (wi >> 4) & 15; sq = wi >> 8; mbase = sq * SEQ + ck * 128; T = 128; }
    S5Par P; s5_params(a, l, g, lane, P);
    float hr, hi;
    if (smp) { const f32x2 v = *(const f32x2*)(a.inp(I_SSSM) + (((size_t)(l * DB + sq) * 16 + g) * 64 + lane) * 2); hr = v.x; hi = v.y; }
    else {
        float pr = P.ab_re, pi = P.ab_im;
#pragma unroll
        for (int k = 0; k < 7; ++k) { const float nr = pr * pr - pi * pi, ni = 2.0f * pr * pi; pr = nr; pi = ni; }
        hr = 0.f; hi = 0.f;
        const f32x2* E = (const f32x2*)(a.ws + WS_S5E) + ((size_t)(sq * 16 + g) * 16) * 64 + lane;
        for (int c = 0; c < ck; ++c) { const f32x2 e = E[(size_t)c * 64]; const float nr = pr * hr - pi * hi + e.x, ni = pr * hi + pi * hr + e.y; hr = nr; hi = ni; }
    }
    const int cc = lane & 15, kq = lane >> 4;
    bf16x8 cf[4];
    {
        const float* crp = a.inp(I_CRE) + ((size_t)(l * 16 + g) * 16 + cc) * 64 + 8 * kq; const float* cip = a.inp(I_CIM) + ((size_t)(l * 16 + g) * 16 + cc) * 64 + 8 * kq;
#pragma unroll
        for (int ks = 0; ks < 4; ++ks) { const float* p = (ks < 2 ? crp : cip) + 32 * (ks & 1); const float sg = ks < 2 ? 1.f : -1.f;
            const f32x4 x0 = *(const f32x4*)p, x1 = *(const f32x4*)(p + 4);
            u32x4 w; w.x = pk2(sg * x0.x, sg * x0.y); w.y = pk2(sg * x0.z, sg * x0.w); w.z = pk2(sg * x1.x, sg * x1.y); w.w = pk2(sg * x1.z, sg * x1.w); cf[ks] = __builtin_bit_cast(bf16x8, w); }
    }
    const f32x4 dd4 = *(const f32x4*)(a.inp(I_S5D) + l * 256 + g * 16 + 4 * kq);
    for (int t0 = 0; t0 < T; t0 += 32) {
        const int nt = (T - t0) < 32 ? (T - t0) : 32;
        s5_bu_block(P, PROJ, (size_t)(mbase + t0), nt, g, HR, HI, lane);
        for (int t = 0; t < nt; ++t) { const float br = HR[t * 68 + lane], bi = HI[t * 68 + lane];
            const float nr = P.ab_re * hr - P.ab_im * hi + br, ni = P.ab_re * hi + P.ab_im * hr + bi; hr = nr; hi = ni;
            HR[t * 68 + lane] = hr; HI[t * 68 + lane] = hi; }
        asm volatile("s_waitcnt lgkmcnt(0)" ::: "memory");
#pragma unroll
        for (int tt = 0; tt < 2; ++tt) {
            if (tt * 16 < nt) {
                f32x4 acc = (f32x4){0.f, 0.f, 0.f, 0.f};
#pragma unroll
                for (int ks = 0; ks < 4; ++ks) { const LAS float* hp = (ks < 2 ? HR : HI) + (tt * 16 + cc) * 68 + 32 * (ks & 1) + 8 * kq;
                    const f32x4 x0 = *(const LAS f32x4*)hp, x1 = *(const LAS f32x4*)(hp + 4);
                    u32x4 w; w.x = pk2(x0.x, x0.y); w.y = pk2(x0.z, x0.w); w.z = pk2(x1.x, x1.y); w.w = pk2(x1.z, x1.w);
                    acc = __builtin_amdgcn_mfma_f32_16x16x32_bf16(cf[ks], __builtin_bit_cast(bf16x8, w), acc, 0, 0, 0); }
                const int t = tt * 16 + cc;
                if (t < nt) { const size_t m = (size_t)(mbase + t0 + t);
                    const f32x4 u4 = ldp4(PROJ + m * DIN + OFF_D + g * 16 + 4 * kq);
                    u32x2 zz; zz.x = pk2(gelu_tanh(acc.x + dd4.x * u4.x), gelu_tanh(acc.y + dd4.y * u4.y)); zz.y = pk2(gelu_tanh(acc.z + dd4.z * u4.z), gelu_tanh(acc.w + dd4.w * u4.w));
                    *(u32x2*)(ZB + m * 256 + g * 16 + 4 * kq) = zz; }
            }
        }
        asm volatile("s_waitcnt lgkmcnt(0)" ::: "memory");
    }
    if (smp) *(f32x2*)(a.out + OUT_SSM_S + (((size_t)(l * DB + sq) * 16 + g) * 64 + lane) * 2) = (f32x2){hr, hi};
    else if (ck == 15) *(f32x2*)(a.out + OUT_SSM_P + (((size_t)(l * 8 + sq) * 16 + g) * 64 + lane) * 2) = (f32x2){hr, hi};
}

__device__ __forceinline__ bf16x8 pack8(const f32x16& p, int s) {
    u32x4 w; w.x = pk2(p[8 * s + 0], p[8 * s + 1]); w.y = pk2(p[8 * s + 2], p[8 * s + 3]); w.z = pk2(p[8 * s + 4], p[8 * s + 5]); w.w = pk2(p[8 * s + 6], p[8 * s + 7]);
    return __builtin_bit_cast(bf16x8, w);
}
__device__ __forceinline__ void attn_load4(const bf16* F, size_t fragbase, bf16x8 (&f)[4]) {
#pragma unroll
    for (int cs = 0; cs < 4; ++cs) f[cs] = *(const bf16x8*)(F + fragbase + cs * 512);
}
__device__ __forceinline__ void attn_tile(const bf16x8 (&qf)[2][2], const bf16x8 (&kf)[4], const bf16x8 (&vf)[4], f32x16 (&o)[2][2], float (&mrun)[2], float (&lrun)[2], bool diag, int r, int hh) {
    bf16x8 pf[2][2];
#pragma unroll
    for (int c = 0; c < 2; ++c) {
        f32x16 st;
#pragma unroll
        for (int e = 0; e < 16; ++e) st[e] = 0.f;
        st = __builtin_amdgcn_mfma_f32_32x32x16_bf16(kf[c * 2 + 0], qf[c][0], st, 0, 0, 0);
        st = __builtin_amdgcn_mfma_f32_32x32x16_bf16(kf[c * 2 + 1], qf[c][1], st, 0, 0, 0);
        if (diag) {
#pragma unroll
            for (int e = 0; e < 16; ++e) { const int key = (e & 3) + 8 * (e >> 2) + 4 * hh; if (key > r) st[e] = -1e30f; }
        }
        float mx = st[0];
#pragma unroll
        for (int e = 1; e < 16; ++e) mx = fmaxf(mx, st[e]);
        mx = fmaxf(mx, __shfl_xor(mx, 32));
        const bool upd = mx > mrun[c] + 8.0f;
        if (__any(upd)) {
            const float mnew = upd ? mx : mrun[c];
            const float corr = __builtin_amdgcn_exp2f(mrun[c] - mnew);
            lrun[c] *= corr; mrun[c] = mnew;
#pragma unroll
            for (int tl = 0; tl < 2; ++tl)
#pragma unroll
                for (int e = 0; e < 16; ++e) o[c][tl][e] *= corr;
        }
        float ps = 0.f;
        const float mcur = mrun[c];
#pragma unroll
        for (int e = 0; e < 16; ++e) { st[e] = __builtin_amdgcn_exp2f(st[e] - mcur); ps += st[e]; }
        lrun[c] += ps;
        pf[c][0] = pack8(st, 0); pf[c][1] = pack8(st, 1);
    }
#pragma unroll
    for (int c = 0; c < 2; ++c)
#pragma unroll
        for (int tl = 0; tl < 2; ++tl) {
            o[c][tl] = __builtin_amdgcn_mfma_f32_32x32x16_bf16(vf[tl * 2 + 0], pf[c][0], o[c][tl], 0, 0, 0);
            o[c][tl] = __builtin_amdgcn_mfma_f32_32x32x16_bf16(vf[tl * 2 + 1], pf[c][1], o[c][tl], 0, 0, 0);
        }
}
__device__ __forceinline__ void attn_prompt_wave(const Ctx& a, int l, int b, int h, int qt, float lam, int lane) {
    OPAQUE(lane);
    const bf16* QB = (const bf16*)(a.ws + WS_QB); const bf16* KF = (const bf16*)(a.ws + WS_KB); const bf16* VF = (const bf16*)(a.ws + WS_VT);
    bf16* OB = (bf16*)(a.ws + WS_OB); const bf16* PROJ = (const bf16*)(a.ws + WS_PROJ);
    const int r = lane & 31, hh = lane >> 5;
    const size_t mq = (size_t)b * SEQ + qt * 32 + r;
    bf16x8 qf[2][2];
#pragma unroll
    for (int c = 0; c < 2; ++c)
#pragma unroll
        for (int s = 0; s < 2; ++s) qf[c][s] = *(const bf16x8*)(QB + mq * 256 + h * 64 + c * 32 + 16 * s + 8 * hh);
    f32x16 o[2][2];
#pragma unroll
    for (int c = 0; c < 2; ++c)
#pragma unroll
        for (int tl = 0; tl < 2; ++tl)
#pragma unroll
            for (int e = 0; e < 16; ++e) o[c][tl][e] = 0.f;
    float mrun[2] = {-1e30f, -1e30f}, lrun[2] = {0.f, 0.f};
    const size_t fb0 = ((size_t)((b * 4 + h) * 64) * 4) * 512 + lane * 8;
    bf16x8 kA[4], kB[4], vv[4];
    attn_load4(KF, fb0, kA);
    int kt = 0;
    for (; kt + 1 <= qt; kt += 2) {
        attn_load4(VF, fb0 + (size_t)kt * 2048, vv);
        attn_load4(KF, fb0 + (size_t)(kt + 1) * 2048, kB);
        attn_tile(qf, kA, vv, o, mrun, lrun, false, r, hh);
        attn_load4(VF, fb0 + (size_t)(kt + 1) * 2048, vv);
        if (kt + 2 <= qt) attn_load4(KF, fb0 + (size_t)(kt + 2) * 2048, kA);
        attn_tile(qf, kB, vv, o, mrun, lrun, kt + 1 == qt, r, hh);
    }
    if (kt == qt) { attn_load4(VF, fb0 + (size_t)kt * 2048, vv); attn_tile(qf, kA, vv, o, mrun, lrun, true, r, hh); }
    const float l0 = lrun[0] + __shfl_xor(lrun[0], 32), l1 = lrun[1] + __shfl_xor(lrun[1], 32);
    const float i0 = 1.0f / l0, i1 = lam / l1;
    float ss = 0.f;
    f32x16 res[2];
#pragma unroll
    for (int tl = 0; tl < 2; ++tl)
#pragma unroll
        for (int e = 0; e < 16; ++e) { const float v = o[0][tl][e] * i0 - o[1][tl][e] * i1; res[tl][e] = v; ss += v * v; }
    ss += __shfl_xor(ss, 32);
    const float rs = rsqrtf(ss * (1.f / 64.f) + NORM_EPS) * (1.0f - lam_init_of(l));
    const float* sw = a.inp(I_SUBLN) + l * 64;
#pragma unroll
    for (int tl = 0; tl < 2; ++tl)
#pragma unroll
        for (int g4 = 0; g4 < 4; ++g4) { const int vd = 32 * tl + 8 * g4 + 4 * hh;
            const f32x4 w4 = *(const f32x4*)(sw + vd);
            f32x4 ov; ov.x = res[tl][4 * g4 + 0] * rs * w4.x; ov.y = res[tl][4 * g4 + 1] * rs * w4.y; ov.z = res[tl][4 * g4 + 2] * rs * w4.z; ov.w = res[tl][4 * g4 + 3] * rs * w4.w;
            const f32x4 gt = ldp4(PROJ + mq * DIN + OFF_G + h * 64 + vd);
            u32x2 ow; ow.x = pk2(ov.x * siluf_(gt.x), ov.y * siluf_(gt.y)); ow.y = pk2(ov.z * siluf_(gt.z), ov.w * siluf_(gt.w));
            *(u32x2*)(OB + mq * DM + h * 64 + vd) = ow; }
}

struct SmpK { f32x4 k[8]; };
__device__ __forceinline__ void smp_load(SmpK& d, const float* kp) {
#pragma unroll
    for (int t = 0; t < 8; ++t) d.k[t] = __builtin_nontemporal_load((const f32x4*)(kp + (size_t)t * 1024));
}
__device__ __forceinline__ void smp_group(const SmpK& d, const SmpK& dv, const f32x4 (&q)[8], f32x4 (&O)[4], float& M, float& Lsum, int nstep, bool isnew, int kk, int g, int lane) {
    float sc[8];
#pragma unroll
    for (int t = 0; t < 8; ++t) {
        float p[8];
#pragma unroll
        for (int i = 0; i < 8; ++i) p[i] = (d.k[t].x * q[i].x + d.k[t].y * q[i].y) + (d.k[t].z * q[i].z + d.k[t].w * q[i].w);
        float n4[4];
#pragma unroll
        for (int k = 0; k < 4; ++k) { const float keep = (g & 4) ? p[4 + k] : p[k], send = (g & 4) ? p[k] : p[4 + k]; n4[k] = keep + dpp_mov<0x141>(send); }
        float n2[2];
#pragma unroll
        for (int k = 0; k < 2; ++k) { const float keep = (g & 2) ? n4[2 + k] : n4[k], send = (g & 2) ? n4[k] : n4[2 + k]; n2[k] = keep + dpp_mov<0x4E>(send); }
        const float keep = (g & 1) ? n2[1] : n2[0], send = (g & 1) ? n2[0] : n2[1];
        float sv = keep + dpp_mov<0xB1>(send);
        if (t >= nstep || (isnew && (4 * t + kk) > g)) sv = -1e30f;
        sc[t] = sv;
    }
    float mx = fmaxf(fmaxf(fmaxf(sc[0], sc[1]), fmaxf(sc[2], sc[3])), fmaxf(fmaxf(sc[4], sc[5]), fmaxf(sc[6], sc[7])));
    mx = fmaxf(mx, __shfl_xor(mx, 16)); mx = fmaxf(mx, __shfl_xor(mx, 32));
    const float Mnew = fmaxf(M, mx);
    const float corr = __builtin_amdgcn_exp2f(M - Mnew);
    float ps = 0.f;
#pragma unroll
    for (int t = 0; t < 8; ++t) { sc[t] = __builtin_amdgcn_exp2f(sc[t] - Mnew); ps += sc[t]; }
    Lsum = Lsum * corr + ps; M = Mnew;
#pragma unroll
    for (int rg = 0; rg < 4; ++rg) { const float cr = __shfl(corr, (lane & 48) | (4 * kk + rg));
        O[0][rg] *= cr; O[1][rg] *= cr; O[2][rg] *= cr; O[3][rg] *= cr; }
    u32x4 pw; pw.x = pk2(sc[0], sc[1]); pw.y = pk2(sc[2], sc[3]); pw.z = pk2(sc[4], sc[5]); pw.w = pk2(sc[6], sc[7]);
    const bf16x8 pa = __builtin_bit_cast(bf16x8, pw);
#pragma unroll
    for (int e = 0; e < 4; ++e) {
        u32x4 vw; vw.x = pk2(dv.k[0][e], dv.k[1][e]); vw.y = pk2(dv.k[2][e], dv.k[3][e]); vw.z = pk2(dv.k[4][e], dv.k[5][e]); vw.w = pk2(dv.k[6][e], dv.k[7][e]);
        O[e] = __builtin_amdgcn_mfma_f32_16x16x32_bf16(pa, __builtin_bit_cast(bf16x8, vw), O[e], 0, 0, 0);
    }
}
__device__ __forceinline__ void attn_sample_wave(const Ctx& a, int l, int wi, int lane) {
    OPAQUE(lane);
    const int h = wi & 3, sp = (wi >> 2) % NSPLIT, b = (wi >> 2) / NSPLIT;
    const bf16* PROJ = (const bf16*)(a.ws + WS_PROJ);
    const int kk = lane >> 4, dq = lane & 15, g = lane & 7;
    f32x4 q[8];
#pragma unroll
    for (int i = 0; i < 8; ++i) { q[i] = ldp4(PROJ + (size_t)(NP + b * 8 + i) * DIN + OFF_AQ + h * 64 + 4 * dq); q[i] *= QSCALE; }
    const bool isnew = (sp == NSPLIT - 1);
    float M = -1e30f, Lsum = 0.f;
    f32x4 O[4];
#pragma unroll
    for (int e = 0; e < 4; ++e) O[e] = (f32x4){0.f, 0.f, 0.f, 0.f};
    if (isnew) {
        SmpK d, dv;
        const bf16* kp = PROJ + (size_t)(NP + b * 8 + kk) * DIN + OFF_AK + h * 64 + 4 * dq;
#pragma unroll
        for (int t = 0; t < 8; ++t) { if (t < 2) { d.k[t] = ldp4(kp + (size_t)t * 4 * DIN); dv.k[t] = ldp4(kp + (size_t)t * 4 * DIN + (OFF_AV - OFF_AK)); }
            else { d.k[t] = (f32x4){0.f, 0.f, 0.f, 0.f}; dv.k[t] = (f32x4){0.f, 0.f, 0.f, 0.f}; } }
        smp_group(d, dv, q, O, M, Lsum, 2, true, kk, g, lane);
    } else {
        const int* pt = (const int*)a.inp(I_PT) + b * NPAGES + sp * 2;
        const int pg0 = pt[0], pg1 = pt[1];
        const size_t lo = (size_t)(kk * 4 + h) * 64 + 4 * dq;
        const float* kb0 = a.inp(I_CK) + ((size_t)l * NPOOL + pg0) * 32768 + lo; const float* kb1 = a.inp(I_CK) + ((size_t)l * NPOOL + pg1) * 32768 + lo;
        const float* vb0 = a.inp(I_CV) + ((size_t)l * NPOOL + pg0) * 32768 + lo; const float* vb1 = a.inp(I_CV) + ((size_t)l * NPOOL + pg1) * 32768 + lo;
        SmpK dA, dB, dV;
        smp_load(dA, kb0);
#pragma unroll
        for (int gi = 0; gi < 8; gi += 2) {
            smp_load(dV, ((gi >> 2) ? vb1 : vb0) + (size_t)(gi & 3) * 8192);
            { const int gn = gi + 1; smp_load(dB, ((gn >> 2) ? kb1 : kb0) + (size_t)(gn & 3) * 8192); }
            smp_group(dA, dV, q, O, M, Lsum, 8, false, kk, g, lane);
            { const int gn = gi + 1; smp_load(dV, ((gn >> 2) ? vb1 : vb0) + (size_t)(gn & 3) * 8192); }
            if (gi + 2 < 8) { const int gn = gi + 2; smp_load(dA, ((gn >> 2) ? kb1 : kb0) + (size_t)(gn & 3) * 8192); }
            smp_group(dB, dV, q, O, M, Lsum, 8, false, kk, g, lane);
        }
    }
    float Lall = Lsum + __shfl_xor(Lsum, 16); Lall += __shfl_xor(Lall, 32);
    float* part = (float*)(a.ws + WS_PART) + ((size_t)(b * 4 + h) * NSPLIT + sp) * PART_FLOATS;
    if (kk == 0) { part[dq] = M; part[16 + dq] = Lall; }
#pragma unroll
    for (int rg = 0; rg < 4; ++rg) *(f32x4*)(part + 32 + (4 * kk + rg) * 64 + 4 * dq) = (f32x4){O[0][rg], O[1][rg], O[2][rg], O[3][rg]};
}

__device__ __forceinline__ void attn_sample_merge_wave(const Ctx& a, int l, int wi, float lam, int lane) {
    OPAQUE(lane);
    const int h = wi & 3, q = wi >> 2, b = q >> 3, i = q & 7;
    const size_t m = (size_t)NP + q;
    const float* pb = (const float*)(a.ws + WS_PART) + ((size_t)(b * 4 + h) * NSPLIT) * PART_FLOATS;
    float oc[2];
#pragma unroll
    for (int c = 0; c < 2; ++c) { const int j = c * 8 + i;
        float ms[NSPLIT], M = -1e30f;
#pragma unroll
        for (int s = 0; s < NSPLIT; ++s) { ms[s] = pb[s * PART_FLOATS + j]; M = fmaxf(M, ms[s]); }
        float L = 0.f, O = 0.f;
#pragma unroll
        for (int s = 0; s < NSPLIT; ++s) { const float w = __builtin_amdgcn_exp2f(ms[s] - M); L += pb[s * PART_FLOATS + 16 + j] * w; O += pb[s * PART_FLOATS + 32 + j * 64 + lane] * w; }
        oc[c] = O / L; }
    const float v = oc[0] - lam * oc[1];
    const float ss = wave_sum(v * v);
    const float ov = v * rsqrtf(ss * (1.f / 64.f) + NORM_EPS) * a.inp(I_SUBLN)[l * 64 + lane] * (1.0f - lam_init_of(l));
    const float gt = ldp1((const bf16*)(a.ws + WS_PROJ) + m * DIN + OFF_G + h * 64 + lane);
    ((bf16*)(a.ws + WS_OB))[m * DM + h * 64 + lane] = (bf16)f2bf(ov * siluf_(gt));
}

__device__ __forceinline__ void glu_wave(const Ctx& a, int l, int unit, int wave, int lane) {
    OPAQUE(lane);
    const bf16* ZB = (const bf16*)(a.ws + WS_ZB); const bf16* WT = (const bf16*)(a.ws + WS_WGLU) + (size_t)l * 65536;
    const bf16* PROJ = (const bf16*)(a.ws + WS_PROJ); bf16* OB = (bf16*)(a.ws + WS_OB);
    const int r = lane & 31, hh = lane >> 5, n0 = wave * 32;
    const size_t m = (size_t)unit * 32 + r;
    const bf16* zp = ZB + m * 256 + 8 * hh; const bf16* wp = WT + (size_t)(n0 + r) * 256 + 8 * hh;
    f32x16 acc;
#pragma unroll
    for (int e = 0; e < 16; ++e) acc[e] = 0.f;
#pragma unroll
    for (int s0 = 0; s0 < 16; s0 += 8) {
        bf16x8 wa[8], zb[8];
#pragma unroll
        for (int s1 = 0; s1 < 8; ++s1) { wa[s1] = *(const bf16x8*)(wp + 16 * (s0 + s1)); zb[s1] = *(const bf16x8*)(zp + 16 * (s0 + s1)); }
#pragma unroll
        for (int s1 = 0; s1 < 8; ++s1) acc = __builtin_amdgcn_mfma_f32_32x32x16_bf16(wa[s1], zb[s1], acc, 0, 0, 0);
    }
    const float* bg = a.inp(I_BGLU) + l * 256;
#pragma unroll
    for (int g4 = 0; g4 < 4; ++g4) { const int n = n0 + 8 * g4 + 4 * hh;
        const f32x4 bb = *(const f32x4*)(bg + n), gt = ldp4(PROJ + m * DIN + OFF_G + 768 + n);
        const u32x2 zz = *(const u32x2*)(ZB + m * 256 + n);
        const float z0 = __builtin_bit_cast(float, zz.x << 16), z1 = __builtin_bit_cast(float, zz.x & 0xffff0000u), z2 = __builtin_bit_cast(float, zz.y << 16), z3 = __builtin_bit_cast(float, zz.y & 0xffff0000u);
        u32x2 o; o.x = pk2(z0 * sigmoidf_(acc[4 * g4 + 0] + bb.x) * siluf_(gt.x), z1 * sigmoidf_(acc[4 * g4 + 1] + bb.y) * siluf_(gt.y));
        o.y = pk2(z2 * sigmoidf_(acc[4 * g4 + 2] + bb.z) * siluf_(gt.z), z3 * sigmoidf_(acc[4 * g4 + 3] + bb.w) * siluf_(gt.w));
        *(u32x2*)(OB + m * DM + 768 + n) = o; }
}

constexpr int MM_RWA = 256;
constexpr int MM_RWB = 224;
constexpr int MM_AP = 256;
constexpr int MM_AS = (DB * NSPLIT * 4) / 8;
constexpr int MM_S5P = 256;
constexpr int MM_S5S = 256;
constexpr int MM_LRU = 128;
constexpr int MM_RWS = DB * 4;
constexpr int MM_MRG = 512;
constexpr int MM_GLU = MTOK / 32;
__device__ __forceinline__ void ph_mixA(const Ctx& a, int lq, int MMSK, LAS unsigned char* lds, volatile LAS unsigned* MISC, int tid, int lane, int wave) {
    const int l = lq & 1;
    unsigned* qctr = (unsigned*)(a.ws + WS_CTL) + CW_QUEUE + 1024 * lq;
    const float lam = compute_lam(a, l, lane);
    int u;
    const bool even = ((blockIdx.x >> 3) & 1) == 0;
#pragma unroll 1
    for (int pass = 0; pass < 2; ++pass) {
        if ((pass == 0) == even) { if ((MMSK >> 0) & 1) while ((u = grab_unit(qctr + 0 * 64, MISC, tid)) < MM_RWA) rwkv_prompt_unitA(a, l, u, lds, tid); }
        else { if ((MMSK >> 2) & 1) while ((u = grab_unit(qctr + 2 * 64, MISC, tid)) < MM_AS) attn_sample_wave(a, l, u * 8 + wave, lane); }
    }
    if ((MMSK >> 1) & 1) while ((u = grab_unit(qctr + 1 * 64, MISC, tid)) < MM_AP) { const int bh = u & 31, qt = 8 * (7 - (u >> 5)) + wave; attn_prompt_wave(a, l, bh >> 2, bh & 3, qt, lam, lane); }
    if ((MMSK >> 3) & 1) while ((u = grab_unit(qctr + 3 * 64, MISC, tid)) < MM_S5P) s5_pass2_wave(a, l, false, u * 8 + wave, lds + wave * 17408, lane);
    if ((MMSK >> 4) & 1) while ((u = grab_unit(qctr + 4 * 64, MISC, tid)) < MM_S5S) s5_pass2_wave(a, l, true, u * 8 + wave, lds + wave * 17408, lane);
    if ((MMSK >> 5) & 1) while ((u = grab_unit(qctr + 5 * 64, MISC, tid)) < MM_LRU) lru_pass2_wave(a, l, u * 8 + wave, lane);
    __syncthreads();
}
__device__ __forceinline__ void ph_mixB(const Ctx& a, int lq, int MMSK, LAS unsigned char* lds, volatile LAS unsigned* MISC, int tid, int lane, int wave) {
    const int l = lq & 1;
    unsigned* qctr = (unsigned*)(a.ws + WS_CTL) + CW_QUEUE + 1024 * lq + 512;
    int u;
    if ((MMSK >> 0) & 1) while ((u = grab_unit(qctr + 0 * 64, MISC, tid)) < MM_RWB) rwkv_prompt_unitB(a, l, u, lds, tid);
    if ((MMSK >> 1) & 1) while ((u = grab_unit(qctr + 1 * 64, MISC, tid)) < MM_RWS) rwkv_sample_unit(a, l, u >> 2, u & 3, lds, tid);
    if ((MMSK >> 2) & 1) while ((u = grab_unit(qctr + 2 * 64, MISC, tid)) < MM_GLU) glu_wave(a, l, u, wave, lane);
    if ((MMSK >> 3) & 1) { const float lam = compute_lam(a, l, lane); while ((u = grab_unit(qctr + 3 * 64, MISC, tid)) < MM_MRG) attn_sample_merge_wave(a, l, u * 8 + wave, lam, lane); }
    __syncthreads();
}

__device__ __forceinline__ void ph_postnorm(const Ctx& a, int l, int lane, int wave, int b0, int nb, int mlo, int mhi) {
    OPAQUE(lane);
    const bf16* YP = (const bf16*)(a.ws + WS_YP);
    const float* xp = a.inp(I_XP);
    const float* xs = a.inp(I_XS) - (size_t)NP * DM;
    bf16* X1b = (bf16*)(a.ws + WS_X1);
    float* yp = a.out + OUT_Y_P;
    float* ys = a.out + OUT_Y_S - (size_t)NP * DM;
    bf16* H = (bf16*)(a.ws + WS_H);
    f32x4 gp[4], g2[4];
#pragma unroll
    for (int j = 0; j < 4; ++j) { gp[j] = ((const f32x4*)(a.inp(I_NPOST) + l * DM) + lane)[64 * j]; g2[j] = ((const f32x4*)(a.inp(I_NPRE) + DM) + lane)[64 * j]; }
    const int gw = ((int)blockIdx.x - b0) * NWAVES + wave, NGW = nb * NWAVES;
    for (int m0 = mlo + gw; m0 < mhi; m0 += 2 * NGW) {
        const int m1 = m0 + NGW; const bool has1 = m1 < mhi; const int mb = has1 ? m1 : m0;
        const bf16* ya = YP + (size_t)m0 * DM + 4 * lane; const bf16* yb = YP + (size_t)mb * DM + 4 * lane;
        const f32x4* xa = (const f32x4*)((m0 < NP ? xp : xs) + (size_t)m0 * DM) + lane; const f32x4* xb = (const f32x4*)((mb < NP ? xp : xs) + (size_t)mb * DM) + lane;
        f32x4 va[4], vb[4], wa[4], wb[4];
#pragma unroll
        for (int j = 0; j < 4; ++j) { va[j] = ldp4(ya + 256 * j); vb[j] = ldp4(yb + 256 * j);
            if (l == 0) { wa[j] = xa[64 * j]; wb[j] = xb[64 * j]; }
            else { wa[j] = ldp4(X1b + (size_t)m0 * DM + 4 * lane + 256 * j); wb[j] = ldp4(X1b + (size_t)mb * DM + 4 * lane + 256 * j); } }
        float sa = 0.f, sb = 0.f;
#pragma unroll
        for (int j = 0; j < 4; ++j) { sa += (va[j].x * va[j].x + va[j].y * va[j].y) + (va[j].z * va[j].z + va[j].w * va[j].w); sb += (vb[j].x * vb[j].x + vb[j].y * vb[j].y) + (vb[j].z * vb[j].z + vb[j].w * vb[j].w); }
        const float ra = rsqrtf(wave_sum_fast(sa) * (1.f / DM) + NORM_EPS), rb = rsqrtf(wave_sum_fast(sb) * (1.f / DM) + NORM_EPS);
        f32x4* oa = (f32x4*)((m0 < NP ? yp : ys) + (size_t)m0 * DM) + lane; f32x4* ob = (f32x4*)((mb < NP ? yp : ys) + (size_t)mb * DM) + lane;
        float ta = 0.f, tb = 0.f;
#pragma unroll
        for (int j = 0; j < 4; ++j) { va[j] = wa[j] + va[j] * ra * gp[j]; vb[j] = wb[j] + vb[j] * rb * gp[j];
            if (l == 0) { u32x2 o; o.x = pk2(va[j].x, va[j].y); o.y = pk2(va[j].z, va[j].w); *(u32x2*)(X1b + (size_t)m0 * DM + 4 * lane + 256 * j) = o;
                if (has1) { u32x2 p; p.x = pk2(vb[j].x, vb[j].y); p.y = pk2(vb[j].z, vb[j].w); *(u32x2*)(X1b + (size_t)mb * DM + 4 * lane + 256 * j) = p; } }
            else { __builtin_nontemporal_store(va[j], oa + 64 * j); if (has1) __builtin_nontemporal_store(vb[j], ob + 64 * j); }
            ta += (va[j].x * va[j].x + va[j].y * va[j].y) + (va[j].z * va[j].z + va[j].w * va[j].w); tb += (vb[j].x * vb[j].x + vb[j].y * vb[j].y) + (vb[j].z * vb[j].z + vb[j].w * vb[j].w); }
        if (l == 0) {
            const float qa = rsqrtf(wave_sum_fast(ta) * (1.f / DM) + NORM_EPS), qb = rsqrtf(wave_sum_fast(tb) * (1.f / DM) + NORM_EPS);
            u32x2* ha = (u32x2*)(H + (size_t)m0 * DM) + lane; u32x2* hb = (u32x2*)(H + (size_t)mb * DM) + lane;
#pragma unroll
            for (int j = 0; j < 4; ++j) { u32x2 o; o.x = pk2(va[j].x * qa * g2[j].x, va[j].y * qa * g2[j].y); o.y = pk2(va[j].z * qa * g2[j].z, va[j].w * qa * g2[j].w); ha[64 * j] = o;
                if (has1) { u32x2 p; p.x = pk2(vb[j].x * qb * g2[j].x, vb[j].y * qb * g2[j].y); p.y = pk2(vb[j].z * qb * g2[j].z, vb[j].w * qb * g2[j].w); hb[64 * j] = p; } }
        }
    }
}

constexpr int N_PHASES = 13;
#ifndef DUP_PHASE
#define DUP_PHASE -1
#endif
#ifndef DUP_MASK
#define DUP_MASK 0x7f
#endif
__global__ void __launch_bounds__(NTHREADS, 2) hymba_fwd(Args args) {
    extern __shared__ __attribute__((aligned(16))) unsigned char lds_raw[];
    LAS unsigned char* lds = (LAS unsigned char*)lds_raw;
    volatile LAS unsigned* MISC = (volatile LAS unsigned*)(lds + MISC_OFF);
    if (threadIdx.x < 64) MISC[threadIdx.x] = 0u;
    if (threadIdx.x < N_IN) *(LAS unsigned long long*)(lds + TAB_OFF + 8 * threadIdx.x) = (unsigned long long)args.in[threadIdx.x];
    Ctx ctx; ctx.out = args.out; ctx.ws = args.ws; ctx.tab = (const LAS unsigned*)(lds + TAB_OFF);
    const int wave_s = __builtin_amdgcn_readfirstlane(threadIdx.x >> 6);
#define TIDS() int tid = wave_s * 64 + lane_id_asm(); const int lane = tid & 63, wave = wave_s; (void)lane; (void)wave; Ctx cx = ctx; { GAS unsigned char* w_ = (GAS unsigned char*)ctx.ws; GAS float* o_ = (GAS float*)ctx.out; asm volatile("" : "+s"(w_), "+s"(o_)); cx.ws = (unsigned char*)w_; cx.out = (float*)o_; }
    __syncthreads();
    unsigned* ctl = (unsigned*)(args.ws + WS_CTL);
#if MK_PER_PHASE
#define GRID_BAR() do { } while (0)
#else
    XcdBarrier bar = xcd_barrier_post(ctl + CW_BAR, MISC);
#define GRID_BAR() xcd_barrier(bar, wave_s == 0 && lane_id_asm() == 0)
#endif
    const int lo = args.ph_lo, hi = args.ph_hi;
#define IN(k) (lo <= (k) && (k) < hi)
#define SEAM(k) do { if (IN(k) && IN((k) + 1)) GRID_BAR(); } while (0)
#define NREP(j) ((DUP_PHASE == (j)) ? 2 : 1)

    if (IN(0)) { TIDS(); ph_prologue(cx, lds, lane, wave); }
    SEAM(0);
    for (int l = 0; l < 2; ++l) {
        const int p0 = 1 + 6 * l;
        if (IN(p0))
#pragma unroll 1
          for (int rp = 0; rp < NREP(1); ++rp) {
            if (rp) GRID_BAR();
            TIDS();
            pg8::Gemm g{(const pg8::bf16_t*)(cx.ws + WS_H), (const pg8::bf16_t*)(cx.ws + WS_WIN) + (size_t)l * DIN * DM, MTOK, DIN, DM};
            pg8::StaticOrder S; S.init(MTOK, DIN, (int)gridDim.x, (int)blockIdx.x);
            EpiProj E{(bf16*)(cx.ws + WS_PROJ), cx.out, l};
            pg8::gemm_phase<EpiProj, pg8::StaticOrder, false>(lds, g, S, E, nullptr, tid);
        }
        SEAM(p0);
        if (IN(p0 + 1)) {
#pragma unroll 1
            for (int rp = 0; rp < NREP(2); ++rp) { if (rp) GRID_BAR(); TIDS(); ph_mixprep(cx, l + 2 * rp, rp ? (DUP_MASK) : 0x1f, lds, MISC, tid, lane, wave); } }
        SEAM(p0 + 1);
        if (IN(p0 + 2)) {
#pragma unroll 1
            for (int rp = 0; rp < NREP(3); ++rp) { if (rp) GRID_BAR(); TIDS(); ph_mixA(cx, l + 2 * rp, rp ? (DUP_MASK) : 0x3f, lds, MISC, tid, lane, wave); } }
        SEAM(p0 + 2);
        if (IN(p0 + 3)) {
#pragma unroll 1
            for (int rp = 0; rp < NREP(4); ++rp) { if (rp) GRID_BAR(); TIDS(); ph_mixB(cx, l + 2 * rp, rp ? (DUP_MASK) : 0xf, lds, MISC, tid, lane, wave); } }
        SEAM(p0 + 3);
        if (IN(p0 + 4)) {
            TIDS();
            {
                pg8::Gemm g{(const pg8::bf16_t*)(cx.ws + WS_OB), (const pg8::bf16_t*)(cx.ws + WS_WOUT) + (size_t)l * DM * DM, NP, DM, DM};
                pg8::StaticOrder S; S.init(NP, DM, (int)gridDim.x, (int)blockIdx.x);
                EpiPlain E{(bf16*)(cx.ws + WS_YP), DM};
                pg8::gemm_phase<EpiPlain, pg8::StaticOrder, false>(lds, g, S, E, nullptr, tid);
            }
            GRID_BAR();
            if ((int)blockIdx.x < 16) {
                pg8::Gemm g{(const pg8::bf16_t*)(cx.ws + WS_OB) + (size_t)NP * DM, (const pg8::bf16_t*)(cx.ws + WS_WOUT) + (size_t)l * DM * DM, NSMP, DM, DM};
                pg8::StaticOrder S; S.init(NSMP, DM, 16, (int)blockIdx.x);
                EpiPlain E{(bf16*)(cx.ws + WS_YP) + (size_t)NP * DM, DM};
                pg8::gemm_phase<EpiPlain, pg8::StaticOrder, false>(lds, g, S, E, nullptr, tid);
            } else ph_postnorm(cx, l, lane, wave, 16, (int)gridDim.x - 16, 0, NP);
        }
        SEAM(p0 + 4);
        if (IN(p0 + 5)) { TIDS(); ph_postnorm(cx, l, lane, wave, 0, (int)gridDim.x, NP, MTOK); }
        SEAM(p0 + 5);
    }
#undef IN
#undef SEAM
}

extern "C" void kernel_launch(void* const* d_in, const int* in_sizes, int n_in, void* d_out, int out_size, void* d_ws, size_t ws_size, hipStream_t stream) {
    static int grid = 0;
    if (grid == 0) {
        if (n_in != N_IN || out_size != (int)OUT_TOTAL || ws_size < WS_END) { fprintf(stderr, "kernel_launch: unexpected shapes: n_in %d out %d ws %zu (need %zu)\n", n_in, out_size, ws_size, (size_t)WS_END); grid = -1; return; }
        int dev = 0, cus = 0, per_cu = 0;
        if (hipGetDevice(&dev) != hipSuccess || hipDeviceGetAttribute(&cus, hipDeviceAttributeMultiprocessorCount, dev) != hipSuccess) { grid = -1; return; }
        if (hipFuncSetAttribute((const void*)hymba_fwd, hipFuncAttributeMaxDynamicSharedMemorySize, LDS_BYTES) != hipSuccess) { fprintf(stderr, "kernel_launch: hipFuncSetAttribute failed\n"); grid = -1; return; }
        if (hipOccupancyMaxActiveBlocksPerMultiprocessor(&per_cu, (const void*)hymba_fwd, NTHREADS, LDS_BYTES) != hipSuccess || per_cu < 1) { fprintf(stderr, "kernel_launch: occupancy query says %d\n", per_cu); }
        (void)hipGetLastError();
        grid = cus;
    }
    if (grid < 0) return;
    (void)hipMemsetAsync((char*)d_ws + WS_CTL, 0, CTL_ZERO_BYTES, stream);
    Args a{};
    for (int i = 0; i < N_IN; ++i) a.in[i] = (const float*)d_in[i];
    a.out = (float*)d_out; a.ws = (unsigned char*)d_ws;
#if MK_PER_PHASE
    for (int p = 0; p < N_PHASES; ++p) { a.ph_lo = p; a.ph_hi = p + 1; hipLaunchKernelGGL(hymba_fwd, dim3(grid), dim3(NTHREADS), LDS_BYTES, stream, a); }
#else
    a.ph_lo = 0; a.ph_hi = N_PHASES; hipLaunchKernelGGL(hymba_fwd, dim3(grid), dim3(NTHREADS), LDS_BYTES, stream, a);
#endif
}
```

```cpp
#include <hip/hip_runtime.h>
#include <cstdio>
#include <cstdint>
#ifndef MK_PER_PHASE
#define MK_PER_PHASE 0
#endif
namespace pg8 {
#define PG8_LAS __attribute__((address_space(3)))
typedef unsigned short bf16_t;
typedef short bf16x8 __attribute__((ext_vector_type(8)));
typedef float f32x4 __attribute__((ext_vector_type(4)));
typedef unsigned u32x4 __attribute__((ext_vector_type(4)));
constexpr int BM = 256, BK = 64, HALF = 128, HTB = HALF * BK * 2  , STAGE_BYTES = 8 * HTB, NXCD = 8, WGM = 8;

__host__ __device__ __forceinline__ int lds_byte(int r, int c) { const int st = (r >> 4) * 2 + (c >> 5), rr = r & 15, cc = c & 31, ob = rr * 64 + cc * 2; return st * 1024 + (ob ^ (((ob >> 9) & 1) << 5)); }
__host__ __device__ __forceinline__ void stage_rc(int b, int& R, int& C) { const int st = b / 1024, sb = b % 1024, swz = sb ^ (((sb >> 9) & 1) << 5); R = (st >> 1) * 16 + swz / 64; C = (st & 1) * 32 + (swz % 64) / 2; }
__host__ __device__ __forceinline__ int perm32(int rho) { const int n = rho >> 4, i = rho & 15; return 8 * (i >> 2) + 4 * n + (i & 3); }

struct Unit { int pm, pn; };
struct Gemm { const bf16_t* A; const bf16_t* Bt; int M, N, K; };

struct StaticOrder {
    int nM, nN, nwg, G, c;
    __host__ __device__ void init(int M, int N, int G_, int c_) { nM = M / BM; nN = N / BM; nwg = nM * nN; G = G_; c = c_; }
    __host__ __device__ bool next(int i, Unit& u) const {
        const long L = (long)i * G + c; if (L >= nwg) return false;
        int wgid = (int)L; { const int q = nwg / NXCD, r = nwg % NXCD, xcd = wgid % NXCD, off = wgid / NXCD; wgid = (xcd < r ? xcd * (q + 1) : r * (q + 1) + (xcd - r) * q) + off; }
        const int nig = WGM * nN, gid = wgid / nig, fm = gid * WGM, gsz = (nM - fm) < WGM ? (nM - fm) : WGM;
        u.pm = fm + ((wgid % nig) % gsz); u.pn = (wgid % nig) / gsz; return true;
    }
    __device__ __forceinline__ void a_ready(const Unit&) const {}
    __device__ __forceinline__ void done(const Unit&) const {}
};
template <class Epi, class Sched, bool STAMP = false>
__device__ __forceinline__ void gemm_phase(PG8_LAS unsigned char* lds, const Gemm g, const Sched& S, const Epi& E, unsigned long long* stamps, int tid_in) {
    int tid = tid_in; asm volatile("" : "+v"(tid));
    const int wid = __builtin_amdgcn_readfirstlane(tid >> 6), lane = tid & 63, wr = wid >> 2, wc = wid & 3, fr = lane & 15, fq = lane >> 4;
    const int K = g.K, nt = K / BK;
    int ts_lo = 0, ts_hi = 0, nts = 0; const unsigned long long rt_entry = STAMP ? (unsigned long long)wall_clock64() : 0ull;
#define PG8_STAMP() do { if (STAMP && wid == 0 && nts < 64) { const unsigned long long _c = (unsigned long long)clock64(); \
        ts_lo = (lane == nts) ? (int)(unsigned)_c : ts_lo; ts_hi = (lane == nts) ? (int)(unsigned)(_c >> 32) : ts_hi; ++nts; } } while (0)
    PG8_STAMP();
    unsigned voffA[2], voffB[2];
#pragma unroll
    for (int i = 0; i < 2; ++i) { int R, C; stage_rc(tid * 16 + i * 8192, R, C); const int Rb = Epi::PERM ? ((R & ~31) + perm32(R & 31)) : R;
        voffA[i] = (unsigned)(R * K + C) * 2u; voffB[i] = (unsigned)(Rb * K + C) * 2u; }
    const size_t kstep = (size_t)(BK * 2);
    const size_t hstep = (size_t)HALF * K * 2;
    const size_t tstep = 2 * hstep;
    const unsigned ldsw = (unsigned)wid * 1024u;
    const int aoff = lds_byte(wr * 64 + fr, fq * 8), boff = lds_byte(wc * 32 + fr, fq * 8);
#define PG8_SA(b, h) (((b) * 2 + (h)) * HTB)
#define PG8_SB(b, h) ((4 + (b) * 2 + (h)) * HTB)
#define PG8_STAGE(bufoff, gbase, voff) do { _Pragma("unroll") for (int _i = 0; _i < 2; ++_i) \
        __builtin_amdgcn_global_load_lds((const unsigned*)((const char*)(gbase) + (voff)[_i]), (PG8_LAS unsigned*)(lds + (bufoff) + ldsw + _i * 8192), 16, 0, 0); } while (0)
#define PG8_LDA(dst, b, h) do { _Pragma("unroll") for (int m = 0; m < 4; ++m) _Pragma("unroll") for (int k = 0; k < 2; ++k) dst[m][k] = *(const PG8_LAS bf16x8*)(lds + PG8_SA(b, h) + aoff + m * 2048 + k * 1024); } while (0)
#define PG8_LDB(dst, b, h) do { _Pragma("unroll") for (int n = 0; n < 2; ++n) _Pragma("unroll") for (int k = 0; k < 2; ++k) dst[n][k] = *(const PG8_LAS bf16x8*)(lds + PG8_SB(b, h) + boff + n * 2048 + k * 1024); } while (0)
#define PG8_MMA(ai, bj, At, Bt) do { __builtin_amdgcn_s_setprio(1); _Pragma("unroll") for (int m = 0; m < 4; ++m) _Pragma("unroll") for (int n = 0; n < 2; ++n) _Pragma("unroll") for (int k = 0; k < 2; ++k) \
        acc[ai][bj][m][n] = __builtin_amdgcn_mfma_f32_16x16x32_bf16(Bt[n][k], At[m][k], acc[ai][bj][m][n], 0, 0, 0); __builtin_amdgcn_s_setprio(0); } while (0)
#define PG8_WAIT_V(n) asm volatile("s_waitcnt vmcnt(" #n ")" ::: "memory")
#define PG8_WAIT_L(n) asm volatile("s_waitcnt lgkmcnt(" #n ")" ::: "memory")
#define PG8_BAR __builtin_amdgcn_s_barrier()
#define PG8_SCHED __builtin_amdgcn_sched_barrier(0)
    Unit cur, nxt; int ui = 0;
    if (!S.next(0, cur)) return;
    f32x4 acc[2][2][4][2];
#pragma unroll
    for (int a = 0; a < 2; ++a)
#pragma unroll
        for (int b = 0; b < 2; ++b)
#pragma unroll
            for (int m = 0; m < 4; ++m)
#pragma unroll
                for (int n = 0; n < 2; ++n) acc[a][b][m][n] = (f32x4){0.f, 0.f, 0.f, 0.f};
    bf16x8 At[4][2], B0[2][2], B1[2][2];
    const char* cA = (const char*)g.A + (size_t)cur.pm * tstep; const char* cB = (const char*)g.Bt + (size_t)cur.pn * tstep;
    S.a_ready(cur);
    PG8_STAGE(PG8_SB(0, 0), cB, voffB); PG8_STAGE(PG8_SA(0, 0), cA, voffA); PG8_STAGE(PG8_SB(0, 1), cB + hstep, voffB); PG8_STAGE(PG8_SA(0, 1), cA + hstep, voffA);
    if (wr == 1) PG8_BAR;
    PG8_WAIT_V(4); PG8_BAR;
    PG8_STAGE(PG8_SB(1, 0), cB + kstep, voffB); PG8_STAGE(PG8_SA(1, 0), cA + kstep, voffA); PG8_STAGE(PG8_SB(1, 1), cB + hstep + kstep, voffB);
    PG8_WAIT_V(6); PG8_BAR;
    PG8_STAMP();
    for (;;) {
        const bool has_next = S.next(ui + 1, nxt);
        const char* nA = has_next ? (const char*)g.A + (size_t)nxt.pm * tstep : cA; const char* nB = has_next ? (const char*)g.Bt + (size_t)nxt.pn * tstep : cB;
        for (int t = 0; t < nt; t += 2) {
            const bool last = (t == nt - 2);
            const char* a1 = cA + (size_t)(t + 1) * kstep;
            const char* a2 = last ? nA : cA + (size_t)(t + 2) * kstep; const char* b2 = last ? nB : cB + (size_t)(t + 2) * kstep;
            const char* a3 = a2 + kstep; const char* b3 = b2 + kstep;
            if (last && has_next) S.a_ready(nxt);
            PG8_LDB(B0, 0, 0); PG8_SCHED; PG8_LDA(At, 0, 0); PG8_STAGE(PG8_SA(1, 1), a1 + hstep, voffA);
            PG8_WAIT_L(8); PG8_BAR; PG8_WAIT_L(0); PG8_MMA(0, 0, At, B0); PG8_BAR; PG8_SCHED;
            PG8_LDB(B1, 0, 1); PG8_STAGE(PG8_SB(0, 0), b2, voffB);
            PG8_BAR; PG8_WAIT_L(0); PG8_MMA(0, 1, At, B1); PG8_BAR;
            PG8_LDA(At, 0, 1); PG8_STAGE(PG8_SA(0, 0), a2, voffA);
            PG8_BAR; PG8_WAIT_L(0); PG8_MMA(1, 0, At, B0); PG8_BAR; PG8_SCHED;
            PG8_STAGE(PG8_SB(0, 1), b2 + hstep, voffB);
            PG8_WAIT_V(6); PG8_BAR; PG8_MMA(1, 1, At, B1); PG8_BAR;
            PG8_LDB(B0, 1, 0); PG8_SCHED; PG8_LDA(At, 1, 0); PG8_STAGE(PG8_SA(0, 1), a2 + hstep, voffA);
            PG8_WAIT_L(8); PG8_BAR; PG8_WAIT_L(0); PG8_MMA(0, 0, At, B0); PG8_BAR; PG8_SCHED;
            PG8_LDB(B1, 1, 1); PG8_STAGE(PG8_SB(1, 0), b3, voffB);
            PG8_BAR; PG8_WAIT_L(0); PG8_MMA(0, 1, At, B1); PG8_BAR;
            PG8_LDA(At, 1, 1); PG8_STAGE(PG8_SA(1, 0), a3, voffA);
            PG8_BAR; PG8_WAIT_L(0); PG8_MMA(1, 0, At, B0); PG8_BAR; PG8_SCHED;
            PG8_STAGE(PG8_SB(1, 1), b3 + hstep, voffB);
            PG8_WAIT_V(6); PG8_BAR; PG8_MMA(1, 1, At, B1); PG8_BAR;
        }
        PG8_STAMP();
        if constexpr (!Epi::AFTER_DRAIN) { int l2; asm volatile("v_mbcnt_lo_u32_b32 %0, -1, 0\n\tv_mbcnt_hi_u32_b32 %0, -1, %0" : "=v"(l2)); E(acc, cur, wr, wc, l2 & 15, l2 >> 4); S.done(cur); }
        PG8_STAMP();
        if (!has_next) break;
#pragma unroll
        for (int a = 0; a < 2; ++a)
#pragma unroll
            for (int b = 0; b < 2; ++b)
#pragma unroll
                for (int m = 0; m < 4; ++m)
#pragma unroll
                    for (int n = 0; n < 2; ++n) acc[a][b][m][n] = (f32x4){0.f, 0.f, 0.f, 0.f};
        cur = nxt; cA = nA; cB = nB; ++ui;
    }
    PG8_WAIT_V(0);
    if (wr == 0) PG8_BAR;
    PG8_BAR;
    if constexpr (Epi::AFTER_DRAIN) { E.fused(acc, cur, wr, wc, fr, fq, lds, wid, lane); S.done(cur); }
    PG8_STAMP();
    if (STAMP && wid == 0) { stamps[lane] = lane < nts ? (((unsigned long long)(unsigned)ts_hi << 32) | (unsigned)ts_lo) : 0ull;
        if (lane == 62) stamps[62] = rt_entry; if (lane == 63) stamps[63] = (unsigned long long)wall_clock64(); }
#undef PG8_STAMP
#undef PG8_SA
#undef PG8_SB
#undef PG8_STAGE
#undef PG8_LDA
#undef PG8_LDB
#undef PG8_MMA
#undef PG8_WAIT_V
#undef PG8_WAIT_L
#undef PG8_BAR
#undef PG8_SCHED
}
}

#define GAS __attribute__((address_space(1)))
#define LAS __attribute__((address_space(3)))
typedef unsigned short bf16;
typedef float f32x4 __attribute__((ext_vector_type(4)));
typedef float f32x2 __attribute__((ext_vector_type(2)));
typedef float f32x16 __attribute__((ext_vector_type(16)));
typedef short bf16x8 __attribute__((ext_vector_type(8)));
typedef unsigned u32x4 __attribute__((ext_vector_type(4)));
typedef unsigned u32x2 __attribute__((ext_vector_type(2)));

constexpr int NWAVES = 8, NTHREADS = 512;
constexpr int DM = 1024, NP = 16384, NSMP = 1024, MTOK = 17408, DIN = 3584, SEQ = 2048, DB = 128, DS = 8;
constexpr int OFF_AQ = 0, OFF_AK = 256, OFF_AV = 512, OFF_B = 768, OFF_C = 1024, OFF_D = 2304, OFF_G = 2560;
constexpr int NPOOL = 2560, NPAGES = 16;
constexpr float NORM_EPS = 1e-6f;
constexpr float QSCALE = 0.17677669529663687f * 1.4426950408889634f;
constexpr int NSPLIT = 9;
constexpr int PART_FLOATS = 16 + 16 + 1024;

constexpr size_t OUT_Y_P = 0, OUT_Y_S = 16777216, OUT_K_P = 17825792, OUT_K_S = 26214400, OUT_V_P = 26738688, OUT_V_S = 35127296,
    OUT_CONV_P = 35651584, OUT_CONV_S = 35663872, OUT_LRU_P = 35860480, OUT_LRU_S = 35864576, OUT_SHIFT_P = 35930112, OUT_SHIFT_S = 35950592,
    OUT_WKV_P = 36278272, OUT_WKV_S = 36540416, OUT_SSM_P = 40734720, OUT_SSM_S = 40767488, OUT_TOTAL = 41291776;

constexpr size_t MiB = 1u << 20;
constexpr size_t WS_CTL = 0, CTL_ZERO_BYTES = 1 * MiB;
constexpr size_t WS_WIN = 1 * MiB;
constexpr size_t WS_WOUT = WS_WIN + (size_t)2 * DIN * DM * 2;
constexpr size_t WS_H = WS_WOUT + (size_t)2 * DM * DM * 2;
constexpr size_t WS_PROJ = WS_H + (size_t)MTOK * DM * 2;
constexpr size_t WS_QB = WS_PROJ + (size_t)MTOK * DIN * 4;
constexpr size_t WS_KB = WS_QB + (size_t)NP * 256 * 2;
constexpr size_t WS_VT = WS_KB + (size_t)NP * 256 * 2;
constexpr size_t WS_LA = WS_VT + (size_t)NP * 256 * 2;
constexpr size_t WS_LB = WS_LA + (size_t)MTOK * 256 * 4;
constexpr size_t WS_LP = WS_LB + (size_t)MTOK * 256 * 4;
constexpr size_t WS_LE = WS_LP + (size_t)8 * 32 * 256 * 4;
constexpr size_t WS_RW = WS_LE + (size_t)8 * 32 * 256 * 4;
constexpr size_t WS_BON = WS_RW + (size_t)MTOK * 1536 * 4;
constexpr size_t WS_S5E = WS_BON + (size_t)MTOK * 4 * 4;
constexpr size_t WS_OMIX = WS_S5E + (size_t)8 * 16 * 16 * 64 * 2 * 4;
constexpr size_t WS_ZB = WS_OMIX, WS_WGLU = WS_OMIX + 16 * MiB, WS_LWT = WS_OMIX + 17 * MiB, WS_W1T = WS_OMIX + 18 * MiB, WS_S5T = WS_OMIX + 19 * MiB;
constexpr size_t WS_OB = WS_OMIX + (size_t)MTOK * DM * 4;
constexpr size_t WS_PART = WS_OB + (size_t)MTOK * DM * 2;
constexpr size_t WS_YP = WS_PART + (size_t)DB * 4 * NSPLIT * PART_FLOATS * 4;
constexpr size_t WS_X1 = WS_YP + (size_t)MTOK * DM * 4;
constexpr size_t WS_PZ = WS_X1 + (size_t)MTOK * DM * 4;
constexpr size_t WS_END = WS_PZ + (size_t)8 * 4 * 8 * 2 * 4096 * 4;
static_assert(WS_H % 256 == 0 && WS_PROJ % 256 == 0 && WS_QB % 256 == 0 && WS_VT % 256 == 0 && WS_RW % 256 == 0 && WS_OMIX % 256 == 0 && WS_PART % 256 == 0 && WS_YP % 256 == 0, "ws align");

constexpr int CW_BAR = 4096;
constexpr int CW_QUEUE = 8192;

constexpr int LDS_BYTES = 147456;
constexpr int MISC_OFF = 147456 - 256;

#define XB_TMO      128
#define XB_XCNT(j)  (256  + 64 * (j))
#define XB_XSUB(j)  (1280 + 64 * (j))
#define XB_XGEN(j)  (2304 + 64 * (j))
#define XB_TOP      3328
#define XB_TOPGEN   3392
#define XCD_BAR_WORDS 3456
#define XB_SPIN_CAP (1u << 18)

__device__ __forceinline__ unsigned xb_ld(unsigned* p)              { return __hip_atomic_load(p, __ATOMIC_RELAXED, __HIP_MEMORY_SCOPE_AGENT); }
__device__ __forceinline__ unsigned xb_add(unsigned* p, unsigned v) { return __hip_atomic_fetch_add(p, v, __ATOMIC_RELAXED, __HIP_MEMORY_SCOPE_AGENT); }
__device__ __forceinline__ unsigned xb_xcc_id() { return (unsigned)__builtin_amdgcn_s_getreg((3 << 11) | 20) & 0xFu; }
#define XB_SPIN(cond, bar) do { unsigned _sp = 0; while (cond) { __builtin_amdgcn_s_sleep(1); \
    if ((++_sp & 255u) == 0u) { if (xb_ld(&(bar)[XB_TMO])) break; if (_sp > XB_SPIN_CAP) { atomicAdd(&(bar)[XB_TMO], 1u); break; } } } } while (0)

struct XcdBarrier { unsigned* bar; unsigned x; volatile LAS unsigned* st; };

__device__ __forceinline__ XcdBarrier xcd_barrier_post(unsigned* bar, volatile LAS unsigned* st) {
    XcdBarrier b; b.bar = bar; b.x = xb_xcc_id(); b.st = st;
    if (threadIdx.x == 0) (void)xb_add(&bar[XB_XCNT(b.x)], 1u);
    return b;
}
__device__ __forceinline__ void xcd_barrier_complete(unsigned* bar, unsigned x, unsigned& nloc, unsigned& nx) {
    const unsigned G = gridDim.x * gridDim.y * gridDim.z;
    unsigned sum, cnt, mine, sp = 0u;
    for (;;) {
        sum = 0u; cnt = 0u; mine = 0u;
#pragma unroll
        for (unsigned j = 0; j < 16; ++j) { const unsigned c = xb_ld(&bar[XB_XCNT(j)]); sum += c; cnt += (c > 0u) ? 1u : 0u; mine = (j == x) ? c : mine; }
        if (sum == G) break;
        __builtin_amdgcn_s_sleep(1);
        if ((++sp & 255u) == 0u) { if (xb_ld(&bar[XB_TMO])) break; if (sp > XB_SPIN_CAP) { atomicAdd(&bar[XB_TMO], 1u); break; } }
    }
    nloc = mine > 0u ? mine : 1u; nx = cnt > 0u ? cnt : 1u;
}
__device__ __forceinline__ void xcd_barrier(const XcdBarrier& b, bool leader) {
    asm volatile("s_waitcnt vmcnt(0)" ::: "memory");
    __syncthreads();
    if (leader) {
        unsigned* bar = b.bar;
        __builtin_amdgcn_s_waitcnt(0);
        unsigned nloc = b.st[0], nx = b.st[1];
        if (nloc == 0u) { xcd_barrier_complete(bar, b.x, nloc, nx); b.st[0] = nloc; b.st[1] = nx; }
        const unsigned old = xb_add(&bar[XB_XSUB(b.x)], 1u);
        const unsigned gen = old / nloc;
        if (old + 1u == (gen + 1u) * nloc) {
            __builtin_amdgcn_fence(__ATOMIC_RELEASE, "agent");
            asm volatile("s_waitcnt vmcnt(0)" ::: "memory");
            const unsigned og = xb_add(&bar[XB_TOP], 1u);
            const unsigned tg = og / nx;
            if (og + 1u == (tg + 1u) * nx) xb_add(&bar[XB_TOPGEN], 1u);
            else XB_SPIN(xb_ld(&bar[XB_TOPGEN]) == tg, bar);
            __builtin_amdgcn_fence(__ATOMIC_ACQUIRE, "agent");
            xb_add(&bar[XB_XGEN(b.x)], 1u);
            asm volatile("s_waitcnt vmcnt(0)" ::: "memory");
        } else {
            XB_SPIN(xb_ld(&bar[XB_XGEN(b.x)]) == gen, bar);
            __builtin_amdgcn_fence(__ATOMIC_ACQUIRE, "agent");
            asm volatile("s_waitcnt vmcnt(0)" ::: "memory");
        }
    }
    __syncthreads();
}

enum InIdx { I_XP = 0, I_XS, I_CK, I_CV, I_PT, I_SCONV, I_SLRU, I_SSHIFT, I_SWKV, I_SSSM, I_NPRE, I_NPOST, I_WIN, I_WOUT, I_LQ1, I_LK1, I_LQ2, I_LK2, I_SUBLN,
             I_CONVW, I_CONVB, I_LWA, I_LBA, I_LWX, I_LBX, I_LLAM, I_MU, I_W0, I_W1, I_W2, I_A0, I_A1, I_A2, I_KK, I_KA, I_RK, I_GNW, I_GNB,
             I_LRE, I_LIM, I_LOGDT, I_BRE, I_BIM, I_CRE, I_CIM, I_S5D, I_WGLU, I_BGLU, N_IN };
struct Args { const float* in[N_IN]; float* out; unsigned char* ws; int ph_lo, ph_hi; };
static_assert(sizeof(Args) == (N_IN + 2) * 8 + 8, "Args has no padding");
constexpr int TAB_OFF = 147456 - 1024;
struct Ctx {
    float* out; unsigned char* ws; const LAS unsigned* tab;
    __device__ __forceinline__ const float* inp(int i) const {
        const unsigned lo = tab[2 * i], hi = tab[2 * i + 1];
        return (const float*)(const GAS float*)(((unsigned long long)(unsigned)__builtin_amdgcn_readfirstlane((int)hi) << 32) | (unsigned long long)(unsigned)__builtin_amdgcn_readfirstlane((int)lo));
    }
};

__device__ __forceinline__ int lane_id_asm() { int l; asm volatile("v_mbcnt_lo_u32_b32 %0, -1, 0\n\tv_mbcnt_hi_u32_b32 %0, -1, %0" : "=v"(l)); return l; }
#define OPAQUE(x) asm volatile("" : "+v"(x))
__device__ __forceinline__ float wave_sum(float v) {
#pragma unroll
    for (int o = 1; o < 64; o <<= 1) v += __shfl_xor(v, o);
    return v;
}
template <int CTRL> __device__ __forceinline__ float dpp_mov(float v) { return __builtin_bit_cast(float, __builtin_amdgcn_update_dpp(0, __builtin_bit_cast(int, v), CTRL, 0xF, 0xF, true)); }
__device__ __forceinline__ float red8(float v) { v += dpp_mov<0xB1>(v); v += dpp_mov<0x4E>(v); v += dpp_mov<0x141>(v); return v; }
__device__ __forceinline__ float red16(float v) { v = red8(v); v += dpp_mov<0x140>(v); return v; }
__device__ __forceinline__ unsigned f2bf(float f) { unsigned u = __builtin_bit_cast(unsigned, f); return (u + 0x7fffu + ((u >> 16) & 1u)) >> 16; }
typedef __bf16 bf16x2_t __attribute__((ext_vector_type(2)));
__device__ __forceinline__ unsigned pk2(float lo, float hi) { const f32x2 v = {lo, hi}; return __builtin_bit_cast(unsigned, __builtin_convertvector(v, bf16x2_t)); }
__device__ __forceinline__ f32x4 ldp4(const bf16* p) { const u32x2 w = *(const u32x2*)p; return (f32x4){__builtin_bit_cast(float, w.x << 16), __builtin_bit_cast(float, w.x & 0xffff0000u), __builtin_bit_cast(float, w.y << 16), __builtin_bit_cast(float, w.y & 0xffff0000u)}; }
__device__ __forceinline__ float ldp1(const bf16* p) { return __builtin_bit_cast(float, (unsigned)(*p) << 16); }
__device__ __forceinline__ float sigmoidf_(float x) { return __builtin_amdgcn_rcpf(1.0f + __builtin_amdgcn_exp2f(-1.4426950408889634f * x)); }
__device__ __forceinline__ float siluf_(float x) { return x * sigmoidf_(x); }
__device__ __forceinline__ float tanhf_(float x) { return 1.0f - 2.0f * __builtin_amdgcn_rcpf(1.0f + __builtin_amdgcn_exp2f(2.8853900817779268f * x)); }
__device__ __forceinline__ float wave_sum_fast(float v) { v = red16(v); v += __shfl_xor(v, 16); v += __shfl_xor(v, 32); return v; }
__device__ __forceinline__ float softplusf_(float x) { return fmaxf(x, 0.f) + log1pf(__expf(-fabsf(x))); }
__device__ __forceinline__ float lam_init_of(int l) { return l == 0 ? 0.2f : 0.35550907f; }
__device__ __forceinline__ float compute_lam(const Ctx& a, int l, int lane) {
    float v1 = 0.f, v2 = 0.f;
    if (lane < 32) { v1 = a.inp(I_LQ1)[l * 32 + lane] * a.inp(I_LK1)[l * 32 + lane]; v2 = a.inp(I_LQ2)[l * 32 + lane] * a.inp(I_LK2)[l * 32 + lane]; }
    v1 = wave_sum(v1); v2 = wave_sum(v2);
    return expf(v1) - expf(v2) + lam_init_of(l);
}

__device__ __forceinline__ void s5_disc_compute(const Ctx& a, int l, int g, int n, float& ab_re, float& ab_im, float& f_re, float& f_im);
__device__ __forceinline__ void p0_transpose_item(const float* W, int K, int N, bf16* WT, LAS float* scr, int item, int lane) {
    const int nblk = N / 32, kb = item / nblk, nb = item % nblk, k0 = 64 * kb, n0 = 32 * nb;
    float wv[32];
#pragma unroll
    for (int i = 0; i < 32; ++i) wv[i] = W[(size_t)(k0 + 2 * i + (lane >> 5)) * N + n0 + (lane & 31)];
#pragma unroll
    for (int i = 0; i < 32; ++i) scr[(2 * i + (lane >> 5)) * 33 + (lane & 31)] = wv[i];
    asm volatile("s_waitcnt lgkmcnt(0)" ::: "memory");
    const int c = lane & 7;
#pragma unroll
    for (int j = 0; j < 4; ++j) { const int n = (lane >> 3) + 8 * j; const LAS float* s = scr + (8 * c) * 33 + n;
        u32x4 o; o.x = pk2(s[0 * 33], s[1 * 33]); o.y = pk2(s[2 * 33], s[3 * 33]); o.z = pk2(s[4 * 33], s[5 * 33]); o.w = pk2(s[6 * 33], s[7 * 33]);
        *(u32x4*)(WT + (size_t)(n0 + n) * K + k0 + 8 * c) = o; }
    asm volatile("s_waitcnt lgkmcnt(0)" ::: "memory");
}
__device__ __forceinline__ void rms_row_to_bf16(const float* xrow, const float* g, bf16* orow, int lane) {
    const f32x4* xr = (const f32x4*)xrow + lane; const f32x4* gr = (const f32x4*)g + lane;
    f32x4 v[4]; float s = 0.f;
#pragma unroll
    for (int j = 0; j < 4; ++j) { v[j] = xr[64 * j]; s += (v[j].x * v[j].x + v[j].y * v[j].y) + (v[j].z * v[j].z + v[j].w * v[j].w); }
    const float r = rsqrtf(wave_sum(s) * (1.f / DM) + NORM_EPS);
    u32x2* o8 = (u32x2*)orow + lane;
#pragma unroll
    for (int j = 0; j < 4; ++j) { const f32x4 gg = gr[64 * j]; u32x2 o; o.x = pk2(v[j].x * r * gg.x, v[j].y * r * gg.y); o.y = pk2(v[j].z * r * gg.z, v[j].w * r * gg.w); o8[64 * j] = o; }
}
__device__ __forceinline__ void ph_prologue(const Ctx& a, LAS unsigned char* lds, int lane, int wave) {
    OPAQUE(lane);
    LAS float* scr = (LAS float*)(lds + wave * 16384);
    const int gw = blockIdx.x * NWAVES + wave, NGW = gridDim.x * NWAVES;
    constexpr int I_IN = (DM / 64) * (DIN / 32), I_OUT = (DM / 64) * (DM / 32), I_GLU = (256 / 64) * (256 / 32), I_L = I_IN + I_OUT + I_GLU;
    for (int it = gw; it < 2 * I_L; it += NGW) {
        const int l = it / I_L, r = it % I_L;
        if (r < I_IN) p0_transpose_item(a.inp(I_WIN) + (size_t)l * DM * DIN, DM, DIN, (bf16*)(a.ws + WS_WIN) + (size_t)l * DIN * DM, scr, r, lane);
        else if (r < I_IN + I_OUT) p0_transpose_item(a.inp(I_WOUT) + (size_t)l * DM * DM, DM, DM, (bf16*)(a.ws + WS_WOUT) + (size_t)l * DM * DM, scr, r - I_IN, lane);
        else p0_transpose_item(a.inp(I_WGLU) + (size_t)l * 65536, 256, 256, (bf16*)(a.ws + WS_WGLU) + (size_t)l * 65536, scr, r - I_IN - I_OUT, lane);
    }
    {
        bf16* LWT = (bf16*)(a.ws + WS_LWT);
        const float* wa = a.inp(I_LWA); const float* wx = a.inp(I_LWX);
        for (int idx = gw * 64 + lane; idx < 2 * 2 * 4 * 64 * 64; idx += NGW * 64) {
            const int c = idx & 63, d = (idx >> 6) & 63, n = (idx >> 12) & 3, p = (idx >> 14) & 1, l = idx >> 15;
            LWT[idx] = (bf16)f2bf((p ? wx : wa)[((size_t)(l * 4 + n) * 64 + c) * 64 + d]);
        }
    }
    {
        float* T = (float*)(a.ws + WS_S5T);
        for (int idx = gw * 64 + lane; idx < 2 * 16 * 64; idx += NGW * 64) {
            float ar, ai, fr, fi; s5_disc_compute(a, idx >> 10, (idx >> 6) & 15, idx & 63, ar, ai, fr, fi);
            *(f32x4*)(T + (size_t)idx * 4) = (f32x4){ar, ai, fr, fi};
        }
    }
    {
        bf16* W1T = (bf16*)(a.ws + WS_W1T);
        const float* w1 = a.inp(I_W1); const float* a1 = a.inp(I_A1);
        for (int idx = gw * 64 + lane; idx < 2 * 2 * 32 * 256; idx += NGW * 64) {
            const int k = idx & 255, n = (idx >> 8) & 31, p = (idx >> 13) & 1, l = idx >> 14;
            W1T[idx] = (bf16)f2bf((p ? a1 : w1)[((size_t)l * 256 + k) * 32 + n]);
        }
    }
    bf16* H = (bf16*)(a.ws + WS_H);
    {
        const float* xp = a.inp(I_XP); const float* xs = a.inp(I_XS) - (size_t)NP * DM;
        f32x4 gg[4];
#pragma unroll
        for (int j = 0; j < 4; ++j) gg[j] = ((const f32x4*)a.inp(I_NPRE) + lane)[64 * j];
        for (int m0 = gw; m0 < MTOK; m0 += 2 * NGW) {
            const int m1 = m0 + NGW; const bool has1 = m1 < MTOK; const int mb = has1 ? m1 : m0;
            const f32x4* xa = (const f32x4*)((m0 < NP ? xp : xs) + (size_t)m0 * DM) + lane; const f32x4* xb = (const f32x4*)((mb < NP ? xp : xs) + (size_t)mb * DM) + lane;
            f32x4 va[4], vb[4]; float sa = 0.f, sb = 0.f;
#pragma unroll
            for (int j = 0; j < 4; ++j) { va[j] = xa[64 * j]; vb[j] = xb[64 * j]; }
#pragma unroll
            for (int j = 0; j < 4; ++j) { sa += (va[j].x * va[j].x + va[j].y * va[j].y) + (va[j].z * va[j].z + va[j].w * va[j].w); sb += (vb[j].x * vb[j].x + vb[j].y * vb[j].y) + (vb[j].z * vb[j].z + vb[j].w * vb[j].w); }
            const float ra = rsqrtf(wave_sum_fast(sa) * (1.f / DM) + NORM_EPS), rb = rsqrtf(wave_sum_fast(sb) * (1.f / DM) + NORM_EPS);
            u32x2* ha = (u32x2*)(H + (size_t)m0 * DM) + lane; u32x2* hb = (u32x2*)(H + (size_t)mb * DM) + lane;
#pragma unroll
            for (int j = 0; j < 4; ++j) { u32x2 o; o.x = pk2(va[j].x * ra * gg[j].x, va[j].y * ra * gg[j].y); o.y = pk2(va[j].z * ra * gg[j].z, va[j].w * ra * gg[j].w); ha[64 * j] = o;
                if (has1) { u32x2 p; p.x = pk2(vb[j].x * rb * gg[j].x, vb[j].y * rb * gg[j].y); p.y = pk2(vb[j].z * rb * gg[j].z, vb[j].w * rb * gg[j].w); hb[64 * j] = p; } }
        }
    }
}

struct EpiProj {
    static constexpr bool PERM = true, AFTER_DRAIN = false;
    bf16* P; float* out; int layer;
    __device__ __forceinline__ void operator()(const pg8::f32x4 (&acc)[2][2][4][2], const pg8::Unit& u, int wr, int wc, int fr, int fq) const {
        const int row0 = u.pm * 256 + wr * 64 + fr, col0 = u.pn * 256 + wc * 32 + 8 * fq;
#pragma unroll
        for (int ai = 0; ai < 2; ++ai)
#pragma unroll
            for (int m = 0; m < 4; ++m) { bf16* rowp = P + (size_t)(row0 + ai * 128 + m * 16) * DIN + col0;
#pragma unroll
                for (int bj = 0; bj < 2; ++bj) { const pg8::f32x4 v0 = acc[ai][bj][m][0], v1 = acc[ai][bj][m][1];
                    u32x4 w; w.x = pk2(v0[0], v0[1]); w.y = pk2(v0[2], v0[3]); w.z = pk2(v1[0], v1[1]); w.w = pk2(v1[2], v1[3]);
                    *(u32x4*)(rowp + bj * 128) = w; } }
        if (u.pn == 1 || u.pn == 2) {
            const bool smp = (u.pm >= 64);
            float* base;
            if (u.pn == 1) base = smp ? out + OUT_K_S + (size_t)layer * NSMP * 256 : out + OUT_K_P + (size_t)layer * NP * 256;
            else           base = smp ? out + OUT_V_S + (size_t)layer * NSMP * 256 : out + OUT_V_P + (size_t)layer * NP * 256;
            const int r0 = row0 - (smp ? NP : 0), c0 = wc * 32 + 8 * fq;
#pragma unroll
            for (int ai = 0; ai < 2; ++ai)
#pragma unroll
                for (int m = 0; m < 4; ++m) { float* rowp = base + (size_t)(r0 + ai * 128 + m * 16) * 256 + c0;
#pragma unroll
                    for (int bj = 0; bj < 2; ++bj) { __builtin_nontemporal_store(acc[ai][bj][m][0], (pg8::f32x4*)(rowp + bj * 128)); __builtin_nontemporal_store(acc[ai][bj][m][1], (pg8::f32x4*)(rowp + bj * 128 + 4)); } }
        }
    }
};
struct EpiPlain {
    static constexpr bool PERM = true, AFTER_DRAIN = false;
    bf16* C; int ldc;
    __device__ __forceinline__ void operator()(const pg8::f32x4 (&acc)[2][2][4][2], const pg8::Unit& u, int wr, int wc, int fr, int fq) const {
        const int row0 = u.pm * 256 + wr * 64 + fr, col0 = u.pn * 256 + wc * 32 + 8 * fq;
#pragma unroll
        for (int ai = 0; ai < 2; ++ai)
#pragma unroll
            for (int m = 0; m < 4; ++m) { bf16* rowp = C + (size_t)(row0 + ai * 128 + m * 16) * ldc + col0;
#pragma unroll
                for (int bj = 0; bj < 2; ++bj) { const pg8::f32x4 v0 = acc[ai][bj][m][0], v1 = acc[ai][bj][m][1];
                    u32x4 w; w.x = pk2(v0[0], v0[1]); w.y = pk2(v0[2], v0[3]); w.z = pk2(v1[0], v1[1]); w.w = pk2(v1[2], v1[3]);
                    *(u32x4*)(rowp + bj * 128) = w; } }
    }
};

__device__ __forceinline__ void lru_prep_item(const Ctx& a, int l, int item, LAS unsigned char* lds, int tid) {
    OPAQUE(tid);
    const bf16* PROJ = (const bf16*)(a.ws + WS_PROJ);
    float* LA = (float*)(a.ws + WS_LA); float* LB = (float*)(a.ws + WS_LB);
    LAS float* X = (LAS float*)lds;
    LAS float* XC = (LAS float*)(lds + 68608);
    const bool smp = item >= 256;
    int nseg, seglen, m0, s = 0, ch = 0, b0 = 0;
    if (!smp) { s = item >> 5; ch = item & 31; nseg = 1; seglen = 64; m0 = s * SEQ + ch * 64; }
    else { const int j = item - 256; nseg = 4; seglen = 8; m0 = NP + j * 32; b0 = j * 4; }
    const int rps = seglen + 3, L = nseg * seglen;
    {
        const float* sconv = a.inp(I_SCONV);
#pragma unroll 4
        for (int idx = tid; idx < nseg * rps * 64; idx += NTHREADS) {
            const int row = idx >> 6, c4 = idx & 63, seg = row / rps, i = row % rps;
            const bool halo = i < 3;
            const bool fromstate = smp && halo;
            f32x4 v = ldp4(PROJ + (size_t)(m0 + seg * seglen + (halo && (smp || ch == 0) ? 3 : i) - 3) * DIN + OFF_B + 4 * c4);
            const f32x4 vs = *(const f32x4*)(sconv + (fromstate ? ((size_t)(l * DB + b0 + seg) * 3 + i) * 256 : (size_t)0) + 4 * c4);
            if (fromstate) v = vs;
            if (!smp && ch == 0 && halo) v = (f32x4){0.f, 0.f, 0.f, 0.f};
            *(LAS f32x4*)(X + row * 256 + 4 * c4) = v;
        }
    }
    __syncthreads();
    if (smp || ch == 31) {
        for (int idx = tid; idx < nseg * 3 * 256; idx += NTHREADS) {
            const int seg = idx / 768, j = (idx % 768) >> 8, c = idx & 255;
            const float v = X[(seg * rps + seglen + j) * 256 + c];
            if (smp) a.out[OUT_CONV_S + ((size_t)(l * DB + b0 + seg) * 3 + j) * 256 + c] = v;
            else a.out[OUT_CONV_P + ((size_t)(l * 8 + s) * 3 + j) * 256 + c] = v;
        }
    }
    {
        const float* cw = a.inp(I_CONVW) + l * 1024; const float* cb = a.inp(I_CONVB) + l * 256;
        for (int idx = tid; idx < L * 256; idx += NTHREADS) {
            const int t = idx >> 8, c = idx & 255, seg = t / seglen, i = t % seglen;
            const LAS float* bp = X + (seg * rps + i) * 256 + c;
            XC[t * 256 + c] = cb[c] + cw[c] * bp[0] + cw[256 + c] * bp[256] + cw[512 + c] * bp[512] + cw[768 + c] * bp[768];
        }
    }
    __syncthreads();
    {
        const int lane = tid & 63, wv = tid >> 6, p = wv >> 2, n = wv & 3, r = lane & 31, hh = lane >> 5, o = tid & 255;
        const bf16* WT = (const bf16*)(a.ws + WS_LWT) + ((size_t)((l * 2 + p) * 4 + n) * 64) * 64;
        bf16x8 wf[2][4];
#pragma unroll
        for (int dt = 0; dt < 2; ++dt)
#pragma unroll
            for (int sx = 0; sx < 4; ++sx) wf[dt][sx] = *(const bf16x8*)(WT + (dt * 32 + r) * 64 + 16 * sx + 8 * hh);
        const float* bp = (p ? a.inp(I_LBX) : a.inp(I_LBA)) + l * 256 + n * 64 + 4 * hh;
        LAS float* GX = X;
        const int LH = L >> 1;
        bf16* OB = (bf16*)(a.ws + WS_OB);
        const float spv = softplusf_(-a.inp(I_LLAM)[l * 256 + o]) * 1.4426950408889634f;
        const float* slru = a.inp(I_SLRU);
        float hs = 0.f, Ps = 1.f;
        for (int hf = 0; hf < 2; ++hf) {
            {
                const LAS float* xr = XC + (hf * LH + r) * 256 + n * 64 + 8 * hh;
                bf16x8 xb[4];
#pragma unroll
                for (int sx = 0; sx < 4; ++sx) { const f32x4 x0 = *(const LAS f32x4*)(xr + 16 * sx), x1 = *(const LAS f32x4*)(xr + 16 * sx + 4);
                    u32x4 w; w.x = pk2(x0.x, x0.y); w.y = pk2(x0.z, x0.w); w.z = pk2(x1.x, x1.y); w.w = pk2(x1.z, x1.w); xb[sx] = __builtin_bit_cast(bf16x8, w); }
#pragma unroll
                for (int dt = 0; dt < 2; ++dt) {
                    f32x16 acc;
#pragma unroll
                    for (int e = 0; e < 16; ++e) acc[e] = 0.f;
#pragma unroll
                    for (int sx = 0; sx < 4; ++sx) acc = __builtin_amdgcn_mfma_f32_32x32x16_bf16(wf[dt][sx], xb[sx], acc, 0, 0, 0);
#pragma unroll
                    for (int g4 = 0; g4 < 4; ++g4) { const f32x4 bb = *(const f32x4*)(bp + dt * 32 + 8 * g4);
                        f32x4 gv; gv.x = sigmoidf_(acc[4 * g4] + bb.x); gv.y = sigmoidf_(acc[4 * g4 + 1] + bb.y); gv.z = sigmoidf_(acc[4 * g4 + 2] + bb.z); gv.w = sigmoidf_(acc[4 * g4 + 3] + bb.w);
                        *(LAS f32x4*)(GX + (p * 32 + r) * 256 + n * 64 + dt * 32 + 8 * g4 + 4 * hh) = gv; }
                }
            }
            __syncthreads();
            if (p == 0) {
              for (int t0 = 0; t0 < LH; t0 += 8) {
                float gts[8];
                if (smp) {
#pragma unroll
                    for (int t = 0; t < 8; ++t) gts[t] = ldp1(PROJ + (size_t)(m0 + hf * LH + t0 + t) * DIN + OFF_G + 256 + o); }
#pragma unroll
                for (int t8 = 0; t8 < 8; ++t8) {
                    const int t = t0 + t8;
                    const int tt = hf * LH + t, seg = tt / seglen, i = tt % seglen;
                    if (i == 0) { hs = smp ? slru[(size_t)(l * DB + b0 + seg) * 256 + o] : 0.f; Ps = 1.f; }
                    const float rg = GX[t * 256 + o], g = GX[(32 + t) * 256 + o];
                    const float av = __builtin_amdgcn_exp2f(-8.0f * rg * spv);
                    const float mult = __builtin_amdgcn_sqrtf(fmaxf(1.0f - av * av, 0.f));
                    const float bv = mult * g * XC[tt * 256 + o];
                    const size_t m = (size_t)(m0 + tt);
                    hs = av * hs + bv; Ps *= av;
                    if (smp) { OB[m * DM + 256 + o] = (bf16)f2bf(hs * siluf_(gts[t8])); if (i == seglen - 1) a.out[OUT_LRU_S + (size_t)(l * DB + b0 + seg) * 256 + o] = hs; }
                    else { LA[m * 256 + o] = av; LB[m * 256 + o] = bv; }
                }
              }
            }
            __syncthreads();
        }
        if (!smp && p == 0) { ((float*)(a.ws + WS_LP))[(size_t)(s * 32 + ch) * 256 + o] = Ps; ((float*)(a.ws + WS_LE))[(size_t)(s * 32 + ch) * 256 + o] = hs; }
    }
    __syncthreads();
}

__device__ __forceinline__ void rwkv_prep_item(const Ctx& a, int l, int item, LAS unsigned char* lds, int tid) {
    OPAQUE(tid);
    const bf16* PROJ = (const bf16*)(a.ws + WS_PROJ);
    float* RW = (float*)(a.ws + WS_RW);
    const float* mu = a.inp(I_MU) + l * 1280; const float* sshift = a.inp(I_SSHIFT) + (size_t)l * DB * 1280;
    LAS float* XWA = (LAS float*)lds;
    LAS float* T1 = (LAS float*)(lds + 65536);
    const int m0 = item * 32;
#pragma unroll
    for (int kb = 0; kb < 20; kb += 10) {
        f32x4 pv[10], ppv[10], psv[10];
#pragma unroll
        for (int k = 0; k < 10; ++k) {
            const int idx = tid + NTHREADS * (kb + k), t = idx / 320, c4 = idx % 320, col = 4 * c4, m = m0 + t;
            const bool first = (m < NP) ? ((m & (SEQ - 1)) == 0) : (((m - NP) & 7) == 0);
            const bool fromstate = first && m >= NP;
            pv[k] = ldp4(PROJ + (size_t)m * DIN + OFF_C + col);
            ppv[k] = ldp4(PROJ + (size_t)(first ? m : m - 1) * DIN + OFF_C + col);
            psv[k] = *(const f32x4*)(sshift + (fromstate ? (size_t)((m - NP) >> 3) * 1280 : (size_t)0) + col);
        }
#pragma unroll
        for (int k = 0; k < 10; ++k) {
            const int idx = tid + NTHREADS * (kb + k), t = idx / 320, c4 = idx % 320, col = 4 * c4, m = m0 + t;
            const bool first = (m < NP) ? ((m & (SEQ - 1)) == 0) : (((m - NP) & 7) == 0);
            f32x4 pp = ppv[k];
            if (first && m >= NP) pp = psv[k];
            if (first && m < NP) pp = (f32x4){0.f, 0.f, 0.f, 0.f};
            const f32x4 xm = pv[k] + (pp - pv[k]) * *(const f32x4*)(mu + col);
            const int sec = c4 >> 6, cc = col & 255;
            if (sec == 1) *(LAS f32x4*)(XWA + t * 512 + cc) = xm;
            else if (sec == 4) *(LAS f32x4*)(XWA + t * 512 + 256 + cc) = xm;
            else *(f32x4*)(RW + (size_t)m * 1536 + (sec == 0 ? 0 : (sec == 2 ? 512 : 768)) + cc) = xm;
        }
    }
    __syncthreads();
    if (tid < 128) {
        const int lane = tid & 63, p = tid >> 6, r = lane & 31, hh = lane >> 5;
        const bf16* wt = (const bf16*)(a.ws + WS_W1T) + ((size_t)(l * 2 + p) * 32 + r) * 256 + 8 * hh;
        const LAS float* xr = XWA + r * 512 + p * 256 + 8 * hh;
        f32x16 acc;
#pragma unroll
        for (int e = 0; e < 16; ++e) acc[e] = 0.f;
#pragma unroll
        for (int sx = 0; sx < 16; ++sx) {
            const bf16x8 af = *(const bf16x8*)(wt + 16 * sx);
            const f32x4 x0 = *(const LAS f32x4*)(xr + 16 * sx), x1 = *(const LAS f32x4*)(xr + 16 * sx + 4);
            u32x4 w; w.x = pk2(x0.x, x0.y); w.y = pk2(x0.z, x0.w); w.z = pk2(x1.x, x1.y); w.w = pk2(x1.z, x1.w);
            acc = __builtin_amdgcn_mfma_f32_32x32x16_bf16(af, __builtin_bit_cast(bf16x8, w), acc, 0, 0, 0);
        }
#pragma unroll
        for (int g4 = 0; g4 < 4; ++g4) { f32x4 v = (f32x4){acc[4 * g4], acc[4 * g4 + 1], acc[4 * g4 + 2], acc[4 * g4 + 3]};
            if (p == 0) { v.x = tanhf_(v.x); v.y = tanhf_(v.y); v.z = tanhf_(v.z); v.w = tanhf_(v.w); }
            *(LAS f32x4*)(T1 + r * 64 + p * 32 + 8 * g4 + 4 * hh) = v; }
    }
    __syncthreads();
    {
        const int o = tid & 255, half = tid >> 8;
        float wr[32];
        const float* w2p = (half ? a.inp(I_A2) : a.inp(I_W2)) + (size_t)l * 32 * 256 + o;
#pragma unroll
        for (int j = 0; j < 32; ++j) wr[j] = w2p[(size_t)j * 256];
        const float b0 = (half ? a.inp(I_A0) : a.inp(I_W0))[l * 256 + o];
        const float kkw = a.inp(I_KK)[l * 256 + o], kaw = a.inp(I_KA)[l * 256 + o];
#pragma unroll
        for (int t0 = 0; t0 < 32; t0 += 8) {
            float xk_[8];
            if (half) {
#pragma unroll
                for (int t = 0; t < 8; ++t) xk_[t] = RW[(size_t)(m0 + t0 + t) * 1536 + 512 + o]; }
#pragma unroll
            for (int t8 = 0; t8 < 8; ++t8) {
                const int t = t0 + t8;
                float z0 = b0, z1 = 0.f;
                const LAS float* tp = T1 + t * 64 + half * 32;
#pragma unroll
                for (int j4 = 0; j4 < 8; ++j4) { const f32x4 tv = *(const LAS f32x4*)(tp + 4 * j4);
                    z0 += tv.x * wr[4 * j4] + tv.y * wr[4 * j4 + 1]; z1 += tv.z * wr[4 * j4 + 2] + tv.w * wr[4 * j4 + 3]; }
                const float z = z0 + z1;
                float* rwp = RW + (size_t)(m0 + t) * 1536 + o;
                if (half == 0) {
                    rwp[256] = __builtin_amdgcn_exp2f(-0.8750566294f * sigmoidf_(z));
                } else {
                    const float aa = sigmoidf_(z);
                    const float xk = xk_[t8];
                    const float kkv = xk * kkw;
                    const float ss = wave_sum_fast(kkv * kkv);
                    const float kkn = kkv * __builtin_amdgcn_rsqf(fmaxf(ss, 1e-24f));
                    rwp[512] = xk * (1.0f + (aa - 1.0f) * kaw); rwp[1024] = -kkn; rwp[1280] = kkn * aa;
                }
            }
        }
    }
    __syncthreads();
}

__device__ __forceinline__ void s5_disc(const Ctx& a, int l, int g, int n, float& ab_re, float& ab_im, float& f_re, float& f_im) {
    const f32x4 t = *(const f32x4*)((const float*)(a.ws + WS_S5T) + ((size_t)(l * 16 + g) * 64 + n) * 4);
    ab_re = t.x; ab_im = t.y; f_re = t.z; f_im = t.w;
}
__device__ __forceinline__ void s5_disc_compute(const Ctx& a, int l, int g, int n, float& ab_re, float& ab_im, float& f_re, float& f_im) {
    const float lr = a.inp(I_LRE)[(l * 16 + g) * 64 + n], li = a.inp(I_LIM)[(l * 16 + g) * 64 + n];
    const float dt = expf(a.inp(I_LOGDT)[l * 16 + g]);
    const float mag = expf(lr * dt);
    ab_re = mag * cosf(li * dt); ab_im = mag * sinf(li * dt);
    const float den = lr * lr + li * li, pr = ab_re - 1.0f;
    f_re = (pr * lr + ab_im * li) / den; f_im = (ab_im * lr - pr * li) / den;
}
struct S5Par { float ab_re, ab_im; bf16x8 bf[4]; };
__device__ __forceinline__ void s5_params(const Ctx& a, int l, int g, int lane, S5Par& P) {
    float fr, fi;
    s5_disc(a, l, g, lane, P.ab_re, P.ab_im, fr, fi);
    const int r = lane & 31, hh = lane >> 5;
#pragma unroll
    for (int nh = 0; nh < 2; ++nh) {
        float xr, xi, f_re, f_im;
        s5_disc(a, l, g, 32 * nh + r, xr, xi, f_re, f_im);
        const float* brp = a.inp(I_BRE) + ((size_t)(l * 16 + g) * 64 + 32 * nh + r) * 16 + 8 * hh; const float* bip = a.inp(I_BIM) + ((size_t)(l * 16 + g) * 64 + 32 * nh + r) * 16 + 8 * hh;
        const f32x4 r0 = *(const f32x4*)brp, r1 = *(const f32x4*)(brp + 4), i0 = *(const f32x4*)bip, i1 = *(const f32x4*)(bip + 4);
        u32x4 wr, wi;
        wr.x = pk2(f_re * r0.x - f_im * i0.x, f_re * r0.y - f_im * i0.y); wr.y = pk2(f_re * r0.z - f_im * i0.z, f_re * r0.w - f_im * i0.w);
        wr.z = pk2(f_re * r1.x - f_im * i1.x, f_re * r1.y - f_im * i1.y); wr.w = pk2(f_re * r1.z - f_im * i1.z, f_re * r1.w - f_im * i1.w);
        wi.x = pk2(f_re * i0.x + f_im * r0.x, f_re * i0.y + f_im * r0.y); wi.y = pk2(f_re * i0.z + f_im * r0.z, f_re * i0.w + f_im * r0.w);
        wi.z = pk2(f_re * i1.x + f_im * r1.x, f_re * i1.y + f_im * r1.y); wi.w = pk2(f_re * i1.z + f_im * r1.z, f_re * i1.w + f_im * r1.w);
        P.bf[nh] = __builtin_bit_cast(bf16x8, wr); P.bf[2 + nh] = __builtin_bit_cast(bf16x8, wi);
    }
}
__device__ __forceinline__ void s5_bu_block(const S5Par& P, const bf16* PROJ, size_t m0, int nvalid, int g, LAS float* HR, LAS float* HI, int lane) {
    const int r = lane & 31, hh = lane >> 5;
    const int tr = r < nvalid ? r : nvalid - 1;
    const bf16x8 uf = *(const bf16x8*)(PROJ + (m0 + tr) * DIN + OFF_D + g * 16 + 8 * hh);
#pragma unroll
    for (int tile = 0; tile < 4; ++tile) {
        f32x16 acc;
#pragma unroll
        for (int e = 0; e < 16; ++e) acc[e] = 0.f;
        acc = __builtin_amdgcn_mfma_f32_32x32x16_bf16(P.bf[tile], uf, acc, 0, 0, 0);
        LAS float* dst = ((tile >> 1) ? HI : HR) + r * 68 + 32 * (tile & 1) + 4 * hh;
#pragma unroll
        for (int g4 = 0; g4 < 4; ++g4) *(LAS f32x4*)(dst + 8 * g4) = (f32x4){acc[4 * g4], acc[4 * g4 + 1], acc[4 * g4 + 2], acc[4 * g4 + 3]};
    }
    asm volatile("s_waitcnt lgkmcnt(0)" ::: "memory");
}
__device__ __forceinline__ void s5_pass1_wave(const Ctx& a, int l, int wi, LAS unsigned char* wlds, int lane) {
    OPAQUE(lane);
    const int ck = wi & 15, g = (wi >> 4) & 15, s = wi >> 8;
    const bf16* PROJ = (const bf16*)(a.ws + WS_PROJ);
    LAS float* HR = (LAS float*)wlds; LAS float* HI = HR + 32 * 68;
    S5Par P; s5_params(a, l, g, lane, P);
    float hr = 0.f, hi = 0.f;
    for (int t0 = 0; t0 < 128; t0 += 32) {
        s5_bu_block(P, PROJ, (size_t)(s * SEQ + ck * 128 + t0), 32, g, HR, HI, lane);
#pragma unroll 8
        for (int t = 0; t < 32; ++t) { const float br = HR[t * 68 + lane], bi = HI[t * 68 + lane];
            const float nr = P.ab_re * hr - P.ab_im * hi + br, ni = P.ab_re * hi + P.ab_im * hr + bi; hr = nr; hi = ni; }
        asm volatile("s_waitcnt lgkmcnt(0)" ::: "memory");
    }
    f32x2* E = (f32x2*)(a.ws + WS_S5E);
    E[((size_t)(s * 16 + g) * 16 + ck) * 64 + lane] = (f32x2){hr, hi};
}

__device__ __forceinline__ void attn_prep_rows_wave(const Ctx& a, int wi, int lane) {
    OPAQUE(lane);
    const bf16* PROJ = (const bf16*)(a.ws + WS_PROJ);
    bf16* QB = (bf16*)(a.ws + WS_QB);
#pragma unroll
    for (int r = 0; r < 8; ++r) { const size_t m = (size_t)wi * 8 + r;
        const f32x4 q = ldp4(PROJ + m * DIN + OFF_AQ + 4 * lane);
        u32x2 qo; qo.x = pk2(q.x * QSCALE, q.y * QSCALE); qo.y = pk2(q.z * QSCALE, q.w * QSCALE);
        *(u32x2*)(QB + m * 256 + 4 * lane) = qo; }
}
__device__ __forceinline__ void attn_prep_kv_wave(const Ctx& a, int wi, int lane) {
    OPAQUE(lane);
    const bf16* PROJ = (const bf16*)(a.ws + WS_PROJ);
    bf16* KF = (bf16*)(a.ws + WS_KB); bf16* VF = (bf16*)(a.ws + WS_VT);
    const int kt = wi & 63, b = wi >> 6, r = lane & 31, hh = lane >> 5;
    const bf16* krow = PROJ + (size_t)(b * SEQ + kt * 32 + r) * DIN + OFF_AK + 8 * hh;
    const bf16* vcol = PROJ + (size_t)(b * SEQ + kt * 32 + 4 * hh) * DIN + OFF_AV + r;
#pragma unroll
    for (int h = 0; h < 4; ++h) {
#pragma unroll
        for (int cs = 0; cs < 4; ++cs) {
            const u32x4 ko = *(const u32x4*)(krow + h * 64 + cs * 16);
            const size_t frag = ((size_t)((b * 4 + h) * 64 + kt) * 4 + cs) * 512 + lane * 8;
            *(u32x4*)(KF + frag) = ko;
            const int tl = cs >> 1, s2 = cs & 1;
            const bf16* vp = vcol + (size_t)(16 * s2) * DIN + h * 64 + 32 * tl;
            unsigned v[8];
#pragma unroll
            for (int jj = 0; jj < 8; ++jj) v[jj] = (unsigned)vp[(size_t)(8 * (jj >> 2) + (jj & 3)) * DIN];
            u32x4 vo; vo.x = v[0] | (v[1] << 16); vo.y = v[2] | (v[3] << 16); vo.z = v[4] | (v[5] << 16); vo.w = v[6] | (v[7] << 16);
            *(u32x4*)(VF + frag) = vo;
        }
    }
}

#ifndef MP_MASK
#define MP_MASK 0x1f
#endif
#ifndef MM_MASK
#define MM_MASK 0x7f
#endif
#define MPE(j) ((MP_MASK >> (j)) & 1)
#define MME(j) ((MM_MASK >> (j)) & 1)
constexpr int MP_LRU = 256 + 32, MP_RW = MTOK / 32, MP_S5 = 256  , MP_AR = 256  , MP_VT = 64  ;
constexpr int MP_TOTAL = MP_LRU + MP_RW + MP_S5 + MP_AR + MP_VT;
__device__ __forceinline__ int grab_unit(unsigned* ctr, volatile LAS unsigned* MISC, int tid) {
    __syncthreads();
    if (tid == 0) MISC[4] = atomicAdd(ctr, 1u);
    __syncthreads();
    return (int)MISC[4];
}
__device__ __forceinline__ void ph_mixprep(const Ctx& a, int lq, int MMSK, LAS unsigned char* lds, volatile LAS unsigned* MISC, int tid, int lane, int wave) {
    const int l = lq & 1;
    unsigned* qctr = (unsigned*)(a.ws + WS_CTL) + CW_QUEUE + 4096 + 512 * lq;
    int u;
    if (MMSK & 1) while ((u = grab_unit(qctr + 0 * 64, MISC, tid)) < MP_LRU) lru_prep_item(a, l, u, lds, tid);
    if (MMSK & 2) while ((u = grab_unit(qctr + 1 * 64, MISC, tid)) < MP_RW) rwkv_prep_item(a, l, u, lds, tid);
    if (MMSK & 4) while ((u = grab_unit(qctr + 2 * 64, MISC, tid)) < MP_S5) s5_pass1_wave(a, l, u * 8 + wave, lds + wave * 17408, lane);
    if (MMSK & 8) while ((u = grab_unit(qctr + 3 * 64, MISC, tid)) < MP_AR) attn_prep_rows_wave(a, u * 8 + wave, lane);
    if (MMSK & 16) while ((u = grab_unit(qctr + 4 * 64, MISC, tid)) < MP_VT) attn_prep_kv_wave(a, u * 8 + wave, lane);
    {
        const bf16* PROJ = (const bf16*)(a.ws + WS_PROJ);
        const int gt = blockIdx.x * NTHREADS + tid, NGT = gridDim.x * NTHREADS;
        for (int idx = gt; idx < 136 * 1280; idx += NGT) {
            const int q = idx / 1280, c = idx % 1280;
            if (q < 8) a.out[OUT_SHIFT_P + (size_t)(l * 8 + q) * 1280 + c] = ldp1(PROJ + (size_t)(q * SEQ + SEQ - 1) * DIN + OFF_C + c);
            else a.out[OUT_SHIFT_S + (size_t)(l * DB + (q - 8)) * 1280 + c] = ldp1(PROJ + (size_t)(NP + (q - 8) * 8 + 7) * DIN + OFF_C + c);
        }
    }
}

struct RwOps { f32x2 w[4], k[4], a[4], b[4], r[4]; float vi; };
__device__ __forceinline__ void rw_ld4(f32x2 (&d)[4], const LAS float* p) { const f32x4 x = *(const LAS f32x4*)p, y = *(const LAS f32x4*)(p + 4);
    d[0] = (f32x2){x.x, x.y}; d[1] = (f32x2){x.z, x.w}; d[2] = (f32x2){y.x, y.y}; d[3] = (f32x2){y.z, y.w}; }
template <int MODE> __device__ __forceinline__ void rw_load_ops(RwOps& o, const LAS float* base, int i, int jq) {
    rw_ld4(o.w, base + 64 + 8 * jq); rw_ld4(o.k, base + 128 + 8 * jq);
    o.vi = base[192 + i];
    rw_ld4(o.a, base + 256 + 8 * jq); rw_ld4(o.b, base + 320 + 8 * jq);
    if (MODE == 0) rw_ld4(o.r, base + 8 * jq);
}
__device__ __forceinline__ float rw_dot(const f32x2 (&S)[4], const f32x2 (&v)[4]) {
    const f32x2 d0 = S[0] * v[0] + S[1] * v[1], d1 = S[2] * v[2] + S[3] * v[3];
    const f32x2 d = d0 + d1;
    return d.x + d.y;
}
template <int MODE> __device__ __forceinline__ void rw_step(const RwOps& o, f32x2 (&S)[4], f32x2 (&Pm)[4], LAS float* yslot, int jq) {
    const float sa = red8(rw_dot(S, o.a));
    const f32x2 sa2 = (f32x2){sa, sa}, vi2 = (f32x2){o.vi, o.vi};
#pragma unroll
    for (int k = 0; k < 4; ++k) S[k] = (S[k] * o.w[k] + vi2 * o.k[k]) + sa2 * o.b[k];
    if (MODE == 0) {
        const float y = red8(rw_dot(S, o.r));
        if (jq == 0) *yslot = y;
    } else {
        const float sp = red8(rw_dot(Pm, o.a));
        const f32x2 sp2 = (f32x2){sp, sp};
#pragma unroll
        for (int k = 0; k < 4; ++k) Pm[k] = Pm[k] * o.w[k] + sp2 * o.b[k];
    }
}
template <int MODE, int TT>
__device__ __forceinline__ void rwkv_core(const Ctx& a, int l, int h, int mbase, int T, float (&S8)[8], float (&P8)[8], LAS unsigned char* lds, int tid) {
    f32x2 S[4], Pm[4];
#pragma unroll
    for (int k = 0; k < 4; ++k) { S[k] = (f32x2){S8[2 * k], S8[2 * k + 1]}; Pm[k] = (f32x2){P8[2 * k], P8[2 * k + 1]}; }
    const float* RW = (const float*)(a.ws + WS_RW);
    const f32x4 rk4 = *(const f32x4*)(a.inp(I_RK) + l * 256 + h * 64 + 4 * (tid & 15));
    bf16* OB = (bf16*)(a.ws + WS_OB); const bf16* PROJ = (const bf16*)(a.ws + WS_PROJ);
    LAS float* RWT = (LAS float*)lds;
    LAS float* Y = (LAS float*)(lds + 49152);
    const int i = tid >> 3, jq = tid & 7;
    f32x4 pre[6];
#define RW_LOAD(tile) do { _Pragma("unroll") for (int k = 0; k < 6; ++k) { const int idx = tid + NTHREADS * k; \
        if (idx < TT * 96) { const int t = idx / 96, rem = idx % 96, sec = rem >> 4, c4 = rem & 15; \
            pre[k] = *(const f32x4*)(RW + (size_t)(mbase + (tile) * TT + t) * 1536 + sec * 256 + h * 64 + 4 * c4); } } } while (0)
#define RW_STORE() do { _Pragma("unroll") for (int k = 0; k < 6; ++k) { const int idx = tid + NTHREADS * k; \
        if (idx < TT * 96) *(LAS f32x4*)(RWT + idx * 4) = pre[k]; } } while (0)
    const int ntile = T / TT;
    const int gt_t = tid >> 4, gt_q = tid & 15;
    f32x4 gn_w = (f32x4){0.f, 0.f, 0.f, 0.f}, gn_b = gn_w, gpre = gn_w;
    if (MODE == 0) { gn_w = *(const f32x4*)(a.inp(I_GNW) + l * 256 + h * 64 + 4 * gt_q); gn_b = *(const f32x4*)(a.inp(I_GNB) + l * 256 + h * 64 + 4 * gt_q); }
    RW_LOAD(0);
    __syncthreads();
    RW_STORE();
    __syncthreads();
    for (int tile = 0; tile < ntile; ++tile) {
        if (tile + 1 < ntile) RW_LOAD(tile + 1);
        if (MODE == 0 && gt_t < TT) gpre = ldp4(PROJ + (size_t)(mbase + tile * TT + gt_t) * DIN + OFF_G + 512 + h * 64 + 4 * gt_q);
        {
            RwOps oa, ob;
            rw_load_ops<MODE>(oa, RWT, i, jq);
            for (int t = 0; t < TT; t += 2) {
                rw_load_ops<MODE>(ob, RWT + (t + 1) * 384, i, jq);
                rw_step<MODE>(oa, S, Pm, Y + t * 64 + i, jq);
                rw_load_ops<MODE>(oa, RWT + (t + 2) * 384, i, jq);
                rw_step<MODE>(ob, S, Pm, Y + (t + 1) * 64 + i, jq);
            }
        }
        __syncthreads();
        if (MODE == 0) {
            const int t = tid >> 4, q = tid & 15;
            if (t < TT) {
                const f32x4 yv = *(const LAS f32x4*)(Y + t * 64 + 4 * q);
                const float mean = red16((yv.x + yv.y) + (yv.z + yv.w)) * (1.f / 64.f);
                const f32x4 dv = yv - mean;
                const float rs = rsqrtf(red16((dv.x * dv.x + dv.y * dv.y) + (dv.z * dv.z + dv.w * dv.w)) * (1.f / 64.f) + 64.0f * 1e-5f);
                const int m = mbase + tile * TT + t;
                const f32x4 gw = gn_w, gb = gn_b;
                const f32x4 vv = *(const LAS f32x4*)(RWT + t * 384 + 192 + 4 * q);
                const f32x4 r4 = *(const LAS f32x4*)(RWT + t * 384 + 4 * q), k4 = *(const LAS f32x4*)(RWT + t * 384 + 128 + 4 * q);
                const float bon = red16((r4.x * k4.x * rk4.x + r4.y * k4.y * rk4.y) + (r4.z * k4.z * rk4.z + r4.w * k4.w * rk4.w));
                const f32x4 o = dv * rs * gw + gb + bon * vv;
                const f32x4 gt = gpre;
                u32x2 ow; ow.x = pk2(o.x * siluf_(gt.x), o.y * siluf_(gt.y)); ow.y = pk2(o.z * siluf_(gt.z), o.w * siluf_(gt.w));
                *(u32x2*)(OB + (size_t)m * DM + 512 + h * 64 + 4 * q) = ow;
            }
            __syncthreads();
        }
        if (tile + 1 < ntile) { RW_STORE(); }
        __syncthreads();
    }
#undef RW_LOAD
#undef RW_STORE
#pragma unroll
    for (int k = 0; k < 4; ++k) { S8[2 * k] = S[k].x; S8[2 * k + 1] = S[k].y; P8[2 * k] = Pm[k].x; P8[2 * k + 1] = Pm[k].y; }
}
__device__ __forceinline__ void st8(float* dst, const float (&S)[8]) { *(f32x4*)dst = (f32x4){S[0], S[1], S[2], S[3]}; *(f32x4*)(dst + 4) = (f32x4){S[4], S[5], S[6], S[7]}; }
__device__ __forceinline__ void ld8(const float* src, float (&S)[8]) { const f32x4 s0 = *(const f32x4*)src, s1 = *(const f32x4*)(src + 4);
    S[0] = s0.x; S[1] = s0.y; S[2] = s0.z; S[3] = s0.w; S[4] = s1.x; S[5] = s1.y; S[6] = s1.z; S[7] = s1.w; }
__device__ __forceinline__ void rwkv_sample_unit(const Ctx& a, int l, int b, int h, LAS unsigned char* lds, int tid) {
    OPAQUE(tid);
    const int i = tid >> 3, jq = tid & 7;
    float S[8], D[8];
    ld8(a.inp(I_SWKV) + (((size_t)(l * DB + b) * 4 + h) * 64 + i) * 64 + 8 * jq, S);
    rwkv_core<0, 8>(a, l, h, NP + b * DS, DS, S, D, lds, tid);
    st8(a.out + OUT_WKV_S + (((size_t)(l * DB + b) * 4 + h) * 64 + i) * 64 + 8 * jq, S);
}
__device__ __forceinline__ void rwkv_prompt_unitA(const Ctx& a, int l, int u, LAS unsigned char* lds, int tid) {
    OPAQUE(tid);
    const int c = u & 7, h = (u >> 3) & 3, s = u >> 5;
    if (c == 7) return;
    const int i = tid >> 3, jq = tid & 7;
    float* pz = (float*)(a.ws + WS_PZ) + ((size_t)((s * 4 + h) * 8 + c) * 2) * 4096 + i * 64 + 8 * jq;
    float S[8], Pm[8];
#pragma unroll
    for (int e = 0; e < 8; ++e) { S[e] = 0.f; Pm[e] = (8 * jq + e == i) ? 1.f : 0.f; }
    if (c == 0) { rwkv_core<0, 32>(a, l, h, s * SEQ, 256, S, Pm, lds, tid); st8(pz + 4096, S); }
    else { rwkv_core<1, 32>(a, l, h, s * SEQ + c * 256, 256, S, Pm, lds, tid); st8(pz, Pm); st8(pz + 4096, S); }
}
__device__ __forceinline__ void rwkv_prompt_unitB(const Ctx& a, int l, int u, LAS unsigned char* lds, int tid) {
    OPAQUE(tid);
    const int c = 7 - (u >> 5), sh = u & 31, s = sh >> 2, h = sh & 3;
    const int i = tid >> 3, jq = tid & 7;
    const float* pzb = (const float*)(a.ws + WS_PZ) + ((size_t)(sh * 8) * 2) * 4096;
    LAS float* SL = (LAS float*)lds;
    LAS float* PL = (LAS float*)(lds + 17408);
    float S[8], Z[8];
    ld8(pzb + 4096 + i * 64 + 8 * jq, S);
    {
        f32x4 pp[6][2]; float ZZ[6][8];
#pragma unroll
        for (int cp = 1; cp <= 6; ++cp) if (cp < c) { const float* pg = pzb + (size_t)cp * 8192;
            pp[cp - 1][0] = *(const f32x4*)(pg + tid * 4); pp[cp - 1][1] = *(const f32x4*)(pg + (tid + NTHREADS) * 4); ld8(pg + 4096 + i * 64 + 8 * jq, ZZ[cp - 1]); }
        __syncthreads();
#pragma unroll
        for (int cp = 1; cp <= 6; ++cp) if (cp < c) { *(LAS f32x4*)(PL + (cp - 1) * 4096 + tid * 4) = pp[cp - 1][0]; *(LAS f32x4*)(PL + (cp - 1) * 4096 + (tid + NTHREADS) * 4) = pp[cp - 1][1]; }
#pragma unroll
        for (int cp = 1; cp <= 6; ++cp) if (cp < c) {
            __syncthreads();
            *(LAS f32x4*)(SL + i * 68 + 8 * jq) = (f32x4){S[0], S[1], S[2], S[3]}; *(LAS f32x4*)(SL + i * 68 + 8 * jq + 4) = (f32x4){S[4], S[5], S[6], S[7]};
            __syncthreads();
            const LAS float* PLc = PL + (cp - 1) * 4096;
#pragma unroll
            for (int e = 0; e < 8; ++e) Z[e] = ZZ[cp - 1][e];
#pragma unroll 4
            for (int k4 = 0; k4 < 16; ++k4) {
                const f32x4 sv = *(const LAS f32x4*)(SL + i * 68 + 4 * k4);
#pragma unroll
                for (int kk = 0; kk < 4; ++kk) { const f32x4 q0 = *(const LAS f32x4*)(PLc + (4 * k4 + kk) * 64 + 8 * jq), q1 = *(const LAS f32x4*)(PLc + (4 * k4 + kk) * 64 + 8 * jq + 4);
                    const float x = sv[kk];
                    Z[0] += x * q0.x; Z[1] += x * q0.y; Z[2] += x * q0.z; Z[3] += x * q0.w; Z[4] += x * q1.x; Z[5] += x * q1.y; Z[6] += x * q1.z; Z[7] += x * q1.w; }
            }
#pragma unroll
            for (int e = 0; e < 8; ++e) S[e] = Z[e];
        }
    }
    rwkv_core<0, 32>(a, l, h, s * SEQ + c * 256, 256, S, Z, lds, tid);
    if (c == 7) st8(a.out + OUT_WKV_P + (((size_t)(l * 8 + s) * 4 + h) * 64 + i) * 64 + 8 * jq, S);
}

__device__ __forceinline__ void lru_pass2_wave(const Ctx& a, int l, int wi, int lane) {
    OPAQUE(lane);
    const int q = wi & 3, ch = (wi >> 2) & 31, s = wi >> 7;
    const int o = q * 64 + lane;
    const float* LA = (const float*)(a.ws + WS_LA); const float* LB = (const float*)(a.ws + WS_LB);
    const float* LP = (const float*)(a.ws + WS_LP); const float* LE = (const float*)(a.ws + WS_LE);
    bf16* OB = (bf16*)(a.ws + WS_OB); const bf16* PROJ = (const bf16*)(a.ws + WS_PROJ);
    float h = 0.f;
#pragma unroll 8
    for (int c = 0; c < ch; ++c) h = LP[(size_t)(s * 32 + c) * 256 + o] * h + LE[(size_t)(s * 32 + c) * 256 + o];
    const size_t m0 = (size_t)s * SEQ + ch * 64;
#pragma unroll
    for (int i0 = 0; i0 < 64; i0 += 32) {
        float av[32], bv[32], gv[32];
#pragma unroll
        for (int i = 0; i < 32; ++i) { av[i] = LA[(m0 + i0 + i) * 256 + o]; bv[i] = LB[(m0 + i0 + i) * 256 + o]; gv[i] = ldp1(PROJ + (m0 + i0 + i) * DIN + OFF_G + 256 + o); }
#pragma unroll
        for (int i = 0; i < 32; ++i) { h = av[i] * h + bv[i]; OB[(m0 + i0 + i) * DM + 256 + o] = (bf16)f2bf(h * siluf_(gv[i])); }
    }
    if (ch == 31) a.out[OUT_LRU_P + (size_t)(l * 8 + s) * 256 + o] = h;
}

__device__ __forceinline__ float gelu_tanh(float y) { return 0.5f * y * (1.0f + tanhf_(0.7978845608028654f * (y + 0.044715f * y * y * y))); }
__device__ __forceinline__ void s5_pass2_wave(const Ctx& a, int l, bool smp, int wi, LAS unsigned char* wlds, int lane) {
    OPAQUE(lane);
    const bf16* PROJ = (const bf16*)(a.ws + WS_PROJ);
    bf16* ZB = (bf16*)(a.ws + WS_ZB);
    LAS float* HR = (LAS float*)wlds;
    LAS float* HI = HR + 32 * 68;
    int g, mbase, T, ck = 0, sq;
    if (smp) { g = wi & 15; sq = wi >> 4; mbase = NP + sq * DS; T = DS; }
    else { ck = wi & 15; g = (wi >> 4) & 15; sq = wi >> 8; mbase = sq * SEQ + ck * 128; T = 128; }
    S5Par P; s5_params(a, l, g, lane, P);
    float hr, hi;
    if (smp) { const f32x2 v = *(const f32x2*)(a.inp(I_SSSM) + (((size_t)(l * DB + sq) * 16 + g) * 64 + lane) * 2); hr = v.x; hi = v.y; }
    else {
        float pr = P.ab_re, pi = P.ab_im;
#pragma unroll
        for (int k = 0; k < 7; ++k) { const float nr = pr * pr - pi * pi, ni = 2.0f * pr * pi; pr = nr; pi = ni; }
        hr = 0.f; hi = 0.f;
        const f32x2* E = (const f32x2*)(a.ws + WS_S5E) + ((size_t)(sq * 16 + g) * 16) * 64 + lane;
        for (int c = 0; c < ck; ++c) { const f32x2 e = E[(size_t)c * 64]; const float nr = pr * hr - pi * hi + e.x, ni = pr * hi + pi * hr + e.y; hr = nr; hi = ni; }
    }
    const int cc = lane & 15, kq = lane >> 4;
    bf16x8 cf[4];
    {
        const float* crp = a.inp(I_CRE) + ((size_t)(l * 16 + g) * 16 + cc) * 64 + 8 * kq; const float* cip = a.inp(I_CIM) + ((size_t)(l * 16 + g) * 16 + cc) * 64 + 8 * kq;
#pragma unroll
        for (int ks = 0; ks < 4; ++ks) { const float* p = (ks < 2 ? crp : cip) + 32 * (ks & 1); const float sg = ks < 2 ? 1.f : -1.f;
            const f32x4 x0 = *(const f32x4*)p, x1 = *(const f32x4*)(p + 4);
            u32x4 w; w.x = pk2(sg * x0.x, sg * x0.y); w.y = pk2(sg * x0.z, sg * x0.w); w.z = pk2(sg * x1.x, sg * x1.y); w.w = pk2(sg * x1.z, sg * x1.w); cf[ks] = __builtin_bit_cast(bf16x8, w); }
    }
    const f32x4 dd4 = *(const f32x4*)(a.inp(I_S5D) + l * 256 + g * 16 + 4 * kq);
    for (int t0 = 0; t0 < T; t0 += 32) {
        const int nt = (T - t0) < 32 ? (T - t0) : 32;
        s5_bu_block(P, PROJ, (size_t)(mbase + t0), nt, g, HR, HI, lane);
        for (int t = 0; t < nt; ++t) { const float br = HR[t * 68 + lane], bi = HI[t * 68 + lane];
            const float nr = P.ab_re * hr - P.ab_im * hi + br, ni = P.ab_re * hi + P.ab_im * hr + bi; hr = nr; hi = ni;
            HR[t * 68 + lane] = hr; HI[t * 68 + lane] = hi; }
        asm volatile("s_waitcnt lgkmcnt(0)" ::: "memory");
#pragma unroll
        for (int tt = 0; tt < 2; ++tt) {
            if (tt * 16 < nt) {
                f32x4 acc = (f32x4){0.f, 0.f, 0.f, 0.f};
#pragma unroll
                for (int ks = 0; ks < 4; ++ks) { const LAS float* hp = (ks < 2 ? HR : HI) + (tt * 16 + cc) * 68 + 32 * (ks & 1) + 8 * kq;
                    const f32x4 x0 = *(const LAS f32x4*)hp, x1 = *(const LAS f32x4*)(hp + 4);
                    u32x4 w; w.x = pk2(x0.x, x0.y); w.y = pk2(x0.z, x0.w); w.z = pk2(x1.x, x1.y); w.w = pk2(x1.z, x1.w);
                    acc = __builtin_amdgcn_mfma_f32_16x16x32_bf16(cf[ks], __builtin_bit_cast(bf16x8, w), acc, 0, 0, 0); }
                const int t = tt * 16 + cc;
                if (t < nt) { const size_t m = (size_t)(mbase + t0 + t);
                    const f32x4 u4 = ldp4(PROJ + m * DIN + OFF_D + g * 16 + 4 * kq);
                    u32x2 zz; zz.x = pk2(gelu_tanh(acc.x + dd4.x * u4.x), gelu_tanh(acc.y + dd4.y * u4.y)); zz.y = pk2(gelu_tanh(acc.z + dd4.z * u4.z), gelu_tanh(acc.w + dd4.w * u4.w));
                    *(u32x2*)(ZB + m * 256 + g * 16 + 4 * kq) = zz; }
            }
        }
        asm volatile("s_waitcnt lgkmcnt(0)" ::: "memory");
    }
    if (smp) *(f32x2*)(a.out + OUT_SSM_S + (((size_t)(l * DB + sq) * 16 + g) * 64 + lane) * 2) = (f32x2){hr, hi};
    else if (ck == 15) *(f32x2*)(a.out + OUT_SSM_P + (((size_t)(l * 8 + sq) * 16 + g) * 64 + lane) * 2) = (f32x2){hr, hi};
}

__device__ __forceinline__ bf16x8 pack8(const f32x16& p, int s) {
    u32x4 w; w.x = pk2(p[8 * s + 0], p[8 * s + 1]); w.y = pk2(p[8 * s + 2], p[8 * s + 3]); w.z = pk2(p[8 * s + 4], p[8 * s + 5]); w.w = pk2(p[8 * s + 6], p[8 * s + 7]);
    return __builtin_bit_cast(bf16x8, w);
}
__device__ __forceinline__ void attn_load4(const bf16* F, size_t fragbase, bf16x8 (&f)[4]) {
#pragma unroll
    for (int cs = 0; cs < 4; ++cs) f[cs] = *(const bf16x8*)(F + fragbase + cs * 512);
}
__device__ __forceinline__ void attn_tile(const bf16x8 (&qf)[2][2], const bf16x8 (&kf)[4], const bf16x8 (&vf)[4], f32x16 (&o)[2][2], float (&mrun)[2], float (&lrun)[2], bool diag, int r, int hh) {
    bf16x8 pf[2][2];
#pragma unroll
    for (int c = 0; c < 2; ++c) {
        f32x16 st;
#pragma unroll
        for (int e = 0; e < 16; ++e) st[e] = 0.f;
        st = __builtin_amdgcn_mfma_f32_32x32x16_bf16(kf[c * 2 + 0], qf[c][0], st, 0, 0, 0);
        st = __builtin_amdgcn_mfma_f32_32x32x16_bf16(kf[c * 2 + 1], qf[c][1], st, 0, 0, 0);
        if (diag) {
#pragma unroll
            for (int e = 0; e < 16; ++e) { const int key = (e & 3) + 8 * (e >> 2) + 4 * hh; if (key > r) st[e] = -1e30f; }
        }
        float mx = st[0];
#pragma unroll
        for (int e = 1; e < 16; ++e) mx = fmaxf(mx, st[e]);
        mx = fmaxf(mx, __shfl_xor(mx, 32));
        const bool upd = mx > mrun[c] + 8.0f;
        if (__any(upd)) {
            const float mnew = upd ? mx : mrun[c];
            const float corr = __builtin_amdgcn_exp2f(mrun[c] - mnew);
            lrun[c] *= corr; mrun[c] = mnew;
#pragma unroll
            for (int tl = 0; tl < 2; ++tl)
#pragma unroll
                for (int e = 0; e < 16; ++e) o[c][tl][e] *= corr;
        }
        float ps = 0.f;
        const float mcur = mrun[c];
#pragma unroll
        for (int e = 0; e < 16; ++e) { st[e] = __builtin_amdgcn_exp2f(st[e] - mcur); ps += st[e]; }
        lrun[c] += ps;
        pf[c][0] = pack8(st, 0); pf[c][1] = pack8(st, 1);
    }
#pragma unroll
    for (int c = 0; c < 2; ++c)
#pragma unroll
        for (int tl = 0; tl < 2; ++tl) {
            o[c][tl] = __builtin_amdgcn_mfma_f32_32x32x16_bf16(vf[tl * 2 + 0], pf[c][0], o[c][tl], 0, 0, 0);
            o[c][tl] = __builtin_amdgcn_mfma_f32_32x32x16_bf16(vf[tl * 2 + 1], pf[c][1], o[c][tl], 0, 0, 0);
        }
}
__device__ __forceinline__ void attn_prompt_wave(const Ctx& a, int l, int b, int h, int qt, float lam, int lane) {
    OPAQUE(lane);
    const bf16* QB = (const bf16*)(a.ws + WS_QB); const bf16* KF = (const bf16*)(a.ws + WS_KB); const bf16* VF = (const bf16*)(a.ws + WS_VT);
    bf16* OB = (bf16*)(a.ws + WS_OB); const bf16* PROJ = (const bf16*)(a.ws + WS_PROJ);
    const int r = lane & 31, hh = lane >> 5;
    const size_t mq = (size_t)b * SEQ + qt * 32 + r;
    bf16x8 qf[2][2];
#pragma unroll
    for (int c = 0; c < 2; ++c)
#pragma unroll
        for (int s = 0; s < 2; ++s) qf[c][s] = *(const bf16x8*)(QB + mq * 256 + h * 64 + c * 32 + 16 * s + 8 * hh);
    f32x16 o[2][2];
#pragma unroll
    for (int c = 0; c < 2; ++c)
#pragma unroll
        for (int tl = 0; tl < 2; ++tl)
#pragma unroll
            for (int e = 0; e < 16; ++e) o[c][tl][e] = 0.f;
    float mrun[2] = {-1e30f, -1e30f}, lrun[2] = {0.f, 0.f};
    const size_t fb0 = ((size_t)((b * 4 + h) * 64) * 4) * 512 + lane * 8;
    bf16x8 kA[4], kB[4], vv[4];
    attn_load4(KF, fb0, kA);
    int kt = 0;
    for (; kt + 1 <= qt; kt += 2) {
        attn_load4(VF, fb0 + (size_t)kt * 2048, vv);
        attn_load4(KF, fb0 + (size_t)(kt + 1) * 2048, kB);
        attn_tile(qf, kA, vv, o, mrun, lrun, false, r, hh);
        attn_load4(VF, fb0 + (size_t)(kt + 1) * 2048, vv);
        if (kt + 2 <= qt) attn_load4(KF, fb0 + (size_t)(kt + 2) * 2048, kA);
        attn_tile(qf, kB, vv, o, mrun, lrun, kt + 1 == qt, r, hh);
    }
    if (kt == qt) { attn_load4(VF, fb0 + (size_t)kt * 2048, vv); attn_tile(qf, kA, vv, o, mrun, lrun, true, r, hh); }
    const float l0 = lrun[0] + __shfl_xor(lrun[0], 32), l1 = lrun[1] + __shfl_xor(lrun[1], 32);
    const float i0 = 1.0f / l0, i1 = lam / l1;
    float ss = 0.f;
    f32x16 res[2];
#pragma unroll
    for (int tl = 0; tl < 2; ++tl)
#pragma unroll
        for (int e = 0; e < 16; ++e) { const float v = o[0][tl][e] * i0 - o[1][tl][e] * i1; res[tl][e] = v; ss += v * v; }
    ss += __shfl_xor(ss, 32);
    const float rs = rsqrtf(ss * (1.f / 64.f) + NORM_EPS) * (1.0f - lam_init_of(l));
    const float* sw = a.inp(I_SUBLN) + l * 64;
#pragma unroll
    for (int tl = 0; tl < 2; ++tl)
#pragma unroll
        for (int g4 = 0; g4 < 4; ++g4) { const int vd = 32 * tl + 8 * g4 + 4 * hh;
            const f32x4 w4 = *(const f32x4*)(sw + vd);
            f32x4 ov; ov.x = res[tl][4 * g4 + 0] * rs * w4.x; ov.y = res[tl][4 * g4 + 1] * rs * w4.y; ov.z = res[tl][4 * g4 + 2] * rs * w4.z; ov.w = res[tl][4 * g4 + 3] * rs * w4.w;
            const f32x4 gt = ldp4(PROJ + mq * DIN + OFF_G + h * 64 + vd);
            u32x2 ow; ow.x = pk2(ov.x * siluf_(gt.x), ov.y * siluf_(gt.y)); ow.y = pk2(ov.z * siluf_(gt.z), ov.w * siluf_(gt.w));
            *(u32x2*)(OB + mq * DM + h * 64 + vd) = ow; }
}

struct SmpK { f32x4 k[8]; };
__device__ __forceinline__ void smp_load(SmpK& d, const float* kp) {
#pragma unroll
    for (int t = 0; t < 8; ++t) d.k[t] = __builtin_nontemporal_load((const f32x4*)(kp + (size_t)t * 1024));
}
__device__ __forceinline__ void smp_group(const SmpK& d, const SmpK& dv, const f32x4 (&q)[8], f32x4 (&O)[4], float& M, float& Lsum, int nstep, bool isnew, int kk, int g, int lane) {
    float sc[8];
#pragma unroll
    for (int t = 0; t < 8; ++t) {
        float p[8];
#pragma unroll
        for (int i = 0; i < 8; ++i) p[i] = (d.k[t].x * q[i].x + d.k[t].y * q[i].y) + (d.k[t].z * q[i].z + d.k[t].w * q[i].w);
        float n4[4];
#pragma unroll
        for (int k = 0; k < 4; ++k) { const float keep = (g & 4) ? p[4 + k] : p[k], send = (g & 4) ? p[k] : p[4 + k]; n4[k] = keep + dpp_mov<0x141>(send); }
        float n2[2];
#pragma unroll
        for (int k = 0; k < 2; ++k) { const float keep = (g & 2) ? n4[2 + k] : n4[k], send = (g & 2) ? n4[k] : n4[2 + k]; n2[k] = keep + dpp_mov<0x4E>(send); }
        const float keep = (g & 1) ? n2[1] : n2[0], send = (g & 1) ? n2[0] : n2[1];
        float sv = keep + dpp_mov<0xB1>(send);
        if (t >= nstep || (isnew && (4 * t + kk) > g)) sv = -1e30f;
        sc[t] = sv;
    }
    float mx = fmaxf(fmaxf(fmaxf(sc[0], sc[1]), fmaxf(sc[2], sc[3])), fmaxf(fmaxf(sc[4], sc[5]), fmaxf(sc[6], sc[7])));
    mx = fmaxf(mx, __shfl_xor(mx, 16)); mx = fmaxf(mx, __shfl_xor(mx, 32));
    const float Mnew = fmaxf(M, mx);
    const float corr = __builtin_amdgcn_exp2f(M - Mnew);
    float ps = 0.f;
#pragma unroll
    for (int t = 0; t < 8; ++t) { sc[t] = __builtin_amdgcn_exp2f(sc[t] - Mnew); ps += sc[t]; }
    Lsum = Lsum * corr + ps; M = Mnew;
#pragma unroll
    for (int rg = 0; rg < 4; ++rg) { const float cr = __shfl(corr, (lane & 48) | (4 * kk + rg));
        O[0][rg] *= cr; O[1][rg] *= cr; O[2][rg] *= cr; O[3][rg] *= cr; }
    u32x4 pw; pw.x = pk2(sc[0], sc[1]); pw.y = pk2(sc[2], sc[3]); pw.z = pk2(sc[4], sc[5]); pw.w = pk2(sc[6], sc[7]);
    const bf16x8 pa = __builtin_bit_cast(bf16x8, pw);
#pragma unroll
    for (int e = 0; e < 4; ++e) {
        u32x4 vw; vw.x = pk2(dv.k[0][e], dv.k[1][e]); vw.y = pk2(dv.k[2][e], dv.k[3][e]); vw.z = pk2(dv.k[4][e], dv.k[5][e]); vw.w = pk2(dv.k[6][e], dv.k[7][e]);
        O[e] = __builtin_amdgcn_mfma_f32_16x16x32_bf16(pa, __builtin_bit_cast(bf16x8, vw), O[e], 0, 0, 0);
    }
}
__device__ __forceinline__ void attn_sample_wave(const Ctx& a, int l, int wi, int lane) {
    OPAQUE(lane);
    const int h = wi & 3, sp = (wi >> 2) % NSPLIT, b = (wi >> 2) / NSPLIT;
    const bf16* PROJ = (const bf16*)(a.ws + WS_PROJ);
    const int kk = lane >> 4, dq = lane & 15, g = lane & 7;
    f32x4 q[8];
#pragma unroll
    for (int i = 0; i < 8; ++i) { q[i] = ldp4(PROJ + (size_t)(NP + b * 8 + i) * DIN + OFF_AQ + h * 64 + 4 * dq); q[i] *= QSCALE; }
    const bool isnew = (sp == NSPLIT - 1);
    float M = -1e30f, Lsum = 0.f;
    f32x4 O[4];
#pragma unroll
    for (int e = 0; e < 4; ++e) O[e] = (f32x4){0.f, 0.f, 0.f, 0.f};
    if (isnew) {
        SmpK d, dv;
        const bf16* kp = PROJ + (size_t)(NP + b * 8 + kk) * DIN + OFF_AK + h * 64 + 4 * dq;
#pragma unroll
        for (int t = 0; t < 8; ++t) { if (t < 2) { d.k[t] = ldp4(kp + (size_t)t * 4 * DIN); dv.k[t] = ldp4(kp + (size_t)t * 4 * DIN + (OFF_AV - OFF_AK)); }
            else { d.k[t] = (f32x4){0.f, 0.f, 0.f, 0.f}; dv.k[t] = (f32x4){0.f, 0.f, 0.f, 0.f}; } }
        smp_group(d, dv, q, O, M, Lsum, 2, true, kk, g, lane);
    } else {
        const int* pt = (const int*)a.inp(I_PT) + b * NPAGES + sp * 2;
        const int pg0 = pt[0], pg1 = pt[1];
        const size_t lo = (size_t)(kk * 4 + h) * 64 + 4 * dq;
        const float* kb0 = a.inp(I_CK) + ((size_t)l * NPOOL + pg0) * 32768 + lo; const float* kb1 = a.inp(I_CK) + ((size_t)l * NPOOL + pg1) * 32768 + lo;
        const float* vb0 = a.inp(I_CV) + ((size_t)l * NPOOL + pg0) * 32768 + lo; const float* vb1 = a.inp(I_CV) + ((size_t)l * NPOOL + pg1) * 32768 + lo;
        SmpK dA, dB, dV;
        smp_load(dA, kb0);
#pragma unroll
        for (int gi = 0; gi < 8; gi += 2) {
            smp_load(dV, ((gi >> 2) ? vb1 : vb0) + (size_t)(gi & 3) * 8192);
            { const int gn = gi + 1; smp_load(dB, ((gn >> 2) ? kb1 : kb0) + (size_t)(gn & 3) * 8192); }
            smp_group(dA, dV, q, O, M, Lsum, 8, false, kk, g, lane);
            { const int gn = gi + 1; smp_load(dV, ((gn >> 2) ? vb1 : vb0) + (size_t)(gn & 3) * 8192); }
            if (gi + 2 < 8) { const int gn = gi + 2; smp_load(dA, ((gn >> 2) ? kb1 : kb0) + (size_t)(gn & 3) * 8192); }
            smp_group(dB, dV, q, O, M, Lsum, 8, false, kk, g, lane);
        }
    }
    float Lall = Lsum + __shfl_xor(Lsum, 16); Lall += __shfl_xor(Lall, 32);
    float* part = (float*)(a.ws + WS_PART) + ((size_t)(b * 4 + h) * NSPLIT + sp) * PART_FLOATS;
    if (kk == 0) { part[dq] = M; part[16 + dq] = Lall; }
#pragma unroll
    for (int rg = 0; rg < 4; ++rg) *(f32x4*)(part + 32 + (4 * kk + rg) * 64 + 4 * dq) = (f32x4){O[0][rg], O[1][rg], O[2][rg], O[3][rg]};
}

__device__ __forceinline__ void attn_sample_merge_wave(const Ctx& a, int l, int wi, float lam, int lane) {
    OPAQUE(lane);
    const int h = wi & 3, q = wi >> 2, b = q >> 3, i = q & 7;
    const size_t m = (size_t)NP + q;
    const float* pb = (const float*)(a.ws + WS_PART) + ((size_t)(b * 4 + h) * NSPLIT) * PART_FLOATS;
    float oc[2];
#pragma unroll
    for (int c = 0; c < 2; ++c) { const int j = c * 8 + i;
        float ms[NSPLIT], M = -1e30f;
#pragma unroll
        for (int s = 0; s < NSPLIT; ++s) { ms[s] = pb[s * PART_FLOATS + j]; M = fmaxf(M, ms[s]); }
        float L = 0.f, O = 0.f;
#pragma unroll
        for (int s = 0; s < NSPLIT; ++s) { const float w = __builtin_amdgcn_exp2f(ms[s] - M); L += pb[s * PART_FLOATS + 16 + j] * w; O += pb[s * PART_FLOATS + 32 + j * 64 + lane] * w; }
        oc[c] = O / L; }
    const float v = oc[0] - lam * oc[1];
    const float ss = wave_sum(v * v);
    const float ov = v * rsqrtf(ss * (1.f / 64.f) + NORM_EPS) * a.inp(I_SUBLN)[l * 64 + lane] * (1.0f - lam_init_of(l));
    const float gt = ldp1((const bf16*)(a.ws + WS_PROJ) + m * DIN + OFF_G + h * 64 + lane);
    ((bf16*)(a.ws + WS_OB))[m * DM + h * 64 + lane] = (bf16)f2bf(ov * siluf_(gt));
}

__device__ __forceinline__ void glu_wave(const Ctx& a, int l, int unit, int wave, int lane) {
    OPAQUE(lane);
    const bf16* ZB = (const bf16*)(a.ws + WS_ZB); const bf16* WT = (const bf16*)(a.ws + WS_WGLU) + (size_t)l * 65536;
    const bf16* PROJ = (const bf16*)(a.ws + WS_PROJ); bf16* OB = (bf16*)(a.ws + WS_OB);
    const int r = lane & 31, hh = lane >> 5, n0 = wave * 32;
    const size_t m = (size_t)unit * 32 + r;
    const bf16* zp = ZB + m * 256 + 8 * hh; const bf16* wp = WT + (size_t)(n0 + r) * 256 + 8 * hh;
    f32x16 acc;
#pragma unroll
    for (int e = 0; e < 16; ++e) acc[e] = 0.f;
#pragma unroll
    for (int s0 = 0; s0 < 16; s0 += 8) {
        bf16x8 wa[8], zb[8];
#pragma unroll
        for (int s1 = 0; s1 < 8; ++s1) { wa[s1] = *(const bf16x8*)(wp + 16 * (s0 + s1)); zb[s1] = *(const bf16x8*)(zp + 16 * (s0 + s1)); }
#pragma unroll
        for (int s1 = 0; s1 < 8; ++s1) acc = __builtin_amdgcn_mfma_f32_32x32x16_bf16(wa[s1], zb[s1], acc, 0, 0, 0);
    }
    const float* bg = a.inp(I_BGLU) + l * 256;
#pragma unroll
    for (int g4 = 0; g4 < 4; ++g4) { const int n = n0 + 8 * g4 + 4 * hh;
        const f32x4 bb = *(const f32x4*)(bg + n), gt = ldp4(PROJ + m * DIN + OFF_G + 768 + n);
        const u32x2 zz = *(const u32x2*)(ZB + m * 256 + n);
        const float z0 = __builtin_bit_cast(float, zz.x << 16), z1 = __builtin_bit_cast(float, zz.x & 0xffff0000u), z2 = __builtin_bit_cast(float, zz.y << 16), z3 = __builtin_bit_cast(float, zz.y & 0xffff0000u);
        u32x2 o; o.x = pk2(z0 * sigmoidf_(acc[4 * g4 + 0] + bb.x) * siluf_(gt.x), z1 * sigmoidf_(acc[4 * g4 + 1] + bb.y) * siluf_(gt.y));
        o.y = pk2(z2 * sigmoidf_(acc[4 * g4 + 2] + bb.z) * siluf_(gt.z), z3 * sigmoidf_(acc[4 * g4 + 3] + bb.w) * siluf_(gt.w));
        *(u32x2*)(OB + m * DM + 768 + n) = o; }
}

constexpr int MM_RWA = 256;
constexpr int MM_RWB = 224;
constexpr int MM_AP = 256;
constexpr int MM_AS = (DB * NSPLIT * 4) / 8;
constexpr int MM_S5P = 256;
constexpr int MM_S5S = 256;
constexpr int MM_LRU = 128;
constexpr int MM_RWS = DB * 4;
constexpr int MM_MRG = 512;
constexpr int MM_GLU = MTOK / 32;
__device__ __forceinline__ void ph_mixA(const Ctx& a, int lq, int MMSK, LAS unsigned char* lds, volatile LAS unsigned* MISC, int tid, int lane, int wave) {
    const int l = lq & 1;
    unsigned* qctr = (unsigned*)(a.ws + WS_CTL) + CW_QUEUE + 1024 * lq;
    const float lam = compute_lam(a, l, lane);
    int u;
#ifndef STREAM_DIV
#define STREAM_DIV 4
#endif
    const bool streamer = ((blockIdx.x >> 3) % STREAM_DIV) == 0;
#pragma unroll 1
    for (int pass = 0; pass < 2; ++pass) {
        if ((pass == 0) == streamer) { if ((MMSK >> 2) & 1) while ((u = grab_unit(qctr + 2 * 64, MISC, tid)) < MM_AS) attn_sample_wave(a, l, u * 8 + wave, lane); }
        if (pass == 0) {
            if ((MMSK >> 0) & 1) while ((u = grab_unit(qctr + 0 * 64, MISC, tid)) < MM_RWA) rwkv_prompt_unitA(a, l, u, lds, tid);
            if ((MMSK >> 1) & 1) while ((u = grab_unit(qctr + 1 * 64, MISC, tid)) < MM_AP) { const int bh = u & 31, qt = 8 * (7 - (u >> 5)) + wave; attn_prompt_wave(a, l, bh >> 2, bh & 3, qt, lam, lane); }
            if ((MMSK >> 3) & 1) while ((u = grab_unit(qctr + 3 * 64, MISC, tid)) < MM_S5P) s5_pass2_wave(a, l, false, u * 8 + wave, lds + wave * 17408, lane);
            if ((MMSK >> 4) & 1) while ((u = grab_unit(qctr + 4 * 64, MISC, tid)) < MM_S5S) s5_pass2_wave(a, l, true, u * 8 + wave, lds + wave * 17408, lane);
            if ((MMSK >> 5) & 1) while ((u = grab_unit(qctr + 5 * 64, MISC, tid)) < MM_LRU) lru_pass2_wave(a, l, u * 8 + wave, lane);
        }
    }
    __syncthreads();
}
__device__ __forceinline__ void ph_mixB(const Ctx& a, int lq, int MMSK, LAS unsigned char* lds, volatile LAS unsigned* MISC, int tid, int lane, int wave) {
    const int l = lq & 1;
    unsigned* qctr = (unsigned*)(a.ws + WS_CTL) + CW_QUEUE + 1024 * lq + 512;
    int u;
    if ((MMSK >> 0) & 1) while ((u = grab_unit(qctr + 0 * 64, MISC, tid)) < MM_RWB) rwkv_prompt_unitB(a, l, u, lds, tid);
    if ((MMSK >> 1) & 1) while ((u = grab_unit(qctr + 1 * 64, MISC, tid)) < MM_RWS) rwkv_sample_unit(a, l, u >> 2, u & 3, lds, tid);
    if ((MMSK >> 2) & 1) while ((u = grab_unit(qctr + 2 * 64, MISC, tid)) < MM_GLU) glu_wave(a, l, u, wave, lane);
    if ((MMSK >> 3) & 1) { const float lam = compute_lam(a, l, lane); while ((u = grab_unit(qctr + 3 * 64, MISC, tid)) < MM_MRG) attn_sample_merge_wave(a, l, u * 8 + wave, lam, lane); }
    __syncthreads();
}

__device__ __forceinline__ void ph_postnorm(const Ctx& a, int l, int lane, int wave) {
    OPAQUE(lane);
    const bf16* YP = (const bf16*)(a.ws + WS_YP);
    const float* xp = a.inp(I_XP);
    const float* xs = a.inp(I_XS) - (size_t)NP * DM;
    bf16* X1b = (bf16*)(a.ws + WS_X1);
    float* yp = a.out + OUT_Y_P;
    float* ys = a.out + OUT_Y_S - (size_t)NP * DM;
    bf16* H = (bf16*)(a.ws + WS_H);
    f32x4 gp[4], g2[4];
#pragma unroll
    for (int j = 0; j < 4; ++j) { gp[j] = ((const f32x4*)(a.inp(I_NPOST) + l * DM) + lane)[64 * j]; g2[j] = ((const f32x4*)(a.inp(I_NPRE) + DM) + lane)[64 * j]; }
    const int gw = blockIdx.x * NWAVES + wave, NGW = gridDim.x * NWAVES;
    for (int m0 = gw; m0 < MTOK; m0 += 2 * NGW) {
        const int m1 = m0 + NGW; const bool has1 = m1 < MTOK; const int mb = has1 ? m1 : m0;
        const bf16* ya = YP + (size_t)m0 * DM + 4 * lane; const bf16* yb = YP + (size_t)mb * DM + 4 * lane;
        const f32x4* xa = (const f32x4*)((m0 < NP ? xp : xs) + (size_t)m0 * DM) + lane; const f32x4* xb = (const f32x4*)((mb < NP ? xp : xs) + (size_t)mb * DM) + lane;
        f32x4 va[4], vb[4], wa[4], wb[4];
#pragma unroll
        for (int j = 0; j < 4; ++j) { va[j] = ldp4(ya + 256 * j); vb[j] = ldp4(yb + 256 * j);
            if (l == 0) { wa[j] = xa[64 * j]; wb[j] = xb[64 * j]; }
            else { wa[j] = ldp4(X1b + (size_t)m0 * DM + 4 * lane + 256 * j); wb[j] = ldp4(X1b + (size_t)mb * DM + 4 * lane + 256 * j); } }
        float sa = 0.f, sb = 0.f;
#pragma unroll
        for (int j = 0; j < 4; ++j) { sa += (va[j].x * va[j].x + va[j].y * va[j].y) + (va[j].z * va[j].z + va[j].w * va[j].w); sb += (vb[j].x * vb[j].x + vb[j].y * vb[j].y) + (vb[j].z * vb[j].z + vb[j].w * vb[j].w); }
        const float ra = rsqrtf(wave_sum_fast(sa) * (1.f / DM) + NORM_EPS), rb = rsqrtf(wave_sum_fast(sb) * (1.f / DM) + NORM_EPS);
        f32x4* oa = (f32x4*)((m0 < NP ? yp : ys) + (size_t)m0 * DM) + lane; f32x4* ob = (f32x4*)((mb < NP ? yp : ys) + (size_t)mb * DM) + lane;
        float ta = 0.f, tb = 0.f;
#pragma unroll
        for (int j = 0; j < 4; ++j) { va[j] = wa[j] + va[j] * ra * gp[j]; vb[j] = wb[j] + vb[j] * rb * gp[j];
            if (l == 0) { u32x2 o; o.x = pk2(va[j].x, va[j].y); o.y = pk2(va[j].z, va[j].w); *(u32x2*)(X1b + (size_t)m0 * DM + 4 * lane + 256 * j) = o;
                if (has1) { u32x2 p; p.x = pk2(vb[j].x, vb[j].y); p.y = pk2(vb[j].z, vb[j].w); *(u32x2*)(X1b + (size_t)mb * DM + 4 * lane + 256 * j) = p; } }
            else { __builtin_nontemporal_store(va[j], oa + 64 * j); if (has1) __builtin_nontemporal_store(vb[j], ob + 64 * j); }
            ta += (va[j].x * va[j].x + va[j].y * va[j].y) + (va[j].z * va[j].z + va[j].w * va[j].w); tb += (vb[j].x * vb[j].x + vb[j].y * vb[j].y) + (vb[j].z * vb[j].z + vb[j].w * vb[j].w); }
        if (l == 0) {
            const float qa = rsqrtf(wave_sum_fast(ta) * (1.f / DM) + NORM_EPS), qb = rsqrtf(wave_sum_fast(tb) * (1.f / DM) + NORM_EPS);
            u32x2* ha = (u32x2*)(H + (size_t)m0 * DM) + lane; u32x2* hb = (u32x2*)(H + (size_t)mb * DM) + lane;
#pragma unroll
            for (int j = 0; j < 4; ++j) { u32x2 o; o.x = pk2(va[j].x * qa * g2[j].x, va[j].y * qa * g2[j].y); o.y = pk2(va[j].z * qa * g2[j].z, va[j].w * qa * g2[j].w); ha[64 * j] = o;
                if (has1) { u32x2 p; p.x = pk2(vb[j].x * qb * g2[j].x, vb[j].y * qb * g2[j].y); p.y = pk2(vb[j].z * qb * g2[j].z, vb[j].w * qb * g2[j].w); hb[64 * j] = p; } }
        }
    }
}

constexpr int N_PHASES = 13;
#ifndef DUP_PHASE
#define DUP_PHASE -1
#endif
#ifndef DUP_MASK
#define DUP_MASK 0x7f
#endif
__global__ void __launch_bounds__(NTHREADS, 2) hymba_fwd(Args args) {
    extern __shared__ __attribute__((aligned(16))) unsigned char lds_raw[];
    LAS unsigned char* lds = (LAS unsigned char*)lds_raw;
    volatile LAS unsigned* MISC = (volatile LAS unsigned*)(lds + MISC_OFF);
    if (threadIdx.x < 64) MISC[threadIdx.x] = 0u;
    if (threadIdx.x < N_IN) *(LAS unsigned long long*)(lds + TAB_OFF + 8 * threadIdx.x) = (unsigned long long)args.in[threadIdx.x];
    Ctx ctx; ctx.out = args.out; ctx.ws = args.ws; ctx.tab = (const LAS unsigned*)(lds + TAB_OFF);
    const int wave_s = __builtin_amdgcn_readfirstlane(threadIdx.x >> 6);
#define TIDS() int tid = wave_s * 64 + lane_id_asm(); const int lane = tid & 63, wave = wave_s; (void)lane; (void)wave; Ctx cx = ctx; { GAS unsigned char* w_ = (GAS unsigned char*)ctx.ws; GAS float* o_ = (GAS float*)ctx.out; asm volatile("" : "+s"(w_), "+s"(o_)); cx.ws = (unsigned char*)w_; cx.out = (float*)o_; }
    __syncthreads();
    unsigned* ctl = (unsigned*)(args.ws + WS_CTL);
#if MK_PER_PHASE
#define GRID_BAR() do { } while (0)
#else
    XcdBarrier bar = xcd_barrier_post(ctl + CW_BAR, MISC);
#define GRID_BAR() xcd_barrier(bar, wave_s == 0 && lane_id_asm() == 0)
#endif
    const int lo = args.ph_lo, hi = args.ph_hi;
#define IN(k) (lo <= (k) && (k) < hi)
#define SEAM(k) do { if (IN(k) && IN((k) + 1)) GRID_BAR(); } while (0)
#define NREP(j) ((DUP_PHASE == (j)) ? 2 : 1)

    if (IN(0)) { TIDS(); ph_prologue(cx, lds, lane, wave); }
    SEAM(0);
    for (int l = 0; l < 2; ++l) {
        const int p0 = 1 + 6 * l;
        if (IN(p0))
#pragma unroll 1
          for (int rp = 0; rp < NREP(1); ++rp) {
            if (rp) GRID_BAR();
            TIDS();
            pg8::Gemm g{(const pg8::bf16_t*)(cx.ws + WS_H), (const pg8::bf16_t*)(cx.ws + WS_WIN) + (size_t)l * DIN * DM, MTOK, DIN, DM};
            pg8::StaticOrder S; S.init(MTOK, DIN, (int)gridDim.x, (int)blockIdx.x);
            EpiProj E{(bf16*)(cx.ws + WS_PROJ), cx.out, l};
            pg8::gemm_phase<EpiProj, pg8::StaticOrder, false>(lds, g, S, E, nullptr, tid);
        }
        SEAM(p0);
        if (IN(p0 + 1)) {
#pragma unroll 1
            for (int rp = 0; rp < NREP(2); ++rp) { if (rp) GRID_BAR(); TIDS(); ph_mixprep(cx, l + 2 * rp, rp ? (DUP_MASK) : 0x1f, lds, MISC, tid, lane, wave); } }
        SEAM(p0 + 1);
        if (IN(p0 + 2)) {
#pragma unroll 1
            for (int rp = 0; rp < NREP(3); ++rp) { if (rp) GRID_BAR(); TIDS(); ph_mixA(cx, l + 2 * rp, rp ? (DUP_MASK) : 0x3f, lds, MISC, tid, lane, wave); } }
        SEAM(p0 + 2);
        if (IN(p0 + 3)) {
#pragma unroll 1
            for (int rp = 0; rp < NREP(4); ++rp) { if (rp) GRID_BAR(); TIDS(); ph_mixB(cx, l + 2 * rp, rp ? (DUP_MASK) : 0xf, lds, MISC, tid, lane, wave); } }
        SEAM(p0 + 3);
        if (IN(p0 + 4))
#pragma unroll 1
          for (int rp = 0; rp < NREP(5); ++rp) {
            if (rp) GRID_BAR();
            TIDS();
            pg8::Gemm g{(const pg8::bf16_t*)(cx.ws + WS_OB), (const pg8::bf16_t*)(cx.ws + WS_WOUT) + (size_t)l * DM * DM, MTOK, DM, DM};
            pg8::StaticOrder S; S.init(MTOK, DM, (int)gridDim.x, (int)blockIdx.x);
            EpiPlain E{(bf16*)(cx.ws + WS_YP), DM};
            pg8::gemm_phase<EpiPlain, pg8::StaticOrder, false>(lds, g, S, E, nullptr, tid);
        }
        SEAM(p0 + 4);
        if (IN(p0 + 5)) {
#pragma unroll 1
            for (int rp = 0; rp < NREP(6); ++rp) { if (rp) GRID_BAR(); TIDS(); ph_postnorm(cx, l, lane, wave); } }
        SEAM(p0 + 5);
    }
#undef IN
#undef SEAM
}

extern "C" void kernel_launch(void* const* d_in, const int* in_sizes, int n_in, void* d_out, int out_size, void* d_ws, size_t ws_size, hipStream_t stream) {
    static int grid = 0;
    if (grid == 0) {
        if (n_in != N_IN || out_size != (int)OUT_TOTAL || ws_size < WS_END) { fprintf(stderr, "kernel_launch: unexpected shapes: n_in %d out %d ws %zu (need %zu)\n", n_in, out_size, ws_size, (size_t)WS_END); grid = -1; return; }
        int dev = 0, cus = 0, per_cu = 0;
        if (hipGetDevice(&dev) != hipSuccess || hipDeviceGetAttribute(&cus, hipDeviceAttributeMultiprocessorCount, dev) != hipSuccess) { grid = -1; return; }
        if (hipFuncSetAttribute((const void*)hymba_fwd, hipFuncAttributeMaxDynamicSharedMemorySize, LDS_BYTES) != hipSuccess) { fprintf(stderr, "kernel_launch: hipFuncSetAttribute failed\n"); grid = -1; return; }
        if (hipOccupancyMaxActiveBlocksPerMultiprocessor(&per_cu, (const void*)hymba_fwd, NTHREADS, LDS_BYTES) != hipSuccess || per_cu < 1) { fprintf(stderr, "kernel_launch: occupancy query says %d\n", per_cu); }
        (void)hipGetLastError();
        grid = cus;
    }
    if (grid < 0) return;
    (void)hipMemsetAsync((char*)d_ws + WS_CTL, 0, CTL_ZERO_BYTES, stream);
    Args a{};
    for (int i = 0; i < N_IN; ++i) a.in[i] = (const float*)d_in[i];
    a.out = (float*)d_out; a.ws = (unsigned char*)d_ws;
#if MK_PER_PHASE
    for (int p = 0; p < N_PHASES; ++p) { a.ph_lo = p; a.ph_hi = p + 1; hipLaunchKernelGGL(hymba_fwd, dim3(grid), dim3(NTHREADS), LDS_BYTES, stream, a); }
#else
    a.ph_lo = 0; a.ph_hi = N_PHASES; hipLaunchKernelGGL(hymba_fwd, dim3(grid), dim3(NTHREADS), LDS_BYTES, stream, a);
#endif
}
```

```cpp
#include <hip/hip_runtime.h>
#include <cstdio>
#include <cstdint>
#ifndef MK_PER_PHASE
#define MK_PER_PHASE 0
#endif
namespace pg8 {
#define PG8_LAS __attribute__((address_space(3)))
typedef unsigned short bf16_t;
typedef short bf16x8 __attribute__((ext_vector_type(8)));
typedef float f32x4 __attribute__((ext_vector_type(4)));
typedef unsigned u32x4 __attribute__((ext_vector_type(4)));
constexpr int BM = 256, BK = 64, HALF = 128, HTB = HALF * BK * 2  , STAGE_BYTES = 8 * HTB, NXCD = 8, WGM = 8;

__host__ __device__ __forceinline__ int lds_byte(int r, int c) { const int st = (r >> 4) * 2 + (c >> 5), rr = r & 15, cc = c & 31, ob = rr * 64 + cc * 2; return st * 1024 + (ob ^ (((ob >> 9) & 1) << 5)); }
__host__ __device__ __forceinline__ void stage_rc(int b, int& R, int& C) { const int st = b / 1024, sb = b % 1024, swz = sb ^ (((sb >> 9) & 1) << 5); R = (st >> 1) * 16 + swz / 64; C = (st & 1) * 32 + (swz % 64) / 2; }
__host__ __device__ __forceinline__ int perm32(int rho) { const int n = rho >> 4, i = rho & 15; return 8 * (i >> 2) + 4 * n + (i & 3); }

struct Unit { int pm, pn; };
struct Gemm { const bf16_t* A; const bf16_t* Bt; int M, N, K; };

struct StaticOrder {
    int nM, nN, nwg, G, c;
    __host__ __device__ void init(int M, int N, int G_, int c_) { nM = M / BM; nN = N / BM; nwg = nM * nN; G = G_; c = c_; }
    __host__ __device__ bool next(int i, Unit& u) const {
        const long L = (long)i * G + c; if (L >= nwg) return false;
        int wgid = (int)L; { const int q = nwg / NXCD, r = nwg % NXCD, xcd = wgid % NXCD, off = wgid / NXCD; wgid = (xcd < r ? xcd * (q + 1) : r * (q + 1) + (xcd - r) * q) + off; }
        const int nig = WGM * nN, gid = wgid / nig, fm = gid * WGM, gsz = (nM - fm) < WGM ? (nM - fm) : WGM;
        u.pm = fm + ((wgid % nig) % gsz); u.pn = (wgid % nig) / gsz; return true;
    }
    __device__ __forceinline__ void a_ready(const Unit&) const {}
    __device__ __forceinline__ void done(const Unit&) const {}
};
template <class Epi, class Sched, bool STAMP = false>
__device__ __forceinline__ void gemm_phase(PG8_LAS unsigned char* lds, const Gemm g, const Sched& S, const Epi& E, unsigned long long* stamps, int tid_in) {
    int tid = tid_in; asm volatile("" : "+v"(tid));
    const int wid = __builtin_amdgcn_readfirstlane(tid >> 6), lane = tid & 63, wr = wid >> 2, wc = wid & 3, fr = lane & 15, fq = lane >> 4;
    const int K = g.K, nt = K / BK;
    int ts_lo = 0, ts_hi = 0, nts = 0; const unsigned long long rt_entry = STAMP ? (unsigned long long)wall_clock64() : 0ull;
#define PG8_STAMP() do { if (STAMP && wid == 0 && nts < 64) { const unsigned long long _c = (unsigned long long)clock64(); \
        ts_lo = (lane == nts) ? (int)(unsigned)_c : ts_lo; ts_hi = (lane == nts) ? (int)(unsigned)(_c >> 32) : ts_hi; ++nts; } } while (0)
    PG8_STAMP();
    unsigned voffA[2], voffB[2];
#pragma unroll
    for (int i = 0; i < 2; ++i) { int R, C; stage_rc(tid * 16 + i * 8192, R, C); const int Rb = Epi::PERM ? ((R & ~31) + perm32(R & 31)) : R;
        voffA[i] = (unsigned)(R * K + C) * 2u; voffB[i] = (unsigned)(Rb * K + C) * 2u; }
    const size_t kstep = (size_t)(BK * 2);
    const size_t hstep = (size_t)HALF * K * 2;
    const size_t tstep = 2 * hstep;
    const unsigned ldsw = (unsigned)wid * 1024u;
    const int aoff = lds_byte(wr * 64 + fr, fq * 8), boff = lds_byte(wc * 32 + fr, fq * 8);
#define PG8_SA(b, h) (((b) * 2 + (h)) * HTB)
#define PG8_SB(b, h) ((4 + (b) * 2 + (h)) * HTB)
#define PG8_STAGE(bufoff, gbase, voff) do { _Pragma("unroll") for (int _i = 0; _i < 2; ++_i) \
        __builtin_amdgcn_global_load_lds((const unsigned*)((const char*)(gbase) + (voff)[_i]), (PG8_LAS unsigned*)(lds + (bufoff) + ldsw + _i * 8192), 16, 0, 0); } while (0)
#define PG8_LDA(dst, b, h) do { _Pragma("unroll") for (int m = 0; m < 4; ++m) _Pragma("unroll") for (int k = 0; k < 2; ++k) dst[m][k] = *(const PG8_LAS bf16x8*)(lds + PG8_SA(b, h) + aoff + m * 2048 + k * 1024); } while (0)
#define PG8_LDB(dst, b, h) do { _Pragma("unroll") for (int n = 0; n < 2; ++n) _Pragma("unroll") for (int k = 0; k < 2; ++k) dst[n][k] = *(const PG8_LAS bf16x8*)(lds + PG8_SB(b, h) + boff + n * 2048 + k * 1024); } while (0)
#define PG8_MMA(ai, bj, At, Bt) do { __builtin_amdgcn_s_setprio(1); _Pragma("unroll") for (int m = 0; m < 4; ++m) _Pragma("unroll") for (int n = 0; n < 2; ++n) _Pragma("unroll") for (int k = 0; k < 2; ++k) \
        acc[ai][bj][m][n] = __builtin_amdgcn_mfma_f32_16x16x32_bf16(Bt[n][k], At[m][k], acc[ai][bj][m][n], 0, 0, 0); __builtin_amdgcn_s_setprio(0); } while (0)
#define PG8_WAIT_V(n) asm volatile("s_waitcnt vmcnt(" #n ")" ::: "memory")
#define PG8_WAIT_L(n) asm volatile("s_waitcnt lgkmcnt(" #n ")" ::: "memory")
#define PG8_BAR __builtin_amdgcn_s_barrier()
#define PG8_SCHED __builtin_amdgcn_sched_barrier(0)
    Unit cur, nxt; int ui = 0;
    if (!S.next(0, cur)) return;
    f32x4 acc[2][2][4][2];
#pragma unroll
    for (int a = 0; a < 2; ++a)
#pragma unroll
        for (int b = 0; b < 2; ++b)
#pragma unroll
            for (int m = 0; m < 4; ++m)
#pragma unroll
                for (int n = 0; n < 2; ++n) acc[a][b][m][n] = (f32x4){0.f, 0.f, 0.f, 0.f};
    bf16x8 At[4][2], B0[2][2], B1[2][2];
    const char* cA = (const char*)g.A + (size_t)cur.pm * tstep; const char* cB = (const char*)g.Bt + (size_t)cur.pn * tstep;
    S.a_ready(cur);
    PG8_STAGE(PG8_SB(0, 0), cB, voffB); PG8_STAGE(PG8_SA(0, 0), cA, voffA); PG8_STAGE(PG8_SB(0, 1), cB + hstep, voffB); PG8_STAGE(PG8_SA(0, 1), cA + hstep, voffA);
    if (wr == 1) PG8_BAR;
    PG8_WAIT_V(4); PG8_BAR;
    PG8_STAGE(PG8_SB(1, 0), cB + kstep, voffB); PG8_STAGE(PG8_SA(1, 0), cA + kstep, voffA); PG8_STAGE(PG8_SB(1, 1), cB + hstep + kstep, voffB);
    PG8_WAIT_V(6); PG8_BAR;
    PG8_STAMP();
    for (;;) {
        const bool has_next = S.next(ui + 1, nxt);
        const char* nA = has_next ? (const char*)g.A + (size_t)nxt.pm * tstep : cA; const char* nB = has_next ? (const char*)g.Bt + (size_t)nxt.pn * tstep : cB;
        for (int t = 0; t < nt; t += 2) {
            const bool last = (t == nt - 2);
            const char* a1 = cA + (size_t)(t + 1) * kstep;
            const char* a2 = last ? nA : cA + (size_t)(t + 2) * kstep; const char* b2 = last ? nB : cB + (size_t)(t + 2) * kstep;
            const char* a3 = a2 + kstep; const char* b3 = b2 + kstep;
            if (last && has_next) S.a_ready(nxt);
            PG8_LDB(B0, 0, 0); PG8_SCHED; PG8_LDA(At, 0, 0); PG8_STAGE(PG8_SA(1, 1), a1 + hstep, voffA);
            PG8_WAIT_L(8); PG8_BAR; PG8_WAIT_L(0); PG8_MMA(0, 0, At, B0); PG8_BAR; PG8_SCHED;
            PG8_LDB(B1, 0, 1); PG8_STAGE(PG8_SB(0, 0), b2, voffB);
            PG8_BAR; PG8_WAIT_L(0); PG8_MMA(0, 1, At, B1); PG8_BAR;
            PG8_LDA(At, 0, 1); PG8_STAGE(PG8_SA(0, 0), a2, voffA);
            PG8_BAR; PG8_WAIT_L(0); PG8_MMA(1, 0, At, B0); PG8_BAR; PG8_SCHED;
            PG8_STAGE(PG8_SB(0, 1), b2 + hstep, voffB);
            PG8_WAIT_V(6); PG8_BAR; PG8_MMA(1, 1, At, B1); PG8_BAR;
            PG8_LDB(B0, 1, 0); PG8_SCHED; PG8_LDA(At, 1, 0); PG8_STAGE(PG8_SA(0, 1), a2 + hstep, voffA);
            PG8_WAIT_L(8); PG8_BAR; PG8_WAIT_L(0); PG8_MMA(0, 0, At, B0); PG8_BAR; PG8_SCHED;
            PG8_LDB(B1, 1, 1); PG8_STAGE(PG8_SB(1, 0), b3, voffB);
            PG8_BAR; PG8_WAIT_L(0); PG8_MMA(0, 1, At, B1); PG8_BAR;
            PG8_LDA(At, 1, 1); PG8_STAGE(PG8_SA(1, 0), a3, voffA);
            PG8_BAR; PG8_WAIT_L(0); PG8_MMA(1, 0, At, B0); PG8_BAR; PG8_SCHED;
            PG8_STAGE(PG8_SB(1, 1), b3 + hstep, voffB);
            PG8_WAIT_V(6); PG8_BAR; PG8_MMA(1, 1, At, B1); PG8_BAR;
        }
        PG8_STAMP();
        if constexpr (!Epi::AFTER_DRAIN) { int l2; asm volatile("v_mbcnt_lo_u32_b32 %0, -1, 0\n\tv_mbcnt_hi_u32_b32 %0, -1, %0" : "=v"(l2)); E(acc, cur, wr, wc, l2 & 15, l2 >> 4); S.done(cur); }
        PG8_STAMP();
        if (!has_next) break;
#pragma unroll
        for (int a = 0; a < 2; ++a)
#pragma unroll
            for (int b = 0; b < 2; ++b)
#pragma unroll
                for (int m = 0; m < 4; ++m)
#pragma unroll
                    for (int n = 0; n < 2; ++n) acc[a][b][m][n] = (f32x4){0.f, 0.f, 0.f, 0.f};
        cur = nxt; cA = nA; cB = nB; ++ui;
    }
    PG8_WAIT_V(0);
    if (wr == 0) PG8_BAR;
    PG8_BAR;
    if constexpr (Epi::AFTER_DRAIN) { E.fused(acc, cur, wr, wc, fr, fq, lds, wid, lane); S.done(cur); }
    PG8_STAMP();
    if (STAMP && wid == 0) { stamps[lane] = lane < nts ? (((unsigned long long)(unsigned)ts_hi << 32) | (unsigned)ts_lo) : 0ull;
        if (lane == 62) stamps[62] = rt_entry; if (lane == 63) stamps[63] = (unsigned long long)wall_clock64(); }
#undef PG8_STAMP
#undef PG8_SA
#undef PG8_SB
#undef PG8_STAGE
#undef PG8_LDA
#undef PG8_LDB
#undef PG8_MMA
#undef PG8_WAIT_V
#undef PG8_WAIT_L
#undef PG8_BAR
#undef PG8_SCHED
}
}

#define GAS __attribute__((address_space(1)))
#define LAS __attribute__((address_space(3)))
typedef unsigned short bf16;
typedef float f32x4 __attribute__((ext_vector_type(4)));
typedef float f32x2 __attribute__((ext_vector_type(2)));
typedef float f32x16 __attribute__((ext_vector_type(16)));
typedef short bf16x8 __attribute__((ext_vector_type(8)));
typedef unsigned u32x4 __attribute__((ext_vector_type(4)));
typedef unsigned u32x2 __attribute__((ext_vector_type(2)));

constexpr int NWAVES = 8, NTHREADS = 512;
constexpr int DM = 1024, NP = 16384, NSMP = 1024, MTOK = 17408, DIN = 3584, SEQ = 2048, DB = 128, DS = 8;
constexpr int OFF_AQ = 0, OFF_AK = 256, OFF_AV = 512, OFF_B = 768, OFF_C = 1024, OFF_D = 2304, OFF_G = 2560;
constexpr int NPOOL = 2560, NPAGES = 16;
constexpr float NORM_EPS = 1e-6f;
constexpr float QSCALE = 0.17677669529663687f * 1.4426950408889634f;
constexpr int NSPLIT = 9;
constexpr int PART_FLOATS = 16 + 16 + 1024;

constexpr size_t OUT_Y_P = 0, OUT_Y_S = 16777216, OUT_K_P = 17825792, OUT_K_S = 26214400, OUT_V_P = 26738688, OUT_V_S = 35127296,
    OUT_CONV_P = 35651584, OUT_CONV_S = 35663872, OUT_LRU_P = 35860480, OUT_LRU_S = 35864576, OUT_SHIFT_P = 35930112, OUT_SHIFT_S = 35950592,
    OUT_WKV_P = 36278272, OUT_WKV_S = 36540416, OUT_SSM_P = 40734720, OUT_SSM_S = 40767488, OUT_TOTAL = 41291776;

constexpr size_t MiB = 1u << 20;
constexpr size_t WS_CTL = 0, CTL_ZERO_BYTES = 1 * MiB;
constexpr size_t WS_WIN = 1 * MiB;
constexpr size_t WS_WOUT = WS_WIN + (size_t)2 * DIN * DM * 2;
constexpr size_t WS_H = WS_WOUT + (size_t)2 * DM * DM * 2;
constexpr size_t WS_PROJ = WS_H + (size_t)MTOK * DM * 2;
constexpr size_t WS_QB = WS_PROJ + (size_t)MTOK * DIN * 4;
constexpr size_t WS_KB = WS_QB + (size_t)NP * 256 * 2;
constexpr size_t WS_VT = WS_KB + (size_t)NP * 256 * 2;
constexpr size_t WS_LA = WS_VT + (size_t)NP * 256 * 2;
constexpr size_t WS_LB = WS_LA + (size_t)MTOK * 256 * 4;
constexpr size_t WS_LP = WS_LB + (size_t)MTOK * 256 * 4;
constexpr size_t WS_LE = WS_LP + (size_t)8 * 32 * 256 * 4;
constexpr size_t WS_RW = WS_LE + (size_t)8 * 32 * 256 * 4;
constexpr size_t WS_BON = WS_RW + (size_t)MTOK * 1536 * 4;
constexpr size_t WS_S5E = WS_BON + (size_t)MTOK * 4 * 4;
constexpr size_t WS_OMIX = WS_S5E + (size_t)8 * 16 * 16 * 64 * 2 * 4;
constexpr size_t WS_ZB = WS_OMIX, WS_WGLU = WS_OMIX + 16 * MiB, WS_LWT = WS_OMIX + 17 * MiB, WS_W1T = WS_OMIX + 18 * MiB, WS_S5T = WS_OMIX + 19 * MiB;
constexpr size_t WS_OB = WS_OMIX + (size_t)MTOK * DM * 4;
constexpr size_t WS_PART = WS_OB + (size_t)MTOK * DM * 2;
constexpr size_t WS_YP = WS_PART + (size_t)DB * 4 * NSPLIT * PART_FLOATS * 4;
constexpr size_t WS_X1 = WS_YP + (size_t)MTOK * DM * 4;
constexpr size_t WS_PZ = WS_X1 + (size_t)MTOK * DM * 4;
constexpr size_t WS_END = WS_PZ + (size_t)8 * 4 * 8 * 2 * 4096 * 4;
static_assert(WS_H % 256 == 0 && WS_PROJ % 256 == 0 && WS_QB % 256 == 0 && WS_VT % 256 == 0 && WS_RW % 256 == 0 && WS_OMIX % 256 == 0 && WS_PART % 256 == 0 && WS_YP % 256 == 0, "ws align");

constexpr int CW_BAR = 4096;
constexpr int CW_QUEUE = 8192;

constexpr int LDS_BYTES = 147456;
constexpr int MISC_OFF = 147456 - 256;

#define XB_TMO      128
#define XB_XCNT(j)  (256  + 64 * (j))
#define XB_XSUB(j)  (1280 + 64 * (j))
#define XB_XGEN(j)  (2304 + 64 * (j))
#define XB_TOP      3328
#define XB_TOPGEN   3392
#define XCD_BAR_WORDS 3456
#define XB_SPIN_CAP (1u << 18)

__device__ __forceinline__ unsigned xb_ld(unsigned* p)              { return __hip_atomic_load(p, __ATOMIC_RELAXED, __HIP_MEMORY_SCOPE_AGENT); }
__device__ __forceinline__ unsigned xb_add(unsigned* p, unsigned v) { return __hip_atomic_fetch_add(p, v, __ATOMIC_RELAXED, __HIP_MEMORY_SCOPE_AGENT); }
__device__ __forceinline__ unsigned xb_xcc_id() { return (unsigned)__builtin_amdgcn_s_getreg((3 << 11) | 20) & 0xFu; }
#define XB_SPIN(cond, bar) do { unsigned _sp = 0; while (cond) { __builtin_amdgcn_s_sleep(1); \
    if ((++_sp & 255u) == 0u) { if (xb_ld(&(bar)[XB_TMO])) break; if (_sp > XB_SPIN_CAP) { atomicAdd(&(bar)[XB_TMO], 1u); break; } } } } while (0)

struct XcdBarrier { unsigned* bar; unsigned x; volatile LAS unsigned* st; };

__device__ __forceinline__ XcdBarrier xcd_barrier_post(unsigned* bar, volatile LAS unsigned* st) {
    XcdBarrier b; b.bar = bar; b.x = xb_xcc_id(); b.st = st;
    if (threadIdx.x == 0) (void)xb_add(&bar[XB_XCNT(b.x)], 1u);
    return b;
}
__device__ __forceinline__ void xcd_barrier_complete(unsigned* bar, unsigned x, unsigned& nloc, unsigned& nx) {
    const unsigned G = gridDim.x * gridDim.y * gridDim.z;
    unsigned sum, cnt, mine, sp = 0u;
    for (;;) {
        sum = 0u; cnt = 0u; mine = 0u;
#pragma unroll
        for (unsigned j = 0; j < 16; ++j) { const unsigned c = xb_ld(&bar[XB_XCNT(j)]); sum += c; cnt += (c > 0u) ? 1u : 0u; mine = (j == x) ? c : mine; }
        if (sum == G) break;
        __builtin_amdgcn_s_sleep(1);
        if ((++sp & 255u) == 0u) { if (xb_ld(&bar[XB_TMO])) break; if (sp > XB_SPIN_CAP) { atomicAdd(&bar[XB_TMO], 1u); break; } }
    }
    nloc = mine > 0u ? mine : 1u; nx = cnt > 0u ? cnt : 1u;
}
__device__ __forceinline__ void xcd_barrier(const XcdBarrier& b, bool leader) {
    asm volatile("s_waitcnt vmcnt(0)" ::: "memory");
    __syncthreads();
    if (leader) {
        unsigned* bar = b.bar;
        __builtin_amdgcn_s_waitcnt(0);
        unsigned nloc = b.st[0], nx = b.st[1];
        if (nloc == 0u) { xcd_barrier_complete(bar, b.x, nloc, nx); b.st[0] = nloc; b.st[1] = nx; }
        const unsigned old = xb_add(&bar[XB_XSUB(b.x)], 1u);
        const unsigned gen = old / nloc;
        if (old + 1u == (gen + 1u) * nloc) {
            __builtin_amdgcn_fence(__ATOMIC_RELEASE, "agent");
            asm volatile("s_waitcnt vmcnt(0)" ::: "memory");
            const unsigned og = xb_add(&bar[XB_TOP], 1u);
            const unsigned tg = og / nx;
            if (og + 1u == (tg + 1u) * nx) xb_add(&bar[XB_TOPGEN], 1u);
            else XB_SPIN(xb_ld(&bar[XB_TOPGEN]) == tg, bar);
            __builtin_amdgcn_fence(__ATOMIC_ACQUIRE, "agent");
            xb_add(&bar[XB_XGEN(b.x)], 1u);
            asm volatile("s_waitcnt vmcnt(0)" ::: "memory");
        } else {
            XB_SPIN(xb_ld(&bar[XB_XGEN(b.x)]) == gen, bar);
            __builtin_amdgcn_fence(__ATOMIC_ACQUIRE, "agent");
            asm volatile("s_waitcnt vmcnt(0)" ::: "memory");
        }
    }
    __syncthreads();
}

enum InIdx { I_XP = 0, I_XS, I_CK, I_CV, I_PT, I_SCONV, I_SLRU, I_SSHIFT, I_SWKV, I_SSSM, I_NPRE, I_NPOST, I_WIN, I_WOUT, I_LQ1, I_LK1, I_LQ2, I_LK2, I_SUBLN,
             I_CONVW, I_CONVB, I_LWA, I_LBA, I_LWX, I_LBX, I_LLAM, I_MU, I_W0, I_W1, I_W2, I_A0, I_A1, I_A2, I_KK, I_KA, I_RK, I_GNW, I_GNB,
             I_LRE, I_LIM, I_LOGDT, I_BRE, I_BIM, I_CRE, I_CIM, I_S5D, I_WGLU, I_BGLU, N_IN };
struct Args { const float* in[N_IN]; float* out; unsigned char* ws; int ph_lo, ph_hi; };
static_assert(sizeof(Args) == (N_IN + 2) * 8 + 8, "Args has no padding");
constexpr int TAB_OFF = 147456 - 1024;
struct Ctx {
    float* out; unsigned char* ws; const LAS unsigned* tab;
    __device__ __forceinline__ const float* inp(int i) const {
        const unsigned lo = tab[2 * i], hi = tab[2 * i + 1];
        return (const float*)(const GAS float*)(((unsigned long long)(unsigned)__builtin_amdgcn_readfirstlane((int)hi) << 32) | (unsigned long long)(unsigned)__builtin_amdgcn_readfirstlane((int)lo));
    }
};

__device__ __forceinline__ int lane_id_asm() { int l; asm volatile("v_mbcnt_lo_u32_b32 %0, -1, 0\n\tv_mbcnt_hi_u32_b32 %0, -1, %0" : "=v"(l)); return l; }
#define OPAQUE(x) asm volatile("" : "+v"(x))
__device__ __forceinline__ float wave_sum(float v) {
#pragma unroll
    for (int o = 1; o < 64; o <<= 1) v += __shfl_xor(v, o);
    return v;
}
template <int CTRL> __device__ __forceinline__ float dpp_mov(float v) { return __builtin_bit_cast(float, __builtin_amdgcn_update_dpp(0, __builtin_bit_cast(int, v), CTRL, 0xF, 0xF, true)); }
__device__ __forceinline__ float red8(float v) { v += dpp_mov<0xB1>(v); v += dpp_mov<0x4E>(v); v += dpp_mov<0x141>(v); return v; }
__device__ __forceinline__ float red16(float v) { v = red8(v); v += dpp_mov<0x140>(v); return v; }
__device__ __forceinline__ unsigned f2bf(float f) { unsigned u = __builtin_bit_cast(unsigned, f); return (u + 0x7fffu + ((u >> 16) & 1u)) >> 16; }
typedef __bf16 bf16x2_t __attribute__((ext_vector_type(2)));
__device__ __forceinline__ unsigned pk2(float lo, float hi) { const f32x2 v = {lo, hi}; return __builtin_bit_cast(unsigned, __builtin_convertvector(v, bf16x2_t)); }
__device__ __forceinline__ f32x4 ldp4(const bf16* p) { const u32x2 w = *(const u32x2*)p; return (f32x4){__builtin_bit_cast(float, w.x << 16), __builtin_bit_cast(float, w.x & 0xffff0000u), __builtin_bit_cast(float, w.y << 16), __builtin_bit_cast(float, w.y & 0xffff0000u)}; }
__device__ __forceinline__ float ldp1(const bf16* p) { return __builtin_bit_cast(float, (unsigned)(*p) << 16); }
__device__ __forceinline__ float sigmoidf_(float x) { return __builtin_amdgcn_rcpf(1.0f + __builtin_amdgcn_exp2f(-1.4426950408889634f * x)); }
__device__ __forceinline__ float siluf_(float x) { return x * sigmoidf_(x); }
__device__ __forceinline__ float tanhf_(float x) { return 1.0f - 2.0f * __builtin_amdgcn_rcpf(1.0f + __builtin_amdgcn_exp2f(2.8853900817779268f * x)); }
__device__ __forceinline__ float wave_sum_fast(float v) { v = red16(v); v += __shfl_xor(v, 16); v += __shfl_xor(v, 32); return v; }
__device__ __forceinline__ float softplusf_(float x) { return fmaxf(x, 0.f) + log1pf(__expf(-fabsf(x))); }
__device__ __forceinline__ float lam_init_of(int l) { return l == 0 ? 0.2f : 0.35550907f; }
__device__ __forceinline__ float compute_lam(const Ctx& a, int l, int lane) {
    float v1 = 0.f, v2 = 0.f;
    if (lane < 32) { v1 = a.inp(I_LQ1)[l * 32 + lane] * a.inp(I_LK1)[l * 32 + lane]; v2 = a.inp(I_LQ2)[l * 32 + lane] * a.inp(I_LK2)[l * 32 + lane]; }
    v1 = wave_sum(v1); v2 = wave_sum(v2);
    return expf(v1) - expf(v2) + lam_init_of(l);
}

__device__ __forceinline__ void s5_disc_compute(const Ctx& a, int l, int g, int n, float& ab_re, float& ab_im, float& f_re, float& f_im);
__device__ __forceinline__ void p0_transpose_item(const float* W, int K, int N, bf16* WT, LAS float* scr, int item, int lane) {
    const int nblk = N / 32, kb = item / nblk, nb = item % nblk, k0 = 64 * kb, n0 = 32 * nb;
    float wv[32];
#pragma unroll
    for (int i = 0; i < 32; ++i) wv[i] = W[(size_t)(k0 + 2 * i + (lane >> 5)) * N + n0 + (lane & 31)];
#pragma unroll
    for (int i = 0; i < 32; ++i) scr[(2 * i + (lane >> 5)) * 33 + (lane & 31)] = wv[i];
    asm volatile("s_waitcnt lgkmcnt(0)" ::: "memory");
    const int c = lane & 7;
#pragma unroll
    for (int j = 0; j < 4; ++j) { const int n = (lane >> 3) + 8 * j; const LAS float* s = scr + (8 * c) * 33 + n;
        u32x4 o; o.x = pk2(s[0 * 33], s[1 * 33]); o.y = pk2(s[2 * 33], s[3 * 33]); o.z = pk2(s[4 * 33], s[5 * 33]); o.w = pk2(s[6 * 33], s[7 * 33]);
        *(u32x4*)(WT + (size_t)(n0 + n) * K + k0 + 8 * c) = o; }
    asm volatile("s_waitcnt lgkmcnt(0)" ::: "memory");
}
__device__ __forceinline__ void rms_row_to_bf16(const float* xrow, const float* g, bf16* orow, int lane) {
    const f32x4* xr = (const f32x4*)xrow + lane; const f32x4* gr = (const f32x4*)g + lane;
    f32x4 v[4]; float s = 0.f;
#pragma unroll
    for (int j = 0; j < 4; ++j) { v[j] = xr[64 * j]; s += (v[j].x * v[j].x + v[j].y * v[j].y) + (v[j].z * v[j].z + v[j].w * v[j].w); }
    const float r = rsqrtf(wave_sum(s) * (1.f / DM) + NORM_EPS);
    u32x2* o8 = (u32x2*)orow + lane;
#pragma unroll
    for (int j = 0; j < 4; ++j) { const f32x4 gg = gr[64 * j]; u32x2 o; o.x = pk2(v[j].x * r * gg.x, v[j].y * r * gg.y); o.y = pk2(v[j].z * r * gg.z, v[j].w * r * gg.w); o8[64 * j] = o; }
}
__device__ __forceinline__ void ph_prologue(const Ctx& a, LAS unsigned char* lds, int lane, int wave) {
    OPAQUE(lane);
    LAS float* scr = (LAS float*)(lds + wave * 16384);
    const int gw = blockIdx.x * NWAVES + wave, NGW = gridDim.x * NWAVES;
    constexpr int I_IN = (DM / 64) * (DIN / 32), I_OUT = (DM / 64) * (DM / 32), I_GLU = (256 / 64) * (256 / 32), I_L = I_IN + I_OUT + I_GLU;
    for (int it = gw; it < 2 * I_L; it += NGW) {
        const int l = it / I_L, r = it % I_L;
        if (r < I_IN) p0_transpose_item(a.inp(I_WIN) + (size_t)l * DM * DIN, DM, DIN, (bf16*)(a.ws + WS_WIN) + (size_t)l * DIN * DM, scr, r, lane);
        else if (r < I_IN + I_OUT) p0_transpose_item(a.inp(I_WOUT) + (size_t)l * DM * DM, DM, DM, (bf16*)(a.ws + WS_WOUT) + (size_t)l * DM * DM, scr, r - I_IN, lane);
        else p0_transpose_item(a.inp(I_WGLU) + (size_t)l * 65536, 256, 256, (bf16*)(a.ws + WS_WGLU) + (size_t)l * 65536, scr, r - I_IN - I_OUT, lane);
    }
    {
        bf16* LWT = (bf16*)(a.ws + WS_LWT);
        const float* wa = a.inp(I_LWA); const float* wx = a.inp(I_LWX);
        for (int idx = gw * 64 + lane; idx < 2 * 2 * 4 * 64 * 64; idx += NGW * 64) {
            const int c = idx & 63, d = (idx >> 6) & 63, n = (idx >> 12) & 3, p = (idx >> 14) & 1, l = idx >> 15;
            LWT[idx] = (bf16)f2bf((p ? wx : wa)[((size_t)(l * 4 + n) * 64 + c) * 64 + d]);
        }
    }
    {
        float* T = (float*)(a.ws + WS_S5T);
        for (int idx = gw * 64 + lane; idx < 2 * 16 * 64; idx += NGW * 64) {
            float ar, ai, fr, fi; s5_disc_compute(a, idx >> 10, (idx >> 6) & 15, idx & 63, ar, ai, fr, fi);
            *(f32x4*)(T + (size_t)idx * 4) = (f32x4){ar, ai, fr, fi};
        }
    }
    {
        bf16* W1T = (bf16*)(a.ws + WS_W1T);
        const float* w1 = a.inp(I_W1); const float* a1 = a.inp(I_A1);
        for (int idx = gw * 64 + lane; idx < 2 * 2 * 32 * 256; idx += NGW * 64) {
            const int k = idx & 255, n = (idx >> 8) & 31, p = (idx >> 13) & 1, l = idx >> 14;
            W1T[idx] = (bf16)f2bf((p ? a1 : w1)[((size_t)l * 256 + k) * 32 + n]);
        }
    }
    bf16* H = (bf16*)(a.ws + WS_H);
    {
        const float* xp = a.inp(I_XP); const float* xs = a.inp(I_XS) - (size_t)NP * DM;
        f32x4 gg[4];
#pragma unroll
        for (int j = 0; j < 4; ++j) gg[j] = ((const f32x4*)a.inp(I_NPRE) + lane)[64 * j];
        for (int m0 = gw; m0 < MTOK; m0 += 2 * NGW) {
            const int m1 = m0 + NGW; const bool has1 = m1 < MTOK; const int mb = has1 ? m1 : m0;
            const f32x4* xa = (const f32x4*)((m0 < NP ? xp : xs) + (size_t)m0 * DM) + lane; const f32x4* xb = (const f32x4*)((mb < NP ? xp : xs) + (size_t)mb * DM) + lane;
            f32x4 va[4], vb[4]; float sa = 0.f, sb = 0.f;
#pragma unroll
            for (int j = 0; j < 4; ++j) { va[j] = xa[64 * j]; vb[j] = xb[64 * j]; }
#pragma unroll
            for (int j = 0; j < 4; ++j) { sa += (va[j].x * va[j].x + va[j].y * va[j].y) + (va[j].z * va[j].z + va[j].w * va[j].w); sb += (vb[j].x * vb[j].x + vb[j].y * vb[j].y) + (vb[j].z * vb[j].z + vb[j].w * vb[j].w); }
            const float ra = rsqrtf(wave_sum_fast(sa) * (1.f / DM) + NORM_EPS), rb = rsqrtf(wave_sum_fast(sb) * (1.f / DM) + NORM_EPS);
            u32x2* ha = (u32x2*)(H + (size_t)m0 * DM) + lane; u32x2* hb = (u32x2*)(H + (size_t)mb * DM) + lane;
#pragma unroll
            for (int j = 0; j < 4; ++j) { u32x2 o; o.x = pk2(va[j].x * ra * gg[j].x, va[j].y * ra * gg[j].y); o.y = pk2(va[j].z * ra * gg[j].z, va[j].w * ra * gg[j].w); ha[64 * j] = o;
                if (has1) { u32x2 p; p.x = pk2(vb[j].x * rb * gg[j].x, vb[j].y * rb * gg[j].y); p.y = pk2(vb[j].z * rb * gg[j].z, vb[j].w * rb * gg[j].w); hb[64 * j] = p; } }
        }
    }
}

struct EpiProj {
    static constexpr bool PERM = true, AFTER_DRAIN = false;
    bf16* P; float* out; int layer;
    __device__ __forceinline__ void operator()(const pg8::f32x4 (&acc)[2][2][4][2], const pg8::Unit& u, int wr, int wc, int fr, int fq) const {
        const int row0 = u.pm * 256 + wr * 64 + fr, col0 = u.pn * 256 + wc * 32 + 8 * fq;
#pragma unroll
        for (int ai = 0; ai < 2; ++ai)
#pragma unroll
            for (int m = 0; m < 4; ++m) { bf16* rowp = P + (size_t)(row0 + ai * 128 + m * 16) * DIN + col0;
#pragma unroll
                for (int bj = 0; bj < 2; ++bj) { const pg8::f32x4 v0 = acc[ai][bj][m][0], v1 = acc[ai][bj][m][1];
                    u32x4 w; w.x = pk2(v0[0], v0[1]); w.y = pk2(v0[2], v0[3]); w.z = pk2(v1[0], v1[1]); w.w = pk2(v1[2], v1[3]);
                    *(u32x4*)(rowp + bj * 128) = w; } }
        if (u.pn == 1 || u.pn == 2) {
            const bool smp = (u.pm >= 64);
            float* base;
            if (u.pn == 1) base = smp ? out + OUT_K_S + (size_t)layer * NSMP * 256 : out + OUT_K_P + (size_t)layer * NP * 256;
            else           base = smp ? out + OUT_V_S + (size_t)layer * NSMP * 256 : out + OUT_V_P + (size_t)layer * NP * 256;
            const int r0 = row0 - (smp ? NP : 0), c0 = wc * 32 + 8 * fq;
#pragma unroll
            for (int ai = 0; ai < 2; ++ai)
#pragma unroll
                for (int m = 0; m < 4; ++m) { float* rowp = base + (size_t)(r0 + ai * 128 + m * 16) * 256 + c0;
#pragma unroll
                    for (int bj = 0; bj < 2; ++bj) { __builtin_nontemporal_store(acc[ai][bj][m][0], (pg8::f32x4*)(rowp + bj * 128)); __builtin_nontemporal_store(acc[ai][bj][m][1], (pg8::f32x4*)(rowp + bj * 128 + 4)); } }
        }
    }
};
struct EpiPlain {
    static constexpr bool PERM = true, AFTER_DRAIN = false;
    bf16* C; int ldc;
    __device__ __forceinline__ void operator()(const pg8::f32x4 (&acc)[2][2][4][2], const pg8::Unit& u, int wr, int wc, int fr, int fq) const {
        const int row0 = u.pm * 256 + wr * 64 + fr, col0 = u.pn * 256 + wc * 32 + 8 * fq;
#pragma unroll
        for (int ai = 0; ai < 2; ++ai)
#pragma unroll
            for (int m = 0; m < 4; ++m) { bf16* rowp = C + (size_t)(row0 + ai * 128 + m * 16) * ldc + col0;
#pragma unroll
                for (int bj = 0; bj < 2; ++bj) { const pg8::f32x4 v0 = acc[ai][bj][m][0], v1 = acc[ai][bj][m][1];
                    u32x4 w; w.x = pk2(v0[0], v0[1]); w.y = pk2(v0[2], v0[3]); w.z = pk2(v1[0], v1[1]); w.w = pk2(v1[2], v1[3]);
                    *(u32x4*)(rowp + bj * 128) = w; } }
    }
};

__device__ __forceinline__ void lru_prep_item(const Ctx& a, int l, int item, LAS unsigned char* lds, int tid) {
    OPAQUE(tid);
    const bf16* PROJ = (const bf16*)(a.ws + WS_PROJ);
    float* LA = (float*)(a.ws + WS_LA); float* LB = (float*)(a.ws + WS_LB);
    LAS float* X = (LAS float*)lds;
    LAS float* XC = (LAS float*)(lds + 68608);
    const bool smp = item >= 256;
    int nseg, seglen, m0, s = 0, ch = 0, b0 = 0;
    if (!smp) { s = item >> 5; ch = item & 31; nseg = 1; seglen = 64; m0 = s * SEQ + ch * 64; }
    else { const int j = item - 256; nseg = 4; seglen = 8; m0 = NP + j * 32; b0 = j * 4; }
    const int rps = seglen + 3, L = nseg * seglen;
    {
        const float* sconv = a.inp(I_SCONV);
#pragma unroll 4
        for (int idx = tid; idx < nseg * rps * 64; idx += NTHREADS) {
            const int row = idx >> 6, c4 = idx & 63, seg = row / rps, i = row % rps;
            const bool halo = i < 3;
            const bool fromstate = smp && halo;
            f32x4 v = ldp4(PROJ + (size_t)(m0 + seg * seglen + (halo && (smp || ch == 0) ? 3 : i) - 3) * DIN + OFF_B + 4 * c4);
            const f32x4 vs = *(const f32x4*)(sconv + (fromstate ? ((size_t)(l * DB + b0 + seg) * 3 + i) * 256 : (size_t)0) + 4 * c4);
            if (fromstate) v = vs;
            if (!smp && ch == 0 && halo) v = (f32x4){0.f, 0.f, 0.f, 0.f};
            *(LAS f32x4*)(X + row * 256 + 4 * c4) = v;
        }
    }
    __syncthreads();
    if (smp || ch == 31) {
        for (int idx = tid; idx < nseg * 3 * 256; idx += NTHREADS) {
            const int seg = idx / 768, j = (idx % 768) >> 8, c = idx & 255;
            const float v = X[(seg * rps + seglen + j) * 256 + c];
            if (smp) a.out[OUT_CONV_S + ((size_t)(l * DB + b0 + seg) * 3 + j) * 256 + c] = v;
            else a.out[OUT_CONV_P + ((size_t)(l * 8 + s) * 3 + j) * 256 + c] = v;
        }
    }
    {
        const float* cw = a.inp(I_CONVW) + l * 1024; const float* cb = a.inp(I_CONVB) + l * 256;
        for (int idx = tid; idx < L * 256; idx += NTHREADS) {
            const int t = idx >> 8, c = idx & 255, seg = t / seglen, i = t % seglen;
            const LAS float* bp = X + (seg * rps + i) * 256 + c;
            XC[t * 256 + c] = cb[c] + cw[c] * bp[0] + cw[256 + c] * bp[256] + cw[512 + c] * bp[512] + cw[768 + c] * bp[768];
        }
    }
    __syncthreads();
    {
        const int lane = tid & 63, wv = tid >> 6, p = wv >> 2, n = wv & 3, r = lane & 31, hh = lane >> 5, o = tid & 255;
        const bf16* WT = (const bf16*)(a.ws + WS_LWT) + ((size_t)((l * 2 + p) * 4 + n) * 64) * 64;
        bf16x8 wf[2][4];
#pragma unroll
        for (int dt = 0; dt < 2; ++dt)
#pragma unroll
            for (int sx = 0; sx < 4; ++sx) wf[dt][sx] = *(const bf16x8*)(WT + (dt * 32 + r) * 64 + 16 * sx + 8 * hh);
        const float* bp = (p ? a.inp(I_LBX) : a.inp(I_LBA)) + l * 256 + n * 64 + 4 * hh;
        LAS float* GX = X;
        const int LH = L >> 1;
        bf16* OB = (bf16*)(a.ws + WS_OB);
        const float spv = softplusf_(-a.inp(I_LLAM)[l * 256 + o]) * 1.4426950408889634f;
        const float* slru = a.inp(I_SLRU);
        float hs = 0.f, Ps = 1.f;
        for (int hf = 0; hf < 2; ++hf) {
            {
                const LAS float* xr = XC + (hf * LH + r) * 256 + n * 64 + 8 * hh;
                bf16x8 xb[4];
#pragma unroll
                for (int sx = 0; sx < 4; ++sx) { const f32x4 x0 = *(const LAS f32x4*)(xr + 16 * sx), x1 = *(const LAS f32x4*)(xr + 16 * sx + 4);
                    u32x4 w; w.x = pk2(x0.x, x0.y); w.y = pk2(x0.z, x0.w); w.z = pk2(x1.x, x1.y); w.w = pk2(x1.z, x1.w); xb[sx] = __builtin_bit_cast(bf16x8, w); }
#pragma unroll
                for (int dt = 0; dt < 2; ++dt) {
                    f32x16 acc;
#pragma unroll
                    for (int e = 0; e < 16; ++e) acc[e] = 0.f;
#pragma unroll
                    for (int sx = 0; sx < 4; ++sx) acc = __builtin_amdgcn_mfma_f32_32x32x16_bf16(wf[dt][sx], xb[sx], acc, 0, 0, 0);
#pragma unroll
                    for (int g4 = 0; g4 < 4; ++g4) { const f32x4 bb = *(const f32x4*)(bp + dt * 32 + 8 * g4);
                        f32x4 gv; gv.x = sigmoidf_(acc[4 * g4] + bb.x); gv.y = sigmoidf_(acc[4 * g4 + 1] + bb.y); gv.z = sigmoidf_(acc[4 * g4 + 2] + bb.z); gv.w = sigmoidf_(acc[4 * g4 + 3] + bb.w);
                        *(LAS f32x4*)(GX + (p * 32 + r) * 256 + n * 64 + dt * 32 + 8 * g4 + 4 * hh) = gv; }
                }
            }
            __syncthreads();
            if (p == 0) {
              for (int t0 = 0; t0 < LH; t0 += 8) {
                float gts[8];
                if (smp) {
#pragma unroll
                    for (int t = 0; t < 8; ++t) gts[t] = ldp1(PROJ + (size_t)(m0 + hf * LH + t0 + t) * DIN + OFF_G + 256 + o); }
#pragma unroll
                for (int t8 = 0; t8 < 8; ++t8) {
                    const int t = t0 + t8;
                    const int tt = hf * LH + t, seg = tt / seglen, i = tt % seglen;
                    if (i == 0) { hs = smp ? slru[(size_t)(l * DB + b0 + seg) * 256 + o] : 0.f; Ps = 1.f; }
                    const float rg = GX[t * 256 + o], g = GX[(32 + t) * 256 + o];
                    const float av = __builtin_amdgcn_exp2f(-8.0f * rg * spv);
                    const float mult = __builtin_amdgcn_sqrtf(fmaxf(1.0f - av * av, 0.f));
                    const float bv = mult * g * XC[tt * 256 + o];
                    const size_t m = (size_t)(m0 + tt);
                    hs = av * hs + bv; Ps *= av;
                    if (smp) { OB[m * DM + 256 + o] = (bf16)f2bf(hs * siluf_(gts[t8])); if (i == seglen - 1) a.out[OUT_LRU_S + (size_t)(l * DB + b0 + seg) * 256 + o] = hs; }
                    else { LA[m * 256 + o] = av; LB[m * 256 + o] = bv; }
                }
              }
            }
            __syncthreads();
        }
        if (!smp && p == 0) { ((float*)(a.ws + WS_LP))[(size_t)(s * 32 + ch) * 256 + o] = Ps; ((float*)(a.ws + WS_LE))[(size_t)(s * 32 + ch) * 256 + o] = hs; }
    }
    __syncthreads();
}

__device__ __forceinline__ void rwkv_prep_item(const Ctx& a, int l, int item, LAS unsigned char* lds, int tid) {
    OPAQUE(tid);
    const bf16* PROJ = (const bf16*)(a.ws + WS_PROJ);
    float* RW = (float*)(a.ws + WS_RW);
    const float* mu = a.inp(I_MU) + l * 1280; const float* sshift = a.inp(I_SSHIFT) + (size_t)l * DB * 1280;
    LAS float* XWA = (LAS float*)lds;
    LAS float* T1 = (LAS float*)(lds + 65536);
    const int m0 = item * 32;
#pragma unroll
    for (int kb = 0; kb < 20; kb += 10) {
        f32x4 pv[10], ppv[10], psv[10];
#pragma unroll
        for (int k = 0; k < 10; ++k) {
            const int idx = tid + NTHREADS * (kb + k), t = idx / 320, c4 = idx % 320, col = 4 * c4, m = m0 + t;
            const bool first = (m < NP) ? ((m & (SEQ - 1)) == 0) : (((m - NP) & 7) == 0);
            const bool fromstate = first && m >= NP;
            pv[k] = ldp4(PROJ + (size_t)m * DIN + OFF_C + col);
            ppv[k] = ldp4(PROJ + (size_t)(first ? m : m - 1) * DIN + OFF_C + col);
            psv[k] = *(const f32x4*)(sshift + (fromstate ? (size_t)((m - NP) >> 3) * 1280 : (size_t)0) + col);
        }
#pragma unroll
        for (int k = 0; k < 10; ++k) {
            const int idx = tid + NTHREADS * (kb + k), t = idx / 320, c4 = idx % 320, col = 4 * c4, m = m0 + t;
            const bool first = (m < NP) ? ((m & (SEQ - 1)) == 0) : (((m - NP) & 7) == 0);
            f32x4 pp = ppv[k];
            if (first && m >= NP) pp = psv[k];
            if (first && m < NP) pp = (f32x4){0.f, 0.f, 0.f, 0.f};
            const f32x4 xm = pv[k] + (pp - pv[k]) * *(const f32x4*)(mu + col);
            const int sec = c4 >> 6, cc = col & 255;
            if (sec == 1) *(LAS f32x4*)(XWA + t * 512 + cc) = xm;
            else if (sec == 4) *(LAS f32x4*)(XWA + t * 512 + 256 + cc) = xm;
            else *(f32x4*)(RW + (size_t)m * 1536 + (sec == 0 ? 0 : (sec == 2 ? 512 : 768)) + cc) = xm;
        }
    }
    __syncthreads();
    if (tid < 128) {
        const int lane = tid & 63, p = tid >> 6, r = lane & 31, hh = lane >> 5;
        const bf16* wt = (const bf16*)(a.ws + WS_W1T) + ((size_t)(l * 2 + p) * 32 + r) * 256 + 8 * hh;
        const LAS float* xr = XWA + r * 512 + p * 256 + 8 * hh;
        f32x16 acc;
#pragma unroll
        for (int e = 0; e < 16; ++e) acc[e] = 0.f;
#pragma unroll
        for (int sx = 0; sx < 16; ++sx) {
            const bf16x8 af = *(const bf16x8*)(wt + 16 * sx);
            const f32x4 x0 = *(const LAS f32x4*)(xr + 16 * sx), x1 = *(const LAS f32x4*)(xr + 16 * sx + 4);
            u32x4 w; w.x = pk2(x0.x, x0.y); w.y = pk2(x0.z, x0.w); w.z = pk2(x1.x, x1.y); w.w = pk2(x1.z, x1.w);
            acc = __builtin_amdgcn_mfma_f32_32x32x16_bf16(af, __builtin_bit_cast(bf16x8, w), acc, 0, 0, 0);
        }
#pragma unroll
        for (int g4 = 0; g4 < 4; ++g4) { f32x4 v = (f32x4){acc[4 * g4], acc[4 * g4 + 1], acc[4 * g4 + 2], acc[4 * g4 + 3]};
            if (p == 0) { v.x = tanhf_(v.x); v.y = tanhf_(v.y); v.z = tanhf_(v.z); v.w = tanhf_(v.w); }
            *(LAS f32x4*)(T1 + r * 64 + p * 32 + 8 * g4 + 4 * hh) = v; }
    }
    __syncthreads();
    {
        const int o = tid & 255, half = tid >> 8;
        float wr[32];
        const float* w2p = (half ? a.inp(I_A2) : a.inp(I_W2)) + (size_t)l * 32 * 256 + o;
#pragma unroll
        for (int j = 0; j < 32; ++j) wr[j] = w2p[(size_t)j * 256];
        const float b0 = (half ? a.inp(I_A0) : a.inp(I_W0))[l * 256 + o];
        const float kkw = a.inp(I_KK)[l * 256 + o], kaw = a.inp(I_KA)[l * 256 + o];
#pragma unroll
        for (int t0 = 0; t0 < 32; t0 += 8) {
            float xk_[8];
            if (half) {
#pragma unroll
                for (int t = 0; t < 8; ++t) xk_[t] = RW[(size_t)(m0 + t0 + t) * 1536 + 512 + o]; }
#pragma unroll
            for (int t8 = 0; t8 < 8; ++t8) {
                const int t = t0 + t8;
                float z0 = b0, z1 = 0.f;
                const LAS float* tp = T1 + t * 64 + half * 32;
#pragma unroll
                for (int j4 = 0; j4 < 8; ++j4) { const f32x4 tv = *(const LAS f32x4*)(tp + 4 * j4);
                    z0 += tv.x * wr[4 * j4] + tv.y * wr[4 * j4 + 1]; z1 += tv.z * wr[4 * j4 + 2] + tv.w * wr[4 * j4 + 3]; }
                const float z = z0 + z1;
                float* rwp = RW + (size_t)(m0 + t) * 1536 + o;
                if (half == 0) {
                    rwp[256] = __builtin_amdgcn_exp2f(-0.8750566294f * sigmoidf_(z));
                } else {
                    const float aa = sigmoidf_(z);
                    const float xk = xk_[t8];
                    const float kkv = xk * kkw;
                    const float ss = wave_sum_fast(kkv * kkv);
                    const float kkn = kkv * __builtin_amdgcn_rsqf(fmaxf(ss, 1e-24f));
                    rwp[512] = xk * (1.0f + (aa - 1.0f) * kaw); rwp[1024] = -kkn; rwp[1280] = kkn * aa;
                }
            }
        }
    }
    __syncthreads();
}

__device__ __forceinline__ void s5_disc(const Ctx& a, int l, int g, int n, float& ab_re, float& ab_im, float& f_re, float& f_im) {
    const f32x4 t = *(const f32x4*)((const float*)(a.ws + WS_S5T) + ((size_t)(l * 16 + g) * 64 + n) * 4);
    ab_re = t.x; ab_im = t.y; f_re = t.z; f_im = t.w;
}
__device__ __forceinline__ void s5_disc_compute(const Ctx& a, int l, int g, int n, float& ab_re, float& ab_im, float& f_re, float& f_im) {
    const float lr = a.inp(I_LRE)[(l * 16 + g) * 64 + n], li = a.inp(I_LIM)[(l * 16 + g) * 64 + n];
    const float dt = expf(a.inp(I_LOGDT)[l * 16 + g]);
    const float mag = expf(lr * dt);
    ab_re = mag * cosf(li * dt); ab_im = mag * sinf(li * dt);
    const float den = lr * lr + li * li, pr = ab_re - 1.0f;
    f_re = (pr * lr + ab_im * li) / den; f_im = (ab_im * lr - pr * li) / den;
}
struct S5Par { float ab_re, ab_im; bf16x8 bf[4]; };
__device__ __forceinline__ void s5_params(const Ctx& a, int l, int g, int lane, S5Par& P) {
    float fr, fi;
    s5_disc(a, l, g, lane, P.ab_re, P.ab_im, fr, fi);
    const int r = lane & 31, hh = lane >> 5;
#pragma unroll
    for (int nh = 0; nh < 2; ++nh) {
        float xr, xi, f_re, f_im;
        s5_disc(a, l, g, 32 * nh + r, xr, xi, f_re, f_im);
        const float* brp = a.inp(I_BRE) + ((size_t)(l * 16 + g) * 64 + 32 * nh + r) * 16 + 8 * hh; const float* bip = a.inp(I_BIM) + ((size_t)(l * 16 + g) * 64 + 32 * nh + r) * 16 + 8 * hh;
        const f32x4 r0 = *(const f32x4*)brp, r1 = *(const f32x4*)(brp + 4), i0 = *(const f32x4*)bip, i1 = *(const f32x4*)(bip + 4);
        u32x4 wr, wi;
        wr.x = pk2(f_re * r0.x - f_im * i0.x, f_re * r0.y - f_im * i0.y); wr.y = pk2(f_re * r0.z - f_im * i0.z, f_re * r0.w - f_im * i0.w);
        wr.z = pk2(f_re * r1.x - f_im * i1.x, f_re * r1.y - f_im * i1.y); wr.w = pk2(f_re * r1.z - f_im * i1.z, f_re * r1.w - f_im * i1.w);
        wi.x = pk2(f_re * i0.x + f_im * r0.x, f_re * i0.y + f_im * r0.y); wi.y = pk2(f_re * i0.z + f_im * r0.z, f_re * i0.w + f_im * r0.w);
        wi.z = pk2(f_re * i1.x + f_im * r1.x, f_re * i1.y + f_im * r1.y); wi.w = pk2(f_re * i1.z + f_im * r1.z, f_re * i1.w + f_im * r1.w);
        P.bf[nh] = __builtin_bit_cast(bf16x8, wr); P.bf[2 + nh] = __builtin_bit_cast(bf16x8, wi);
    }
}
__device__ __forceinline__ void s5_bu_block(const S5Par& P, const bf16* PROJ, size_t m0, int nvalid, int g, LAS float* HR, LAS float* HI, int lane) {
    const int r = lane & 31, hh = lane >> 5;
    const int tr = r < nvalid ? r : nvalid - 1;
    const bf16x8 uf = *(const bf16x8*)(PROJ + (m0 + tr) * DIN + OFF_D + g * 16 + 8 * hh);
#pragma unroll
    for (int tile = 0; tile < 4; ++tile) {
        f32x16 acc;
#pragma unroll
        for (int e = 0; e < 16; ++e) acc[e] = 0.f;
        acc = __builtin_amdgcn_mfma_f32_32x32x16_bf16(P.bf[tile], uf, acc, 0, 0, 0);
        LAS float* dst = ((tile >> 1) ? HI : HR) + r * 68 + 32 * (tile & 1) + 4 * hh;
#pragma unroll
        for (int g4 = 0; g4 < 4; ++g4) *(LAS f32x4*)(dst + 8 * g4) = (f32x4){acc[4 * g4], acc[4 * g4 + 1], acc[4 * g4 + 2], acc[4 * g4 + 3]};
    }
    asm volatile("s_waitcnt lgkmcnt(0)" ::: "memory");
}
__device__ __forceinline__ void s5_pass1_wave(const Ctx& a, int l, int wi, LAS unsigned char* wlds, int lane) {
    OPAQUE(lane);
    const int ck = wi & 15, g = (wi >> 4) & 15, s = wi >> 8;
    const bf16* PROJ = (const bf16*)(a.ws + WS_PROJ);
    LAS float* HR = (LAS float*)wlds; LAS float* HI = HR + 32 * 68;
    S5Par P; s5_params(a, l, g, lane, P);
    float hr = 0.f, hi = 0.f;
    for (int t0 = 0; t0 < 128; t0 += 32) {
        s5_bu_block(P, PROJ, (size_t)(s * SEQ + ck * 128 + t0), 32, g, HR, HI, lane);
#pragma unroll 8
        for (int t = 0; t < 32; ++t) { const float br = HR[t * 68 + lane], bi = HI[t * 68 + lane];
            const float nr = P.ab_re * hr - P.ab_im * hi + br, ni = P.ab_re * hi + P.ab_im * hr + bi; hr = nr; hi = ni; }
        asm volatile("s_waitcnt lgkmcnt(0)" ::: "memory");
    }
    f32x2* E = (f32x2*)(a.ws + WS_S5E);
    E[((size_t)(s * 16 + g) * 16 + ck) * 64 + lane] = (f32x2){hr, hi};
}

__device__ __forceinline__ void attn_prep_rows_wave(const Ctx& a, int wi, int lane) {
    OPAQUE(lane);
    const bf16* PROJ = (const bf16*)(a.ws + WS_PROJ);
    bf16* QB = (bf16*)(a.ws + WS_QB);
#pragma unroll
    for (int r = 0; r < 8; ++r) { const size_t m = (size_t)wi * 8 + r;
        const f32x4 q = ldp4(PROJ + m * DIN + OFF_AQ + 4 * lane);
        u32x2 qo; qo.x = pk2(q.x * QSCALE, q.y * QSCALE); qo.y = pk2(q.z * QSCALE, q.w * QSCALE);
        *(u32x2*)(QB + m * 256 + 4 * lane) = qo; }
}
__device__ __forceinline__ void attn_prep_kv_wave(const Ctx& a, int wi, int lane) {
    OPAQUE(lane);
    const bf16* PROJ = (const bf16*)(a.ws + WS_PROJ);
    bf16* KF = (bf16*)(a.ws + WS_KB); bf16* VF = (bf16*)(a.ws + WS_VT);
    const int kt = wi & 63, b = wi >> 6, r = lane & 31, hh = lane >> 5;
    const bf16* krow = PROJ + (size_t)(b * SEQ + kt * 32 + r) * DIN + OFF_AK + 8 * hh;
    const bf16* vcol = PROJ + (size_t)(b * SEQ + kt * 32 + 4 * hh) * DIN + OFF_AV + r;
#pragma unroll
    for (int h = 0; h < 4; ++h) {
#pragma unroll
        for (int cs = 0; cs < 4; ++cs) {
            const u32x4 ko = *(const u32x4*)(krow + h * 64 + cs * 16);
            const size_t frag = ((size_t)((b * 4 + h) * 64 + kt) * 4 + cs) * 512 + lane * 8;
            *(u32x4*)(KF + frag) = ko;
            const int tl = cs >> 1, s2 = cs & 1;
            const bf16* vp = vcol + (size_t)(16 * s2) * DIN + h * 64 + 32 * tl;
            unsigned v[8];
#pragma unroll
            for (int jj = 0; jj < 8; ++jj) v[jj] = (unsigned)vp[(size_t)(8 * (jj >> 2) + (jj & 3)) * DIN];
            u32x4 vo; vo.x = v[0] | (v[1] << 16); vo.y = v[2] | (v[3] << 16); vo.z = v[4] | (v[5] << 16); vo.w = v[6] | (v[7] << 16);
            *(u32x4*)(VF + frag) = vo;
        }
    }
}

#ifndef MP_MASK
#define MP_MASK 0x1f
#endif
#ifndef MM_MASK
#define MM_MASK 0x7f
#endif
#define MPE(j) ((MP_MASK >> (j)) & 1)
#define MME(j) ((MM_MASK >> (j)) & 1)
constexpr int MP_LRU = 256 + 32, MP_RW = MTOK / 32, MP_S5 = 256  , MP_AR = 256  , MP_VT = 64  ;
constexpr int MP_TOTAL = MP_LRU + MP_RW + MP_S5 + MP_AR + MP_VT;
__device__ __forceinline__ int grab_unit(unsigned* ctr, volatile LAS unsigned* MISC, int tid) {
    __syncthreads();
    if (tid == 0) MISC[4] = atomicAdd(ctr, 1u);
    __syncthreads();
    return (int)MISC[4];
}
__device__ __forceinline__ void ph_mixprep(const Ctx& a, int lq, int MMSK, LAS unsigned char* lds, volatile LAS unsigned* MISC, int tid, int lane, int wave) {
    const int l = lq & 1;
    unsigned* qctr = (unsigned*)(a.ws + WS_CTL) + CW_QUEUE + 4096 + 512 * lq;
    int u;
    if (MMSK & 1) while ((u = grab_unit(qctr + 0 * 64, MISC, tid)) < MP_LRU) lru_prep_item(a, l, u, lds, tid);
    if (MMSK & 2) while ((u = grab_unit(qctr + 1 * 64, MISC, tid)) < MP_RW) rwkv_prep_item(a, l, u, lds, tid);
    if (MMSK & 4) while ((u = grab_unit(qctr + 2 * 64, MISC, tid)) < MP_S5) s5_pass1_wave(a, l, u * 8 + wave, lds + wave * 17408, lane);
    if (MMSK & 8) while ((u = grab_unit(qctr + 3 * 64, MISC, tid)) < MP_AR) attn_prep_rows_wave(a, u * 8 + wave, lane);
    if (MMSK & 16) while ((u = grab_unit(qctr + 4 * 64, MISC, tid)) < MP_VT) attn_prep_kv_wave(a, u * 8 + wave, lane);
    {
        const bf16* PROJ = (const bf16*)(a.ws + WS_PROJ);
        const int gt = blockIdx.x * NTHREADS + tid, NGT = gridDim.x * NTHREADS;
        for (int idx = gt; idx < 136 * 1280; idx += NGT) {
            const int q = idx / 1280, c = idx % 1280;
            if (q < 8) a.out[OUT_SHIFT_P + (size_t)(l * 8 + q) * 1280 + c] = ldp1(PROJ + (size_t)(q * SEQ + SEQ - 1) * DIN + OFF_C + c);
            else a.out[OUT_SHIFT_S + (size_t)(l * DB + (q - 8)) * 1280 + c] = ldp1(PROJ + (size_t)(NP + (q - 8) * 8 + 7) * DIN + OFF_C + c);
        }
    }
}

struct RwOps { f32x2 w[4], k[4], a[4], b[4], r[4]; float vi; };
__device__ __forceinline__ void rw_ld4(f32x2 (&d)[4], const LAS float* p) { const f32x4 x = *(const LAS f32x4*)p, y = *(const LAS f32x4*)(p + 4);
    d[0] = (f32x2){x.x, x.y}; d[1] = (f32x2){x.z, x.w}; d[2] = (f32x2){y.x, y.y}; d[3] = (f32x2){y.z, y.w}; }
template <int MODE> __device__ __forceinline__ void rw_load_ops(RwOps& o, const LAS float* base, int i, int jq) {
    rw_ld4(o.w, base + 64 + 8 * jq); rw_ld4(o.k, base + 128 + 8 * jq);
    o.vi = base[192 + i];
    rw_ld4(o.a, base + 256 + 8 * jq); rw_ld4(o.b, base + 320 + 8 * jq);
    if (MODE == 0) rw_ld4(o.r, base + 8 * jq);
}
__device__ __forceinline__ float rw_dot(const f32x2 (&S)[4], const f32x2 (&v)[4]) {
    const f32x2 d0 = S[0] * v[0] + S[1] * v[1], d1 = S[2] * v[2] + S[3] * v[3];
    const f32x2 d = d0 + d1;
    return d.x + d.y;
}
template <int MODE> __device__ __forceinline__ void rw_step(const RwOps& o, f32x2 (&S)[4], f32x2 (&Pm)[4], LAS float* yslot, int jq) {
    const float sa = red8(rw_dot(S, o.a));
    const f32x2 sa2 = (f32x2){sa, sa}, vi2 = (f32x2){o.vi, o.vi};
#pragma unroll
    for (int k = 0; k < 4; ++k) S[k] = (S[k] * o.w[k] + vi2 * o.k[k]) + sa2 * o.b[k];
    if (MODE == 0) {
        const float y = red8(rw_dot(S, o.r));
        if (jq == 0) *yslot = y;
    } else {
        const float sp = red8(rw_dot(Pm, o.a));
        const f32x2 sp2 = (f32x2){sp, sp};
#pragma unroll
        for (int k = 0; k < 4; ++k) Pm[k] = Pm[k] * o.w[k] + sp2 * o.b[k];
    }
}
template <int MODE, int TT>
__device__ __forceinline__ void rwkv_core(const Ctx& a, int l, int h, int mbase, int T, float (&S8)[8], float (&P8)[8], LAS unsigned char* lds, int tid) {
    f32x2 S[4], Pm[4];
#pragma unroll
    for (int k = 0; k < 4; ++k) { S[k] = (f32x2){S8[2 * k], S8[2 * k + 1]}; Pm[k] = (f32x2){P8[2 * k], P8[2 * k + 1]}; }
    const float* RW = (const float*)(a.ws + WS_RW);
    const f32x4 rk4 = *(const f32x4*)(a.inp(I_RK) + l * 256 + h * 64 + 4 * (tid & 15));
    bf16* OB = (bf16*)(a.ws + WS_OB); const bf16* PROJ = (const bf16*)(a.ws + WS_PROJ);
    LAS float* RWT = (LAS float*)lds;
    LAS float* Y = (LAS float*)(lds + 49152);
    const int i = tid >> 3, jq = tid & 7;
    f32x4 pre[6];
#define RW_LOAD(tile) do { _Pragma("unroll") for (int k = 0; k < 6; ++k) { const int idx = tid + NTHREADS * k; \
        if (idx < TT * 96) { const int t = idx / 96, rem = idx % 96, sec = rem >> 4, c4 = rem & 15; \
            pre[k] = *(const f32x4*)(RW + (size_t)(mbase + (tile) * TT + t) * 1536 + sec * 256 + h * 64 + 4 * c4); } } } while (0)
#define RW_STORE() do { _Pragma("unroll") for (int k = 0; k < 6; ++k) { const int idx = tid + NTHREADS * k; \
        if (idx < TT * 96) *(LAS f32x4*)(RWT + idx * 4) = pre[k]; } } while (0)
    const int ntile = T / TT;
    const int gt_t = tid >> 4, gt_q = tid & 15;
    f32x4 gn_w = (f32x4){0.f, 0.f, 0.f, 0.f}, gn_b = gn_w, gpre = gn_w;
    if (MODE == 0) { gn_w = *(const f32x4*)(a.inp(I_GNW) + l * 256 + h * 64 + 4 * gt_q); gn_b = *(const f32x4*)(a.inp(I_GNB) + l * 256 + h * 64 + 4 * gt_q); }
    RW_LOAD(0);
    __syncthreads();
    RW_STORE();
    __syncthreads();
    for (int tile = 0; tile < ntile; ++tile) {
        if (tile + 1 < ntile) RW_LOAD(tile + 1);
        if (MODE == 0 && gt_t < TT) gpre = ldp4(PROJ + (size_t)(mbase + tile * TT + gt_t) * DIN + OFF_G + 512 + h * 64 + 4 * gt_q);
        {
            RwOps oa, ob;
            rw_load_ops<MODE>(oa, RWT, i, jq);
            for (int t = 0; t < TT; t += 2) {
                rw_load_ops<MODE>(ob, RWT + (t + 1) * 384, i, jq);
                rw_step<MODE>(oa, S, Pm, Y + t * 64 + i, jq);
                rw_load_ops<MODE>(oa, RWT + (t + 2) * 384, i, jq);
                rw_step<MODE>(ob, S, Pm, Y + (t + 1) * 64 + i, jq);
            }
        }
        __syncthreads();
        if (MODE == 0) {
            const int t = tid >> 4, q = tid & 15;
            if (t < TT) {
                const f32x4 yv = *(const LAS f32x4*)(Y + t * 64 + 4 * q);
                const float mean = red16((yv.x + yv.y) + (yv.z + yv.w)) * (1.f / 64.f);
                const f32x4 dv = yv - mean;
                const float rs = rsqrtf(red16((dv.x * dv.x + dv.y * dv.y) + (dv.z * dv.z + dv.w * dv.w)) * (1.f / 64.f) + 64.0f * 1e-5f);
                const int m = mbase + tile * TT + t;
                const f32x4 gw = gn_w, gb = gn_b;
                const f32x4 vv = *(const LAS f32x4*)(RWT + t * 384 + 192 + 4 * q);
                const f32x4 r4 = *(const LAS f32x4*)(RWT + t * 384 + 4 * q), k4 = *(const LAS f32x4*)(RWT + t * 384 + 128 + 4 * q);
                const float bon = red16((r4.x * k4.x * rk4.x + r4.y * k4.y * rk4.y) + (r4.z * k4.z * rk4.z + r4.w * k4.w * rk4.w));
                const f32x4 o = dv * rs * gw + gb + bon * vv;
                const f32x4 gt = gpre;
                u32x2 ow; ow.x = pk2(o.x * siluf_(gt.x), o.y * siluf_(gt.y)); ow.y = pk2(o.z * siluf_(gt.z), o.w * siluf_(gt.w));
                *(u32x2*)(OB + (size_t)m * DM + 512 + h * 64 + 4 * q) = ow;
            }
            __syncthreads();
        }
        if (tile + 1 < ntile) { RW_STORE(); }
        __syncthreads();
    }
#undef RW_LOAD
#undef RW_STORE
#pragma unroll
    for (int k = 0; k < 4; ++k) { S8[2 * k] = S[k].x; S8[2 * k + 1] = S[k].y; P8[2 * k] = Pm[k].x; P8[2 * k + 1] = Pm[k].y; }
}
__device__ __forceinline__ void st8(float* dst, const float (&S)[8]) { *(f32x4*)dst = (f32x4){S[0], S[1], S[2], S[3]}; *(f32x4*)(dst + 4) = (f32x4){S[4], S[5], S[6], S[7]}; }
__device__ __forceinline__ void ld8(const float* src, float (&S)[8]) { const f32x4 s0 = *(const f32x4*)src, s1 = *(const f32x4*)(src + 4);
    S[0] = s0.x; S[1] = s0.y; S[2] = s0.z; S[3] = s0.w; S[4] = s1.x; S[5] = s1.y; S[6] = s1.z; S[7] = s1.w; }
__device__ __forceinline__ void rwkv_sample_unit(const Ctx& a, int l, int b, int h, LAS unsigned char* lds, int tid) {
    OPAQUE(tid);
    const int i = tid >> 3, jq = tid & 7;
    float S[8], D[8];
    ld8(a.inp(I_SWKV) + (((size_t)(l * DB + b) * 4 + h) * 64 + i) * 64 + 8 * jq, S);
    rwkv_core<0, 8>(a, l, h, NP + b * DS, DS, S, D, lds, tid);
    st8(a.out + OUT_WKV_S + (((size_t)(l * DB + b) * 4 + h) * 64 + i) * 64 + 8 * jq, S);
}
__device__ __forceinline__ void rwkv_prompt_unitA(const Ctx& a, int l, int u, LAS unsigned char* lds, int tid) {
    OPAQUE(tid);
    const int c = u & 7, h = (u >> 3) & 3, s = u >> 5;
    if (c == 7) return;
    const int i = tid >> 3, jq = tid & 7;
    float* pz = (float*)(a.ws + WS_PZ) + ((size_t)((s * 4 + h) * 8 + c) * 2) * 4096 + i * 64 + 8 * jq;
    float S[8], Pm[8];
#pragma unroll
    for (int e = 0; e < 8; ++e) { S[e] = 0.f; Pm[e] = (8 * jq + e == i) ? 1.f : 0.f; }
    if (c == 0) { rwkv_core<0, 32>(a, l, h, s * SEQ, 256, S, Pm, lds, tid); st8(pz + 4096, S); }
    else { rwkv_core<1, 32>(a, l, h, s * SEQ + c * 256, 256, S, Pm, lds, tid); st8(pz, Pm); st8(pz + 4096, S); }
}
__device__ __forceinline__ void rwkv_prompt_unitB(const Ctx& a, int l, int u, LAS unsigned char* lds, int tid) {
    OPAQUE(tid);
    const int c = 7 - (u >> 5), sh = u & 31, s = sh >> 2, h = sh & 3;
    const int i = tid >> 3, jq = tid & 7;
    const float* pzb = (const float*)(a.ws + WS_PZ) + ((size_t)(sh * 8) * 2) * 4096;
    LAS float* SL = (LAS float*)lds;
    LAS float* PL = (LAS float*)(lds + 17408);
    float S[8], Z[8];
    ld8(pzb + 4096 + i * 64 + 8 * jq, S);
    {
        f32x4 pp[6][2]; float ZZ[6][8];
#pragma unroll
        for (int cp = 1; cp <= 6; ++cp) if (cp < c) { const float* pg = pzb + (size_t)cp * 8192;
            pp[cp - 1][0] = *(const f32x4*)(pg + tid * 4); pp[cp - 1][1] = *(const f32x4*)(pg + (tid + NTHREADS) * 4); ld8(pg + 4096 + i * 64 + 8 * jq, ZZ[cp - 1]); }
        __syncthreads();
#pragma unroll
        for (int cp = 1; cp <= 6; ++cp) if (cp < c) { *(LAS f32x4*)(PL + (cp - 1) * 4096 + tid * 4) = pp[cp - 1][0]; *(LAS f32x4*)(PL + (cp - 1) * 4096 + (tid + NTHREADS) * 4) = pp[cp - 1][1]; }
#pragma unroll
        for (int cp = 1; cp <= 6; ++cp) if (cp < c) {
            __syncthreads();
            *(LAS f32x4*)(SL + i * 68 + 8 * jq) = (f32x4){S[0], S[1], S[2], S[3]}; *(LAS f32x4*)(SL + i * 68 + 8 * jq + 4) = (f32x4){S[4], S[5], S[6], S[7]};
            __syncthreads();
            const LAS float* PLc = PL + (cp - 1) * 4096;
#pragma unroll
            for (int e = 0; e < 8; ++e) Z[e] = ZZ[cp - 1][e];
#pragma unroll 4
            for (int k4 = 0; k4 < 16; ++k4) {
                const f32x4 sv = *(const LAS f32x4*)(SL + i * 68 + 4 * k4);
#pragma unroll
                for (int kk = 0; kk < 4; ++kk) { const f32x4 q0 = *(const LAS f32x4*)(PLc + (4 * k4 + kk) * 64 + 8 * jq), q1 = *(const LAS f32x4*)(PLc + (4 * k4 + kk) * 64 + 8 * jq + 4);
                    const float x = sv[kk];
                    Z[0] += x * q0.x; Z[1] += x * q0.y; Z[2] += x * q0.z; Z[3] += x * q0.w; Z[4] += x * q1.x; Z[5] += x * q1.y; Z[6] += x * q1.z; Z[7] += x * q1.w; }
            }
#pragma unroll
            for (int e = 0; e < 8; ++e) S[e] = Z[e];
        }
    }
    rwkv_core<0, 32>(a, l, h, s * SEQ + c * 256, 256, S, Z, lds, tid);
    if (c == 7) st8(a.out + OUT_WKV_P + (((size_t)(l * 8 + s) * 4 + h) * 64 + i) * 64 + 8 * jq, S);
}

__device__ __forceinline__ void lru_pass2_wave(const Ctx& a, int l, int wi, int lane) {
    OPAQUE(lane);
    const int q = wi & 3, ch = (wi >> 2) & 31, s = wi >> 7;
    const int o = q * 64 + lane;
    const float* LA = (const float*)(a.ws + WS_LA); const float* LB = (const float*)(a.ws + WS_LB);
    const float* LP = (const float*)(a.ws + WS_LP); const float* LE = (const float*)(a.ws + WS_LE);
    bf16* OB = (bf16*)(a.ws + WS_OB); const bf16* PROJ = (const bf16*)(a.ws + WS_PROJ);
    float h = 0.f;
#pragma unroll 8
    for (int c = 0; c < ch; ++c) h = LP[(size_t)(s * 32 + c) * 256 + o] * h + LE[(size_t)(s * 32 + c) * 256 + o];
    const size_t m0 = (size_t)s * SEQ + ch * 64;
#pragma unroll
    for (int i0 = 0; i0 < 64; i0 += 32) {
        float av[32], bv[32], gv[32];
#pragma unroll
        for (int i = 0; i < 32; ++i) { av[i] = LA[(m0 + i0 + i) * 256 + o]; bv[i] = LB[(m0 + i0 + i) * 256 + o]; gv[i] = ldp1(PROJ + (m0 + i0 + i) * DIN + OFF_G + 256 + o); }
#pragma unroll
        for (int i = 0; i < 32; ++i) { h = av[i] * h + bv[i]; OB[(m0 + i0 + i) * DM + 256 + o] = (bf16)f2bf(h * siluf_(gv[i])); }
    }
    if (ch == 31) a.out[OUT_LRU_P + (size_t)(l * 8 + s) * 256 + o] = h;
}

__device__ __forceinline__ float gelu_tanh(float y) { return 0.5f * y * (1.0f + tanhf_(0.7978845608028654f * (y + 0.044715f * y * y * y))); }
__device__ __forceinline__ void s5_pass2_wave(const Ctx& a, int l, bool smp, int wi, LAS unsigned char* wlds, int lane) {
    OPAQUE(lane);
    const bf16* PROJ = (const bf16*)(a.ws + WS_PROJ);
    bf16* ZB = (bf16*)(a.ws + WS_ZB);
    LAS float* HR = (LAS float*)wlds;
    LAS float* HI = HR + 32 * 68;
    int g, mbase, T, ck = 0, sq;
    if (smp) { g = wi & 15; sq = wi >> 4; mbase = NP + sq * DS; T = DS; }
    else { ck = wi & 15; g = (wi >> 4) & 15; sq = wi >> 8; mbase = sq * SEQ + ck * 128; T = 128; }
    S5Par P; s5_params(a, l, g, lane, P);
    float hr, hi;
    if (smp) { const f32x2 v = *(const f32x2*)(a.inp(I_SSSM) + (((size_t)(l * DB + sq) * 16 + g) * 64 + lane) * 2); hr = v.x; hi = v.y; }
    else {
        float pr = P.ab_re, pi = P.ab_im;
#pragma unroll
        for (int k = 0; k < 7; ++k) { const float nr = pr * pr - pi * pi, ni = 2.0f * pr * pi; pr = nr; pi = ni; }
        hr = 0.f; hi = 0.f;
        const f32x2* E = (const f32x2*)(a.ws + WS_S5E) + ((size_t)(sq * 16 + g) * 16) * 64 + lane;
        for (int c = 0; c < ck; ++c) { const f32x2 e = E[(size_t)c * 64]; const float nr = pr * hr - pi * hi + e.x, ni = pr * hi + pi * hr + e.y; hr = nr; hi = ni; }
    }
    const int cc = lane & 15, kq = lane >> 4;
    bf16x8 cf[4];
    {
        const float* crp = a.inp(I_CRE) + ((size_t)(l * 16 + g) * 16 + cc) * 64 + 8 * kq; const float* cip = a.inp(I_CIM) + ((size_t)(l * 16 + g) * 16 + cc) * 64 + 8 * kq;
#pragma unroll
        for (int ks = 0; ks < 4; ++ks) { const float* p = (ks < 2 ? crp : cip) + 32 * (ks & 1); const float sg = ks < 2 ? 1.f : -1.f;
            const f32x4 x0 = *(const f32x4*)p, x1 = *(const f32x4*)(p + 4);
            u32x4 w; w.x = pk2(sg * x0.x, sg * x0.y); w.y = pk2(sg * x0.z, sg * x0.w); w.z = pk2(sg * x1.x, sg * x1.y); w.w = pk2(sg * x1.z, sg * x1.w); cf[ks] = __builtin_bit_cast(bf16x8, w); }
    }
    const f32x4 dd4 = *(const f32x4*)(a.inp(I_S5D) + l * 256 + g * 16 + 4 * kq);
    for (int t0 = 0; t0 < T; t0 += 32) {
        const int nt = (T - t0) < 32 ? (T - t0) : 32;
        s5_bu_block(P, PROJ, (size_t)(mbase + t0), nt, g, HR, HI, lane);
        for (int t = 0; t < nt; ++t) { const float br = HR[t * 68 + lane], bi = HI[t * 68 + lane];
            const float nr = P.ab_re * hr - P.ab_im * hi + br, ni = P.ab_re * hi + P.ab_im * hr + bi; hr = nr; hi = ni;
            HR[t * 68 + lane] = hr; HI[t * 68 + lane] = hi; }
        asm volatile("s_waitcnt lgkmcnt(0)" ::: "memory");
#pragma unroll
        for (int tt = 0; tt < 2; ++tt) {
            if (tt * 16 < nt) {
                f32x4 acc = (f32x4){0.f, 0.f, 0.f, 0.f};
#pragma unroll
                for (int ks = 0; ks < 4; ++ks) { const LAS float* hp = (ks < 2 ? HR : HI) + (tt * 16 + cc) * 68 + 32 * (ks & 1) + 8 * kq;
                    const f32x4 x0 = *(const LAS f32x4*)hp, x1 = *(const LAS f32x4*)(hp + 4);
                    u32x4 w; w.x = pk2(x0.x, x0.y); w.y = pk2(x0.z, x0.w); w.z = pk2(x1.x, x1.y); w.w = pk2(x1.z, x1.w);
                    acc = __builtin_amdgcn_mfma_f32_16x16x32_bf16(cf[ks], __builtin_bit_cast(bf16x8, w), acc, 0, 0, 0); }
                const int t = tt * 16 + cc;
                if (t < nt) { const size_t m = (size_t)(mbase + t0 + t);
                    const f32x4 u4 = ldp4(PROJ + m * DIN + OFF_D + g * 16 + 4 * kq);
                    u32x2 zz; zz.x = pk2(gelu_tanh(acc.x + dd4.x * u4.x), gelu_tanh(acc.y + dd4.y * u4.y)); zz.y = pk2(gelu_tanh(acc.z + dd4.z * u4.z), gelu_tanh(acc.w + dd4.w * u4.w));
                    *(u32x2*)(ZB + m * 256 + g * 16 + 4 * kq) = zz; }
            }
        }
        asm volatile("s_waitcnt lgkmcnt(0)" ::: "memory");
    }
    if (smp) *(f32x2*)(a.out + OUT_SSM_S + (((size_t)(l * DB + sq) * 16 + g) * 64 + lane) * 2) = (f32x2){hr, hi};
    else if (ck == 15) *(f32x2*)(a.out + OUT_SSM_P + (((size_t)(l * 8 + sq) * 16 + g) * 64 + lane) * 2) = (f32x2){hr, hi};
}

__device__ __forceinline__ bf16x8 pack8(const f32x16& p, int s) {
    u32x4 w; w.x = pk2(p[8 * s + 0], p[8 * s + 1]); w.y = pk2(p[8 * s + 2], p[8 * s + 3]); w.z = pk2(p[8 * s + 4], p[8 * s + 5]); w.w = pk2(p[8 * s + 6], p[8 * s + 7]);
    return __builtin_bit_cast(bf16x8, w);
}
__device__ __forceinline__ void attn_load4(const bf16* F, size_t fragbase, bf16x8 (&f)[4]) {
#pragma unroll
    for (int cs = 0; cs < 4; ++cs) f[cs] = *(const bf16x8*)(F + fragbase + cs * 512);
}
__device__ __forceinline__ void attn_tile(const bf16x8 (&qf)[2][2], const bf16x8 (&kf)[4], const bf16x8 (&vf)[4], f32x16 (&o)[2][2], float (&mrun)[2], float (&lrun)[2], bool diag, int r, int hh) {
    bf16x8 pf[2][2];
#pragma unroll
    for (int c = 0; c < 2; ++c) {
        f32x16 st;
#pragma unroll
        for (int e = 0; e < 16; ++e) st[e] = 0.f;
        st = __builtin_amdgcn_mfma_f32_32x32x16_bf16(kf[c * 2 + 0], qf[c][0], st, 0, 0, 0);
        st = __builtin_amdgcn_mfma_f32_32x32x16_bf16(kf[c * 2 + 1], qf[c][1], st, 0, 0, 0);
        if (diag) {
#pragma unroll
            for (int e = 0; e < 16; ++e) { const int key = (e & 3) + 8 * (e >> 2) + 4 * hh; if (key > r) st[e] = -1e30f; }
        }
        float mx = st[0];
#pragma unroll
        for (int e = 1; e < 16; ++e) mx = fmaxf(mx, st[e]);
        mx = fmaxf(mx, __shfl_xor(mx, 32));
        const bool upd = mx > mrun[c] + 8.0f;
        if (__any(upd)) {
            const float mnew = upd ? mx : mrun[c];
            const float corr = __builtin_amdgcn_exp2f(mrun[c] - mnew);
            lrun[c] *= corr; mrun[c] = mnew;
#pragma unroll
            for (int tl = 0; tl < 2; ++tl)
#pragma unroll
                for (int e = 0; e < 16; ++e) o[c][tl][e] *= corr;
        }
        float ps = 0.f;
        const float mcur = mrun[c];
#pragma unroll
        for (int e = 0; e < 16; ++e) { st[e] = __builtin_amdgcn_exp2f(st[e] - mcur); ps += st[e]; }
        lrun[c] += ps;
        pf[c][0] = pack8(st, 0); pf[c][1] = pack8(st, 1);
    }
#pragma unroll
    for (int c = 0; c < 2; ++c)
#pragma unroll
        for (int tl = 0; tl < 2; ++tl) {
            o[c][tl] = __builtin_amdgcn_mfma_f32_32x32x16_bf16(vf[tl * 2 + 0], pf[c][0], o[c][tl], 0, 0, 0);
            o[c][tl] = __builtin_amdgcn_mfma_f32_32x32x16_bf16(vf[tl * 2 + 1], pf[c][1], o[c][tl], 0, 0, 0);
        }
}
__device__ __forceinline__ void attn_prompt_wave(const Ctx& a, int l, int b, int h, int qt, float lam, int lane) {
    OPAQUE(lane);
    const bf16* QB = (const bf16*)(a.ws + WS_QB); const bf16* KF = (const bf16*)(a.ws + WS_KB); const bf16* VF = (const bf16*)(a.ws + WS_VT);
    bf16* OB = (bf16*)(a.ws + WS_OB); const bf16* PROJ = (const bf16*)(a.ws + WS_PROJ);
    const int r = lane & 31, hh = lane >> 5;
    const size_t mq = (size_t)b * SEQ + qt * 32 + r;
    bf16x8 qf[2][2];
#pragma unroll
    for (int c = 0; c < 2; ++c)
#pragma unroll
        for (int s = 0; s < 2; ++s) qf[c][s] = *(const bf16x8*)(QB + mq * 256 + h * 64 + c * 32 + 16 * s + 8 * hh);
    f32x16 o[2][2];
#pragma unroll
    for (int c = 0; c < 2; ++c)
#pragma unroll
        for (int tl = 0; tl < 2; ++tl)
#pragma unroll
            for (int e = 0; e < 16; ++e) o[c][tl][e] = 0.f;
    float mrun[2] = {-1e30f, -1e30f}, lrun[2] = {0.f, 0.f};
    const size_t fb0 = ((size_t)((b * 4 + h) * 64) * 4) * 512 + lane * 8;
    bf16x8 kA[4], kB[4], vv[4];
    attn_load4(KF, fb0, kA);
    int kt = 0;
    for (; kt + 1 <= qt; kt += 2) {
        attn_load4(VF, fb0 + (size_t)kt * 2048, vv);
        attn_load4(KF, fb0 + (size_t)(kt + 1) * 2048, kB);
        attn_tile(qf, kA, vv, o, mrun, lrun, false, r, hh);
        attn_load4(VF, fb0 + (size_t)(kt + 1) * 2048, vv);
        if (kt + 2 <= qt) attn_load4(KF, fb0 + (size_t)(kt + 2) * 2048, kA);
        attn_tile(qf, kB, vv, o, mrun, lrun, kt + 1 == qt, r, hh);
    }
    if (kt == qt) { attn_load4(VF, fb0 + (size_t)kt * 2048, vv); attn_tile(qf, kA, vv, o, mrun, lrun, true, r, hh); }
    const float l0 = lrun[0] + __shfl_xor(lrun[0], 32), l1 = lrun[1] + __shfl_xor(lrun[1], 32);
    const float i0 = 1.0f / l0, i1 = lam / l1;
    float ss = 0.f;
    f32x16 res[2];
#pragma unroll
    for (int tl = 0; tl < 2; ++tl)
#pragma unroll
        for (int e = 0; e < 16; ++e) { const float v = o[0][tl][e] * i0 - o[1][tl][e] * i1; res[tl][e] = v; ss += v * v; }
    ss += __shfl_xor(ss, 32);
    const float rs = rsqrtf(ss * (1.f / 64.f) + NORM_EPS) * (1.0f - lam_init_of(l));
    const float* sw = a.inp(I_SUBLN) + l * 64;
#pragma unroll
    for (int tl = 0; tl < 2; ++tl)
#pragma unroll
        for (int g4 = 0; g4 < 4; ++g4) { const int vd = 32 * tl + 8 * g4 + 4 * hh;
            const f32x4 w4 = *(const f32x4*)(sw + vd);
            f32x4 ov; ov.x = res[tl][4 * g4 + 0] * rs * w4.x; ov.y = res[tl][4 * g4 + 1] * rs * w4.y; ov.z = res[tl][4 * g4 + 2] * rs * w4.z; ov.w = res[tl][4 * g4 + 3] * rs * w4.w;
            const f32x4 gt = ldp4(PROJ + mq * DIN + OFF_G + h * 64 + vd);
            u32x2 ow; ow.x = pk2(ov.x * siluf_(gt.x), ov.y * siluf_(gt.y)); ow.y = pk2(ov.z * siluf_(gt.z), ov.w * siluf_(gt.w));
            *(u32x2*)(OB + mq * DM + h * 64 + vd) = ow; }
}

struct SmpK { f32x4 k[8]; };
__device__ __forceinline__ void smp_load(SmpK& d, const float* kp) {
#pragma unroll
    for (int t = 0; t < 8; ++t) d.k[t] = __builtin_nontemporal_load((const f32x4*)(kp + (size_t)t * 1024));
}
__device__ __forceinline__ void smp_group(const SmpK& d, const SmpK& dv, const f32x4 (&q)[8], f32x4 (&O)[4], float& M, float& Lsum, int nstep, bool isnew, int kk, int g, int lane) {
    float sc[8];
#pragma unroll
    for (int t = 0; t < 8; ++t) {
        float p[8];
#pragma unroll
        for (int i = 0; i < 8; ++i) p[i] = (d.k[t].x * q[i].x + d.k[t].y * q[i].y) + (d.k[t].z * q[i].z + d.k[t].w * q[i].w);
        float n4[4];
#pragma unroll
        for (int k = 0; k < 4; ++k) { const float keep = (g & 4) ? p[4 + k] : p[k], send = (g & 4) ? p[k] : p[4 + k]; n4[k] = keep + dpp_mov<0x141>(send); }
        float n2[2];
#pragma unroll
        for (int k = 0; k < 2; ++k) { const float keep = (g & 2) ? n4[2 + k] : n4[k], send = (g & 2) ? n4[k] : n4[2 + k]; n2[k] = keep + dpp_mov<0x4E>(send); }
        const float keep = (g & 1) ? n2[1] : n2[0], send = (g & 1) ? n2[0] : n2[1];
        float sv = keep + dpp_mov<0xB1>(send);
        if (t >= nstep || (isnew && (4 * t + kk) > g)) sv = -1e30f;
        sc[t] = sv;
    }
    float mx = fmaxf(fmaxf(fmaxf(sc[0], sc[1]), fmaxf(sc[2], sc[3])), fmaxf(fmaxf(sc[4], sc[5]), fmaxf(sc[6], sc[7])));
    mx = fmaxf(mx, __shfl_xor(mx, 16)); mx = fmaxf(mx, __shfl_xor(mx, 32));
    const float Mnew = fmaxf(M, mx);
    const float corr = __builtin_amdgcn_exp2f(M - Mnew);
    float ps = 0.f;
#pragma unroll
    for (int t = 0; t < 8; ++t) { sc[t] = __builtin_amdgcn_exp2f(sc[t] - Mnew); ps += sc[t]; }
    Lsum = Lsum * corr + ps; M = Mnew;
#pragma unroll
    for (int rg = 0; rg < 4; ++rg) { const float cr = __shfl(corr, (lane & 48) | (4 * kk + rg));
        O[0][rg] *= cr; O[1][rg] *= cr; O[2][rg] *= cr; O[3][rg] *= cr; }
    u32x4 pw; pw.x = pk2(sc[0], sc[1]); pw.y = pk2(sc[2], sc[3]); pw.z = pk2(sc[4], sc[5]); pw.w = pk2(sc[6], sc[7]);
    const bf16x8 pa = __builtin_bit_cast(bf16x8, pw);
#pragma unroll
    for (int e = 0; e < 4; ++e) {
        u32x4 vw; vw.x = pk2(dv.k[0][e], dv.k[1][e]); vw.y = pk2(dv.k[2][e], dv.k[3][e]); vw.z = pk2(dv.k[4][e], dv.k[5][e]); vw.w = pk2(dv.k[6][e], dv.k[7][e]);
        O[e] = __builtin_amdgcn_mfma_f32_16x16x32_bf16(pa, __builtin_bit_cast(bf16x8, vw), O[e], 0, 0, 0);
    }
}
__device__ __forceinline__ void attn_sample_wave(const Ctx& a, int l, int wi, int lane) {
    OPAQUE(lane);
    const int h = wi & 3, sp = (wi >> 2) % NSPLIT, b = (wi >> 2) / NSPLIT;
    const bf16* PROJ = (const bf16*)(a.ws + WS_PROJ);
    const int kk = lane >> 4, dq = lane & 15, g = lane & 7;
    f32x4 q[8];
#pragma unroll
    for (int i = 0; i < 8; ++i) { q[i] = ldp4(PROJ + (size_t)(NP + b * 8 + i) * DIN + OFF_AQ + h * 64 + 4 * dq); q[i] *= QSCALE; }
    const bool isnew = (sp == NSPLIT - 1);
    float M = -1e30f, Lsum = 0.f;
    f32x4 O[4];
#pragma unroll
    for (int e = 0; e < 4; ++e) O[e] = (f32x4){0.f, 0.f, 0.f, 0.f};
    if (isnew) {
        SmpK d, dv;
        const bf16* kp = PROJ + (size_t)(NP + b * 8 + kk) * DIN + OFF_AK + h * 64 + 4 * dq;
#pragma unroll
        for (int t = 0; t < 8; ++t) { if (t < 2) { d.k[t] = ldp4(kp + (size_t)t * 4 * DIN); dv.k[t] = ldp4(kp + (size_t)t * 4 * DIN + (OFF_AV - OFF_AK)); }
            else { d.k[t] = (f32x4){0.f, 0.f, 0.f, 0.f}; dv.k[t] = (f32x4){0.f, 0.f, 0.f, 0.f}; } }
        smp_group(d, dv, q, O, M, Lsum, 2, true, kk, g, lane);
    } else {
        const int* pt = (const int*)a.inp(I_PT) + b * NPAGES + sp * 2;
        const int pg0 = pt[0], pg1 = pt[1];
        const size_t lo = (size_t)(kk * 4 + h) * 64 + 4 * dq;
        const float* kb0 = a.inp(I_CK) + ((size_t)l * NPOOL + pg0) * 32768 + lo; const float* kb1 = a.inp(I_CK) + ((size_t)l * NPOOL + pg1) * 32768 + lo;
        const float* vb0 = a.inp(I_CV) + ((size_t)l * NPOOL + pg0) * 32768 + lo; const float* vb1 = a.inp(I_CV) + ((size_t)l * NPOOL + pg1) * 32768 + lo;
        SmpK dA, dB, dV;
        smp_load(dA, kb0);
#pragma unroll
        for (int gi = 0; gi < 8; gi += 2) {
            smp_load(dV, ((gi >> 2) ? vb1 : vb0) + (size_t)(gi & 3) * 8192);
            { const int gn = gi + 1; smp_load(dB, ((gn >> 2) ? kb1 : kb0) + (size_t)(gn & 3) * 8192); }
            smp_group(dA, dV, q, O, M, Lsum, 8, false, kk, g, lane);
            { const int gn = gi + 1; smp_load(dV, ((gn >> 2) ? vb1 : vb0) + (size_t)(gn & 3) * 8192); }
            if (gi + 2 < 8) { const int gn = gi + 2; smp_load(dA, ((gn >> 2) ? kb1 : kb0) + (size_t)(gn & 3) * 8192); }
            smp_group(dB, dV, q, O, M, Lsum, 8, false, kk, g, lane);
        }
    }
    float Lall = Lsum + __shfl_xor(Lsum, 16); Lall += __shfl_xor(Lall, 32);
    float* part = (float*)(a.ws + WS_PART) + ((size_t)(b * 4 + h) * NSPLIT + sp) * PART_FLOATS;
    if (kk == 0) { part[dq] = M; part[16 + dq] = Lall; }
#pragma unroll
    for (int rg = 0; rg < 4; ++rg) *(f32x4*)(part + 32 + (4 * kk + rg) * 64 + 4 * dq) = (f32x4){O[0][rg], O[1][rg], O[2][rg], O[3][rg]};
}

__device__ __forceinline__ void attn_sample_merge_wave(const Ctx& a, int l, int wi, float lam, int lane) {
    OPAQUE(lane);
    const int h = wi & 3, q = wi >> 2, b = q >> 3, i = q & 7;
    const size_t m = (size_t)NP + q;
    const float* pb = (const float*)(a.ws + WS_PART) + ((size_t)(b * 4 + h) * NSPLIT) * PART_FLOATS;
    float oc[2];
#pragma unroll
    for (int c = 0; c < 2; ++c) { const int j = c * 8 + i;
        float ms[NSPLIT], M = -1e30f;
#pragma unroll
        for (int s = 0; s < NSPLIT; ++s) { ms[s] = pb[s * PART_FLOATS + j]; M = fmaxf(M, ms[s]); }
        float L = 0.f, O = 0.f;
#pragma unroll
        for (int s = 0; s < NSPLIT; ++s) { const float w = __builtin_amdgcn_exp2f(ms[s] - M); L += pb[s * PART_FLOATS + 16 + j] * w; O += pb[s * PART_FLOATS + 32 + j * 64 + lane] * w; }
        oc[c] = O / L; }
    const float v = oc[0] - lam * oc[1];
    const float ss = wave_sum(v * v);
    const float ov = v * rsqrtf(ss * (1.f / 64.f) + NORM_EPS) * a.inp(I_SUBLN)[l * 64 + lane] * (1.0f - lam_init_of(l));
    const float gt = ldp1((const bf16*)(a.ws + WS_PROJ) + m * DIN + OFF_G + h * 64 + lane);
    ((bf16*)(a.ws + WS_OB))[m * DM + h * 64 + lane] = (bf16)f2bf(ov * siluf_(gt));
}

__device__ __forceinline__ void glu_wave(const Ctx& a, int l, int unit, int wave, int lane) {
    OPAQUE(lane);
    const bf16* ZB = (const bf16*)(a.ws + WS_ZB); const bf16* WT = (const bf16*)(a.ws + WS_WGLU) + (size_t)l * 65536;
    const bf16* PROJ = (const bf16*)(a.ws + WS_PROJ); bf16* OB = (bf16*)(a.ws + WS_OB);
    const int r = lane & 31, hh = lane >> 5, n0 = wave * 32;
    const size_t m = (size_t)unit * 32 + r;
    const bf16* zp = ZB + m * 256 + 8 * hh; const bf16* wp = WT + (size_t)(n0 + r) * 256 + 8 * hh;
    f32x16 acc;
#pragma unroll
    for (int e = 0; e < 16; ++e) acc[e] = 0.f;
#pragma unroll
    for (int s0 = 0; s0 < 16; s0 += 8) {
        bf16x8 wa[8], zb[8];
#pragma unroll
        for (int s1 = 0; s1 < 8; ++s1) { wa[s1] = *(const bf16x8*)(wp + 16 * (s0 + s1)); zb[s1] = *(const bf16x8*)(zp + 16 * (s0 + s1)); }
#pragma unroll
        for (int s1 = 0; s1 < 8; ++s1) acc = __builtin_amdgcn_mfma_f32_32x32x16_bf16(wa[s1], zb[s1], acc, 0, 0, 0);
    }
    const float* bg = a.inp(I_BGLU) + l * 256;
#pragma unroll
    for (int g4 = 0; g4 < 4; ++g4) { const int n = n0 + 8 * g4 + 4 * hh;
        const f32x4 bb = *(const f32x4*)(bg + n), gt = ldp4(PROJ + m * DIN + OFF_G + 768 + n);
        const u32x2 zz = *(const u32x2*)(ZB + m * 256 + n);
        const float z0 = __builtin_bit_cast(float, zz.x << 16), z1 = __builtin_bit_cast(float, zz.x & 0xffff0000u), z2 = __builtin_bit_cast(float, zz.y << 16), z3 = __builtin_bit_cast(float, zz.y & 0xffff0000u);
        u32x2 o; o.x = pk2(z0 * sigmoidf_(acc[4 * g4 + 0] + bb.x) * siluf_(gt.x), z1 * sigmoidf_(acc[4 * g4 + 1] + bb.y) * siluf_(gt.y));
        o.y = pk2(z2 * sigmoidf_(acc[4 * g4 + 2] + bb.z) * siluf_(gt.z), z3 * sigmoidf_(acc[4 * g4 + 3] + bb.w) * siluf_(gt.w));
        *(u32x2*)(OB + m * DM + 768 + n) = o; }
}

constexpr int MM_RWA = 256;
constexpr int MM_RWB = 224;
constexpr int MM_AP = 256;
constexpr int MM_AS = (DB * NSPLIT * 4) / 8;
constexpr int MM_S5P = 256;
constexpr int MM_S5S = 256;
constexpr int MM_LRU = 128;
constexpr int MM_RWS = DB * 4;
constexpr int MM_MRG = 512;
constexpr int MM_GLU = MTOK / 32;
__device__ __forceinline__ void ph_mixA(const Ctx& a, int lq, int MMSK, LAS unsigned char* lds, volatile LAS unsigned* MISC, int tid, int lane, int wave) {
    const int l = lq & 1;
    unsigned* qctr = (unsigned*)(a.ws + WS_CTL) + CW_QUEUE + 1024 * lq;
    const float lam = compute_lam(a, l, lane);
    int u;
#ifndef STREAM_DIV
#define STREAM_DIV 6
#endif
    const bool streamer = ((blockIdx.x >> 3) % STREAM_DIV) == 0;
#pragma unroll 1
    for (int pass = 0; pass < 2; ++pass) {
        if ((pass == 0) == streamer) { if ((MMSK >> 2) & 1) while ((u = grab_unit(qctr + 2 * 64, MISC, tid)) < MM_AS) attn_sample_wave(a, l, u * 8 + wave, lane); }
        if (pass == 0) {
            if ((MMSK >> 0) & 1) while ((u = grab_unit(qctr + 0 * 64, MISC, tid)) < MM_RWA) rwkv_prompt_unitA(a, l, u, lds, tid);
            if ((MMSK >> 1) & 1) while ((u = grab_unit(qctr + 1 * 64, MISC, tid)) < MM_AP) { const int bh = u & 31, qt = 8 * (7 - (u >> 5)) + wave; attn_prompt_wave(a, l, bh >> 2, bh & 3, qt, lam, lane); }
            if ((MMSK >> 3) & 1) while ((u = grab_unit(qctr + 3 * 64, MISC, tid)) < MM_S5P) s5_pass2_wave(a, l, false, u * 8 + wave, lds + wave * 17408, lane);
            if ((MMSK >> 4) & 1) while ((u = grab_unit(qctr + 4 * 64, MISC, tid)) < MM_S5S) s5_pass2_wave(a, l, true, u * 8 + wave, lds + wave * 17408, lane);
            if ((MMSK >> 5) & 1) while ((u = grab_unit(qctr + 5 * 64, MISC, tid)) < MM_LRU) lru_pass2_wave(a, l, u * 8 + wave, lane);
        }
    }
    __syncthreads();
}
__device__ __forceinline__ void ph_mixB(const Ctx& a, int lq, int MMSK, LAS unsigned char* lds, volatile LAS unsigned* MISC, int tid, int lane, int wave) {
    const int l = lq & 1;
    unsigned* qctr = (unsigned*)(a.ws + WS_CTL) + CW_QUEUE + 1024 * lq + 512;
    int u;
    if ((MMSK >> 0) & 1) while ((u = grab_unit(qctr + 0 * 64, MISC, tid)) < MM_RWB) rwkv_prompt_unitB(a, l, u, lds, tid);
    if ((MMSK >> 1) & 1) while ((u = grab_unit(qctr + 1 * 64, MISC, tid)) < MM_RWS) rwkv_sample_unit(a, l, u >> 2, u & 3, lds, tid);
    if ((MMSK >> 2) & 1) while ((u = grab_unit(qctr + 2 * 64, MISC, tid)) < MM_GLU) glu_wave(a, l, u, wave, lane);
    if ((MMSK >> 3) & 1) { const float lam = compute_lam(a, l, lane); while ((u = grab_unit(qctr + 3 * 64, MISC, tid)) < MM_MRG) attn_sample_merge_wave(a, l, u * 8 + wave, lam, lane); }
    __syncthreads();
}

__device__ __forceinline__ void ph_postnorm(const Ctx& a, int l, int lane, int wave) {
    OPAQUE(lane);
    const bf16* YP = (const bf16*)(a.ws + WS_YP);
    const float* xp = a.inp(I_XP);
    const float* xs = a.inp(I_XS) - (size_t)NP * DM;
    bf16* X1b = (bf16*)(a.ws + WS_X1);
    float* yp = a.out + OUT_Y_P;
    float* ys = a.out + OUT_Y_S - (size_t)NP * DM;
    bf16* H = (bf16*)(a.ws + WS_H);
    f32x4 gp[4], g2[4];
#pragma unroll
    for (int j = 0; j < 4; ++j) { gp[j] = ((const f32x4*)(a.inp(I_NPOST) + l * DM) + lane)[64 * j]; g2[j] = ((const f32x4*)(a.inp(I_NPRE) + DM) + lane)[64 * j]; }
    const int gw = blockIdx.x * NWAVES + wave, NGW = gridDim.x * NWAVES;
    for (int m0 = gw; m0 < MTOK; m0 += 2 * NGW) {
        const int m1 = m0 + NGW; const bool has1 = m1 < MTOK; const int mb = has1 ? m1 : m0;
        const bf16* ya = YP + (size_t)m0 * DM + 4 * lane; const bf16* yb = YP + (size_t)mb * DM + 4 * lane;
        const f32x4* xa = (const f32x4*)((m0 < NP ? xp : xs) + (size_t)m0 * DM) + lane; const f32x4* xb = (const f32x4*)((mb < NP ? xp : xs) + (size_t)mb * DM) + lane;
        f32x4 va[4], vb[4], wa[4], wb[4];
#pragma unroll
        for (int j = 0; j < 4; ++j) { va[j] = ldp4(ya + 256 * j); vb[j] = ldp4(yb + 256 * j);
            if (l == 0) { wa[j] = xa[64 * j]; wb[j] = xb[64 * j]; }
            else { wa[j] = ldp4(X1b + (size_t)m0 * DM + 4 * lane + 256 * j); wb[j] = ldp4(X1b + (size_t)mb * DM + 4 * lane + 256 * j); } }
        float sa = 0.f, sb = 0.f;
#pragma unroll
        for (int j = 0; j < 4; ++j) { sa += (va[j].x * va[j].x + va[j].y * va[j].y) + (va[j].z * va[j].z + va[j].w * va[j].w); sb += (vb[j].x * vb[j].x + vb[j].y * vb[j].y) + (vb[j].z * vb[j].z + vb[j].w * vb[j].w); }
        const float ra = rsqrtf(wave_sum_fast(sa) * (1.f / DM) + NORM_EPS), rb = rsqrtf(wave_sum_fast(sb) * (1.f / DM) + NORM_EPS);
        f32x4* oa = (f32x4*)((m0 < NP ? yp : ys) + (size_t)m0 * DM) + lane; f32x4* ob = (f32x4*)((mb < NP ? yp : ys) + (size_t)mb * DM) + lane;
        float ta = 0.f, tb = 0.f;
#pragma unroll
        for (int j = 0; j < 4; ++j) { va[j] = wa[j] + va[j] * ra * gp[j]; vb[j] = wb[j] + vb[j] * rb * gp[j];
            if (l == 0) { u32x2 o; o.x = pk2(va[j].x, va[j].y); o.y = pk2(va[j].z, va[j].w); *(u32x2*)(X1b + (size_t)m0 * DM + 4 * lane + 256 * j) = o;
                if (has1) { u32x2 p; p.x = pk2(vb[j].x, vb[j].y); p.y = pk2(vb[j].z, vb[j].w); *(u32x2*)(X1b + (size_t)mb * DM + 4 * lane + 256 * j) = p; } }
            else { __builtin_nontemporal_store(va[j], oa + 64 * j); if (has1) __builtin_nontemporal_store(vb[j], ob + 64 * j); }
            ta += (va[j].x * va[j].x + va[j].y * va[j].y) + (va[j].z * va[j].z + va[j].w * va[j].w); tb += (vb[j].x * vb[j].x + vb[j].y * vb[j].y) + (vb[j].z * vb[j].z + vb[j].w * vb[j].w); }
        if (l == 0) {
            const float qa = rsqrtf(wave_sum_fast(ta) * (1.f / DM) + NORM_EPS), qb = rsqrtf(wave_sum_fast(tb) * (1.f / DM) + NORM_EPS);
            u32x2* ha = (u32x2*)(H + (size_t)m0 * DM) + lane; u32x2* hb = (u32x2*)(H + (size_t)mb * DM) + lane;
#pragma unroll
            for (int j = 0; j < 4; ++j) { u32x2 o; o.x = pk2(va[j].x * qa * g2[j].x, va[j].y * qa * g2[j].y); o.y = pk2(va[j].z * qa * g2[j].z, va[j].w * qa * g2[j].w); ha[64 * j] = o;
                if (has1) { u32x2 p; p.x = pk2(vb[j].x * qb * g2[j].x, vb[j].y * qb * g2[j].y); p.y = pk2(vb[j].z * qb * g2[j].z, vb[j].w * qb * g2[j].w); hb[64 * j] = p; } }
        }
    }
}

constexpr int N_PHASES = 13;
#ifndef DUP_PHASE
#define DUP_PHASE -1
#endif
#ifndef DUP_MASK
#define DUP_MASK 0x7f
#endif
__global__ void __launch_bounds__(NTHREADS, 2) hymba_fwd(Args args) {
    extern __shared__ __attribute__((aligned(16))) unsigned char lds_raw[];
    LAS unsigned char* lds = (LAS unsigned char*)lds_raw;
    volatile LAS unsigned* MISC = (volatile LAS unsigned*)(lds + MISC_OFF);
    if (threadIdx.x < 64) MISC[threadIdx.x] = 0u;
    if (threadIdx.x < N_IN) *(LAS unsigned long long*)(lds + TAB_OFF + 8 * threadIdx.x) = (unsigned long long)args.in[threadIdx.x];
    Ctx ctx; ctx.out = args.out; ctx.ws = args.ws; ctx.tab = (const LAS unsigned*)(lds + TAB_OFF);
    const int wave_s = __builtin_amdgcn_readfirstlane(threadIdx.x >> 6);
#define TIDS() int tid = wave_s * 64 + lane_id_asm(); const int lane = tid & 63, wave = wave_s; (void)lane; (void)wave; Ctx cx = ctx; { GAS unsigned char* w_ = (GAS unsigned char*)ctx.ws; GAS float* o_ = (GAS float*)ctx.out; asm volatile("" : "+s"(w_), "+s"(o_)); cx.ws = (unsigned char*)w_; cx.out = (float*)o_; }
    __syncthreads();
    unsigned* ctl = (unsigned*)(args.ws + WS_CTL);
#if MK_PER_PHASE
#define GRID_BAR() do { } while (0)
#else
    XcdBarrier bar = xcd_barrier_post(ctl + CW_BAR, MISC);
#define GRID_BAR() xcd_barrier(bar, wave_s == 0 && lane_id_asm() == 0)
#endif
    const int lo = args.ph_lo, hi = args.ph_hi;
#define IN(k) (lo <= (k) && (k) < hi)
#define SEAM(k) do { if (IN(k) && IN((k) + 1)) GRID_BAR(); } while (0)
#define NREP(j) ((DUP_PHASE == (j)) ? 2 : 1)

    if (IN(0)) { TIDS(); ph_prologue(cx, lds, lane, wave); }
    SEAM(0);
    for (int l = 0; l < 2; ++l) {
        const int p0 = 1 + 6 * l;
        if (IN(p0))
#pragma unroll 1
          for (int rp = 0; rp < NREP(1); ++rp) {
            if (rp) GRID_BAR();
            TIDS();
            pg8::Gemm g{(const pg8::bf16_t*)(cx.ws + WS_H), (const pg8::bf16_t*)(cx.ws + WS_WIN) + (size_t)l * DIN * DM, MTOK, DIN, DM};
            pg8::StaticOrder S; S.init(MTOK, DIN, (int)gridDim.x, (int)blockIdx.x);
            EpiProj E{(bf16*)(cx.ws + WS_PROJ), cx.out, l};
            pg8::gemm_phase<EpiProj, pg8::StaticOrder, false>(lds, g, S, E, nullptr, tid);
        }
        SEAM(p0);
        if (IN(p0 + 1)) {
#pragma unroll 1
            for (int rp = 0; rp < NREP(2); ++rp) { if (rp) GRID_BAR(); TIDS(); ph_mixprep(cx, l + 2 * rp, rp ? (DUP_MASK) : 0x1f, lds, MISC, tid, lane, wave); } }
        SEAM(p0 + 1);
        if (IN(p0 + 2)) {
#pragma unroll 1
            for (int rp = 0; rp < NREP(3); ++rp) { if (rp) GRID_BAR(); TIDS(); ph_mixA(cx, l + 2 * rp, rp ? (DUP_MASK) : 0x3f, lds, MISC, tid, lane, wave); } }
        SEAM(p0 + 2);
        if (IN(p0 + 3)) {
#pragma unroll 1
            for (int rp = 0; rp < NREP(4); ++rp) { if (rp) GRID_BAR(); TIDS(); ph_mixB(cx, l + 2 * rp, rp ? (DUP_MASK) : 0xf, lds, MISC, tid, lane, wave); } }
        SEAM(p0 + 3);
        if (IN(p0 + 4))
#pragma unroll 1
          for (int rp = 0; rp < NREP(5); ++rp) {
            if (rp) GRID_BAR();
            TIDS();
            pg8::Gemm g{(const pg8::bf16_t*)(cx.ws + WS_OB), (const pg8::bf16_t*)(cx.ws + WS_WOUT) + (size_t)l * DM * DM, MTOK, DM, DM};
            pg8::StaticOrder S; S.init(MTOK, DM, (int)gridDim.x, (int)blockIdx.x);
            EpiPlain E{(bf16*)(cx.ws + WS_YP), DM};
            pg8::gemm_phase<EpiPlain, pg8::StaticOrder, false>(lds, g, S, E, nullptr, tid);
        }
        SEAM(p0 + 4);
        if (IN(p0 + 5)) {
#pragma unroll 1
            for (int rp = 0; rp < NREP(6); ++rp) { if (rp) GRID_BAR(); TIDS(); ph_postnorm(cx, l, lane, wave); } }
        SEAM(p0 + 5);
    }
#undef IN
#undef SEAM
}

extern "C" void kernel_launch(void* const* d_in, const int* in_sizes, int n_in, void* d_out, int out_size, void* d_ws, size_t ws_size, hipStream_t stream) {
    static int grid = 0;
    if (grid == 0) {
        if (n_in != N_IN || out_size != (int)OUT_TOTAL || ws_size < WS_END) { fprintf(stderr, "kernel_launch: unexpected shapes: n_in %d out %d ws %zu (need %zu)\n", n_in, out_size, ws_size, (size_t)WS_END); grid = -1; return; }
        int dev = 0, cus = 0, per_cu = 0;
        if (hipGetDevice(&dev) != hipSuccess || hipDeviceGetAttribute(&cus, hipDeviceAttributeMultiprocessorCount, dev) != hipSuccess) { grid = -1; return; }
        if (hipFuncSetAttribute((const void*)hymba_fwd, hipFuncAttributeMaxDynamicSharedMemorySize, LDS_BYTES) != hipSuccess) { fprintf(stderr, "kernel_launch: hipFuncSetAttribute failed\n"); grid = -1; return; }
        if (hipOccupancyMaxActiveBlocksPerMultiprocessor(&per_cu, (const void*)hymba_fwd, NTHREADS, LDS_BYTES) != hipSuccess || per_cu < 1) { fprintf(stderr, "kernel_launch: occupancy query says %d\n", per_cu); }
        (void)hipGetLastError();
        grid = cus;
    }
    if (grid < 0) return;
    (void)hipMemsetAsync((char*)d_ws + WS_CTL, 0, CTL_ZERO_BYTES, stream);
    Args a{};
    for (int i = 0; i < N_IN; ++i) a.in[i] = (const float*)d_in[i];
    a.out = (float*)d_out; a.ws = (unsigned char*)d_ws;
#if MK_PER_PHASE
    for (int p = 0; p < N_PHASES; ++p) { a.ph_lo = p; a.ph_hi = p + 1; hipLaunchKernelGGL(hymba_fwd, dim3(grid), dim3(NTHREADS), LDS_BYTES, stream, a); }
#else
    a.ph_lo = 0; a.ph_hi = N_PHASES; hipLaunchKernelGGL(hymba_fwd, dim3(grid), dim3(NTHREADS), LDS_BYTES, stream, a);
#endif
}
```

```cpp
#include <hip/hip_runtime.h>
#include <cstdio>
#include <cstdint>
#ifndef MK_PER_PHASE
#define MK_PER_PHASE 0
#endif
namespace pg8 {
#define PG8_LAS __attribute__((address_space(3)))
typedef unsigned short bf16_t;
typedef short bf16x8 __attribute__((ext_vector_type(8)));
typedef float f32x4 __attribute__((ext_vector_type(4)));
typedef unsigned u32x4 __attribute__((ext_vector_type(4)));
constexpr int BM = 256, BK = 64, HALF = 128, HTB = HALF * BK * 2  , STAGE_BYTES = 8 * HTB, NXCD = 8, WGM = 8;

__host__ __device__ __forceinline__ int lds_byte(int r, int c) { const int st = (r >> 4) * 2 + (c >> 5), rr = r & 15, cc = c & 31, ob = rr * 64 + cc * 2; return st * 1024 + (ob ^ (((ob >> 9) & 1) << 5)); }
__host__ __device__ __forceinline__ void stage_rc(int b, int& R, int& C) { const int st = b / 1024, sb = b % 1024, swz = sb ^ (((sb >> 9) & 1) << 5); R = (st >> 1) * 16 + swz / 64; C = (st & 1) * 32 + (swz % 64) / 2; }
__host__ __device__ __forceinline__ int perm32(int rho) { const int n = rho >> 4, i = rho & 15; return 8 * (i >> 2) + 4 * n + (i & 3); }

struct Unit { int pm, pn; };
struct Gemm { const bf16_t* A; const bf16_t* Bt; int M, N, K; };

struct StaticOrder {
    int nM, nN, nwg, G, c;
    __host__ __device__ void init(int M, int N, int G_, int c_) { nM = M / BM; nN = N / BM; nwg = nM * nN; G = G_; c = c_; }
    __host__ __device__ bool next(int i, Unit& u) const {
        const long L = (long)i * G + c; if (L >= nwg) return false;
        int wgid = (int)L; { const int q = nwg / NXCD, r = nwg % NXCD, xcd = wgid % NXCD, off = wgid / NXCD; wgid = (xcd < r ? xcd * (q + 1) : r * (q + 1) + (xcd - r) * q) + off; }
        const int nig = WGM * nN, gid = wgid / nig, fm = gid * WGM, gsz = (nM - fm) < WGM ? (nM - fm) : WGM;
        u.pm = fm + ((wgid % nig) % gsz); u.pn = (wgid % nig) / gsz; return true;
    }
    __device__ __forceinline__ void a_ready(const Unit&) const {}
    __device__ __forceinline__ void done(const Unit&) const {}
};
template <class Epi, class Sched, bool STAMP = false>
__device__ __forceinline__ void gemm_phase(PG8_LAS unsigned char* lds, const Gemm g, const Sched& S, const Epi& E, unsigned long long* stamps, int tid_in) {
    int tid = tid_in; asm volatile("" : "+v"(tid));
    const int wid = __builtin_amdgcn_readfirstlane(tid >> 6), lane = tid & 63, wr = wid >> 2, wc = wid & 3, fr = lane & 15, fq = lane >> 4;
    const int K = g.K, nt = K / BK;
    int ts_lo = 0, ts_hi = 0, nts = 0; const unsigned long long rt_entry = STAMP ? (unsigned long long)wall_clock64() : 0ull;
#define PG8_STAMP() do { if (STAMP && wid == 0 && nts < 64) { const unsigned long long _c = (unsigned long long)clock64(); \
        ts_lo = (lane == nts) ? (int)(unsigned)_c : ts_lo; ts_hi = (lane == nts) ? (int)(unsigned)(_c >> 32) : ts_hi; ++nts; } } while (0)
    PG8_STAMP();
    unsigned voffA[2], voffB[2];
#pragma unroll
    for (int i = 0; i < 2; ++i) { int R, C; stage_rc(tid * 16 + i * 8192, R, C); const int Rb = Epi::PERM ? ((R & ~31) + perm32(R & 31)) : R;
        voffA[i] = (unsigned)(R * K + C) * 2u; voffB[i] = (unsigned)(Rb * K + C) * 2u; }
    const size_t kstep = (size_t)(BK * 2);
    const size_t hstep = (size_t)HALF * K * 2;
    const size_t tstep = 2 * hstep;
    const unsigned ldsw = (unsigned)wid * 1024u;
    const int aoff = lds_byte(wr * 64 + fr, fq * 8), boff = lds_byte(wc * 32 + fr, fq * 8);
#define PG8_SA(b, h) (((b) * 2 + (h)) * HTB)
#define PG8_SB(b, h) ((4 + (b) * 2 + (h)) * HTB)
#define PG8_STAGE(bufoff, gbase, voff) do { _Pragma("unroll") for (int _i = 0; _i < 2; ++_i) \
        __builtin_amdgcn_global_load_lds((const unsigned*)((const char*)(gbase) + (voff)[_i]), (PG8_LAS unsigned*)(lds + (bufoff) + ldsw + _i * 8192), 16, 0, 0); } while (0)
#define PG8_LDA(dst, b, h) do { _Pragma("unroll") for (int m = 0; m < 4; ++m) _Pragma("unroll") for (int k = 0; k < 2; ++k) dst[m][k] = *(const PG8_LAS bf16x8*)(lds + PG8_SA(b, h) + aoff + m * 2048 + k * 1024); } while (0)
#define PG8_LDB(dst, b, h) do { _Pragma("unroll") for (int n = 0; n < 2; ++n) _Pragma("unroll") for (int k = 0; k < 2; ++k) dst[n][k] = *(const PG8_LAS bf16x8*)(lds + PG8_SB(b, h) + boff + n * 2048 + k * 1024); } while (0)
#define PG8_MMA(ai, bj, At, Bt) do { __builtin_amdgcn_s_setprio(1); _Pragma("unroll") for (int m = 0; m < 4; ++m) _Pragma("unroll") for (int n = 0; n < 2; ++n) _Pragma("unroll") for (int k = 0; k < 2; ++k) \
        acc[ai][bj][m][n] = __builtin_amdgcn_mfma_f32_16x16x32_bf16(Bt[n][k], At[m][k], acc[ai][bj][m][n], 0, 0, 0); __builtin_amdgcn_s_setprio(0); } while (0)
#define PG8_WAIT_V(n) asm volatile("s_waitcnt vmcnt(" #n ")" ::: "memory")
#define PG8_WAIT_L(n) asm volatile("s_waitcnt lgkmcnt(" #n ")" ::: "memory")
#define PG8_BAR __builtin_amdgcn_s_barrier()
#define PG8_SCHED __builtin_amdgcn_sched_barrier(0)
    Unit cur, nxt; int ui = 0;
    if (!S.next(0, cur)) return;
    f32x4 acc[2][2][4][2];
#pragma unroll
    for (int a = 0; a < 2; ++a)
#pragma unroll
        for (int b = 0; b < 2; ++b)
#pragma unroll
            for (int m = 0; m < 4; ++m)
#pragma unroll
                for (int n = 0; n < 2; ++n) acc[a][b][m][n] = (f32x4){0.f, 0.f, 0.f, 0.f};
    bf16x8 At[4][2], B0[2][2], B1[2][2];
    const char* cA = (const char*)g.A + (size_t)cur.pm * tstep; const char* cB = (const char*)g.Bt + (size_t)cur.pn * tstep;
    S.a_ready(cur);
    PG8_STAGE(PG8_SB(0, 0), cB, voffB); PG8_STAGE(PG8_SA(0, 0), cA, voffA); PG8_STAGE(PG8_SB(0, 1), cB + hstep, voffB); PG8_STAGE(PG8_SA(0, 1), cA + hstep, voffA);
    if (wr == 1) PG8_BAR;
    PG8_WAIT_V(4); PG8_BAR;
    PG8_STAGE(PG8_SB(1, 0), cB + kstep, voffB); PG8_STAGE(PG8_SA(1, 0), cA + kstep, voffA); PG8_STAGE(PG8_SB(1, 1), cB + hstep + kstep, voffB);
    PG8_WAIT_V(6); PG8_BAR;
    PG8_STAMP();
    for (;;) {
        const bool has_next = S.next(ui + 1, nxt);
        const char* nA = has_next ? (const char*)g.A + (size_t)nxt.pm * tstep : cA; const char* nB = has_next ? (const char*)g.Bt + (size_t)nxt.pn * tstep : cB;
        for (int t = 0; t < nt; t += 2) {
            const bool last = (t == nt - 2);
            const char* a1 = cA + (size_t)(t + 1) * kstep;
            const char* a2 = last ? nA : cA + (size_t)(t + 2) * kstep; const char* b2 = last ? nB : cB + (size_t)(t + 2) * kstep;
            const char* a3 = a2 + kstep; const char* b3 = b2 + kstep;
            if (last && has_next) S.a_ready(nxt);
            PG8_LDB(B0, 0, 0); PG8_SCHED; PG8_LDA(At, 0, 0); PG8_STAGE(PG8_SA(1, 1), a1 + hstep, voffA);
            PG8_WAIT_L(8); PG8_BAR; PG8_WAIT_L(0); PG8_MMA(0, 0, At, B0); PG8_BAR; PG8_SCHED;
            PG8_LDB(B1, 0, 1); PG8_STAGE(PG8_SB(0, 0), b2, voffB);
            PG8_BAR; PG8_WAIT_L(0); PG8_MMA(0, 1, At, B1); PG8_BAR;
            PG8_LDA(At, 0, 1); PG8_STAGE(PG8_SA(0, 0), a2, voffA);
            PG8_BAR; PG8_WAIT_L(0); PG8_MMA(1, 0, At, B0); PG8_BAR; PG8_SCHED;
            PG8_STAGE(PG8_SB(0, 1), b2 + hstep, voffB);
            PG8_WAIT_V(6); PG8_BAR; PG8_MMA(1, 1, At, B1); PG8_BAR;
            PG8_LDB(B0, 1, 0); PG8_SCHED; PG8_LDA(At, 1, 0); PG8_STAGE(PG8_SA(0, 1), a2 + hstep, voffA);
            PG8_WAIT_L(8); PG8_BAR; PG8_WAIT_L(0); PG8_MMA(0, 0, At, B0); PG8_BAR; PG8_SCHED;
            PG8_LDB(B1, 1, 1); PG8_STAGE(PG8_SB(1, 0), b3, voffB);
            PG8_BAR; PG8_WAIT_L(0); PG8_MMA(0, 1, At, B1); PG8_BAR;
            PG8_LDA(At, 1, 1); PG8_STAGE(PG8_SA(1, 0), a3, voffA);
            PG8_BAR; PG8_WAIT_L(0); PG8_MMA(1, 0, At, B0); PG8_BAR; PG8_SCHED;
            PG8_STAGE(PG8_SB(1, 1), b3 + hstep, voffB);
            PG8_WAIT_V(6); PG8_BAR; PG8_MMA(1, 1, At, B1); PG8_BAR;
        }
        PG8_STAMP();
        if constexpr (!Epi::AFTER_DRAIN) { int l2; asm volatile("v_mbcnt_lo_u32_b32 %0, -1, 0\n\tv_mbcnt_hi_u32_b32 %0, -1, %0" : "=v"(l2)); E(acc, cur, wr, wc, l2 & 15, l2 >> 4); S.done(cur); }
        PG8_STAMP();
        if (!has_next) break;
#pragma unroll
        for (int a = 0; a < 2; ++a)
#pragma unroll
            for (int b = 0; b < 2; ++b)
#pragma unroll
                for (int m = 0; m < 4; ++m)
#pragma unroll
                    for (int n = 0; n < 2; ++n) acc[a][b][m][n] = (f32x4){0.f, 0.f, 0.f, 0.f};
        cur = nxt; cA = nA; cB = nB; ++ui;
    }
    PG8_WAIT_V(0);
    if (wr == 0) PG8_BAR;
    PG8_BAR;
    if constexpr (Epi::AFTER_DRAIN) { E.fused(acc, cur, wr, wc, fr, fq, lds, wid, lane); S.done(cur); }
    PG8_STAMP();
    if (STAMP && wid == 0) { stamps[lane] = lane < nts ? (((unsigned long long)(unsigned)ts_hi << 32) | (unsigned)ts_lo) : 0ull;
        if (lane == 62) stamps[62] = rt_entry; if (lane == 63) stamps[63] = (unsigned long long)wall_clock64(); }
#undef PG8_STAMP
#undef PG8_SA
#undef PG8_SB
#undef PG8_STAGE
#undef PG8_LDA
#undef PG8_LDB
#undef PG8_MMA
#undef PG8_WAIT_V
#undef PG8_WAIT_L
#undef PG8_BAR
#undef PG8_SCHED
}
}

#define GAS __attribute__((address_space(1)))
#define LAS __attribute__((address_space(3)))
typedef unsigned short bf16;
typedef float f32x4 __attribute__((ext_vector_type(4)));
typedef float f32x2 __attribute__((ext_vector_type(2)));
typedef float f32x16 __attribute__((ext_vector_type(16)));
typedef short bf16x8 __attribute__((ext_vector_type(8)));
typedef unsigned u32x4 __attribute__((ext_vector_type(4)));
typedef unsigned u32x2 __attribute__((ext_vector_type(2)));

constexpr int NWAVES = 8, NTHREADS = 512;
constexpr int DM = 1024, NP = 16384, NSMP = 1024, MTOK = 17408, DIN = 3584, SEQ = 2048, DB = 128, DS = 8;
constexpr int OFF_AQ = 0, OFF_AK = 256, OFF_AV = 512, OFF_B = 768, OFF_C = 1024, OFF_D = 2304, OFF_G = 2560;
constexpr int NPOOL = 2560, NPAGES = 16;
constexpr float NORM_EPS = 1e-6f;
constexpr float QSCALE = 0.17677669529663687f * 1.4426950408889634f;
constexpr int NSPLIT = 9;
constexpr int PART_FLOATS = 16 + 16 + 1024;

constexpr size_t OUT_Y_P = 0, OUT_Y_S = 16777216, OUT_K_P = 17825792, OUT_K_S = 26214400, OUT_V_P = 26738688, OUT_V_S = 35127296,
    OUT_CONV_P = 35651584, OUT_CONV_S = 35663872, OUT_LRU_P = 35860480, OUT_LRU_S = 35864576, OUT_SHIFT_P = 35930112, OUT_SHIFT_S = 35950592,
    OUT_WKV_P = 36278272, OUT_WKV_S = 36540416, OUT_SSM_P = 40734720, OUT_SSM_S = 40767488, OUT_TOTAL = 41291776;

constexpr size_t MiB = 1u << 20;
constexpr size_t WS_CTL = 0, CTL_ZERO_BYTES = 1 * MiB;
constexpr size_t WS_WIN = 1 * MiB;
constexpr size_t WS_WOUT = WS_WIN + (size_t)2 * DIN * DM * 2;
constexpr size_t WS_H = WS_WOUT + (size_t)2 * DM * DM * 2;
constexpr size_t WS_PROJ = WS_H + (size_t)MTOK * DM * 2;
constexpr size_t WS_QB = WS_PROJ + (size_t)MTOK * DIN * 4;
constexpr size_t WS_KB = WS_QB + (size_t)NP * 256 * 2;
constexpr size_t WS_VT = WS_KB + (size_t)NP * 256 * 2;
constexpr size_t WS_LA = WS_VT + (size_t)NP * 256 * 2;
constexpr size_t WS_LB = WS_LA + (size_t)MTOK * 256 * 4;
constexpr size_t WS_LP = WS_LB + (size_t)MTOK * 256 * 4;
constexpr size_t WS_LE = WS_LP + (size_t)8 * 32 * 256 * 4;
constexpr size_t WS_RW = WS_LE + (size_t)8 * 32 * 256 * 4;
constexpr size_t WS_BON = WS_RW + (size_t)MTOK * 1536 * 4;
constexpr size_t WS_S5E = WS_BON + (size_t)MTOK * 4 * 4;
constexpr size_t WS_OMIX = WS_S5E + (size_t)8 * 16 * 16 * 64 * 2 * 4;
constexpr size_t WS_ZB = WS_OMIX, WS_WGLU = WS_OMIX + 16 * MiB, WS_LWT = WS_OMIX + 17 * MiB, WS_W1T = WS_OMIX + 18 * MiB, WS_S5T = WS_OMIX + 19 * MiB;
constexpr size_t WS_OB = WS_OMIX + (size_t)MTOK * DM * 4;
constexpr size_t WS_PART = WS_OB + (size_t)MTOK * DM * 2;
constexpr size_t WS_YP = WS_PART + (size_t)DB * 4 * NSPLIT * PART_FLOATS * 4;
constexpr size_t WS_X1 = WS_YP + (size_t)MTOK * DM * 4;
constexpr size_t WS_PZ = WS_X1 + (size_t)MTOK * DM * 4;
constexpr size_t WS_END = WS_PZ + (size_t)8 * 4 * 8 * 2 * 4096 * 4;
static_assert(WS_H % 256 == 0 && WS_PROJ % 256 == 0 && WS_QB % 256 == 0 && WS_VT % 256 == 0 && WS_RW % 256 == 0 && WS_OMIX % 256 == 0 && WS_PART % 256 == 0 && WS_YP % 256 == 0, "ws align");

constexpr int CW_BAR = 4096;
constexpr int CW_QUEUE = 8192;

constexpr int LDS_BYTES = 147456;
constexpr int MISC_OFF = 147456 - 256;

#define XB_TMO      128
#define XB_XCNT(j)  (256  + 64 * (j))
#define XB_XSUB(j)  (1280 + 64 * (j))
#define XB_XGEN(j)  (2304 + 64 * (j))
#define XB_TOP      3328
#define XB_TOPGEN   3392
#define XCD_BAR_WORDS 3456
#define XB_SPIN_CAP (1u << 18)

__device__ __forceinline__ unsigned xb_ld(unsigned* p)              { return __hip_atomic_load(p, __ATOMIC_RELAXED, __HIP_MEMORY_SCOPE_AGENT); }
__device__ __forceinline__ unsigned xb_add(unsigned* p, unsigned v) { return __hip_atomic_fetch_add(p, v, __ATOMIC_RELAXED, __HIP_MEMORY_SCOPE_AGENT); }
__device__ __forceinline__ unsigned xb_xcc_id() { return (unsigned)__builtin_amdgcn_s_getreg((3 << 11) | 20) & 0xFu; }
#define XB_SPIN(cond, bar) do { unsigned _sp = 0; while (cond) { __builtin_amdgcn_s_sleep(1); \
    if ((++_sp & 255u) == 0u) { if (xb_ld(&(bar)[XB_TMO])) break; if (_sp > XB_SPIN_CAP) { atomicAdd(&(bar)[XB_TMO], 1u); break; } } } } while (0)

struct XcdBarrier { unsigned* bar; unsigned x; volatile LAS unsigned* st; };

__device__ __forceinline__ XcdBarrier xcd_barrier_post(unsigned* bar, volatile LAS unsigned* st) {
    XcdBarrier b; b.bar = bar; b.x = xb_xcc_id(); b.st = st;
    if (threadIdx.x == 0) (void)xb_add(&bar[XB_XCNT(b.x)], 1u);
    return b;
}
__device__ __forceinline__ void xcd_barrier_complete(unsigned* bar, unsigned x, unsigned& nloc, unsigned& nx) {
    const unsigned G = gridDim.x * gridDim.y * gridDim.z;
    unsigned sum, cnt, mine, sp = 0u;
    for (;;) {
        sum = 0u; cnt = 0u; mine = 0u;
#pragma unroll
        for (unsigned j = 0; j < 16; ++j) { const unsigned c = xb_ld(&bar[XB_XCNT(j)]); sum += c; cnt += (c > 0u) ? 1u : 0u; mine = (j == x) ? c : mine; }
        if (sum == G) break;
        __builtin_amdgcn_s_sleep(1);
        if ((++sp & 255u) == 0u) { if (xb_ld(&bar[XB_TMO])) break; if (sp > XB_SPIN_CAP) { atomicAdd(&bar[XB_TMO], 1u); break; } }
    }
    nloc = mine > 0u ? mine : 1u; nx = cnt > 0u ? cnt : 1u;
}
__device__ __forceinline__ void xcd_barrier(const XcdBarrier& b, bool leader) {
    asm volatile("s_waitcnt vmcnt(0)" ::: "memory");
    __syncthreads();
    if (leader) {
        unsigned* bar = b.bar;
        __builtin_amdgcn_s_waitcnt(0);
        unsigned nloc = b.st[0], nx = b.st[1];
        if (nloc == 0u) { xcd_barrier_complete(bar, b.x, nloc, nx); b.st[0] = nloc; b.st[1] = nx; }
        const unsigned old = xb_add(&bar[XB_XSUB(b.x)], 1u);
        const unsigned gen = old / nloc;
        if (old + 1u == (gen + 1u) * nloc) {
            __builtin_amdgcn_fence(__ATOMIC_RELEASE, "agent");
            asm volatile("s_waitcnt vmcnt(0)" ::: "memory");
            const unsigned og = xb_add(&bar[XB_TOP], 1u);
            const unsigned tg = og / nx;
            if (og + 1u == (tg + 1u) * nx) xb_add(&bar[XB_TOPGEN], 1u);
            else XB_SPIN(xb_ld(&bar[XB_TOPGEN]) == tg, bar);
            __builtin_amdgcn_fence(__ATOMIC_ACQUIRE, "agent");
            xb_add(&bar[XB_XGEN(b.x)], 1u);
            asm volatile("s_waitcnt vmcnt(0)" ::: "memory");
        } else {
            XB_SPIN(xb_ld(&bar[XB_XGEN(b.x)]) == gen, bar);
            __builtin_amdgcn_fence(__ATOMIC_ACQUIRE, "agent");
            asm volatile("s_waitcnt vmcnt(0)" ::: "memory");
        }
    }
    __syncthreads();
}

enum InIdx { I_XP = 0, I_XS, I_CK, I_CV, I_PT, I_SCONV, I_SLRU, I_SSHIFT, I_SWKV, I_SSSM, I_NPRE, I_NPOST, I_WIN, I_WOUT, I_LQ1, I_LK1, I_LQ2, I_LK2, I_SUBLN,
             I_CONVW, I_CONVB, I_LWA, I_LBA, I_LWX, I_LBX, I_LLAM, I_MU, I_W0, I_W1, I_W2, I_A0, I_A1, I_A2, I_KK, I_KA, I_RK, I_GNW, I_GNB,
             I_LRE, I_LIM, I_LOGDT, I_BRE, I_BIM, I_CRE, I_CIM, I_S5D, I_WGLU, I_BGLU, N_IN };
struct Args { const float* in[N_IN]; float* out; unsigned char* ws; int ph_lo, ph_hi; };
static_assert(sizeof(Args) == (N_IN + 2) * 8 + 8, "Args has no padding");
constexpr int TAB_OFF = 147456 - 1024;
struct Ctx {
    float* out; unsigned char* ws; const LAS unsigned* tab;
    __device__ __forceinline__ const float* inp(int i) const {
        const unsigned lo = tab[2 * i], hi = tab[2 * i + 1];
        return (const float*)(const GAS float*)(((unsigned long long)(unsigned)__builtin_amdgcn_readfirstlane((int)hi) << 32) | (unsigned long long)(unsigned)__builtin_amdgcn_readfirstlane((int)lo));
    }
};

__device__ __forceinline__ int lane_id_asm() { int l; asm volatile("v_mbcnt_lo_u32_b32 %0, -1, 0\n\tv_mbcnt_hi_u32_b32 %0, -1, %0" : "=v"(l)); return l; }
#define OPAQUE(x) asm volatile("" : "+v"(x))
__device__ __forceinline__ float wave_sum(float v) {
#pragma unroll
    for (int o = 1; o < 64; o <<= 1) v += __shfl_xor(v, o);
    return v;
}
template <int CTRL> __device__ __forceinline__ float dpp_mov(float v) { return __builtin_bit_cast(float, __builtin_amdgcn_update_dpp(0, __builtin_bit_cast(int, v), CTRL, 0xF, 0xF, true)); }
__device__ __forceinline__ float red8(float v) { v += dpp_mov<0xB1>(v); v += dpp_mov<0x4E>(v); v += dpp_mov<0x141>(v); return v; }
__device__ __forceinline__ float red16(float v) { v = red8(v); v += dpp_mov<0x140>(v); return v; }
__device__ __forceinline__ unsigned f2bf(float f) { unsigned u = __builtin_bit_cast(unsigned, f); return (u + 0x7fffu + ((u >> 16) & 1u)) >> 16; }
typedef __bf16 bf16x2_t __attribute__((ext_vector_type(2)));
__device__ __forceinline__ unsigned pk2(float lo, float hi) { const f32x2 v = {lo, hi}; return __builtin_bit_cast(unsigned, __builtin_convertvector(v, bf16x2_t)); }
__device__ __forceinline__ f32x4 ldp4(const bf16* p) { const u32x2 w = *(const u32x2*)p; return (f32x4){__builtin_bit_cast(float, w.x << 16), __builtin_bit_cast(float, w.x & 0xffff0000u), __builtin_bit_cast(float, w.y << 16), __builtin_bit_cast(float, w.y & 0xffff0000u)}; }
__device__ __forceinline__ float ldp1(const bf16* p) { return __builtin_bit_cast(float, (unsigned)(*p) << 16); }
__device__ __forceinline__ float sigmoidf_(float x) { return __builtin_amdgcn_rcpf(1.0f + __builtin_amdgcn_exp2f(-1.4426950408889634f * x)); }
__device__ __forceinline__ float siluf_(float x) { return x * sigmoidf_(x); }
__device__ __forceinline__ float tanhf_(float x) { return 1.0f - 2.0f * __builtin_amdgcn_rcpf(1.0f + __builtin_amdgcn_exp2f(2.8853900817779268f * x)); }
__device__ __forceinline__ float wave_sum_fast(float v) { v = red16(v); v += __shfl_xor(v, 16); v += __shfl_xor(v, 32); return v; }
__device__ __forceinline__ float softplusf_(float x) { return fmaxf(x, 0.f) + log1pf(__expf(-fabsf(x))); }
__device__ __forceinline__ float lam_init_of(int l) { return l == 0 ? 0.2f : 0.35550907f; }
__device__ __forceinline__ float compute_lam(const Ctx& a, int l, int lane) {
    float v1 = 0.f, v2 = 0.f;
    if (lane < 32) { v1 = a.inp(I_LQ1)[l * 32 + lane] * a.inp(I_LK1)[l * 32 + lane]; v2 = a.inp(I_LQ2)[l * 32 + lane] * a.inp(I_LK2)[l * 32 + lane]; }
    v1 = wave_sum(v1); v2 = wave_sum(v2);
    return expf(v1) - expf(v2) + lam_init_of(l);
}

__device__ __forceinline__ void s5_disc_compute(const Ctx& a, int l, int g, int n, float& ab_re, float& ab_im, float& f_re, float& f_im);
__device__ __forceinline__ void p0_transpose_item(const float* W, int K, int N, bf16* WT, LAS float* scr, int item, int lane) {
    const int nblk = N / 32, kb = item / nblk, nb = item % nblk, k0 = 64 * kb, n0 = 32 * nb;
    float wv[32];
#pragma unroll
    for (int i = 0; i < 32; ++i) wv[i] = W[(size_t)(k0 + 2 * i + (lane >> 5)) * N + n0 + (lane & 31)];
#pragma unroll
    for (int i = 0; i < 32; ++i) scr[(2 * i + (lane >> 5)) * 33 + (lane & 31)] = wv[i];
    asm volatile("s_waitcnt lgkmcnt(0)" ::: "memory");
    const int c = lane & 7;
#pragma unroll
    for (int j = 0; j < 4; ++j) { const int n = (lane >> 3) + 8 * j; const LAS float* s = scr + (8 * c) * 33 + n;
        u32x4 o; o.x = pk2(s[0 * 33], s[1 * 33]); o.y = pk2(s[2 * 33], s[3 * 33]); o.z = pk2(s[4 * 33], s[5 * 33]); o.w = pk2(s[6 * 33], s[7 * 33]);
        *(u32x4*)(WT + (size_t)(n0 + n) * K + k0 + 8 * c) = o; }
    asm volatile("s_waitcnt lgkmcnt(0)" ::: "memory");
}
__device__ __forceinline__ void rms_row_to_bf16(const float* xrow, const float* g, bf16* orow, int lane) {
    const f32x4* xr = (const f32x4*)xrow + lane; const f32x4* gr = (const f32x4*)g + lane;
    f32x4 v[4]; float s = 0.f;
#pragma unroll
    for (int j = 0; j < 4; ++j) { v[j] = xr[64 * j]; s += (v[j].x * v[j].x + v[j].y * v[j].y) + (v[j].z * v[j].z + v[j].w * v[j].w); }
    const float r = rsqrtf(wave_sum(s) * (1.f / DM) + NORM_EPS);
    u32x2* o8 = (u32x2*)orow + lane;
#pragma unroll
    for (int j = 0; j < 4; ++j) { const f32x4 gg = gr[64 * j]; u32x2 o; o.x = pk2(v[j].x * r * gg.x, v[j].y * r * gg.y); o.y = pk2(v[j].z * r * gg.z, v[j].w * r * gg.w); o8[64 * j] = o; }
}
__device__ __forceinline__ void ph_prologue(const Ctx& a, LAS unsigned char* lds, int lane, int wave) {
    OPAQUE(lane);
    LAS float* scr = (LAS float*)(lds + wave * 16384);
    const int gw = blockIdx.x * NWAVES + wave, NGW = gridDim.x * NWAVES;
    constexpr int I_IN = (DM / 64) * (DIN / 32), I_OUT = (DM / 64) * (DM / 32), I_GLU = (256 / 64) * (256 / 32), I_L = I_IN + I_OUT + I_GLU;
    for (int it = gw; it < 2 * I_L; it += NGW) {
        const int l = it / I_L, r = it % I_L;
        if (r < I_IN) p0_transpose_item(a.inp(I_WIN) + (size_t)l * DM * DIN, DM, DIN, (bf16*)(a.ws + WS_WIN) + (size_t)l * DIN * DM, scr, r, lane);
        else if (r < I_IN + I_OUT) p0_transpose_item(a.inp(I_WOUT) + (size_t)l * DM * DM, DM, DM, (bf16*)(a.ws + WS_WOUT) + (size_t)l * DM * DM, scr, r - I_IN, lane);
        else p0_transpose_item(a.inp(I_WGLU) + (size_t)l * 65536, 256, 256, (bf16*)(a.ws + WS_WGLU) + (size_t)l * 65536, scr, r - I_IN - I_OUT, lane);
    }
    {
        bf16* LWT = (bf16*)(a.ws + WS_LWT);
        const float* wa = a.inp(I_LWA); const float* wx = a.inp(I_LWX);
        for (int idx = gw * 64 + lane; idx < 2 * 2 * 4 * 64 * 64; idx += NGW * 64) {
            const int c = idx & 63, d = (idx >> 6) & 63, n = (idx >> 12) & 3, p = (idx >> 14) & 1, l = idx >> 15;
            LWT[idx] = (bf16)f2bf((p ? wx : wa)[((size_t)(l * 4 + n) * 64 + c) * 64 + d]);
        }
    }
    {
        float* T = (float*)(a.ws + WS_S5T);
        for (int idx = gw * 64 + lane; idx < 2 * 16 * 64; idx += NGW * 64) {
            float ar, ai, fr, fi; s5_disc_compute(a, idx >> 10, (idx >> 6) & 15, idx & 63, ar, ai, fr, fi);
            *(f32x4*)(T + (size_t)idx * 4) = (f32x4){ar, ai, fr, fi};
        }
    }
    {
        bf16* W1T = (bf16*)(a.ws + WS_W1T);
        const float* w1 = a.inp(I_W1); const float* a1 = a.inp(I_A1);
        for (int idx = gw * 64 + lane; idx < 2 * 2 * 32 * 256; idx += NGW * 64) {
            const int k = idx & 255, n = (idx >> 8) & 31, p = (idx >> 13) & 1, l = idx >> 14;
            W1T[idx] = (bf16)f2bf((p ? a1 : w1)[((size_t)l * 256 + k) * 32 + n]);
        }
    }
    bf16* H = (bf16*)(a.ws + WS_H);
    {
        const float* xp = a.inp(I_XP); const float* xs = a.inp(I_XS) - (size_t)NP * DM;
        f32x4 gg[4];
#pragma unroll
        for (int j = 0; j < 4; ++j) gg[j] = ((const f32x4*)a.inp(I_NPRE) + lane)[64 * j];
        for (int m0 = gw; m0 < MTOK; m0 += 2 * NGW) {
            const int m1 = m0 + NGW; const bool has1 = m1 < MTOK; const int mb = has1 ? m1 : m0;
            const f32x4* xa = (const f32x4*)((m0 < NP ? xp : xs) + (size_t)m0 * DM) + lane; const f32x4* xb = (const f32x4*)((mb < NP ? xp : xs) + (size_t)mb * DM) + lane;
            f32x4 va[4], vb[4]; float sa = 0.f, sb = 0.f;
#pragma unroll
            for (int j = 0; j < 4; ++j) { va[j] = xa[64 * j]; vb[j] = xb[64 * j]; }
#pragma unroll
            for (int j = 0; j < 4; ++j) { sa += (va[j].x * va[j].x + va[j].y * va[j].y) + (va[j].z * va[j].z + va[j].w * va[j].w); sb += (vb[j].x * vb[j].x + vb[j].y * vb[j].y) + (vb[j].z * vb[j].z + vb[j].w * vb[j].w); }
            const float ra = rsqrtf(wave_sum_fast(sa) * (1.f / DM) + NORM_EPS), rb = rsqrtf(wave_sum_fast(sb) * (1.f / DM) + NORM_EPS);
            u32x2* ha = (u32x2*)(H + (size_t)m0 * DM) + lane; u32x2* hb = (u32x2*)(H + (size_t)mb * DM) + lane;
#pragma unroll
            for (int j = 0; j < 4; ++j) { u32x2 o; o.x = pk2(va[j].x * ra * gg[j].x, va[j].y * ra * gg[j].y); o.y = pk2(va[j].z * ra * gg[j].z, va[j].w * ra * gg[j].w); ha[64 * j] = o;
                if (has1) { u32x2 p; p.x = pk2(vb[j].x * rb * gg[j].x, vb[j].y * rb * gg[j].y); p.y = pk2(vb[j].z * rb * gg[j].z, vb[j].w * rb * gg[j].w); hb[64 * j] = p; } }
        }
    }
}

struct EpiProj {
    static constexpr bool PERM = true, AFTER_DRAIN = false;
    bf16* P; float* out; int layer;
    __device__ __forceinline__ void operator()(const pg8::f32x4 (&acc)[2][2][4][2], const pg8::Unit& u, int wr, int wc, int fr, int fq) const {
        const int row0 = u.pm * 256 + wr * 64 + fr, col0 = u.pn * 256 + wc * 32 + 8 * fq;
#pragma unroll
        for (int ai = 0; ai < 2; ++ai)
#pragma unroll
            for (int m = 0; m < 4; ++m) { bf16* rowp = P + (size_t)(row0 + ai * 128 + m * 16) * DIN + col0;
#pragma unroll
                for (int bj = 0; bj < 2; ++bj) { const pg8::f32x4 v0 = acc[ai][bj][m][0], v1 = acc[ai][bj][m][1];
                    u32x4 w; w.x = pk2(v0[0], v0[1]); w.y = pk2(v0[2], v0[3]); w.z = pk2(v1[0], v1[1]); w.w = pk2(v1[2], v1[3]);
                    *(u32x4*)(rowp + bj * 128) = w; } }
        if (u.pn == 1 || u.pn == 2) {
            const bool smp = (u.pm >= 64);
            float* base;
            if (u.pn == 1) base = smp ? out + OUT_K_S + (size_t)layer * NSMP * 256 : out + OUT_K_P + (size_t)layer * NP * 256;
            else           base = smp ? out + OUT_V_S + (size_t)layer * NSMP * 256 : out + OUT_V_P + (size_t)layer * NP * 256;
            const int r0 = row0 - (smp ? NP : 0), c0 = wc * 32 + 8 * fq;
#pragma unroll
            for (int ai = 0; ai < 2; ++ai)
#pragma unroll
                for (int m = 0; m < 4; ++m) { float* rowp = base + (size_t)(r0 + ai * 128 + m * 16) * 256 + c0;
#pragma unroll
                    for (int bj = 0; bj < 2; ++bj) { __builtin_nontemporal_store(acc[ai][bj][m][0], (pg8::f32x4*)(rowp + bj * 128)); __builtin_nontemporal_store(acc[ai][bj][m][1], (pg8::f32x4*)(rowp + bj * 128 + 4)); } }
        }
    }
};
struct EpiPlain {
    static constexpr bool PERM = true, AFTER_DRAIN = false;
    bf16* C; int ldc;
    __device__ __forceinline__ void operator()(const pg8::f32x4 (&acc)[2][2][4][2], const pg8::Unit& u, int wr, int wc, int fr, int fq) const {
        const int row0 = u.pm * 256 + wr * 64 + fr, col0 = u.pn * 256 + wc * 32 + 8 * fq;
#pragma unroll
        for (int ai = 0; ai < 2; ++ai)
#pragma unroll
            for (int m = 0; m < 4; ++m) { bf16* rowp = C + (size_t)(row0 + ai * 128 + m * 16) * ldc + col0;
#pragma unroll
                for (int bj = 0; bj < 2; ++bj) { const pg8::f32x4 v0 = acc[ai][bj][m][0], v1 = acc[ai][bj][m][1];
                    u32x4 w; w.x = pk2(v0[0], v0[1]); w.y = pk2(v0[2], v0[3]); w.z = pk2(v1[0], v1[1]); w.w = pk2(v1[2], v1[3]);
                    *(u32x4*)(rowp + bj * 128) = w; } }
    }
};

__device__ __forceinline__ void lru_prep_item(const Ctx& a, int l, int item, LAS unsigned char* lds, int tid) {
    OPAQUE(tid);
    const bf16* PROJ = (const bf16*)(a.ws + WS_PROJ);
    float* LA = (float*)(a.ws + WS_LA); float* LB = (float*)(a.ws + WS_LB);
    LAS float* X = (LAS float*)lds;
    LAS float* XC = (LAS float*)(lds + 68608);
    const bool smp = item >= 256;
    int nseg, seglen, m0, s = 0, ch = 0, b0 = 0;
    if (!smp) { s = item >> 5; ch = item & 31; nseg = 1; seglen = 64; m0 = s * SEQ + ch * 64; }
    else { const int j = item - 256; nseg = 4; seglen = 8; m0 = NP + j * 32; b0 = j * 4; }
    const int rps = seglen + 3, L = nseg * seglen;
    {
        const float* sconv = a.inp(I_SCONV);
#pragma unroll 4
        for (int idx = tid; idx < nseg * rps * 64; idx += NTHREADS) {
            const int row = idx >> 6, c4 = idx & 63, seg = row / rps, i = row % rps;
            const bool halo = i < 3;
            const bool fromstate = smp && halo;
            f32x4 v = ldp4(PROJ + (size_t)(m0 + seg * seglen + (halo && (smp || ch == 0) ? 3 : i) - 3) * DIN + OFF_B + 4 * c4);
            const f32x4 vs = *(const f32x4*)(sconv + (fromstate ? ((size_t)(l * DB + b0 + seg) * 3 + i) * 256 : (size_t)0) + 4 * c4);
            if (fromstate) v = vs;
            if (!smp && ch == 0 && halo) v = (f32x4){0.f, 0.f, 0.f, 0.f};
            *(LAS f32x4*)(X + row * 256 + 4 * c4) = v;
        }
    }
    __syncthreads();
    if (smp || ch == 31) {
        for (int idx = tid; idx < nseg * 3 * 256; idx += NTHREADS) {
            const int seg = idx / 768, j = (idx % 768) >> 8, c = idx & 255;
            const float v = X[(seg * rps + seglen + j) * 256 + c];
            if (smp) a.out[OUT_CONV_S + ((size_t)(l * DB + b0 + seg) * 3 + j) * 256 + c] = v;
            else a.out[OUT_CONV_P + ((size_t)(l * 8 + s) * 3 + j) * 256 + c] = v;
        }
    }
    {
        const float* cw = a.inp(I_CONVW) + l * 1024; const float* cb = a.inp(I_CONVB) + l * 256;
        for (int idx = tid; idx < L * 256; idx += NTHREADS) {
            const int t = idx >> 8, c = idx & 255, seg = t / seglen, i = t % seglen;
            const LAS float* bp = X + (seg * rps + i) * 256 + c;
            XC[t * 256 + c] = cb[c] + cw[c] * bp[0] + cw[256 + c] * bp[256] + cw[512 + c] * bp[512] + cw[768 + c] * bp[768];
        }
    }
    __syncthreads();
    {
        const int lane = tid & 63, wv = tid >> 6, p = wv >> 2, n = wv & 3, r = lane & 31, hh = lane >> 5, o = tid & 255;
        const bf16* WT = (const bf16*)(a.ws + WS_LWT) + ((size_t)((l * 2 + p) * 4 + n) * 64) * 64;
        bf16x8 wf[2][4];
#pragma unroll
        for (int dt = 0; dt < 2; ++dt)
#pragma unroll
            for (int sx = 0; sx < 4; ++sx) wf[dt][sx] = *(const bf16x8*)(WT + (dt * 32 + r) * 64 + 16 * sx + 8 * hh);
        const float* bp = (p ? a.inp(I_LBX) : a.inp(I_LBA)) + l * 256 + n * 64 + 4 * hh;
        LAS float* GX = X;
        const int LH = L >> 1;
        bf16* OB = (bf16*)(a.ws + WS_OB);
        const float spv = softplusf_(-a.inp(I_LLAM)[l * 256 + o]) * 1.4426950408889634f;
        const float* slru = a.inp(I_SLRU);
        float hs = 0.f, Ps = 1.f;
        for (int hf = 0; hf < 2; ++hf) {
            {
                const LAS float* xr = XC + (hf * LH + r) * 256 + n * 64 + 8 * hh;
                bf16x8 xb[4];
#pragma unroll
                for (int sx = 0; sx < 4; ++sx) { const f32x4 x0 = *(const LAS f32x4*)(xr + 16 * sx), x1 = *(const LAS f32x4*)(xr + 16 * sx + 4);
                    u32x4 w; w.x = pk2(x0.x, x0.y); w.y = pk2(x0.z, x0.w); w.z = pk2(x1.x, x1.y); w.w = pk2(x1.z, x1.w); xb[sx] = __builtin_bit_cast(bf16x8, w); }
#pragma unroll
                for (int dt = 0; dt < 2; ++dt) {
                    f32x16 acc;
#pragma unroll
                    for (int e = 0; e < 16; ++e) acc[e] = 0.f;
#pragma unroll
                    for (int sx = 0; sx < 4; ++sx) acc = __builtin_amdgcn_mfma_f32_32x32x16_bf16(wf[dt][sx], xb[sx], acc, 0, 0, 0);
#pragma unroll
                    for (int g4 = 0; g4 < 4; ++g4) { const f32x4 bb = *(const f32x4*)(bp + dt * 32 + 8 * g4);
                        f32x4 gv; gv.x = sigmoidf_(acc[4 * g4] + bb.x); gv.y = sigmoidf_(acc[4 * g4 + 1] + bb.y); gv.z = sigmoidf_(acc[4 * g4 + 2] + bb.z); gv.w = sigmoidf_(acc[4 * g4 + 3] + bb.w);
                        *(LAS f32x4*)(GX + (p * 32 + r) * 256 + n * 64 + dt * 32 + 8 * g4 + 4 * hh) = gv; }
                }
            }
            __syncthreads();
            if (p == 0) {
              for (int t0 = 0; t0 < LH; t0 += 8) {
                float gts[8];
                if (smp) {
#pragma unroll
                    for (int t = 0; t < 8; ++t) gts[t] = ldp1(PROJ + (size_t)(m0 + hf * LH + t0 + t) * DIN + OFF_G + 256 + o); }
#pragma unroll
                for (int t8 = 0; t8 < 8; ++t8) {
                    const int t = t0 + t8;
                    const int tt = hf * LH + t, seg = tt / seglen, i = tt % seglen;
                    if (i == 0) { hs = smp ? slru[(size_t)(l * DB + b0 + seg) * 256 + o] : 0.f; Ps = 1.f; }
                    const float rg = GX[t * 256 + o], g = GX[(32 + t) * 256 + o];
                    const float av = __builtin_amdgcn_exp2f(-8.0f * rg * spv);
                    const float mult = __builtin_amdgcn_sqrtf(fmaxf(1.0f - av * av, 0.f));
                    const float bv = mult * g * XC[tt * 256 + o];
                    const size_t m = (size_t)(m0 + tt);
                    hs = av * hs + bv; Ps *= av;
                    if (smp) { OB[m * DM + 256 + o] = (bf16)f2bf(hs * siluf_(gts[t8])); if (i == seglen - 1) a.out[OUT_LRU_S + (size_t)(l * DB + b0 + seg) * 256 + o] = hs; }
                    else { LA[m * 256 + o] = av; LB[m * 256 + o] = bv; }
                }
              }
            }
            __syncthreads();
        }
        if (!smp && p == 0) { ((float*)(a.ws + WS_LP))[(size_t)(s * 32 + ch) * 256 + o] = Ps; ((float*)(a.ws + WS_LE))[(size_t)(s * 32 + ch) * 256 + o] = hs; }
    }
    __syncthreads();
}

__device__ __forceinline__ void rwkv_prep_item(const Ctx& a, int l, int item, LAS unsigned char* lds, int tid) {
    OPAQUE(tid);
    const bf16* PROJ = (const bf16*)(a.ws + WS_PROJ);
    float* RW = (float*)(a.ws + WS_RW);
    const float* mu = a.inp(I_MU) + l * 1280; const float* sshift = a.inp(I_SSHIFT) + (size_t)l * DB * 1280;
    LAS float* XWA = (LAS float*)lds;
    LAS float* T1 = (LAS float*)(lds + 65536);
    const int m0 = item * 32;
#pragma unroll
    for (int kb = 0; kb < 20; kb += 10) {
        f32x4 pv[10], ppv[10], psv[10];
#pragma unroll
        for (int k = 0; k < 10; ++k) {
            const int idx = tid + NTHREADS * (kb + k), t = idx / 320, c4 = idx % 320, col = 4 * c4, m = m0 + t;
            const bool first = (m < NP) ? ((m & (SEQ - 1)) == 0) : (((m - NP) & 7) == 0);
            const bool fromstate = first && m >= NP;
            pv[k] = ldp4(PROJ + (size_t)m * DIN + OFF_C + col);
            ppv[k] = ldp4(PROJ + (size_t)(first ? m : m - 1) * DIN + OFF_C + col);
            psv[k] = *(const f32x4*)(sshift + (fromstate ? (size_t)((m - NP) >> 3) * 1280 : (size_t)0) + col);
        }
#pragma unroll
        for (int k = 0; k < 10; ++k) {
            const int idx = tid + NTHREADS * (kb + k), t = idx / 320, c4 = idx % 320, col = 4 * c4, m = m0 + t;
            const bool first = (m < NP) ? ((m & (SEQ - 1)) == 0) : (((m - NP) & 7) == 0);
            f32x4 pp = ppv[k];
            if (first && m >= NP) pp = psv[k];
            if (first && m < NP) pp = (f32x4){0.f, 0.f, 0.f, 0.f};
            const f32x4 xm = pv[k] + (pp - pv[k]) * *(const f32x4*)(mu + col);
            const int sec = c4 >> 6, cc = col & 255;
            if (sec == 1) *(LAS f32x4*)(XWA + t * 512 + cc) = xm;
            else if (sec == 4) *(LAS f32x4*)(XWA + t * 512 + 256 + cc) = xm;
            else *(f32x4*)(RW + (size_t)m * 1536 + (sec == 0 ? 0 : (sec == 2 ? 512 : 768)) + cc) = xm;
        }
    }
    __syncthreads();
    if (tid < 128) {
        const int lane = tid & 63, p = tid >> 6, r = lane & 31, hh = lane >> 5;
        const bf16* wt = (const bf16*)(a.ws + WS_W1T) + ((size_t)(l * 2 + p) * 32 + r) * 256 + 8 * hh;
        const LAS float* xr = XWA + r * 512 + p * 256 + 8 * hh;
        f32x16 acc;
#pragma unroll
        for (int e = 0; e < 16; ++e) acc[e] = 0.f;
#pragma unroll
        for (int sx = 0; sx < 16; ++sx) {
            const bf16x8 af = *(const bf16x8*)(wt + 16 * sx);
            const f32x4 x0 = *(const LAS f32x4*)(xr + 16 * sx), x1 = *(const LAS f32x4*)(xr + 16 * sx + 4);
            u32x4 w; w.x = pk2(x0.x, x0.y); w.y = pk2(x0.z, x0.w); w.z = pk2(x1.x, x1.y); w.w = pk2(x1.z, x1.w);
            acc = __builtin_amdgcn_mfma_f32_32x32x16_bf16(af, __builtin_bit_cast(bf16x8, w), acc, 0, 0, 0);
        }
#pragma unroll
        for (int g4 = 0; g4 < 4; ++g4) { f32x4 v = (f32x4){acc[4 * g4], acc[4 * g4 + 1], acc[4 * g4 + 2], acc[4 * g4 + 3]};
            if (p == 0) { v.x = tanhf_(v.x); v.y = tanhf_(v.y); v.z = tanhf_(v.z); v.w = tanhf_(v.w); }
            *(LAS f32x4*)(T1 + r * 64 + p * 32 + 8 * g4 + 4 * hh) = v; }
    }
    __syncthreads();
    {
        const int o = tid & 255, half = tid >> 8;
        float wr[32];
        const float* w2p = (half ? a.inp(I_A2) : a.inp(I_W2)) + (size_t)l * 32 * 256 + o;
#pragma unroll
        for (int j = 0; j < 32; ++j) wr[j] = w2p[(size_t)j * 256];
        const float b0 = (half ? a.inp(I_A0) : a.inp(I_W0))[l * 256 + o];
        const float kkw = a.inp(I_KK)[l * 256 + o], kaw = a.inp(I_KA)[l * 256 + o];
#pragma unroll
        for (int t0 = 0; t0 < 32; t0 += 8) {
            float xk_[8];
            if (half) {
#pragma unroll
                for (int t = 0; t < 8; ++t) xk_[t] = RW[(size_t)(m0 + t0 + t) * 1536 + 512 + o]; }
#pragma unroll
            for (int t8 = 0; t8 < 8; ++t8) {
                const int t = t0 + t8;
                float z0 = b0, z1 = 0.f;
                const LAS float* tp = T1 + t * 64 + half * 32;
#pragma unroll
                for (int j4 = 0; j4 < 8; ++j4) { const f32x4 tv = *(const LAS f32x4*)(tp + 4 * j4);
                    z0 += tv.x * wr[4 * j4] + tv.y * wr[4 * j4 + 1]; z1 += tv.z * wr[4 * j4 + 2] + tv.w * wr[4 * j4 + 3]; }
                const float z = z0 + z1;
                float* rwp = RW + (size_t)(m0 + t) * 1536 + o;
                if (half == 0) {
                    rwp[256] = __builtin_amdgcn_exp2f(-0.8750566294f * sigmoidf_(z));
                } else {
                    const float aa = sigmoidf_(z);
                    const float xk = xk_[t8];
                    const float kkv = xk * kkw;
                    const float ss = wave_sum_fast(kkv * kkv);
                    const float kkn = kkv * __builtin_amdgcn_rsqf(fmaxf(ss, 1e-24f));
                    rwp[512] = xk * (1.0f + (aa - 1.0f) * kaw); rwp[1024] = -kkn; rwp[1280] = kkn * aa;
                }
            }
        }
    }
    __syncthreads();
}

__device__ __forceinline__ void s5_disc(const Ctx& a, int l, int g, int n, float& ab_re, float& ab_im, float& f_re, float& f_im) {
    const f32x4 t = *(const f32x4*)((const float*)(a.ws + WS_S5T) + ((size_t)(l * 16 + g) * 64 + n) * 4);
    ab_re = t.x; ab_im = t.y; f_re = t.z; f_im = t.w;
}
__device__ __forceinline__ void s5_disc_compute(const Ctx& a, int l, int g, int n, float& ab_re, float& ab_im, float& f_re, float& f_im) {
    const float lr = a.inp(I_LRE)[(l * 16 + g) * 64 + n], li = a.inp(I_LIM)[(l * 16 + g) * 64 + n];
    const float dt = expf(a.inp(I_LOGDT)[l * 16 + g]);
    const float mag = expf(lr * dt);
    ab_re = mag * cosf(li * dt); ab_im = mag * sinf(li * dt);
    const float den = lr * lr + li * li, pr = ab_re - 1.0f;
    f_re = (pr * lr + ab_im * li) / den; f_im = (ab_im * lr - pr * li) / den;
}
struct S5Par { float ab_re, ab_im; bf16x8 bf[4]; };
__device__ __forceinline__ void s5_params(const Ctx& a, int l, int g, int lane, S5Par& P) {
    float fr, fi;
    s5_disc(a, l, g, lane, P.ab_re, P.ab_im, fr, fi);
    const int r = lane & 31, hh = lane >> 5;
#pragma unroll
    for (int nh = 0; nh < 2; ++nh) {
        float xr, xi, f_re, f_im;
        s5_disc(a, l, g, 32 * nh + r, xr, xi, f_re, f_im);
        const float* brp = a.inp(I_BRE) + ((size_t)(l * 16 + g) * 64 + 32 * nh + r) * 16 + 8 * hh; const float* bip = a.inp(I_BIM) + ((size_t)(l * 16 + g) * 64 + 32 * nh + r) * 16 + 8 * hh;
        const f32x4 r0 = *(const f32x4*)brp, r1 = *(const f32x4*)(brp + 4), i0 = *(const f32x4*)bip, i1 = *(const f32x4*)(bip + 4);
        u32x4 wr, wi;
        wr.x = pk2(f_re * r0.x - f_im * i0.x, f_re * r0.y - f_im * i0.y); wr.y = pk2(f_re * r0.z - f_im * i0.z, f_re * r0.w - f_im * i0.w);
        wr.z = pk2(f_re * r1.x - f_im * i1.x, f_re * r1.y - f_im * i1.y); wr.w = pk2(f_re * r1.z - f_im * i1.z, f_re * r1.w - f_im * i1.w);
        wi.x = pk2(f_re * i0.x + f_im * r0.x, f_re * i0.y + f_im * r0.y); wi.y = pk2(f_re * i0.z + f_im * r0.z, f_re * i0.w + f_im * r0.w);
        wi.z = pk2(f_re * i1.x + f_im * r1.x, f_re * i1.y + f_im * r1.y); wi.w = pk2(f_re * i1.z + f_im * r1.z, f_re * i1.w + f_im * r1.w);
        P.bf[nh] = __builtin_bit_cast(bf16x8, wr); P.bf[2 + nh] = __builtin_bit_cast(bf16x8, wi);
    }
}
__device__ __forceinline__ void s5_bu_block(const S5Par& P, const bf16* PROJ, size_t m0, int nvalid, int g, LAS float* HR, LAS float* HI, int lane) {
    const int r = lane & 31, hh = lane >> 5;
    const int tr = r < nvalid ? r : nvalid - 1;
    const bf16x8 uf = *(const bf16x8*)(PROJ + (m0 + tr) * DIN + OFF_D + g * 16 + 8 * hh);
#pragma unroll
    for (int tile = 0; tile < 4; ++tile) {
        f32x16 acc;
#pragma unroll
        for (int e = 0; e < 16; ++e) acc[e] = 0.f;
        acc = __builtin_amdgcn_mfma_f32_32x32x16_bf16(P.bf[tile], uf, acc, 0, 0, 0);
        LAS float* dst = ((tile >> 1) ? HI : HR) + r * 68 + 32 * (tile & 1) + 4 * hh;
#pragma unroll
        for (int g4 = 0; g4 < 4; ++g4) *(LAS f32x4*)(dst + 8 * g4) = (f32x4){acc[4 * g4], acc[4 * g4 + 1], acc[4 * g4 + 2], acc[4 * g4 + 3]};
    }
    asm volatile("s_waitcnt lgkmcnt(0)" ::: "memory");
}
__device__ __forceinline__ void s5_pass1_wave(const Ctx& a, int l, int wi, LAS unsigned char* wlds, int lane) {
    OPAQUE(lane);
    const int ck = wi & 15, g = (wi >> 4) & 15, s = wi >> 8;
    const bf16* PROJ = (const bf16*)(a.ws + WS_PROJ);
    LAS float* HR = (LAS float*)wlds; LAS float* HI = HR + 32 * 68;
    S5Par P; s5_params(a, l, g, lane, P);
    float hr = 0.f, hi = 0.f;
    for (int t0 = 0; t0 < 128; t0 += 32) {
        s5_bu_block(P, PROJ, (size_t)(s * SEQ + ck * 128 + t0), 32, g, HR, HI, lane);
#pragma unroll 8
        for (int t = 0; t < 32; ++t) { const float br = HR[t * 68 + lane], bi = HI[t * 68 + lane];
            const float nr = P.ab_re * hr - P.ab_im * hi + br, ni = P.ab_re * hi + P.ab_im * hr + bi; hr = nr; hi = ni; }
        asm volatile("s_waitcnt lgkmcnt(0)" ::: "memory");
    }
    f32x2* E = (f32x2*)(a.ws + WS_S5E);
    E[((size_t)(s * 16 + g) * 16 + ck) * 64 + lane] = (f32x2){hr, hi};
}

__device__ __forceinline__ void attn_prep_rows_wave(const Ctx& a, int wi, int lane) {
    OPAQUE(lane);
    const bf16* PROJ = (const bf16*)(a.ws + WS_PROJ);
    bf16* QB = (bf16*)(a.ws + WS_QB);
#pragma unroll
    for (int r = 0; r < 8; ++r) { const size_t m = (size_t)wi * 8 + r;
        const f32x4 q = ldp4(PROJ + m * DIN + OFF_AQ + 4 * lane);
        u32x2 qo; qo.x = pk2(q.x * QSCALE, q.y * QSCALE); qo.y = pk2(q.z * QSCALE, q.w * QSCALE);
        *(u32x2*)(QB + m * 256 + 4 * lane) = qo; }
}
__device__ __forceinline__ void attn_prep_kv_wave(const Ctx& a, int wi, int lane) {
    OPAQUE(lane);
    const bf16* PROJ = (const bf16*)(a.ws + WS_PROJ);
    bf16* KF = (bf16*)(a.ws + WS_KB); bf16* VF = (bf16*)(a.ws + WS_VT);
    const int kt = wi & 63, b = wi >> 6, r = lane & 31, hh = lane >> 5;
    const bf16* krow = PROJ + (size_t)(b * SEQ + kt * 32 + r) * DIN + OFF_AK + 8 * hh;
    const bf16* vcol = PROJ + (size_t)(b * SEQ + kt * 32 + 4 * hh) * DIN + OFF_AV + r;
#pragma unroll
    for (int h = 0; h < 4; ++h) {
#pragma unroll
        for (int cs = 0; cs < 4; ++cs) {
            const u32x4 ko = *(const u32x4*)(krow + h * 64 + cs * 16);
            const size_t frag = ((size_t)((b * 4 + h) * 64 + kt) * 4 + cs) * 512 + lane * 8;
            *(u32x4*)(KF + frag) = ko;
            const int tl = cs >> 1, s2 = cs & 1;
            const bf16* vp = vcol + (size_t)(16 * s2) * DIN + h * 64 + 32 * tl;
            unsigned v[8];
#pragma unroll
            for (int jj = 0; jj < 8; ++jj) v[jj] = (unsigned)vp[(size_t)(8 * (jj >> 2) + (jj & 3)) * DIN];
            u32x4 vo; vo.x = v[0] | (v[1] << 16); vo.y = v[2] | (v[3] << 16); vo.z = v[4] | (v[5] << 16); vo.w = v[6] | (v[7] << 16);
            *(u32x4*)(VF + frag) = vo;
        }
    }
}

#ifndef MP_MASK
#define MP_MASK 0x1f
#endif
#ifndef MM_MASK
#define MM_MASK 0x7f
#endif
#define MPE(j) ((MP_MASK >> (j)) & 1)
#define MME(j) ((MM_MASK >> (j)) & 1)
constexpr int MP_LRU = 256 + 32, MP_RW = MTOK / 32, MP_S5 = 256  , MP_AR = 256  , MP_VT = 64  ;
constexpr int MP_TOTAL = MP_LRU + MP_RW + MP_S5 + MP_AR + MP_VT;
__device__ __forceinline__ int grab_unit(unsigned* ctr, volatile LAS unsigned* MISC, int tid) {
    __syncthreads();
    if (tid == 0) MISC[4] = atomicAdd(ctr, 1u);
    __syncthreads();
    return (int)MISC[4];
}
__device__ __forceinline__ void ph_mixprep(const Ctx& a, int lq, int MMSK, LAS unsigned char* lds, volatile LAS unsigned* MISC, int tid, int lane, int wave) {
    const int l = lq & 1;
    unsigned* qctr = (unsigned*)(a.ws + WS_CTL) + CW_QUEUE + 4096 + 512 * lq;
    int u;
    const bool rwfirst = ((blockIdx.x >> 3) & 1) != 0;
#pragma unroll 1
    for (int pass = 0; pass < 2; ++pass) {
        if ((pass == 0) == rwfirst) { if (MMSK & 2) while ((u = grab_unit(qctr + 1 * 64, MISC, tid)) < MP_RW) rwkv_prep_item(a, l, u, lds, tid); }
        else { if (MMSK & 1) while ((u = grab_unit(qctr + 0 * 64, MISC, tid)) < MP_LRU) lru_prep_item(a, l, u, lds, tid); }
    }
    if (MMSK & 4) while ((u = grab_unit(qctr + 2 * 64, MISC, tid)) < MP_S5) s5_pass1_wave(a, l, u * 8 + wave, lds + wave * 17408, lane);
    if (MMSK & 8) while ((u = grab_unit(qctr + 3 * 64, MISC, tid)) < MP_AR) attn_prep_rows_wave(a, u * 8 + wave, lane);
    if (MMSK & 16) while ((u = grab_unit(qctr + 4 * 64, MISC, tid)) < MP_VT) attn_prep_kv_wave(a, u * 8 + wave, lane);
    {
        const bf16* PROJ = (const bf16*)(a.ws + WS_PROJ);
        const int gt = blockIdx.x * NTHREADS + tid, NGT = gridDim.x * NTHREADS;
        for (int idx = gt; idx < 136 * 1280; idx += NGT) {
            const int q = idx / 1280, c = idx % 1280;
            if (q < 8) a.out[OUT_SHIFT_P + (size_t)(l * 8 + q) * 1280 + c] = ldp1(PROJ + (size_t)(q * SEQ + SEQ - 1) * DIN + OFF_C + c);
            else a.out[OUT_SHIFT_S + (size_t)(l * DB + (q - 8)) * 1280 + c] = ldp1(PROJ + (size_t)(NP + (q - 8) * 8 + 7) * DIN + OFF_C + c);
        }
    }
}

struct RwOps { f32x2 w[4], k[4], a[4], b[4], r[4]; float vi; };
__device__ __forceinline__ void rw_ld4(f32x2 (&d)[4], const LAS float* p) { const f32x4 x = *(const LAS f32x4*)p, y = *(const LAS f32x4*)(p + 4);
    d[0] = (f32x2){x.x, x.y}; d[1] = (f32x2){x.z, x.w}; d[2] = (f32x2){y.x, y.y}; d[3] = (f32x2){y.z, y.w}; }
template <int MODE> __device__ __forceinline__ void rw_load_ops(RwOps& o, const LAS float* base, int i, int jq) {
    rw_ld4(o.w, base + 64 + 8 * jq); rw_ld4(o.k, base + 128 + 8 * jq);
    o.vi = base[192 + i];
    rw_ld4(o.a, base + 256 + 8 * jq); rw_ld4(o.b, base + 320 + 8 * jq);
    if (MODE == 0) rw_ld4(o.r, base + 8 * jq);
}
__device__ __forceinline__ float rw_dot(const f32x2 (&S)[4], const f32x2 (&v)[4]) {
    const f32x2 d0 = S[0] * v[0] + S[1] * v[1], d1 = S[2] * v[2] + S[3] * v[3];
    const f32x2 d = d0 + d1;
    return d.x + d.y;
}
template <int MODE> __device__ __forceinline__ void rw_step(const RwOps& o, f32x2 (&S)[4], f32x2 (&Pm)[4], LAS float* yslot, int jq) {
    const float sa = red8(rw_dot(S, o.a));
    const f32x2 sa2 = (f32x2){sa, sa}, vi2 = (f32x2){o.vi, o.vi};
#pragma unroll
    for (int k = 0; k < 4; ++k) S[k] = (S[k] * o.w[k] + vi2 * o.k[k]) + sa2 * o.b[k];
    if (MODE == 0) {
        const float y = red8(rw_dot(S, o.r));
        if (jq == 0) *yslot = y;
    } else {
        const float sp = red8(rw_dot(Pm, o.a));
        const f32x2 sp2 = (f32x2){sp, sp};
#pragma unroll
        for (int k = 0; k < 4; ++k) Pm[k] = Pm[k] * o.w[k] + sp2 * o.b[k];
    }
}
template <int MODE, int TT>
__device__ __forceinline__ void rwkv_core(const Ctx& a, int l, int h, int mbase, int T, float (&S8)[8], float (&P8)[8], LAS unsigned char* lds, int tid) {
    f32x2 S[4], Pm[4];
#pragma unroll
    for (int k = 0; k < 4; ++k) { S[k] = (f32x2){S8[2 * k], S8[2 * k + 1]}; Pm[k] = (f32x2){P8[2 * k], P8[2 * k + 1]}; }
    const float* RW = (const float*)(a.ws + WS_RW);
    const f32x4 rk4 = *(const f32x4*)(a.inp(I_RK) + l * 256 + h * 64 + 4 * (tid & 15));
    bf16* OB = (bf16*)(a.ws + WS_OB); const bf16* PROJ = (const bf16*)(a.ws + WS_PROJ);
    LAS float* RWT = (LAS float*)lds;
    LAS float* Y = (LAS float*)(lds + 49152);
    const int i = tid >> 3, jq = tid & 7;
    f32x4 pre[6];
#define RW_LOAD(tile) do { _Pragma("unroll") for (int k = 0; k < 6; ++k) { const int idx = tid + NTHREADS * k; \
        if (idx < TT * 96) { const int t = idx / 96, rem = idx % 96, sec = rem >> 4, c4 = rem & 15; \
            pre[k] = *(const f32x4*)(RW + (size_t)(mbase + (tile) * TT + t) * 1536 + sec * 256 + h * 64 + 4 * c4); } } } while (0)
#define RW_STORE() do { _Pragma("unroll") for (int k = 0; k < 6; ++k) { const int idx = tid + NTHREADS * k; \
        if (idx < TT * 96) *(LAS f32x4*)(RWT + idx * 4) = pre[k]; } } while (0)
    const int ntile = T / TT;
    const int gt_t = tid >> 4, gt_q = tid & 15;
    f32x4 gn_w = (f32x4){0.f, 0.f, 0.f, 0.f}, gn_b = gn_w, gpre = gn_w;
    if (MODE == 0) { gn_w = *(const f32x4*)(a.inp(I_GNW) + l * 256 + h * 64 + 4 * gt_q); gn_b = *(const f32x4*)(a.inp(I_GNB) + l * 256 + h * 64 + 4 * gt_q); }
    RW_LOAD(0);
    __syncthreads();
    RW_STORE();
    __syncthreads();
    for (int tile = 0; tile < ntile; ++tile) {
        if (tile + 1 < ntile) RW_LOAD(tile + 1);
        if (MODE == 0 && gt_t < TT) gpre = ldp4(PROJ + (size_t)(mbase + tile * TT + gt_t) * DIN + OFF_G + 512 + h * 64 + 4 * gt_q);
        {
            RwOps oa, ob;
            rw_load_ops<MODE>(oa, RWT, i, jq);
            for (int t = 0; t < TT; t += 2) {
                rw_load_ops<MODE>(ob, RWT + (t + 1) * 384, i, jq);
                rw_step<MODE>(oa, S, Pm, Y + t * 64 + i, jq);
                rw_load_ops<MODE>(oa, RWT + (t + 2) * 384, i, jq);
                rw_step<MODE>(ob, S, Pm, Y + (t + 1) * 64 + i, jq);
            }
        }
        __syncthreads();
        if (MODE == 0) {
            const int t = tid >> 4, q = tid & 15;
            if (t < TT) {
                const f32x4 yv = *(const LAS f32x4*)(Y + t * 64 + 4 * q);
                const float mean = red16((yv.x + yv.y) + (yv.z + yv.w)) * (1.f / 64.f);
                const f32x4 dv = yv - mean;
                const float rs = rsqrtf(red16((dv.x * dv.x + dv.y * dv.y) + (dv.z * dv.z + dv.w * dv.w)) * (1.f / 64.f) + 64.0f * 1e-5f);
                const int m = mbase + tile * TT + t;
                const f32x4 gw = gn_w, gb = gn_b;
                const f32x4 vv = *(const LAS f32x4*)(RWT + t * 384 + 192 + 4 * q);
                const f32x4 r4 = *(const LAS f32x4*)(RWT + t * 384 + 4 * q), k4 = *(const LAS f32x4*)(RWT + t * 384 + 128 + 4 * q);
                const float bon = red16((r4.x * k4.x * rk4.x + r4.y * k4.y * rk4.y) + (r4.z * k4.z * rk4.z + r4.w * k4.w * rk4.w));
                const f32x4 o = dv * rs * gw + gb + bon * vv;
                const f32x4 gt = gpre;
                u32x2 ow; ow.x = pk2(o.x * siluf_(gt.x), o.y * siluf_(gt.y)); ow.y = pk2(o.z * siluf_(gt.z), o.w * siluf_(gt.w));
                *(u32x2*)(OB + (size_t)m * DM + 512 + h * 64 + 4 * q) = ow;
            }
            __syncthreads();
        }
        if (tile + 1 < ntile) { RW_STORE(); }
        __syncthreads();
    }
#undef RW_LOAD
#undef RW_STORE
#pragma unroll
    for (int k = 0; k < 4; ++k) { S8[2 * k] = S[k].x; S8[2 * k + 1] = S[k].y; P8[2 * k] = Pm[k].x; P8[2 * k + 1] = Pm[k].y; }
}
__device__ __forceinline__ void st8(float* dst, const float (&S)[8]) { *(f32x4*)dst = (f32x4){S[0], S[1], S[2], S[3]}; *(f32x4*)(dst + 4) = (f32x4){S[4], S[5], S[6], S[7]}; }
__device__ __forceinline__ void ld8(const float* src, float (&S)[8]) { const f32x4 s0 = *(const f32x4*)src, s1 = *(const f32x4*)(src + 4);
    S[0] = s0.x; S[1] = s0.y; S[2] = s0.z; S[3] = s0.w; S[4] = s1.x; S[5] = s1.y; S[6] = s1.z; S[7] = s1.w; }
__device__ __forceinline__ void rwkv_sample_unit(const Ctx& a, int l, int b, int h, LAS unsigned char* lds, int tid) {
    OPAQUE(tid);
    const int i = tid >> 3, jq = tid & 7;
    float S[8], D[8];
    ld8(a.inp(I_SWKV) + (((size_t)(l * DB + b) * 4 + h) * 64 + i) * 64 + 8 * jq, S);
    rwkv_core<0, 8>(a, l, h, NP + b * DS, DS, S, D, lds, tid);
    st8(a.out + OUT_WKV_S + (((size_t)(l * DB + b) * 4 + h) * 64 + i) * 64 + 8 * jq, S);
}
__device__ __forceinline__ void rwkv_prompt_unitA(const Ctx& a, int l, int u, LAS unsigned char* lds, int tid) {
    OPAQUE(tid);
    const int c = u & 7, h = (u >> 3) & 3, s = u >> 5;
    if (c == 7) return;
    const int i = tid >> 3, jq = tid & 7;
    float* pz = (float*)(a.ws + WS_PZ) + ((size_t)((s * 4 + h) * 8 + c) * 2) * 4096 + i * 64 + 8 * jq;
    float S[8], Pm[8];
#pragma unroll
    for (int e = 0; e < 8; ++e) { S[e] = 0.f; Pm[e] = (8 * jq + e == i) ? 1.f : 0.f; }
    if (c == 0) { rwkv_core<0, 32>(a, l, h, s * SEQ, 256, S, Pm, lds, tid); st8(pz + 4096, S); }
    else { rwkv_core<1, 32>(a, l, h, s * SEQ + c * 256, 256, S, Pm, lds, tid); st8(pz, Pm); st8(pz + 4096, S); }
}
__device__ __forceinline__ void rwkv_prompt_unitB(const Ctx& a, int l, int u, LAS unsigned char* lds, int tid) {
    OPAQUE(tid);
    const int c = 7 - (u >> 5), sh = u & 31, s = sh >> 2, h = sh & 3;
    const int i = tid >> 3, jq = tid & 7;
    const float* pzb = (const float*)(a.ws + WS_PZ) + ((size_t)(sh * 8) * 2) * 4096;
    LAS float* SL = (LAS float*)lds;
    LAS float* PL = (LAS float*)(lds + 17408);
    float S[8], Z[8];
    ld8(pzb + 4096 + i * 64 + 8 * jq, S);
    {
        f32x4 pp[6][2]; float ZZ[6][8];
#pragma unroll
        for (int cp = 1; cp <= 6; ++cp) if (cp < c) { const float* pg = pzb + (size_t)cp * 8192;
            pp[cp - 1][0] = *(const f32x4*)(pg + tid * 4); pp[cp - 1][1] = *(const f32x4*)(pg + (tid + NTHREADS) * 4); ld8(pg + 4096 + i * 64 + 8 * jq, ZZ[cp - 1]); }
        __syncthreads();
#pragma unroll
        for (int cp = 1; cp <= 6; ++cp) if (cp < c) { *(LAS f32x4*)(PL + (cp - 1) * 4096 + tid * 4) = pp[cp - 1][0]; *(LAS f32x4*)(PL + (cp - 1) * 4096 + (tid + NTHREADS) * 4) = pp[cp - 1][1]; }
#pragma unroll
        for (int cp = 1; cp <= 6; ++cp) if (cp < c) {
            __syncthreads();
            *(LAS f32x4*)(SL + i * 68 + 8 * jq) = (f32x4){S[0], S[1], S[2], S[3]}; *(LAS f32x4*)(SL + i * 68 + 8 * jq + 4) = (f32x4){S[4], S[5], S[6], S[7]};
            __syncthreads();
            const LAS float* PLc = PL + (cp - 1) * 4096;
#pragma unroll
            for (int e = 0; e < 8; ++e) Z[e] = ZZ[cp - 1][e];
#pragma unroll 4
            for (int k4 = 0; k4 < 16; ++k4) {
                const f32x4 sv = *(const LAS f32x4*)(SL + i * 68 + 4 * k4);
#pragma unroll
                for (int kk = 0; kk < 4; ++kk) { const f32x4 q0 = *(const LAS f32x4*)(PLc + (4 * k4 + kk) * 64 + 8 * jq), q1 = *(const LAS f32x4*)(PLc + (4 * k4 + kk) * 64 + 8 * jq + 4);
                    const float x = sv[kk];
                    Z[0] += x * q0.x; Z[1] += x * q0.y; Z[2] += x * q0.z; Z[3] += x * q0.w; Z[4] += x * q1.x; Z[5] += x * q1.y; Z[6] += x * q1.z; Z[7] += x * q1.w; }
            }
#pragma unroll
            for (int e = 0; e < 8; ++e) S[e] = Z[e];
        }
    }
    rwkv_core<0, 32>(a, l, h, s * SEQ + c * 256, 256, S, Z, lds, tid);
    if (c == 7) st8(a.out + OUT_WKV_P + (((size_t)(l * 8 + s) * 4 + h) * 64 + i) * 64 + 8 * jq, S);
}

__device__ __forceinline__ void lru_pass2_wave(const Ctx& a, int l, int wi, int lane) {
    OPAQUE(lane);
    const int q = wi & 3, ch = (wi >> 2) & 31, s = wi >> 7;
    const int o = q * 64 + lane;
    const float* LA = (const float*)(a.ws + WS_LA); const float* LB = (const float*)(a.ws + WS_LB);
    const float* LP = (const float*)(a.ws + WS_LP); const float* LE = (const float*)(a.ws + WS_LE);
    bf16* OB = (bf16*)(a.ws + WS_OB); const bf16* PROJ = (const bf16*)(a.ws + WS_PROJ);
    float h = 0.f;
#pragma unroll 8
    for (int c = 0; c < ch; ++c) h = LP[(size_t)(s * 32 + c) * 256 + o] * h + LE[(size_t)(s * 32 + c) * 256 + o];
    const size_t m0 = (size_t)s * SEQ + ch * 64;
#pragma unroll
    for (int i0 = 0; i0 < 64; i0 += 32) {
        float av[32], bv[32], gv[32];
#pragma unroll
        for (int i = 0; i < 32; ++i) { av[i] = LA[(m0 + i0 + i) * 256 + o]; bv[i] = LB[(m0 + i0 + i) * 256 + o]; gv[i] = ldp1(PROJ + (m0 + i0 + i) * DIN + OFF_G + 256 + o); }
#pragma unroll
        for (int i = 0; i < 32; ++i) { h = av[i] * h + bv[i]; OB[(m0 + i0 + i) * DM + 256 + o] = (bf16)f2bf(h * siluf_(gv[i])); }
    }
    if (ch == 31) a.out[OUT_LRU_P + (size_t)(l * 8 + s) * 256 + o] = h;
}

__device__ __forceinline__ float gelu_tanh(float y) { return 0.5f * y * (1.0f + tanhf_(0.7978845608028654f * (y + 0.044715f * y * y * y))); }
__device__ __forceinline__ void s5_pass2_wave(const Ctx& a, int l, bool smp, int wi, LAS unsigned char* wlds, int lane) {
    OPAQUE(lane);
    const bf16* PROJ = (const bf16*)(a.ws + WS_PROJ);
    bf16* ZB = (bf16*)(a.ws + WS_ZB);
    LAS float* HR = (LAS float*)wlds;
    LAS float* HI = HR + 32 * 68;
    int g, mbase, T, ck = 0, sq;
    if (smp) { g = wi & 15; sq = wi >> 4; mbase = NP + sq * DS; T = DS; }
    else { ck = wi & 15; g = (wi >> 4) & 15; sq = wi >> 8; mbase = sq * SEQ + ck * 128; T = 128; }
    S5Par P; s5_params(a, l, g, lane, P);
    float hr, hi;
    if (smp) { const f32x2 v = *(const f32x2*)(a.inp(I_SSSM) + (((size_t)(l * DB + sq) * 16 + g) * 64 + lane) * 2); hr = v.x; hi = v.y; }
    else {
        float pr = P.ab_re, pi = P.ab_im;
#pragma unroll
        for (int k = 0; k < 7; ++k) { const float nr = pr * pr - pi * pi, ni = 2.0f * pr * pi; pr = nr; pi = ni; }
        hr = 0.f; hi = 0.f;
        const f32x2* E = (const f32x2*)(a.ws + WS_S5E) + ((size_t)(sq * 16 + g) * 16) * 64 + lane;
        for (int c = 0; c < ck; ++c) { const f32x2 e = E[(size_t)c * 64]; const float nr = pr * hr - pi * hi + e.x, ni = pr * hi + pi * hr + e.y; hr = nr; hi = ni; }
    }
    const int cc = lane & 15, kq = lane >> 4;
    bf16x8 cf[4];
    {
        const float* crp = a.inp(I_CRE) + ((size_t)(l * 16 + g) * 16 + cc) * 64 + 8 * kq; const float* cip = a.inp(I_CIM) + ((size_t)(l * 16 + g) * 16 + cc) * 64 + 8 * kq;
#pragma unroll
        for (int ks = 0; ks < 4; ++ks) { const float* p = (ks < 2 ? crp : cip) + 32 * (ks & 1); const float sg = ks < 2 ? 1.f : -1.f;
            const f32x4 x0 = *(const f32x4*)p, x1 = *(const f32x4*)(p + 4);
            u32x4 w; w.x = pk2(sg * x0.x, sg * x0.y); w.y = pk2(sg * x0.z, sg * x0.w); w.z = pk2(sg * x1.x, sg * x1.y); w.w = pk2(sg * x1.z, sg * x1.w); cf[ks] = __builtin_bit_cast(bf16x8, w); }
    }
    const f32x4 dd4 = *(const f32x4*)(a.inp(I_S5D) + l * 256 + g * 16 + 4 * kq);
    for (int t0 = 0; t0 < T; t0 += 32) {
        const int nt = (T - t0) < 32 ? (T - t0) : 32;
        s5_bu_block(P, PROJ, (size_t)(mbase + t0), nt, g, HR, HI, lane);
        for (int t = 0; t < nt; ++t) { const float br = HR[t * 68 + lane], bi = HI[t * 68 + lane];
            const float nr = P.ab_re * hr - P.ab_im * hi + br, ni = P.ab_re * hi + P.ab_im * hr + bi; hr = nr; hi = ni;
            HR[t * 68 + lane] = hr; HI[t * 68 + lane] = hi; }
        asm volatile("s_waitcnt lgkmcnt(0)" ::: "memory");
#pragma unroll
        for (int tt = 0; tt < 2; ++tt) {
            if (tt * 16 < nt) {
                f32x4 acc = (f32x4){0.f, 0.f, 0.f, 0.f};
#pragma unroll
                for (int ks = 0; ks < 4; ++ks) { const LAS float* hp = (ks < 2 ? HR : HI) + (tt * 16 + cc) * 68 + 32 * (ks & 1) + 8 * kq;
                    const f32x4 x0 = *(const LAS f32x4*)hp, x1 = *(const LAS f32x4*)(hp + 4);
                    u32x4 w; w.x = pk2(x0.x, x0.y); w.y = pk2(x0.z, x0.w); w.z = pk2(x1.x, x1.y); w.w = pk2(x1.z, x1.w);
                    acc = __builtin_amdgcn_mfma_f32_16x16x32_bf16(cf[ks], __builtin_bit_cast(bf16x8, w), acc, 0, 0, 0); }
                const int t = tt * 16 + cc;
                if (t < nt) { const size_t m = (size_t)(mbase + t0 + t);
                    const f32x4 u4 = ldp4(PROJ + m * DIN + OFF_D + g * 16 + 4 * kq);
                    u32x2 zz; zz.x = pk2(gelu_tanh(acc.x + dd4.x * u4.x), gelu_tanh(acc.y + dd4.y * u4.y)); zz.y = pk2(gelu_tanh(acc.z + dd4.z * u4.z), gelu_tanh(acc.w + dd4.w * u4.w));
                    *(u32x2*)(ZB + m * 256 + g * 16 + 4 * kq) = zz; }
            }
        }
        asm volatile("s_waitcnt lgkmcnt(0)" ::: "memory");
    }
    if (smp) *(f32x2*)(a.out + OUT_SSM_S + (((size_t)(l * DB + sq) * 16 + g) * 64 + lane) * 2) = (f32x2){hr, hi};
    else if (ck == 15) *(f32x2*)(a.out + OUT_SSM_P + (((size_t)(l * 8 + sq) * 16 + g) * 64 + lane) * 2) = (f32x2){hr, hi};
}

__device__ __forceinline__ bf16x8 pack8(const f32x16& p, int s) {
    u32x4 w; w.x = pk2(p[8 * s + 0], p[8 * s + 1]); w.y = pk2(p[8 * s + 2], p[8 * s + 3]); w.z = pk2(p[8 * s + 4], p[8 * s + 5]); w.w = pk2(p[8 * s + 6], p[8 * s + 7]);
    return __builtin_bit_cast(bf16x8, w);
}
__device__ __forceinline__ void attn_load4(const bf16* F, size_t fragbase, bf16x8 (&f)[4]) {
#pragma unroll
    for (int cs = 0; cs < 4; ++cs) f[cs] = *(const bf16x8*)(F + fragbase + cs * 512);
}
__device__ __forceinline__ void attn_tile(const bf16x8 (&qf)[2][2], const bf16x8 (&kf)[4], const bf16x8 (&vf)[4], f32x16 (&o)[2][2], float (&mrun)[2], float (&lrun)[2], bool diag, int r, int hh) {
    bf16x8 pf[2][2];
#pragma unroll
    for (int c = 0; c < 2; ++c) {
        f32x16 st;
#pragma unroll
        for (int e = 0; e < 16; ++e) st[e] = 0.f;
        st = __builtin_amdgcn_mfma_f32_32x32x16_bf16(kf[c * 2 + 0], qf[c][0], st, 0, 0, 0);
        st = __builtin_amdgcn_mfma_f32_32x32x16_bf16(kf[c * 2 + 1], qf[c][1], st, 0, 0, 0);
        if (diag) {
#pragma unroll
            for (int e = 0; e < 16; ++e) { const int key = (e & 3) + 8 * (e >> 2) + 4 * hh; if (key > r) st[e] = -1e30f; }
        }
        float mx = st[0];
#pragma unroll
        for (int e = 1; e < 16; ++e) mx = fmaxf(mx, st[e]);
        mx = fmaxf(mx, __shfl_xor(mx, 32));
        const bool upd = mx > mrun[c] + 8.0f;
        if (__any(upd)) {
            const float mnew = upd ? mx : mrun[c];
            const float corr = __builtin_amdgcn_exp2f(mrun[c] - mnew);
            lrun[c] *= corr; mrun[c] = mnew;
#pragma unroll
            for (int tl = 0; tl < 2; ++tl)
#pragma unroll
                for (int e = 0; e < 16; ++e) o[c][tl][e] *= corr;
        }
        float ps = 0.f;
        const float mcur = mrun[c];
#pragma unroll
        for (int e = 0; e < 16; ++e) { st[e] = __builtin_amdgcn_exp2f(st[e] - mcur); ps += st[e]; }
        lrun[c] += ps;
        pf[c][0] = pack8(st, 0); pf[c][1] = pack8(st, 1);
    }
#pragma unroll
    for (int c = 0; c < 2; ++c)
#pragma unroll
        for (int tl = 0; tl < 2; ++tl) {
            o[c][tl] = __builtin_amdgcn_mfma_f32_32x32x16_bf16(vf[tl * 2 + 0], pf[c][0], o[c][tl], 0, 0, 0);
            o[c][tl] = __builtin_amdgcn_mfma_f32_32x32x16_bf16(vf[tl * 2 + 1], pf[c][1], o[c][tl], 0, 0, 0);
        }
}
__device__ __forceinline__ void attn_prompt_wave(const Ctx& a, int l, int b, int h, int qt, float lam, int lane) {
    OPAQUE(lane);
    const bf16* QB = (const bf16*)(a.ws + WS_QB); const bf16* KF = (const bf16*)(a.ws + WS_KB); const bf16* VF = (const bf16*)(a.ws + WS_VT);
    bf16* OB = (bf16*)(a.ws + WS_OB); const bf16* PROJ = (const bf16*)(a.ws + WS_PROJ);
    const int r = lane & 31, hh = lane >> 5;
    const size_t mq = (size_t)b * SEQ + qt * 32 + r;
    bf16x8 qf[2][2];
#pragma unroll
    for (int c = 0; c < 2; ++c)
#pragma unroll
        for (int s = 0; s < 2; ++s) qf[c][s] = *(const bf16x8*)(QB + mq * 256 + h * 64 + c * 32 + 16 * s + 8 * hh);
    f32x16 o[2][2];
#pragma unroll
    for (int c = 0; c < 2; ++c)
#pragma unroll
        for (int tl = 0; tl < 2; ++tl)
#pragma unroll
            for (int e = 0; e < 16; ++e) o[c][tl][e] = 0.f;
    float mrun[2] = {-1e30f, -1e30f}, lrun[2] = {0.f, 0.f};
    const size_t fb0 = ((size_t)((b * 4 + h) * 64) * 4) * 512 + lane * 8;
    bf16x8 kA[4], kB[4], vv[4];
    attn_load4(KF, fb0, kA);
    int kt = 0;
    for (; kt + 1 <= qt; kt += 2) {
        attn_load4(VF, fb0 + (size_t)kt * 2048, vv);
        attn_load4(KF, fb0 + (size_t)(kt + 1) * 2048, kB);
        attn_tile(qf, kA, vv, o, mrun, lrun, false, r, hh);
        attn_load4(VF, fb0 + (size_t)(kt + 1) * 2048, vv);
        if (kt + 2 <= qt) attn_load4(KF, fb0 + (size_t)(kt + 2) * 2048, kA);
        attn_tile(qf, kB, vv, o, mrun, lrun, kt + 1 == qt, r, hh);
    }
    if (kt == qt) { attn_load4(VF, fb0 + (size_t)kt * 2048, vv); attn_tile(qf, kA, vv, o, mrun, lrun, true, r, hh); }
    const float l0 = lrun[0] + __shfl_xor(lrun[0], 32), l1 = lrun[1] + __shfl_xor(lrun[1], 32);
    const float i0 = 1.0f / l0, i1 = lam / l1;
    float ss = 0.f;
    f32x16 res[2];
#pragma unroll
    for (int tl = 0; tl < 2; ++tl)
#pragma unroll
        for (int e = 0; e < 16; ++e) { const float v = o[0][tl][e] * i0 - o[1][tl][e] * i1; res[tl][e] = v; ss += v * v; }
    ss += __shfl_xor(ss, 32);
    const float rs = rsqrtf(ss * (1.f / 64.f) + NORM_EPS) * (1.0f - lam_init_of(l));
    const float* sw = a.inp(I_SUBLN) + l * 64;
#pragma unroll
    for (int tl = 0; tl < 2; ++tl)
#pragma unroll
        for (int g4 = 0; g4 < 4; ++g4) { const int vd = 32 * tl + 8 * g4 + 4 * hh;
            const f32x4 w4 = *(const f32x4*)(sw + vd);
            f32x4 ov; ov.x = res[tl][4 * g4 + 0] * rs * w4.x; ov.y = res[tl][4 * g4 + 1] * rs * w4.y; ov.z = res[tl][4 * g4 + 2] * rs * w4.z; ov.w = res[tl][4 * g4 + 3] * rs * w4.w;
            const f32x4 gt = ldp4(PROJ + mq * DIN + OFF_G + h * 64 + vd);
            u32x2 ow; ow.x = pk2(ov.x * siluf_(gt.x), ov.y * siluf_(gt.y)); ow.y = pk2(ov.z * siluf_(gt.z), ov.w * siluf_(gt.w));
            *(u32x2*)(OB + mq * DM + h * 64 + vd) = ow; }
}

struct SmpK { f32x4 k[8]; };
__device__ __forceinline__ void smp_load(SmpK& d, const float* kp) {
#pragma unroll
    for (int t = 0; t < 8; ++t) d.k[t] = __builtin_nontemporal_load((const f32x4*)(kp + (size_t)t * 1024));
}
__device__ __forceinline__ void smp_group(const SmpK& d, const SmpK& dv, const f32x4 (&q)[8], f32x4 (&O)[4], float& M, float& Lsum, int nstep, bool isnew, int kk, int g, int lane) {
    float sc[8];
#pragma unroll
    for (int t = 0; t < 8; ++t) {
        float p[8];
#pragma unroll
        for (int i = 0; i < 8; ++i) p[i] = (d.k[t].x * q[i].x + d.k[t].y * q[i].y) + (d.k[t].z * q[i].z + d.k[t].w * q[i].w);
        float n4[4];
#pragma unroll
        for (int k = 0; k < 4; ++k) { const float keep = (g & 4) ? p[4 + k] : p[k], send = (g & 4) ? p[k] : p[4 + k]; n4[k] = keep + dpp_mov<0x141>(send); }
        float n2[2];
#pragma unroll
        for (int k = 0; k < 2; ++k) { const float keep = (g & 2) ? n4[2 + k] : n4[k], send = (g & 2) ? n4[k] : n4[2 + k]; n2[k] = keep + dpp_mov<0x4E>(send); }
        const float keep = (g & 1) ? n2[1] : n2[0], send = (g & 1) ? n2[0] : n2[1];
        float sv = keep + dpp_mov<0xB1>(send);
        if (t >= nstep || (isnew && (4 * t + kk) > g)) sv = -1e30f;
        sc[t] = sv;
    }
    float mx = fmaxf(fmaxf(fmaxf(sc[0], sc[1]), fmaxf(sc[2], sc[3])), fmaxf(fmaxf(sc[4], sc[5]), fmaxf(sc[6], sc[7])));
    mx = fmaxf(mx, __shfl_xor(mx, 16)); mx = fmaxf(mx, __shfl_xor(mx, 32));
    const float Mnew = fmaxf(M, mx);
    const float corr = __builtin_amdgcn_exp2f(M - Mnew);
    float ps = 0.f;
#pragma unroll
    for (int t = 0; t < 8; ++t) { sc[t] = __builtin_amdgcn_exp2f(sc[t] - Mnew); ps += sc[t]; }
    Lsum = Lsum * corr + ps; M = Mnew;
#pragma unroll
    for (int rg = 0; rg < 4; ++rg) { const float cr = __shfl(corr, (lane & 48) | (4 * kk + rg));
        O[0][rg] *= cr; O[1][rg] *= cr; O[2][rg] *= cr; O[3][rg] *= cr; }
    u32x4 pw; pw.x = pk2(sc[0], sc[1]); pw.y = pk2(sc[2], sc[3]); pw.z = pk2(sc[4], sc[5]); pw.w = pk2(sc[6], sc[7]);
    const bf16x8 pa = __builtin_bit_cast(bf16x8, pw);
#pragma unroll
    for (int e = 0; e < 4; ++e) {
        u32x4 vw; vw.x = pk2(dv.k[0][e], dv.k[1][e]); vw.y = pk2(dv.k[2][e], dv.k[3][e]); vw.z = pk2(dv.k[4][e], dv.k[5][e]); vw.w = pk2(dv.k[6][e], dv.k[7][e]);
        O[e] = __builtin_amdgcn_mfma_f32_16x16x32_bf16(pa, __builtin_bit_cast(bf16x8, vw), O[e], 0, 0, 0);
    }
}
__device__ __forceinline__ void attn_sample_wave(const Ctx& a, int l, int wi, int lane) {
    OPAQUE(lane);
    const int h = wi & 3, sp = (wi >> 2) % NSPLIT, b = (wi >> 2) / NSPLIT;
    const bf16* PROJ = (const bf16*)(a.ws + WS_PROJ);
    const int kk = lane >> 4, dq = lane & 15, g = lane & 7;
    f32x4 q[8];
#pragma unroll
    for (int i = 0; i < 8; ++i) { q[i] = ldp4(PROJ + (size_t)(NP + b * 8 + i) * DIN + OFF_AQ + h * 64 + 4 * dq); q[i] *= QSCALE; }
    const bool isnew = (sp == NSPLIT - 1);
    float M = -1e30f, Lsum = 0.f;
    f32x4 O[4];
#pragma unroll
    for (int e = 0; e < 4; ++e) O[e] = (f32x4){0.f, 0.f, 0.f, 0.f};
    if (isnew) {
        SmpK d, dv;
        const bf16* kp = PROJ + (size_t)(NP + b * 8 + kk) * DIN + OFF_AK + h * 64 + 4 * dq;
#pragma unroll
        for (int t = 0; t < 8; ++t) { if (t < 2) { d.k[t] = ldp4(kp + (size_t)t * 4 * DIN); dv.k[t] = ldp4(kp + (size_t)t * 4 * DIN + (OFF_AV - OFF_AK)); }
            else { d.k[t] = (f32x4){0.f, 0.f, 0.f, 0.f}; dv.k[t] = (f32x4){0.f, 0.f, 0.f, 0.f}; } }
        smp_group(d, dv, q, O, M, Lsum, 2, true, kk, g, lane);
    } else {
        const int* pt = (const int*)a.inp(I_PT) + b * NPAGES + sp * 2;
        const int pg0 = pt[0], pg1 = pt[1];
        const size_t lo = (size_t)(kk * 4 + h) * 64 + 4 * dq;
        const float* kb0 = a.inp(I_CK) + ((size_t)l * NPOOL + pg0) * 32768 + lo; const float* kb1 = a.inp(I_CK) + ((size_t)l * NPOOL + pg1) * 32768 + lo;
        const float* vb0 = a.inp(I_CV) + ((size_t)l * NPOOL + pg0) * 32768 + lo; const float* vb1 = a.inp(I_CV) + ((size_t)l * NPOOL + pg1) * 32768 + lo;
        SmpK dA, dB, dV;
        smp_load(dA, kb0);
#pragma unroll
        for (int gi = 0; gi < 8; gi += 2) {
            smp_load(dV, ((gi >> 2) ? vb1 : vb0) + (size_t)(gi & 3) * 8192);
            { const int gn = gi + 1; smp_load(dB, ((gn >> 2) ? kb1 : kb0) + (size_t)(gn & 3) * 8192); }
            smp_group(dA, dV, q, O, M, Lsum, 8, false, kk, g, lane);
            { const int gn = gi + 1; smp_load(dV, ((gn >> 2) ? vb1 : vb0) + (size_t)(gn & 3) * 8192); }
            if (gi + 2 < 8) { const int gn = gi + 2; smp_load(dA, ((gn >> 2) ? kb1 : kb0) + (size_t)(gn & 3) * 8192); }
            smp_group(dB, dV, q, O, M, Lsum, 8, false, kk, g, lane);
        }
    }
    float Lall = Lsum + __shfl_xor(Lsum, 16); Lall += __shfl_xor(Lall, 32);
    float* part = (float*)(a.ws + WS_PART) + ((size_t)(b * 4 + h) * NSPLIT + sp) * PART_FLOATS;
    if (kk == 0) { part[dq] = M; part[16 + dq] = Lall; }
#pragma unroll
    for (int rg = 0; rg < 4; ++rg) *(f32x4*)(part + 32 + (4 * kk + rg) * 64 + 4 * dq) = (f32x4){O[0][rg], O[1][rg], O[2][rg], O[3][rg]};
}

__device__ __forceinline__ void attn_sample_merge_wave(const Ctx& a, int l, int wi, float lam, int lane) {
    OPAQUE(lane);
    const int h = wi & 3, q = wi >> 2, b = q >> 3, i = q & 7;
    const size_t m = (size_t)NP + q;
    const float* pb = (const float*)(a.ws + WS_PART) + ((size_t)(b * 4 + h) * NSPLIT) * PART_FLOATS;
    float oc[2];
#pragma unroll
    for (int c = 0; c < 2; ++c) { const int j = c * 8 + i;
        float ms[NSPLIT], M = -1e30f;
#pragma unroll
        for (int s = 0; s < NSPLIT; ++s) { ms[s] = pb[s * PART_FLOATS + j]; M = fmaxf(M, ms[s]); }
        float L = 0.f, O = 0.f;
#pragma unroll
        for (int s = 0; s < NSPLIT; ++s) { const float w = __builtin_amdgcn_exp2f(ms[s] - M); L += pb[s * PART_FLOATS + 16 + j] * w; O += pb[s * PART_FLOATS + 32 + j * 64 + lane] * w; }
        oc[c] = O / L; }
    const float v = oc[0] - lam * oc[1];
    const float ss = wave_sum(v * v);
    const float ov = v * rsqrtf(ss * (1.f / 64.f) + NORM_EPS) * a.inp(I_SUBLN)[l * 64 + lane] * (1.0f - lam_init_of(l));
    const float gt = ldp1((const bf16*)(a.ws + WS_PROJ) + m * DIN + OFF_G + h * 64 + lane);
    ((bf16*)(a.ws + WS_OB))[m * DM + h * 64 + lane] = (bf16)f2bf(ov * siluf_(gt));
}

__device__ __forceinline__ void glu_wave(const Ctx& a, int l, int unit, int wave, int lane) {
    OPAQUE(lane);
    const bf16* ZB = (const bf16*)(a.ws + WS_ZB); const bf16* WT = (const bf16*)(a.ws + WS_WGLU) + (size_t)l * 65536;
    const bf16* PROJ = (const bf16*)(a.ws + WS_PROJ); bf16* OB = (bf16*)(a.ws + WS_OB);
    const int r = lane & 31, hh = lane >> 5, n0 = wave * 32;
    const size_t m = (size_t)unit * 32 + r;
    const bf16* zp = ZB + m * 256 + 8 * hh; const bf16* wp = WT + (size_t)(n0 + r) * 256 + 8 * hh;
    f32x16 acc;
#pragma unroll
    for (int e = 0; e < 16; ++e) acc[e] = 0.f;
#pragma unroll
    for (int s0 = 0; s0 < 16; s0 += 8) {
        bf16x8 wa[8], zb[8];
#pragma unroll
        for (int s1 = 0; s1 < 8; ++s1) { wa[s1] = *(const bf16x8*)(wp + 16 * (s0 + s1)); zb[s1] = *(const bf16x8*)(zp + 16 * (s0 + s1)); }
#pragma unroll
        for (int s1 = 0; s1 < 8; ++s1) acc = __builtin_amdgcn_mfma_f32_32x32x16_bf16(wa[s1], zb[s1], acc, 0, 0, 0);
    }
    const float* bg = a.inp(I_BGLU) + l * 256;
#pragma unroll
    for (int g4 = 0; g4 < 4; ++g4) { const int n = n0 + 8 * g4 + 4 * hh;
        const f32x4 bb = *(const f32x4*)(bg + n), gt = ldp4(PROJ + m * DIN + OFF_G + 768 + n);
        const u32x2 zz = *(const u32x2*)(ZB + m * 256 + n);
        const float z0 = __builtin_bit_cast(float, zz.x << 16), z1 = __builtin_bit_cast(float, zz.x & 0xffff0000u), z2 = __builtin_bit_cast(float, zz.y << 16), z3 = __builtin_bit_cast(float, zz.y & 0xffff0000u);
        u32x2 o; o.x = pk2(z0 * sigmoidf_(acc[4 * g4 + 0] + bb.x) * siluf_(gt.x), z1 * sigmoidf_(acc[4 * g4 + 1] + bb.y) * siluf_(gt.y));
        o.y = pk2(z2 * sigmoidf_(acc[4 * g4 + 2] + bb.z) * siluf_(gt.z), z3 * sigmoidf_(acc[4 * g4 + 3] + bb.w) * siluf_(gt.w));
        *(u32x2*)(OB + m * DM + 768 + n) = o; }
}

constexpr int MM_RWA = 256;
constexpr int MM_RWB = 224;
constexpr int MM_AP = 256;
constexpr int MM_AS = (DB * NSPLIT * 4) / 8;
constexpr int MM_S5P = 256;
constexpr int MM_S5S = 256;
constexpr int MM_LRU = 128;
constexpr int MM_RWS = DB * 4;
constexpr int MM_MRG = 512;
constexpr int MM_GLU = MTOK / 32;
__device__ __forceinline__ void ph_mixA(const Ctx& a, int lq, int MMSK, LAS unsigned char* lds, volatile LAS unsigned* MISC, int tid, int lane, int wave) {
    const int l = lq & 1;
    unsigned* qctr = (unsigned*)(a.ws + WS_CTL) + CW_QUEUE + 1024 * lq;
    const float lam = compute_lam(a, l, lane);
    int u;
#ifndef STREAM_DIV
#define STREAM_DIV 6
#endif
    const bool streamer = ((blockIdx.x >> 3) % STREAM_DIV) == 0;
#pragma unroll 1
    for (int pass = 0; pass < 2; ++pass) {
        if ((pass == 0) == streamer) { if ((MMSK >> 2) & 1) while ((u = grab_unit(qctr + 2 * 64, MISC, tid)) < MM_AS) attn_sample_wave(a, l, u * 8 + wave, lane); }
        if (pass == 0) {
            if ((MMSK >> 0) & 1) while ((u = grab_unit(qctr + 0 * 64, MISC, tid)) < MM_RWA) rwkv_prompt_unitA(a, l, u, lds, tid);
            if ((MMSK >> 1) & 1) while ((u = grab_unit(qctr + 1 * 64, MISC, tid)) < MM_AP) { const int bh = u & 31, qt = 8 * (7 - (u >> 5)) + wave; attn_prompt_wave(a, l, bh >> 2, bh & 3, qt, lam, lane); }
            if ((MMSK >> 3) & 1) while ((u = grab_unit(qctr + 3 * 64, MISC, tid)) < MM_S5P) s5_pass2_wave(a, l, false, u * 8 + wave, lds + wave * 17408, lane);
            if ((MMSK >> 4) & 1) while ((u = grab_unit(qctr + 4 * 64, MISC, tid)) < MM_S5S) s5_pass2_wave(a, l, true, u * 8 + wave, lds + wave * 17408, lane);
            if ((MMSK >> 5) & 1) while ((u = grab_unit(qctr + 5 * 64, MISC, tid)) < MM_LRU) lru_pass2_wave(a, l, u * 8 + wave, lane);
        }
    }
    __syncthreads();
}
__device__ __forceinline__ void ph_mixB(const Ctx& a, int lq, int MMSK, LAS unsigned char* lds, volatile LAS unsigned* MISC, int tid, int lane, int wave) {
    const int l = lq & 1;
    unsigned* qctr = (unsigned*)(a.ws + WS_CTL) + CW_QUEUE + 1024 * lq + 512;
    int u;
    if ((MMSK >> 0) & 1) while ((u = grab_unit(qctr + 0 * 64, MISC, tid)) < MM_RWB) rwkv_prompt_unitB(a, l, u, lds, tid);
    if ((MMSK >> 1) & 1) while ((u = grab_unit(qctr + 1 * 64, MISC, tid)) < MM_RWS) rwkv_sample_unit(a, l, u >> 2, u & 3, lds, tid);
    if ((MMSK >> 2) & 1) while ((u = grab_unit(qctr + 2 * 64, MISC, tid)) < MM_GLU) glu_wave(a, l, u, wave, lane);
    if ((MMSK >> 3) & 1) { const float lam = compute_lam(a, l, lane); while ((u = grab_unit(qctr + 3 * 64, MISC, tid)) < MM_MRG) attn_sample_merge_wave(a, l, u * 8 + wave, lam, lane); }
    __syncthreads();
}

__device__ __forceinline__ void ph_postnorm(const Ctx& a, int l, int lane, int wave) {
    OPAQUE(lane);
    const bf16* YP = (const bf16*)(a.ws + WS_YP);
    const float* xp = a.inp(I_XP);
    const float* xs = a.inp(I_XS) - (size_t)NP * DM;
    bf16* X1b = (bf16*)(a.ws + WS_X1);
    float* yp = a.out + OUT_Y_P;
    float* ys = a.out + OUT_Y_S - (size_t)NP * DM;
    bf16* H = (bf16*)(a.ws + WS_H);
    f32x4 gp[4], g2[4];
#pragma unroll
    for (int j = 0; j < 4; ++j) { gp[j] = ((const f32x4*)(a.inp(I_NPOST) + l * DM) + lane)[64 * j]; g2[j] = ((const f32x4*)(a.inp(I_NPRE) + DM) + lane)[64 * j]; }
    const int gw = blockIdx.x * NWAVES + wave, NGW = gridDim.x * NWAVES;
    for (int m0 = gw; m0 < MTOK; m0 += 2 * NGW) {
        const int m1 = m0 + NGW; const bool has1 = m1 < MTOK; const int mb = has1 ? m1 : m0;
        const bf16* ya = YP + (size_t)m0 * DM + 4 * lane; const bf16* yb = YP + (size_t)mb * DM + 4 * lane;
        const f32x4* xa = (const f32x4*)((m0 < NP ? xp : xs) + (size_t)m0 * DM) + lane; const f32x4* xb = (const f32x4*)((mb < NP ? xp : xs) + (size_t)mb * DM) + lane;
        f32x4 va[4], vb[4], wa[4], wb[4];
#pragma unroll
        for (int j = 0; j < 4; ++j) { va[j] = ldp4(ya + 256 * j); vb[j] = ldp4(yb + 256 * j);
            if (l == 0) { wa[j] = xa[64 * j]; wb[j] = xb[64 * j]; }
            else { wa[j] = ldp4(X1b + (size_t)m0 * DM + 4 * lane + 256 * j); wb[j] = ldp4(X1b + (size_t)mb * DM + 4 * lane + 256 * j); } }
        float sa = 0.f, sb = 0.f;
#pragma unroll
        for (int j = 0; j < 4; ++j) { sa += (va[j].x * va[j].x + va[j].y * va[j].y) + (va[j].z * va[j].z + va[j].w * va[j].w); sb += (vb[j].x * vb[j].x + vb[j].y * vb[j].y) + (vb[j].z * vb[j].z + vb[j].w * vb[j].w); }
        const float ra = rsqrtf(wave_sum_fast(sa) * (1.f / DM) + NORM_EPS), rb = rsqrtf(wave_sum_fast(sb) * (1.f / DM) + NORM_EPS);
        f32x4* oa = (f32x4*)((m0 < NP ? yp : ys) + (size_t)m0 * DM) + lane; f32x4* ob = (f32x4*)((mb < NP ? yp : ys) + (size_t)mb * DM) + lane;
        float ta = 0.f, tb = 0.f;
#pragma unroll
        for (int j = 0; j < 4; ++j) { va[j] = wa[j] + va[j] * ra * gp[j]; vb[j] = wb[j] + vb[j] * rb * gp[j];
            if (l == 0) { u32x2 o; o.x = pk2(va[j].x, va[j].y); o.y = pk2(va[j].z, va[j].w); *(u32x2*)(X1b + (size_t)m0 * DM + 4 * lane + 256 * j) = o;
                if (has1) { u32x2 p; p.x = pk2(vb[j].x, vb[j].y); p.y = pk2(vb[j].z, vb[j].w); *(u32x2*)(X1b + (size_t)mb * DM + 4 * lane + 256 * j) = p; } }
            else { __builtin_nontemporal_store(va[j], oa + 64 * j); if (has1) __builtin_nontemporal_store(vb[j], ob + 64 * j); }
            ta += (va[j].x * va[j].x + va[j].y * va[j].y) + (va[j].z * va[j].z + va[j].w * va[j].w); tb += (vb[j].x * vb[j].x + vb[j].y * vb[j].y) + (vb[j].z * vb[j].z + vb[j].w * vb[j].w); }
        if (l == 0) {
            const float qa = rsqrtf(wave_sum_fast(ta) * (1.f / DM) + NORM_EPS), qb = rsqrtf(wave_sum_fast(tb) * (1.f / DM) + NORM_EPS);
            u32x2* ha = (u32x2*)(H + (size_t)m0 * DM) + lane; u32x2* hb = (u32x2*)(H + (size_t)mb * DM) + lane;
#pragma unroll
            for (int j = 0; j < 4; ++j) { u32x2 o; o.x = pk2(va[j].x * qa * g2[j].x, va[j].y * qa * g2[j].y); o.y = pk2(va[j].z * qa * g2[j].z, va[j].w * qa * g2[j].w); ha[64 * j] = o;
                if (has1) { u32x2 p; p.x = pk2(vb[j].x * qb * g2[j].x, vb[j].y * qb * g2[j].y); p.y = pk2(vb[j].z * qb * g2[j].z, vb[j].w * qb * g2[j].w); hb[64 * j] = p; } }
        }
    }
}

constexpr int N_PHASES = 13;
#ifndef DUP_PHASE
#define DUP_PHASE -1
#endif
#ifndef DUP_MASK
#define DUP_MASK 0x7f
#endif
__global__ void __launch_bounds__(NTHREADS, 2) hymba_fwd(Args args) {
    extern __shared__ __attribute__((aligned(16))) unsigned char lds_raw[];
    LAS unsigned char* lds = (LAS unsigned char*)lds_raw;
    volatile LAS unsigned* MISC = (volatile LAS unsigned*)(lds + MISC_OFF);
    if (threadIdx.x < 64) MISC[threadIdx.x] = 0u;
    if (threadIdx.x < N_IN) *(LAS unsigned long long*)(lds + TAB_OFF + 8 * threadIdx.x) = (unsigned long long)args.in[threadIdx.x];
    Ctx ctx; ctx.out = args.out; ctx.ws = args.ws; ctx.tab = (const LAS unsigned*)(lds + TAB_OFF);
    const int wave_s = __builtin_amdgcn_readfirstlane(threadIdx.x >> 6);
#define TIDS() int tid = wave_s * 64 + lane_id_asm(); const int lane = tid & 63, wave = wave_s; (void)lane; (void)wave; Ctx cx = ctx; { GAS unsigned char* w_ = (GAS unsigned char*)ctx.ws; GAS float* o_ = (GAS float*)ctx.out; asm volatile("" : "+s"(w_), "+s"(o_)); cx.ws = (unsigned char*)w_; cx.out = (float*)o_; }
    __syncthreads();
    unsigned* ctl = (unsigned*)(args.ws + WS_CTL);
#if MK_PER_PHASE
#define GRID_BAR() do { } while (0)
#else
    XcdBarrier bar = xcd_barrier_post(ctl + CW_BAR, MISC);
#define GRID_BAR() xcd_barrier(bar, wave_s == 0 && lane_id_asm() == 0)
#endif
    const int lo = args.ph_lo, hi = args.ph_hi;
#define IN(k) (lo <= (k) && (k) < hi)
#define SEAM(k) do { if (IN(k) && IN((k) + 1)) GRID_BAR(); } while (0)
#define NREP(j) ((DUP_PHASE == (j)) ? 2 : 1)

    if (IN(0)) { TIDS(); ph_prologue(cx, lds, lane, wave); }
    SEAM(0);
    for (int l = 0; l < 2; ++l) {
        const int p0 = 1 + 6 * l;
        if (IN(p0))
#pragma unroll 1
          for (int rp = 0; rp < NREP(1); ++rp) {
            if (rp) GRID_BAR();
            TIDS();
            pg8::Gemm g{(const pg8::bf16_t*)(cx.ws + WS_H), (const pg8::bf16_t*)(cx.ws + WS_WIN) + (size_t)l * DIN * DM, MTOK, DIN, DM};
            pg8::StaticOrder S; S.init(MTOK, DIN, (int)gridDim.x, (int)blockIdx.x);
            EpiProj E{(bf16*)(cx.ws + WS_PROJ), cx.out, l};
            pg8::gemm_phase<EpiProj, pg8::StaticOrder, false>(lds, g, S, E, nullptr, tid);
        }
        SEAM(p0);
        if (IN(p0 + 1)) {
#pragma unroll 1
            for (int rp = 0; rp < NREP(2); ++rp) { if (rp) GRID_BAR(); TIDS(); ph_mixprep(cx, l + 2 * rp, rp ? (DUP_MASK) : 0x1f, lds, MISC, tid, lane, wave); } }
        SEAM(p0 + 1);
        if (IN(p0 + 2)) {
#pragma unroll 1
            for (int rp = 0; rp < NREP(3); ++rp) { if (rp) GRID_BAR(); TIDS(); ph_mixA(cx, l + 2 * rp, rp ? (DUP_MASK) : 0x3f, lds, MISC, tid, lane, wave); } }
        SEAM(p0 + 2);
        if (IN(p0 + 3)) {
#pragma unroll 1
            for (int rp = 0; rp < NREP(4); ++rp) { if (rp) GRID_BAR(); TIDS(); ph_mixB(cx, l + 2 * rp, rp ? (DUP_MASK) : 0xf, lds, MISC, tid, lane, wave); } }
        SEAM(p0 + 3);
        if (IN(p0 + 4))
#pragma unroll 1
          for (int rp = 0; rp < NREP(5); ++rp) {
            if (rp) GRID_BAR();
            TIDS();
            pg8::Gemm g{(const pg8::bf16_t*)(cx.ws + WS_OB), (const pg8::bf16_t*)(cx.ws + WS_WOUT) + (size_t)l * DM * DM, MTOK, DM, DM};
            pg8::StaticOrder S; S.init(MTOK, DM, (int)gridDim.x, (int)blockIdx.x);
            EpiPlain E{(bf16*)(cx.ws + WS_YP), DM};
            pg8::gemm_phase<EpiPlain, pg8::StaticOrder, false>(lds, g, S, E, nullptr, tid);
        }
        SEAM(p0 + 4);
        if (IN(p0 + 5)) {
#pragma unroll 1
            for (int rp = 0; rp < NREP(6); ++rp) { if (rp) GRID_BAR(); TIDS(); ph_postnorm(cx, l, lane, wave); } }
        SEAM(p0 + 5);
    }
#undef IN
#undef SEAM
}

extern "C" void kernel_launch(void* const* d_in, const int* in_sizes, int n_in, void* d_out, int out_size, void* d_ws, size_t ws_size, hipStream_t stream) {
    static int grid = 0;
    if (grid == 0) {
        if (n_in != N_IN || out_size != (int)OUT_TOTAL || ws_size < WS_END) { fprintf(stderr, "kernel_launch: unexpected shapes: n_in %d out %d ws %zu (need %zu)\n", n_in, out_size, ws_size, (size_t)WS_END); grid = -1; return; }
        int dev = 0, cus = 0, per_cu = 0;
        if (hipGetDevice(&dev) != hipSuccess || hipDeviceGetAttribute(&cus, hipDeviceAttributeMultiprocessorCount, dev) != hipSuccess) { grid = -1; return; }
        if (hipFuncSetAttribute((const void*)hymba_fwd, hipFuncAttributeMaxDynamicSharedMemorySize, LDS_BYTES) != hipSuccess) { fprintf(stderr, "kernel_launch: hipFuncSetAttribute failed\n"); grid = -1; return; }
        if (hipOccupancyMaxActiveBlocksPerMultiprocessor(&per_cu, (const void*)hymba_fwd, NTHREADS, LDS_BYTES) != hipSuccess || per_cu < 1) { fprintf(stderr, "kernel_launch: occupancy query says %d\n", per_cu); }
        (void)hipGetLastError();
        grid = cus;
    }
    if (grid < 0) return;
    (void)hipMemsetAsync((char*)d_ws + WS_CTL, 0, CTL_ZERO_BYTES, stream);
    Args a{};
    for (int i = 0; i < N_IN; ++i) a.in[i] = (const float*)d_in[i];
    a.out = (float*)d_out; a.ws = (unsigned char*)d_ws;
#if MK_PER_PHASE
    for (int p = 0; p < N_PHASES; ++p) { a.ph_lo = p; a.ph_hi = p + 1; hipLaunchKernelGGL(hymba_fwd, dim3(grid), dim3(NTHREADS), LDS_BYTES, stream, a); }
#else
    a.ph_lo = 0; a.ph_hi = N_PHASES; hipLaunchKernelGGL(hymba_fwd, dim3(grid), dim3(NTHREADS), LDS_BYTES, stream, a);
#endif
}
```

```cpp
#include <hip/hip_runtime.h>
#include <cstdio>
#include <cstdint>
#ifndef MK_PER_PHASE
#define MK_PER_PHASE 0
#endif
namespace pg8 {
#define PG8_LAS __attribute__((address_space(3)))
typedef unsigned short bf16_t;
typedef short bf16x8 __attribute__((ext_vector_type(8)));
typedef float f32x4 __attribute__((ext_vector_type(4)));
typedef unsigned u32x4 __attribute__((ext_vector_type(4)));
constexpr int BM = 256, BK = 64, HALF = 128, HTB = HALF * BK * 2  , STAGE_BYTES = 8 * HTB, NXCD = 8, WGM = 8;

__host__ __device__ __forceinline__ int lds_byte(int r, int c) { const int st = (r >> 4) * 2 + (c >> 5), rr = r & 15, cc = c & 31, ob = rr * 64 + cc * 2; return st * 1024 + (ob ^ (((ob >> 9) & 1) << 5)); }
__host__ __device__ __forceinline__ void stage_rc(int b, int& R, int& C) { const int st = b / 1024, sb = b % 1024, swz = sb ^ (((sb >> 9) & 1) << 5); R = (st >> 1) * 16 + swz / 64; C = (st & 1) * 32 + (swz % 64) / 2; }
__host__ __device__ __forceinline__ int perm32(int rho) { const int n = rho >> 4, i = rho & 15; return 8 * (i >> 2) + 4 * n + (i & 3); }

struct Unit { int pm, pn; };
struct Gemm { const bf16_t* A; const bf16_t* Bt; int M, N, K; };

struct StaticOrder {
    int nM, nN, nwg, G, c;
    __host__ __device__ void init(int M, int N, int G_, int c_) { nM = M / BM; nN = N / BM; nwg = nM * nN; G = G_; c = c_; }
    __host__ __device__ bool next(int i, Unit& u) const {
        const long L = (long)i * G + c; if (L >= nwg) return false;
        int wgid = (int)L; { const int q = nwg / NXCD, r = nwg % NXCD, xcd = wgid % NXCD, off = wgid / NXCD; wgid = (xcd < r ? xcd * (q + 1) : r * (q + 1) + (xcd - r) * q) + off; }
        const int nig = WGM * nN, gid = wgid / nig, fm = gid * WGM, gsz = (nM - fm) < WGM ? (nM - fm) : WGM;
        u.pm = fm + ((wgid % nig) % gsz); u.pn = (wgid % nig) / gsz; return true;
    }
    __device__ __forceinline__ void a_ready(const Unit&) const {}
    __device__ __forceinline__ void done(const Unit&) const {}
};
template <class Epi, class Sched, bool STAMP = false>
__device__ __forceinline__ void gemm_phase(PG8_LAS unsigned char* lds, const Gemm g, const Sched& S, const Epi& E, unsigned long long* stamps, int tid_in) {
    int tid = tid_in; asm volatile("" : "+v"(tid));
    const int wid = __builtin_amdgcn_readfirstlane(tid >> 6), lane = tid & 63, wr = wid >> 2, wc = wid & 3, fr = lane & 15, fq = lane >> 4;
    const int K = g.K, nt = K / BK;
    int ts_lo = 0, ts_hi = 0, nts = 0; const unsigned long long rt_entry = STAMP ? (unsigned long long)wall_clock64() : 0ull;
#define PG8_STAMP() do { if (STAMP && wid == 0 && nts < 64) { const unsigned long long _c = (unsigned long long)clock64(); \
        ts_lo = (lane == nts) ? (int)(unsigned)_c : ts_lo; ts_hi = (lane == nts) ? (int)(unsigned)(_c >> 32) : ts_hi; ++nts; } } while (0)
    PG8_STAMP();
    unsigned voffA[2], voffB[2];
#pragma unroll
    for (int i = 0; i < 2; ++i) { int R, C; stage_rc(tid * 16 + i * 8192, R, C); const int Rb = Epi::PERM ? ((R & ~31) + perm32(R & 31)) : R;
        voffA[i] = (unsigned)(R * K + C) * 2u; voffB[i] = (unsigned)(Rb * K + C) * 2u; }
    const size_t kstep = (size_t)(BK * 2);
    const size_t hstep = (size_t)HALF * K * 2;
    const size_t tstep = 2 * hstep;
    const unsigned ldsw = (unsigned)wid * 1024u;
    const int aoff = lds_byte(wr * 64 + fr, fq * 8), boff = lds_byte(wc * 32 + fr, fq * 8);
#define PG8_SA(b, h) (((b) * 2 + (h)) * HTB)
#define PG8_SB(b, h) ((4 + (b) * 2 + (h)) * HTB)
#define PG8_STAGE(bufoff, gbase, voff) do { _Pragma("unroll") for (int _i = 0; _i < 2; ++_i) \
        __builtin_amdgcn_global_load_lds((const unsigned*)((const char*)(gbase) + (voff)[_i]), (PG8_LAS unsigned*)(lds + (bufoff) + ldsw + _i * 8192), 16, 0, 0); } while (0)
#define PG8_LDA(dst, b, h) do { _Pragma("unroll") for (int m = 0; m < 4; ++m) _Pragma("unroll") for (int k = 0; k < 2; ++k) dst[m][k] = *(const PG8_LAS bf16x8*)(lds + PG8_SA(b, h) + aoff + m * 2048 + k * 1024); } while (0)
#define PG8_LDB(dst, b, h) do { _Pragma("unroll") for (int n = 0; n < 2; ++n) _Pragma("unroll") for (int k = 0; k < 2; ++k) dst[n][k] = *(const PG8_LAS bf16x8*)(lds + PG8_SB(b, h) + boff + n * 2048 + k * 1024); } while (0)
#define PG8_MMA(ai, bj, At, Bt) do { __builtin_amdgcn_s_setprio(1); _Pragma("unroll") for (int m = 0; m < 4; ++m) _Pragma("unroll") for (int n = 0; n < 2; ++n) _Pragma("unroll") for (int k = 0; k < 2; ++k) \
        acc[ai][bj][m][n] = __builtin_amdgcn_mfma_f32_16x16x32_bf16(Bt[n][k], At[m][k], acc[ai][bj][m][n], 0, 0, 0); __builtin_amdgcn_s_setprio(0); } while (0)
#define PG8_WAIT_V(n) asm volatile("s_waitcnt vmcnt(" #n ")" ::: "memory")
#define PG8_WAIT_L(n) asm volatile("s_waitcnt lgkmcnt(" #n ")" ::: "memory")
#define PG8_BAR __builtin_amdgcn_s_barrier()
#define PG8_SCHED __builtin_amdgcn_sched_barrier(0)
    Unit cur, nxt; int ui = 0;
    if (!S.next(0, cur)) return;
    f32x4 acc[2][2][4][2];
#pragma unroll
    for (int a = 0; a < 2; ++a)
#pragma unroll
        for (int b = 0; b < 2; ++b)
#pragma unroll
            for (int m = 0; m < 4; ++m)
#pragma unroll
                for (int n = 0; n < 2; ++n) acc[a][b][m][n] = (f32x4){0.f, 0.f, 0.f, 0.f};
    bf16x8 At[4][2], B0[2][2], B1[2][2];
    const char* cA = (const char*)g.A + (size_t)cur.pm * tstep; const char* cB = (const char*)g.Bt + (size_t)cur.pn * tstep;
    S.a_ready(cur);
    PG8_STAGE(PG8_SB(0, 0), cB, voffB); PG8_STAGE(PG8_SA(0, 0), cA, voffA); PG8_STAGE(PG8_SB(0, 1), cB + hstep, voffB); PG8_STAGE(PG8_SA(0, 1), cA + hstep, voffA);
    if (wr == 1) PG8_BAR;
    PG8_WAIT_V(4); PG8_BAR;
    PG8_STAGE(PG8_SB(1, 0), cB + kstep, voffB); PG8_STAGE(PG8_SA(1, 0), cA + kstep, voffA); PG8_STAGE(PG8_SB(1, 1), cB + hstep + kstep, voffB);
    PG8_WAIT_V(6); PG8_BAR;
    PG8_STAMP();
    for (;;) {
        const bool has_next = S.next(ui + 1, nxt);
        const char* nA = has_next ? (const char*)g.A + (size_t)nxt.pm * tstep : cA; const char* nB = has_next ? (const char*)g.Bt + (size_t)nxt.pn * tstep : cB;
        for (int t = 0; t < nt; t += 2) {
            const bool last = (t == nt - 2);
            const char* a1 = cA + (size_t)(t + 1) * kstep;
            const char* a2 = last ? nA : cA + (size_t)(t + 2) * kstep; const char* b2 = last ? nB : cB + (size_t)(t + 2) * kstep;
            const char* a3 = a2 + kstep; const char* b3 = b2 + kstep;
            if (last && has_next) S.a_ready(nxt);
            PG8_LDB(B0, 0, 0); PG8_SCHED; PG8_LDA(At, 0, 0); PG8_STAGE(PG8_SA(1, 1), a1 + hstep, voffA);
            PG8_WAIT_L(8); PG8_BAR; PG8_WAIT_L(0); PG8_MMA(0, 0, At, B0); PG8_BAR; PG8_SCHED;
            PG8_LDB(B1, 0, 1); PG8_STAGE(PG8_SB(0, 0), b2, voffB);
            PG8_BAR; PG8_WAIT_L(0); PG8_MMA(0, 1, At, B1); PG8_BAR;
            PG8_LDA(At, 0, 1); PG8_STAGE(PG8_SA(0, 0), a2, voffA);
            PG8_BAR; PG8_WAIT_L(0); PG8_MMA(1, 0, At, B0); PG8_BAR; PG8_SCHED;
            PG8_STAGE(PG8_SB(0, 1), b2 + hstep, voffB);
            PG8_WAIT_V(6); PG8_BAR; PG8_MMA(1, 1, At, B1); PG8_BAR;
            PG8_LDB(B0, 1, 0); PG8_SCHED; PG8_LDA(At, 1, 0); PG8_STAGE(PG8_SA(0, 1), a2 + hstep, voffA);
            PG8_WAIT_L(8); PG8_BAR; PG8_WAIT_L(0); PG8_MMA(0, 0, At, B0); PG8_BAR; PG8_SCHED;
            PG8_LDB(B1, 1, 1); PG8_STAGE(PG8_SB(1, 0), b3, voffB);
            PG8_BAR; PG8_WAIT_L(0); PG8_MMA(0, 1, At, B1); PG8_BAR;
            PG8_LDA(At, 1, 1); PG8_STAGE(PG8_SA(1, 0), a3, voffA);
            PG8_BAR; PG8_WAIT_L(0); PG8_MMA(1, 0, At, B0); PG8_BAR; PG8_SCHED;
            PG8_STAGE(PG8_SB(1, 1), b3 + hstep, voffB);
            PG8_WAIT_V(6); PG8_BAR; PG8_MMA(1, 1, At, B1); PG8_BAR;
        }
        PG8_STAMP();
        if constexpr (!Epi::AFTER_DRAIN) { int l2; asm volatile("v_mbcnt_lo_u32_b32 %0, -1, 0\n\tv_mbcnt_hi_u32_b32 %0, -1, %0" : "=v"(l2)); E(acc, cur, wr, wc, l2 & 15, l2 >> 4); S.done(cur); }
        PG8_STAMP();
        if (!has_next) break;
#pragma unroll
        for (int a = 0; a < 2; ++a)
#pragma unroll
            for (int b = 0; b < 2; ++b)
#pragma unroll
                for (int m = 0; m < 4; ++m)
#pragma unroll
                    for (int n = 0; n < 2; ++n) acc[a][b][m][n] = (f32x4){0.f, 0.f, 0.f, 0.f};
        cur = nxt; cA = nA; cB = nB; ++ui;
    }
    PG8_WAIT_V(0);
    if (wr == 0) PG8_BAR;
    PG8_BAR;
    if constexpr (Epi::AFTER_DRAIN) { E.fused(acc, cur, wr, wc, fr, fq, lds, wid, lane); S.done(cur); }
    PG8_STAMP();
    if (STAMP && wid == 0) { stamps[lane] = lane < nts ? (((unsigned long long)(unsigned)ts_hi << 32) | (unsigned)ts_lo) : 0ull;
        if (lane == 62) stamps[62] = rt_entry; if (lane == 63) stamps[63] = (unsigned long long)wall_clock64(); }
#undef PG8_STAMP
#undef PG8_SA
#undef PG8_SB
#undef PG8_STAGE
#undef PG8_LDA
#undef PG8_LDB
#undef PG8_MMA
#undef PG8_WAIT_V
#undef PG8_WAIT_L
#undef PG8_BAR
#undef PG8_SCHED
}
}

#define GAS __attribute__((address_space(1)))
#define LAS __attribute__((address_space(3)))
typedef unsigned short bf16;
typedef float f32x4 __attribute__((ext_vector_type(4)));
typedef float f32x2 __attribute__((ext_vector_type(2)));
typedef float f32x16 __attribute__((ext_vector_type(16)));
typedef short bf16x8 __attribute__((ext_vector_type(8)));
typedef unsigned u32x4 __attribute__((ext_vector_type(4)));
typedef unsigned u32x2 __attribute__((ext_vector_type(2)));

constexpr int NWAVES = 8, NTHREADS = 512;
constexpr int DM = 1024, NP = 16384, NSMP = 1024, MTOK = 17408, DIN = 3584, SEQ = 2048, DB = 128, DS = 8;
constexpr int OFF_AQ = 0, OFF_AK = 256, OFF_AV = 512, OFF_B = 768, OFF_C = 1024, OFF_D = 2304, OFF_G = 2560;
constexpr int NPOOL = 2560, NPAGES = 16;
constexpr float NORM_EPS = 1e-6f;
constexpr float QSCALE = 0.17677669529663687f * 1.4426950408889634f;
constexpr int NSPLIT = 9;
constexpr int PART_FLOATS = 16 + 16 + 1024;

constexpr size_t OUT_Y_P = 0, OUT_Y_S = 16777216, OUT_K_P = 17825792, OUT_K_S = 26214400, OUT_V_P = 26738688, OUT_V_S = 35127296,
    OUT_CONV_P = 35651584, OUT_CONV_S = 35663872, OUT_LRU_P = 35860480, OUT_LRU_S = 35864576, OUT_SHIFT_P = 35930112, OUT_SHIFT_S = 35950592,
    OUT_WKV_P = 36278272, OUT_WKV_S = 36540416, OUT_SSM_P = 40734720, OUT_SSM_S = 40767488, OUT_TOTAL = 41291776;

constexpr size_t MiB = 1u << 20;
constexpr size_t WS_CTL = 0, CTL_ZERO_BYTES = 1 * MiB;
constexpr size_t WS_WIN = 1 * MiB;
constexpr size_t WS_WOUT = WS_WIN + (size_t)2 * DIN * DM * 2;
constexpr size_t WS_H = WS_WOUT + (size_t)2 * DM * DM * 2;
constexpr size_t WS_PROJ = WS_H + (size_t)MTOK * DM * 2;
constexpr size_t WS_QB = WS_PROJ + (size_t)MTOK * DIN * 4;
constexpr size_t WS_KB = WS_QB + (size_t)NP * 256 * 2;
constexpr size_t WS_VT = WS_KB + (size_t)NP * 256 * 2;
constexpr size_t WS_LA = WS_VT + (size_t)NP * 256 * 2;
constexpr size_t WS_LB = WS_LA + (size_t)MTOK * 256 * 4;
constexpr size_t WS_LP = WS_LB + (size_t)MTOK * 256 * 4;
constexpr size_t WS_LE = WS_LP + (size_t)8 * 32 * 256 * 4;
constexpr size_t WS_RW = WS_LE + (size_t)8 * 32 * 256 * 4;
constexpr size_t WS_BON = WS_RW + (size_t)MTOK * 1536 * 4;
constexpr size_t WS_S5E = WS_BON + (size_t)MTOK * 4 * 4;
constexpr size_t WS_OMIX = WS_S5E + (size_t)8 * 16 * 16 * 64 * 2 * 4;
constexpr size_t WS_ZB = WS_OMIX, WS_WGLU = WS_OMIX + 16 * MiB, WS_LWT = WS_OMIX + 17 * MiB, WS_W1T = WS_OMIX + 18 * MiB, WS_S5T = WS_OMIX + 19 * MiB, WS_W2T = WS_OMIX + 20 * MiB;
constexpr size_t WS_OB = WS_OMIX + (size_t)MTOK * DM * 4;
constexpr size_t WS_PART = WS_OB + (size_t)MTOK * DM * 2;
constexpr size_t WS_YP = WS_PART + (size_t)DB * 4 * NSPLIT * PART_FLOATS * 4;
constexpr size_t WS_X1 = WS_YP + (size_t)MTOK * DM * 4;
constexpr size_t WS_PZ = WS_X1 + (size_t)MTOK * DM * 4;
constexpr size_t WS_END = WS_PZ + (size_t)8 * 4 * 8 * 2 * 4096 * 4;
static_assert(WS_H % 256 == 0 && WS_PROJ % 256 == 0 && WS_QB % 256 == 0 && WS_VT % 256 == 0 && WS_RW % 256 == 0 && WS_OMIX % 256 == 0 && WS_PART % 256 == 0 && WS_YP % 256 == 0, "ws align");

constexpr int CW_BAR = 4096;
constexpr int CW_QUEUE = 8192;

constexpr int LDS_BYTES = 147456;
constexpr int MISC_OFF = 147456 - 256;

#define XB_TMO      128
#define XB_XCNT(j)  (256  + 64 * (j))
#define XB_XSUB(j)  (1280 + 64 * (j))
#define XB_XGEN(j)  (2304 + 64 * (j))
#define XB_TOP      3328
#define XB_TOPGEN   3392
#define XCD_BAR_WORDS 3456
#define XB_SPIN_CAP (1u << 18)

__device__ __forceinline__ unsigned xb_ld(unsigned* p)              { return __hip_atomic_load(p, __ATOMIC_RELAXED, __HIP_MEMORY_SCOPE_AGENT); }
__device__ __forceinline__ unsigned xb_add(unsigned* p, unsigned v) { return __hip_atomic_fetch_add(p, v, __ATOMIC_RELAXED, __HIP_MEMORY_SCOPE_AGENT); }
__device__ __forceinline__ unsigned xb_xcc_id() { return (unsigned)__builtin_amdgcn_s_getreg((3 << 11) | 20) & 0xFu; }
#define XB_SPIN(cond, bar) do { unsigned _sp = 0; while (cond) { __builtin_amdgcn_s_sleep(1); \
    if ((++_sp & 255u) == 0u) { if (xb_ld(&(bar)[XB_TMO])) break; if (_sp > XB_SPIN_CAP) { atomicAdd(&(bar)[XB_TMO], 1u); break; } } } } while (0)

struct XcdBarrier { unsigned* bar; unsigned x; volatile LAS unsigned* st; };

__device__ __forceinline__ XcdBarrier xcd_barrier_post(unsigned* bar, volatile LAS unsigned* st) {
    XcdBarrier b; b.bar = bar; b.x = xb_xcc_id(); b.st = st;
    if (threadIdx.x == 0) (void)xb_add(&bar[XB_XCNT(b.x)], 1u);
    return b;
}
__device__ __forceinline__ void xcd_barrier_complete(unsigned* bar, unsigned x, unsigned& nloc, unsigned& nx) {
    const unsigned G = gridDim.x * gridDim.y * gridDim.z;
    unsigned sum, cnt, mine, sp = 0u;
    for (;;) {
        sum = 0u; cnt = 0u; mine = 0u;
#pragma unroll
        for (unsigned j = 0; j < 16; ++j) { const unsigned c = xb_ld(&bar[XB_XCNT(j)]); sum += c; cnt += (c > 0u) ? 1u : 0u; mine = (j == x) ? c : mine; }
        if (sum == G) break;
        __builtin_amdgcn_s_sleep(1);
        if ((++sp & 255u) == 0u) { if (xb_ld(&bar[XB_TMO])) break; if (sp > XB_SPIN_CAP) { atomicAdd(&bar[XB_TMO], 1u); break; } }
    }
    nloc = mine > 0u ? mine : 1u; nx = cnt > 0u ? cnt : 1u;
}
__device__ __forceinline__ void xcd_barrier(const XcdBarrier& b, bool leader) {
    asm volatile("s_waitcnt vmcnt(0)" ::: "memory");
    __syncthreads();
    if (leader) {
        unsigned* bar = b.bar;
        __builtin_amdgcn_s_waitcnt(0);
        unsigned nloc = b.st[0], nx = b.st[1];
        if (nloc == 0u) { xcd_barrier_complete(bar, b.x, nloc, nx); b.st[0] = nloc; b.st[1] = nx; }
        const unsigned old = xb_add(&bar[XB_XSUB(b.x)], 1u);
        const unsigned gen = old / nloc;
        if (old + 1u == (gen + 1u) * nloc) {
            __builtin_amdgcn_fence(__ATOMIC_RELEASE, "agent");
            asm volatile("s_waitcnt vmcnt(0)" ::: "memory");
            const unsigned og = xb_add(&bar[XB_TOP], 1u);
            const unsigned tg = og / nx;
            if (og + 1u == (tg + 1u) * nx) xb_add(&bar[XB_TOPGEN], 1u);
            else XB_SPIN(xb_ld(&bar[XB_TOPGEN]) == tg, bar);
            __builtin_amdgcn_fence(__ATOMIC_ACQUIRE, "agent");
            xb_add(&bar[XB_XGEN(b.x)], 1u);
            asm volatile("s_waitcnt vmcnt(0)" ::: "memory");
        } else {
            XB_SPIN(xb_ld(&bar[XB_XGEN(b.x)]) == gen, bar);
            __builtin_amdgcn_fence(__ATOMIC_ACQUIRE, "agent");
            asm volatile("s_waitcnt vmcnt(0)" ::: "memory");
        }
    }
    __syncthreads();
}

enum InIdx { I_XP = 0, I_XS, I_CK, I_CV, I_PT, I_SCONV, I_SLRU, I_SSHIFT, I_SWKV, I_SSSM, I_NPRE, I_NPOST, I_WIN, I_WOUT, I_LQ1, I_LK1, I_LQ2, I_LK2, I_SUBLN,
             I_CONVW, I_CONVB, I_LWA, I_LBA, I_LWX, I_LBX, I_LLAM, I_MU, I_W0, I_W1, I_W2, I_A0, I_A1, I_A2, I_KK, I_KA, I_RK, I_GNW, I_GNB,
             I_LRE, I_LIM, I_LOGDT, I_BRE, I_BIM, I_CRE, I_CIM, I_S5D, I_WGLU, I_BGLU, N_IN };
struct Args { const float* in[N_IN]; float* out; unsigned char* ws; int ph_lo, ph_hi; };
static_assert(sizeof(Args) == (N_IN + 2) * 8 + 8, "Args has no padding");
constexpr int TAB_OFF = 147456 - 1024;
struct Ctx {
    float* out; unsigned char* ws; const LAS unsigned* tab;
    __device__ __forceinline__ const float* inp(int i) const {
        const unsigned lo = tab[2 * i], hi = tab[2 * i + 1];
        return (const float*)(const GAS float*)(((unsigned long long)(unsigned)__builtin_amdgcn_readfirstlane((int)hi) << 32) | (unsigned long long)(unsigned)__builtin_amdgcn_readfirstlane((int)lo));
    }
};

__device__ __forceinline__ int lane_id_asm() { int l; asm volatile("v_mbcnt_lo_u32_b32 %0, -1, 0\n\tv_mbcnt_hi_u32_b32 %0, -1, %0" : "=v"(l)); return l; }
#define OPAQUE(x) asm volatile("" : "+v"(x))
__device__ __forceinline__ float wave_sum(float v) {
#pragma unroll
    for (int o = 1; o < 64; o <<= 1) v += __shfl_xor(v, o);
    return v;
}
template <int CTRL> __device__ __forceinline__ float dpp_mov(float v) { return __builtin_bit_cast(float, __builtin_amdgcn_update_dpp(0, __builtin_bit_cast(int, v), CTRL, 0xF, 0xF, true)); }
__device__ __forceinline__ float red8(float v) { v += dpp_mov<0xB1>(v); v += dpp_mov<0x4E>(v); v += dpp_mov<0x141>(v); return v; }
__device__ __forceinline__ float red16(float v) { v = red8(v); v += dpp_mov<0x140>(v); return v; }
__device__ __forceinline__ unsigned f2bf(float f) { unsigned u = __builtin_bit_cast(unsigned, f); return (u + 0x7fffu + ((u >> 16) & 1u)) >> 16; }
typedef __bf16 bf16x2_t __attribute__((ext_vector_type(2)));
__device__ __forceinline__ unsigned pk2(float lo, float hi) { const f32x2 v = {lo, hi}; return __builtin_bit_cast(unsigned, __builtin_convertvector(v, bf16x2_t)); }
__device__ __forceinline__ f32x4 ldp4(const bf16* p) { const u32x2 w = *(const u32x2*)p; return (f32x4){__builtin_bit_cast(float, w.x << 16), __builtin_bit_cast(float, w.x & 0xffff0000u), __builtin_bit_cast(float, w.y << 16), __builtin_bit_cast(float, w.y & 0xffff0000u)}; }
__device__ __forceinline__ float ldp1(const bf16* p) { return __builtin_bit_cast(float, (unsigned)(*p) << 16); }
__device__ __forceinline__ float sigmoidf_(float x) { return __builtin_amdgcn_rcpf(1.0f + __builtin_amdgcn_exp2f(-1.4426950408889634f * x)); }
__device__ __forceinline__ float siluf_(float x) { return x * sigmoidf_(x); }
__device__ __forceinline__ float tanhf_(float x) { return 1.0f - 2.0f * __builtin_amdgcn_rcpf(1.0f + __builtin_amdgcn_exp2f(2.8853900817779268f * x)); }
__device__ __forceinline__ float wave_sum_fast(float v) { v = red16(v); v += __shfl_xor(v, 16); v += __shfl_xor(v, 32); return v; }
__device__ __forceinline__ float softplusf_(float x) { return fmaxf(x, 0.f) + log1pf(__expf(-fabsf(x))); }
__device__ __forceinline__ float lam_init_of(int l) { return l == 0 ? 0.2f : 0.35550907f; }
__device__ __forceinline__ float compute_lam(const Ctx& a, int l, int lane) {
    float v1 = 0.f, v2 = 0.f;
    if (lane < 32) { v1 = a.inp(I_LQ1)[l * 32 + lane] * a.inp(I_LK1)[l * 32 + lane]; v2 = a.inp(I_LQ2)[l * 32 + lane] * a.inp(I_LK2)[l * 32 + lane]; }
    v1 = wave_sum(v1); v2 = wave_sum(v2);
    return expf(v1) - expf(v2) + lam_init_of(l);
}

__device__ __forceinline__ void s5_disc_compute(const Ctx& a, int l, int g, int n, float& ab_re, float& ab_im, float& f_re, float& f_im);
__device__ __forceinline__ void p0_transpose_item(const float* W, int K, int N, bf16* WT, LAS float* scr, int item, int lane) {
    const int nblk = N / 32, kb = item / nblk, nb = item % nblk, k0 = 64 * kb, n0 = 32 * nb;
    float wv[32];
#pragma unroll
    for (int i = 0; i < 32; ++i) wv[i] = W[(size_t)(k0 + 2 * i + (lane >> 5)) * N + n0 + (lane & 31)];
#pragma unroll
    for (int i = 0; i < 32; ++i) scr[(2 * i + (lane >> 5)) * 33 + (lane & 31)] = wv[i];
    asm volatile("s_waitcnt lgkmcnt(0)" ::: "memory");
    const int c = lane & 7;
#pragma unroll
    for (int j = 0; j < 4; ++j) { const int n = (lane >> 3) + 8 * j; const LAS float* s = scr + (8 * c) * 33 + n;
        u32x4 o; o.x = pk2(s[0 * 33], s[1 * 33]); o.y = pk2(s[2 * 33], s[3 * 33]); o.z = pk2(s[4 * 33], s[5 * 33]); o.w = pk2(s[6 * 33], s[7 * 33]);
        *(u32x4*)(WT + (size_t)(n0 + n) * K + k0 + 8 * c) = o; }
    asm volatile("s_waitcnt lgkmcnt(0)" ::: "memory");
}
__device__ __forceinline__ void rms_row_to_bf16(const float* xrow, const float* g, bf16* orow, int lane) {
    const f32x4* xr = (const f32x4*)xrow + lane; const f32x4* gr = (const f32x4*)g + lane;
    f32x4 v[4]; float s = 0.f;
#pragma unroll
    for (int j = 0; j < 4; ++j) { v[j] = xr[64 * j]; s += (v[j].x * v[j].x + v[j].y * v[j].y) + (v[j].z * v[j].z + v[j].w * v[j].w); }
    const float r = rsqrtf(wave_sum(s) * (1.f / DM) + NORM_EPS);
    u32x2* o8 = (u32x2*)orow + lane;
#pragma unroll
    for (int j = 0; j < 4; ++j) { const f32x4 gg = gr[64 * j]; u32x2 o; o.x = pk2(v[j].x * r * gg.x, v[j].y * r * gg.y); o.y = pk2(v[j].z * r * gg.z, v[j].w * r * gg.w); o8[64 * j] = o; }
}
__device__ __forceinline__ void ph_prologue(const Ctx& a, LAS unsigned char* lds, int lane, int wave) {
    OPAQUE(lane);
    LAS float* scr = (LAS float*)(lds + wave * 16384);
    const int gw = blockIdx.x * NWAVES + wave, NGW = gridDim.x * NWAVES;
    constexpr int I_IN = (DM / 64) * (DIN / 32), I_OUT = (DM / 64) * (DM / 32), I_GLU = (256 / 64) * (256 / 32), I_L = I_IN + I_OUT + I_GLU;
    for (int it = gw; it < 2 * I_L; it += NGW) {
        const int l = it / I_L, r = it % I_L;
        if (r < I_IN) p0_transpose_item(a.inp(I_WIN) + (size_t)l * DM * DIN, DM, DIN, (bf16*)(a.ws + WS_WIN) + (size_t)l * DIN * DM, scr, r, lane);
        else if (r < I_IN + I_OUT) p0_transpose_item(a.inp(I_WOUT) + (size_t)l * DM * DM, DM, DM, (bf16*)(a.ws + WS_WOUT) + (size_t)l * DM * DM, scr, r - I_IN, lane);
        else p0_transpose_item(a.inp(I_WGLU) + (size_t)l * 65536, 256, 256, (bf16*)(a.ws + WS_WGLU) + (size_t)l * 65536, scr, r - I_IN - I_OUT, lane);
    }
    {
        bf16* LWT = (bf16*)(a.ws + WS_LWT);
        const float* wa = a.inp(I_LWA); const float* wx = a.inp(I_LWX);
        for (int idx = gw * 64 + lane; idx < 2 * 2 * 4 * 64 * 64; idx += NGW * 64) {
            const int c = idx & 63, d = (idx >> 6) & 63, n = (idx >> 12) & 3, p = (idx >> 14) & 1, l = idx >> 15;
            LWT[idx] = (bf16)f2bf((p ? wx : wa)[((size_t)(l * 4 + n) * 64 + c) * 64 + d]);
        }
    }
    {
        float* T = (float*)(a.ws + WS_S5T);
        for (int idx = gw * 64 + lane; idx < 2 * 16 * 64; idx += NGW * 64) {
            float ar, ai, fr, fi; s5_disc_compute(a, idx >> 10, (idx >> 6) & 15, idx & 63, ar, ai, fr, fi);
            *(f32x4*)(T + (size_t)idx * 4) = (f32x4){ar, ai, fr, fi};
        }
    }
    {
        bf16* W2T = (bf16*)(a.ws + WS_W2T);
        const float* w2 = a.inp(I_W2); const float* a2 = a.inp(I_A2);
        for (int idx = gw * 64 + lane; idx < 2 * 2 * 256 * 32; idx += NGW * 64) {
            const int j = idx & 31, o = (idx >> 5) & 255, p = (idx >> 13) & 1, l = idx >> 14;
            W2T[idx] = (bf16)f2bf((p ? a2 : w2)[((size_t)l * 32 + j) * 256 + o]);
        }
    }
    {
        bf16* W1T = (bf16*)(a.ws + WS_W1T);
        const float* w1 = a.inp(I_W1); const float* a1 = a.inp(I_A1);
        for (int idx = gw * 64 + lane; idx < 2 * 2 * 32 * 256; idx += NGW * 64) {
            const int k = idx & 255, n = (idx >> 8) & 31, p = (idx >> 13) & 1, l = idx >> 14;
            W1T[idx] = (bf16)f2bf((p ? a1 : w1)[((size_t)l * 256 + k) * 32 + n]);
        }
    }
    bf16* H = (bf16*)(a.ws + WS_H);
    {
        const float* xp = a.inp(I_XP); const float* xs = a.inp(I_XS) - (size_t)NP * DM;
        f32x4 gg[4];
#pragma unroll
        for (int j = 0; j < 4; ++j) gg[j] = ((const f32x4*)a.inp(I_NPRE) + lane)[64 * j];
        for (int m0 = gw; m0 < MTOK; m0 += 2 * NGW) {
            const int m1 = m0 + NGW; const bool has1 = m1 < MTOK; const int mb = has1 ? m1 : m0;
            const f32x4* xa = (const f32x4*)((m0 < NP ? xp : xs) + (size_t)m0 * DM) + lane; const f32x4* xb = (const f32x4*)((mb < NP ? xp : xs) + (size_t)mb * DM) + lane;
            f32x4 va[4], vb[4]; float sa = 0.f, sb = 0.f;
#pragma unroll
            for (int j = 0; j < 4; ++j) { va[j] = xa[64 * j]; vb[j] = xb[64 * j]; }
#pragma unroll
            for (int j = 0; j < 4; ++j) { sa += (va[j].x * va[j].x + va[j].y * va[j].y) + (va[j].z * va[j].z + va[j].w * va[j].w); sb += (vb[j].x * vb[j].x + vb[j].y * vb[j].y) + (vb[j].z * vb[j].z + vb[j].w * vb[j].w); }
            const float ra = rsqrtf(wave_sum_fast(sa) * (1.f / DM) + NORM_EPS), rb = rsqrtf(wave_sum_fast(sb) * (1.f / DM) + NORM_EPS);
            u32x2* ha = (u32x2*)(H + (size_t)m0 * DM) + lane; u32x2* hb = (u32x2*)(H + (size_t)mb * DM) + lane;
#pragma unroll
            for (int j = 0; j < 4; ++j) { u32x2 o; o.x = pk2(va[j].x * ra * gg[j].x, va[j].y * ra * gg[j].y); o.y = pk2(va[j].z * ra * gg[j].z, va[j].w * ra * gg[j].w); ha[64 * j] = o;
                if (has1) { u32x2 p; p.x = pk2(vb[j].x * rb * gg[j].x, vb[j].y * rb * gg[j].y); p.y = pk2(vb[j].z * rb * gg[j].z, vb[j].w * rb * gg[j].w); hb[64 * j] = p; } }
        }
    }
}

struct EpiProj {
    static constexpr bool PERM = true, AFTER_DRAIN = false;
    bf16* P; float* out; int layer;
    __device__ __forceinline__ void operator()(const pg8::f32x4 (&acc)[2][2][4][2], const pg8::Unit& u, int wr, int wc, int fr, int fq) const {
        const int row0 = u.pm * 256 + wr * 64 + fr, col0 = u.pn * 256 + wc * 32 + 8 * fq;
#pragma unroll
        for (int ai = 0; ai < 2; ++ai)
#pragma unroll
            for (int m = 0; m < 4; ++m) { bf16* rowp = P + (size_t)(row0 + ai * 128 + m * 16) * DIN + col0;
#pragma unroll
                for (int bj = 0; bj < 2; ++bj) { const pg8::f32x4 v0 = acc[ai][bj][m][0], v1 = acc[ai][bj][m][1];
                    u32x4 w; w.x = pk2(v0[0], v0[1]); w.y = pk2(v0[2], v0[3]); w.z = pk2(v1[0], v1[1]); w.w = pk2(v1[2], v1[3]);
                    *(u32x4*)(rowp + bj * 128) = w; } }
        if (u.pn == 1 || u.pn == 2) {
            const bool smp = (u.pm >= 64);
            float* base;
            if (u.pn == 1) base = smp ? out + OUT_K_S + (size_t)layer * NSMP * 256 : out + OUT_K_P + (size_t)layer * NP * 256;
            else           base = smp ? out + OUT_V_S + (size_t)layer * NSMP * 256 : out + OUT_V_P + (size_t)layer * NP * 256;
            const int r0 = row0 - (smp ? NP : 0), c0 = wc * 32 + 8 * fq;
#pragma unroll
            for (int ai = 0; ai < 2; ++ai)
#pragma unroll
                for (int m = 0; m < 4; ++m) { float* rowp = base + (size_t)(r0 + ai * 128 + m * 16) * 256 + c0;
#pragma unroll
                    for (int bj = 0; bj < 2; ++bj) { __builtin_nontemporal_store(acc[ai][bj][m][0], (pg8::f32x4*)(rowp + bj * 128)); __builtin_nontemporal_store(acc[ai][bj][m][1], (pg8::f32x4*)(rowp + bj * 128 + 4)); } }
        }
    }
};
struct EpiPlain {
    static constexpr bool PERM = true, AFTER_DRAIN = false;
    bf16* C; int ldc;
    __device__ __forceinline__ void operator()(const pg8::f32x4 (&acc)[2][2][4][2], const pg8::Unit& u, int wr, int wc, int fr, int fq) const {
        const int row0 = u.pm * 256 + wr * 64 + fr, col0 = u.pn * 256 + wc * 32 + 8 * fq;
#pragma unroll
        for (int ai = 0; ai < 2; ++ai)
#pragma unroll
            for (int m = 0; m < 4; ++m) { bf16* rowp = C + (size_t)(row0 + ai * 128 + m * 16) * ldc + col0;
#pragma unroll
                for (int bj = 0; bj < 2; ++bj) { const pg8::f32x4 v0 = acc[ai][bj][m][0], v1 = acc[ai][bj][m][1];
                    u32x4 w; w.x = pk2(v0[0], v0[1]); w.y = pk2(v0[2], v0[3]); w.z = pk2(v1[0], v1[1]); w.w = pk2(v1[2], v1[3]);
                    *(u32x4*)(rowp + bj * 128) = w; } }
    }
};

struct FirstRoundOrder : pg8::StaticOrder {
    __device__ __forceinline__ bool next(int i, pg8::Unit& u) const { return i == 0 && pg8::StaticOrder::next(0, u); }
};
__device__ __forceinline__ void gemm_tail64(const bf16* A, const bf16* Bt, bf16* C, int row0, int col0, LAS unsigned char* lds, int tid) {
    OPAQUE(tid);
    const int wid = __builtin_amdgcn_readfirstlane(tid >> 6), lane = tid & 63, fr = lane & 15, fq = lane >> 4;
    const bf16* ap = A + (size_t)(row0 + fr) * DM + wid * 128 + fq * 8; const bf16* bp = Bt + (size_t)(col0 + fr) * DM + wid * 128 + fq * 8;
    f32x4 acc[4][4];
#pragma unroll
    for (int m = 0; m < 4; ++m)
#pragma unroll
        for (int n = 0; n < 4; ++n) acc[m][n] = (f32x4){0.f, 0.f, 0.f, 0.f};
    bf16x8 af[4][4], bfr[4][4];
#pragma unroll
    for (int ks = 0; ks < 4; ++ks)
#pragma unroll
        for (int m = 0; m < 4; ++m) { af[ks][m] = *(const bf16x8*)(ap + (size_t)(16 * m) * DM + 32 * ks); bfr[ks][m] = *(const bf16x8*)(bp + (size_t)(16 * m) * DM + 32 * ks); }
    __builtin_amdgcn_sched_barrier(0);
#pragma unroll
    for (int ks = 0; ks < 4; ++ks)
#pragma unroll
        for (int m = 0; m < 4; ++m)
#pragma unroll
            for (int n = 0; n < 4; ++n) acc[m][n] = __builtin_amdgcn_mfma_f32_16x16x32_bf16(bfr[ks][n], af[ks][m], acc[m][n], 0, 0, 0);
    LAS float* P = (LAS float*)lds + wid * (64 * 68);
#pragma unroll
    for (int m = 0; m < 4; ++m)
#pragma unroll
        for (int n = 0; n < 4; ++n) *(LAS f32x4*)(P + (16 * m + fr) * 68 + 16 * n + 4 * fq) = acc[m][n];
    __syncthreads();
    const int r = tid >> 3, c8 = (tid & 7) * 8;
    f32x4 s0 = (f32x4){0.f, 0.f, 0.f, 0.f}, s1 = s0;
#pragma unroll
    for (int w = 0; w < 8; ++w) { const LAS float* q = (const LAS float*)lds + w * (64 * 68) + r * 68 + c8; s0 += *(const LAS f32x4*)q; s1 += *(const LAS f32x4*)(q + 4); }
    u32x4 o; o.x = pk2(s0[0], s0[1]); o.y = pk2(s0[2], s0[3]); o.z = pk2(s1[0], s1[1]); o.w = pk2(s1[2], s1[3]);
    *(u32x4*)(C + (size_t)(row0 + r) * DM + col0 + c8) = o;
    __syncthreads();
}

__device__ __forceinline__ void g2_tail(const Ctx& a, int l, LAS unsigned char* lds, int tid) {
    constexpr int NWG = (MTOK / 256) * (DM / 256);
    const int G = (int)gridDim.x;
    for (int st = (int)blockIdx.x; st < (NWG - G) * 16; st += G) {
        const int L = G + (st >> 4);
        pg8::StaticOrder T; T.init(MTOK, DM, G, L % G); pg8::Unit u;
        if (T.next(L / G, u))
            gemm_tail64((const bf16*)(a.ws + WS_OB), (const bf16*)(a.ws + WS_WOUT) + (size_t)l * DM * DM, (bf16*)(a.ws + WS_YP), u.pm * 256 + ((st & 15) >> 2) * 64, u.pn * 256 + (st & 3) * 64, lds, tid);
    }
}

__device__ __forceinline__ void lru_prep_item(const Ctx& a, int l, int item, LAS unsigned char* lds, int tid) {
    OPAQUE(tid);
    const bf16* PROJ = (const bf16*)(a.ws + WS_PROJ);
    float* LA = (float*)(a.ws + WS_LA); float* LB = (float*)(a.ws + WS_LB);
    LAS float* X = (LAS float*)lds;
    LAS float* XC = (LAS float*)(lds + 68608);
    const bool smp = item >= 256;
    int nseg, seglen, m0, s = 0, ch = 0, b0 = 0;
    if (!smp) { s = item >> 5; ch = item & 31; nseg = 1; seglen = 64; m0 = s * SEQ + ch * 64; }
    else { const int j = item - 256; nseg = 4; seglen = 8; m0 = NP + j * 32; b0 = j * 4; }
    const int rps = seglen + 3, L = nseg * seglen;
    {
        const float* sconv = a.inp(I_SCONV);
#pragma unroll 4
        for (int idx = tid; idx < nseg * rps * 64; idx += NTHREADS) {
            const int row = idx >> 6, c4 = idx & 63, seg = row / rps, i = row % rps;
            const bool halo = i < 3;
            const bool fromstate = smp && halo;
            f32x4 v = ldp4(PROJ + (size_t)(m0 + seg * seglen + (halo && (smp || ch == 0) ? 3 : i) - 3) * DIN + OFF_B + 4 * c4);
            const f32x4 vs = *(const f32x4*)(sconv + (fromstate ? ((size_t)(l * DB + b0 + seg) * 3 + i) * 256 : (size_t)0) + 4 * c4);
            if (fromstate) v = vs;
            if (!smp && ch == 0 && halo) v = (f32x4){0.f, 0.f, 0.f, 0.f};
            *(LAS f32x4*)(X + row * 256 + 4 * c4) = v;
        }
    }
    __syncthreads();
    if (smp || ch == 31) {
        for (int idx = tid; idx < nseg * 3 * 256; idx += NTHREADS) {
            const int seg = idx / 768, j = (idx % 768) >> 8, c = idx & 255;
            const float v = X[(seg * rps + seglen + j) * 256 + c];
            if (smp) a.out[OUT_CONV_S + ((size_t)(l * DB + b0 + seg) * 3 + j) * 256 + c] = v;
            else a.out[OUT_CONV_P + ((size_t)(l * 8 + s) * 3 + j) * 256 + c] = v;
        }
    }
    {
        const float* cw = a.inp(I_CONVW) + l * 1024; const float* cb = a.inp(I_CONVB) + l * 256;
        for (int idx = tid; idx < L * 256; idx += NTHREADS) {
            const int t = idx >> 8, c = idx & 255, seg = t / seglen, i = t % seglen;
            const LAS float* bp = X + (seg * rps + i) * 256 + c;
            XC[t * 256 + c] = cb[c] + cw[c] * bp[0] + cw[256 + c] * bp[256] + cw[512 + c] * bp[512] + cw[768 + c] * bp[768];
        }
    }
    __syncthreads();
    {
        const int lane = tid & 63, wv = tid >> 6, p = wv >> 2, n = wv & 3, r = lane & 31, hh = lane >> 5, o = tid & 255;
        const bf16* WT = (const bf16*)(a.ws + WS_LWT) + ((size_t)((l * 2 + p) * 4 + n) * 64) * 64;
        bf16x8 wf[2][4];
#pragma unroll
        for (int dt = 0; dt < 2; ++dt)
#pragma unroll
            for (int sx = 0; sx < 4; ++sx) wf[dt][sx] = *(const bf16x8*)(WT + (dt * 32 + r) * 64 + 16 * sx + 8 * hh);
        const float* bp = (p ? a.inp(I_LBX) : a.inp(I_LBA)) + l * 256 + n * 64 + 4 * hh;
        LAS float* GX = X;
        const int LH = L >> 1;
        bf16* OB = (bf16*)(a.ws + WS_OB);
        const float spv = softplusf_(-a.inp(I_LLAM)[l * 256 + o]) * 1.4426950408889634f;
        const float* slru = a.inp(I_SLRU);
        float hs = 0.f, Ps = 1.f;
        for (int hf = 0; hf < 2; ++hf) {
            {
                const LAS float* xr = XC + (hf * LH + r) * 256 + n * 64 + 8 * hh;
                bf16x8 xb[4];
#pragma unroll
                for (int sx = 0; sx < 4; ++sx) { const f32x4 x0 = *(const LAS f32x4*)(xr + 16 * sx), x1 = *(const LAS f32x4*)(xr + 16 * sx + 4);
                    u32x4 w; w.x = pk2(x0.x, x0.y); w.y = pk2(x0.z, x0.w); w.z = pk2(x1.x, x1.y); w.w = pk2(x1.z, x1.w); xb[sx] = __builtin_bit_cast(bf16x8, w); }
#pragma unroll
                for (int dt = 0; dt < 2; ++dt) {
                    f32x16 acc;
#pragma unroll
                    for (int e = 0; e < 16; ++e) acc[e] = 0.f;
#pragma unroll
                    for (int sx = 0; sx < 4; ++sx) acc = __builtin_amdgcn_mfma_f32_32x32x16_bf16(wf[dt][sx], xb[sx], acc, 0, 0, 0);
#pragma unroll
                    for (int g4 = 0; g4 < 4; ++g4) { const f32x4 bb = *(const f32x4*)(bp + dt * 32 + 8 * g4);
                        f32x4 gv; gv.x = sigmoidf_(acc[4 * g4] + bb.x); gv.y = sigmoidf_(acc[4 * g4 + 1] + bb.y); gv.z = sigmoidf_(acc[4 * g4 + 2] + bb.z); gv.w = sigmoidf_(acc[4 * g4 + 3] + bb.w);
                        *(LAS f32x4*)(GX + (p * 32 + r) * 256 + n * 64 + dt * 32 + 8 * g4 + 4 * hh) = gv; }
                }
            }
            __syncthreads();
            if (p == 0) {
              for (int t0 = 0; t0 < LH; t0 += 8) {
                float gts[8];
                if (smp) {
#pragma unroll
                    for (int t = 0; t < 8; ++t) gts[t] = ldp1(PROJ + (size_t)(m0 + hf * LH + t0 + t) * DIN + OFF_G + 256 + o); }
#pragma unroll
                for (int t8 = 0; t8 < 8; ++t8) {
                    const int t = t0 + t8;
                    const int tt = hf * LH + t, seg = tt / seglen, i = tt % seglen;
                    if (i == 0) { hs = smp ? slru[(size_t)(l * DB + b0 + seg) * 256 + o] : 0.f; Ps = 1.f; }
                    const float rg = GX[t * 256 + o], g = GX[(32 + t) * 256 + o];
                    const float av = __builtin_amdgcn_exp2f(-8.0f * rg * spv);
                    const float mult = __builtin_amdgcn_sqrtf(fmaxf(1.0f - av * av, 0.f));
                    const float bv = mult * g * XC[tt * 256 + o];
                    const size_t m = (size_t)(m0 + tt);
                    hs = av * hs + bv; Ps *= av;
                    if (smp) { OB[m * DM + 256 + o] = (bf16)f2bf(hs * siluf_(gts[t8])); if (i == seglen - 1) a.out[OUT_LRU_S + (size_t)(l * DB + b0 + seg) * 256 + o] = hs; }
                    else { LA[m * 256 + o] = av; LB[m * 256 + o] = bv; }
                }
              }
            }
            __syncthreads();
        }
        if (!smp && p == 0) { ((float*)(a.ws + WS_LP))[(size_t)(s * 32 + ch) * 256 + o] = Ps; ((float*)(a.ws + WS_LE))[(size_t)(s * 32 + ch) * 256 + o] = hs; }
    }
    __syncthreads();
}

__device__ __forceinline__ void rwkv_prep_item(const Ctx& a, int l, int item, LAS unsigned char* lds, int tid) {
    OPAQUE(tid);
    const bf16* PROJ = (const bf16*)(a.ws + WS_PROJ);
    float* RW = (float*)(a.ws + WS_RW);
    const float* mu = a.inp(I_MU) + l * 1280; const float* sshift = a.inp(I_SSHIFT) + (size_t)l * DB * 1280;
    LAS float* XWA = (LAS float*)lds;
    LAS float* T1 = (LAS float*)(lds + 65536);
    const int m0 = item * 32;
#pragma unroll
    for (int kb = 0; kb < 20; kb += 10) {
        f32x4 pv[10], ppv[10], psv[10];
#pragma unroll
        for (int k = 0; k < 10; ++k) {
            const int idx = tid + NTHREADS * (kb + k), t = idx / 320, c4 = idx % 320, col = 4 * c4, m = m0 + t;
            const bool first = (m < NP) ? ((m & (SEQ - 1)) == 0) : (((m - NP) & 7) == 0);
            const bool fromstate = first && m >= NP;
            pv[k] = ldp4(PROJ + (size_t)m * DIN + OFF_C + col);
            ppv[k] = ldp4(PROJ + (size_t)(first ? m : m - 1) * DIN + OFF_C + col);
            psv[k] = *(const f32x4*)(sshift + (fromstate ? (size_t)((m - NP) >> 3) * 1280 : (size_t)0) + col);
        }
#pragma unroll
        for (int k = 0; k < 10; ++k) {
            const int idx = tid + NTHREADS * (kb + k), t = idx / 320, c4 = idx % 320, col = 4 * c4, m = m0 + t;
            const bool first = (m < NP) ? ((m & (SEQ - 1)) == 0) : (((m - NP) & 7) == 0);
            f32x4 pp = ppv[k];
            if (first && m >= NP) pp = psv[k];
            if (first && m < NP) pp = (f32x4){0.f, 0.f, 0.f, 0.f};
            const f32x4 xm = pv[k] + (pp - pv[k]) * *(const f32x4*)(mu + col);
            const int sec = c4 >> 6, cc = col & 255;
            if (sec == 1) *(LAS f32x4*)(XWA + t * 512 + cc) = xm;
            else if (sec == 4) *(LAS f32x4*)(XWA + t * 512 + 256 + cc) = xm;
            else *(f32x4*)(RW + (size_t)m * 1536 + (sec == 0 ? 0 : (sec == 2 ? 512 : 768)) + cc) = xm;
        }
    }
    __syncthreads();
    if (tid < 128) {
        const int lane = tid & 63, p = tid >> 6, r = lane & 31, hh = lane >> 5;
        const bf16* wt = (const bf16*)(a.ws + WS_W1T) + ((size_t)(l * 2 + p) * 32 + r) * 256 + 8 * hh;
        const LAS float* xr = XWA + r * 512 + p * 256 + 8 * hh;
        f32x16 acc;
#pragma unroll
        for (int e = 0; e < 16; ++e) acc[e] = 0.f;
#pragma unroll
        for (int sx = 0; sx < 16; ++sx) {
            const bf16x8 af = *(const bf16x8*)(wt + 16 * sx);
            const f32x4 x0 = *(const LAS f32x4*)(xr + 16 * sx), x1 = *(const LAS f32x4*)(xr + 16 * sx + 4);
            u32x4 w; w.x = pk2(x0.x, x0.y); w.y = pk2(x0.z, x0.w); w.z = pk2(x1.x, x1.y); w.w = pk2(x1.z, x1.w);
            acc = __builtin_amdgcn_mfma_f32_32x32x16_bf16(af, __builtin_bit_cast(bf16x8, w), acc, 0, 0, 0);
        }
#pragma unroll
        for (int g4 = 0; g4 < 4; ++g4) { f32x4 v = (f32x4){acc[4 * g4], acc[4 * g4 + 1], acc[4 * g4 + 2], acc[4 * g4 + 3]};
            if (p == 0) { v.x = tanhf_(v.x); v.y = tanhf_(v.y); v.z = tanhf_(v.z); v.w = tanhf_(v.w); }
            *(LAS f32x4*)(T1 + r * 64 + p * 32 + 8 * g4 + 4 * hh) = v; }
    }
    __syncthreads();
    LAS float* ZT = (LAS float*)(lds + 73728);
    {
        const int lane = tid & 63, wv = tid >> 6, p = wv >> 2, hq = wv & 3, r = lane & 31, hh = lane >> 5;
        bf16x8 bfr[2];
#pragma unroll
        for (int sx = 0; sx < 2; ++sx) { const LAS float* tp = T1 + r * 64 + p * 32 + 16 * sx + 8 * hh; const f32x4 x0 = *(const LAS f32x4*)tp, x1 = *(const LAS f32x4*)(tp + 4);
            u32x4 w; w.x = pk2(x0.x, x0.y); w.y = pk2(x0.z, x0.w); w.z = pk2(x1.x, x1.y); w.w = pk2(x1.z, x1.w); bfr[sx] = __builtin_bit_cast(bf16x8, w); }
        const bf16* wt = (const bf16*)(a.ws + WS_W2T) + ((size_t)(l * 2 + p) * 256 + 64 * hq + r) * 32 + 8 * hh;
#pragma unroll
        for (int ot = 0; ot < 2; ++ot) {
            f32x16 acc;
#pragma unroll
            for (int e = 0; e < 16; ++e) acc[e] = 0.f;
            acc = __builtin_amdgcn_mfma_f32_32x32x16_bf16(*(const bf16x8*)(wt + (size_t)(32 * ot) * 32), bfr[0], acc, 0, 0, 0);
            acc = __builtin_amdgcn_mfma_f32_32x32x16_bf16(*(const bf16x8*)(wt + (size_t)(32 * ot) * 32 + 16), bfr[1], acc, 0, 0, 0);
#pragma unroll
            for (int g4 = 0; g4 < 4; ++g4) *(LAS f32x4*)(ZT + (p * 32 + r) * 260 + 64 * hq + 32 * ot + 8 * g4 + 4 * hh) = (f32x4){acc[4 * g4], acc[4 * g4 + 1], acc[4 * g4 + 2], acc[4 * g4 + 3]};
        }
    }
    __syncthreads();
    {
        const int o = tid & 255, half = tid >> 8;
        const float b0 = (half ? a.inp(I_A0) : a.inp(I_W0))[l * 256 + o];
        const float kkw = a.inp(I_KK)[l * 256 + o], kaw = a.inp(I_KA)[l * 256 + o];
#pragma unroll
        for (int t0 = 0; t0 < 32; t0 += 8) {
            float xk_[8];
            if (half) {
#pragma unroll
                for (int t = 0; t < 8; ++t) xk_[t] = RW[(size_t)(m0 + t0 + t) * 1536 + 512 + o]; }
#pragma unroll
            for (int t8 = 0; t8 < 8; ++t8) {
                const int t = t0 + t8;
                const float z = b0 + ZT[(half * 32 + t) * 260 + o];
                float* rwp = RW + (size_t)(m0 + t) * 1536 + o;
                if (half == 0) {
                    rwp[256] = __builtin_amdgcn_exp2f(-0.8750566294f * sigmoidf_(z));
                } else {
                    const float aa = sigmoidf_(z);
                    const float xk = xk_[t8];
                    const float kkv = xk * kkw;
                    const float ss = wave_sum_fast(kkv * kkv);
                    const float kkn = kkv * __builtin_amdgcn_rsqf(fmaxf(ss, 1e-24f));
                    rwp[512] = xk * (1.0f + (aa - 1.0f) * kaw); rwp[1024] = -kkn; rwp[1280] = kkn * aa;
                }
            }
        }
    }
    __syncthreads();
}

__device__ __forceinline__ void s5_disc(const Ctx& a, int l, int g, int n, float& ab_re, float& ab_im, float& f_re, float& f_im) {
    const f32x4 t = *(const f32x4*)((const float*)(a.ws + WS_S5T) + ((size_t)(l * 16 + g) * 64 + n) * 4);
    ab_re = t.x; ab_im = t.y; f_re = t.z; f_im = t.w;
}
__device__ __forceinline__ void s5_disc_compute(const Ctx& a, int l, int g, int n, float& ab_re, float& ab_im, float& f_re, float& f_im) {
    const float lr = a.inp(I_LRE)[(l * 16 + g) * 64 + n], li = a.inp(I_LIM)[(l * 16 + g) * 64 + n];
    const float dt = expf(a.inp(I_LOGDT)[l * 16 + g]);
    const float mag = expf(lr * dt);
    ab_re = mag * cosf(li * dt); ab_im = mag * sinf(li * dt);
    const float den = lr * lr + li * li, pr = ab_re - 1.0f;
    f_re = (pr * lr + ab_im * li) / den; f_im = (ab_im * lr - pr * li) / den;
}
struct S5Par { float ab_re, ab_im; bf16x8 bf[4]; };
__device__ __forceinline__ void s5_params(const Ctx& a, int l, int g, int lane, S5Par& P) {
    float fr, fi;
    s5_disc(a, l, g, lane, P.ab_re, P.ab_im, fr, fi);
    const int r = lane & 31, hh = lane >> 5;
#pragma unroll
    for (int nh = 0; nh < 2; ++nh) {
        float xr, xi, f_re, f_im;
        s5_disc(a, l, g, 32 * nh + r, xr, xi, f_re, f_im);
        const float* brp = a.inp(I_BRE) + ((size_t)(l * 16 + g) * 64 + 32 * nh + r) * 16 + 8 * hh; const float* bip = a.inp(I_BIM) + ((size_t)(l * 16 + g) * 64 + 32 * nh + r) * 16 + 8 * hh;
        const f32x4 r0 = *(const f32x4*)brp, r1 = *(const f32x4*)(brp + 4), i0 = *(const f32x4*)bip, i1 = *(const f32x4*)(bip + 4);
        u32x4 wr, wi;
        wr.x = pk2(f_re * r0.x - f_im * i0.x, f_re * r0.y - f_im * i0.y); wr.y = pk2(f_re * r0.z - f_im * i0.z, f_re * r0.w - f_im * i0.w);
        wr.z = pk2(f_re * r1.x - f_im * i1.x, f_re * r1.y - f_im * i1.y); wr.w = pk2(f_re * r1.z - f_im * i1.z, f_re * r1.w - f_im * i1.w);
        wi.x = pk2(f_re * i0.x + f_im * r0.x, f_re * i0.y + f_im * r0.y); wi.y = pk2(f_re * i0.z + f_im * r0.z, f_re * i0.w + f_im * r0.w);
        wi.z = pk2(f_re * i1.x + f_im * r1.x, f_re * i1.y + f_im * r1.y); wi.w = pk2(f_re * i1.z + f_im * r1.z, f_re * i1.w + f_im * r1.w);
        P.bf[nh] = __builtin_bit_cast(bf16x8, wr); P.bf[2 + nh] = __builtin_bit_cast(bf16x8, wi);
    }
}
__device__ __forceinline__ void s5_bu_block(const S5Par& P, const bf16* PROJ, size_t m0, int nvalid, int g, LAS float* HR, LAS float* HI, int lane) {
    const int r = lane & 31, hh = lane >> 5;
    const int tr = r < nvalid ? r : nvalid - 1;
    const bf16x8 uf = *(const bf16x8*)(PROJ + (m0 + tr) * DIN + OFF_D + g * 16 + 8 * hh);
#pragma unroll
    for (int tile = 0; tile < 4; ++tile) {
        f32x16 acc;
#pragma unroll
        for (int e = 0; e < 16; ++e) acc[e] = 0.f;
        acc = __builtin_amdgcn_mfma_f32_32x32x16_bf16(P.bf[tile], uf, acc, 0, 0, 0);
        LAS float* dst = ((tile >> 1) ? HI : HR) + r * 68 + 32 * (tile & 1) + 4 * hh;
#pragma unroll
        for (int g4 = 0; g4 < 4; ++g4) *(LAS f32x4*)(dst + 8 * g4) = (f32x4){acc[4 * g4], acc[4 * g4 + 1], acc[4 * g4 + 2], acc[4 * g4 + 3]};
    }
    asm volatile("s_waitcnt lgkmcnt(0)" ::: "memory");
}
__device__ __forceinline__ void s5_pass1_wave(const Ctx& a, int l, int wi, LAS unsigned char* wlds, int lane) {
    OPAQUE(lane);
    const int ck = wi & 15, g = (wi >> 4) & 15, s = wi >> 8;
    const bf16* PROJ = (const bf16*)(a.ws + WS_PROJ);
    LAS float* HR = (LAS float*)wlds; LAS float* HI = HR + 32 * 68;
    S5Par P; s5_params(a, l, g, lane, P);
    float hr = 0.f, hi = 0.f;
    for (int t0 = 0; t0 < 128; t0 += 32) {
        s5_bu_block(P, PROJ, (size_t)(s * SEQ + ck * 128 + t0), 32, g, HR, HI, lane);
#pragma unroll 8
        for (int t = 0; t < 32; ++t) { const float br = HR[t * 68 + lane], bi = HI[t * 68 + lane];
            const float nr = P.ab_re * hr - P.ab_im * hi + br, ni = P.ab_re * hi + P.ab_im * hr + bi; hr = nr; hi = ni; }
        asm volatile("s_waitcnt lgkmcnt(0)" ::: "memory");
    }
    f32x2* E = (f32x2*)(a.ws + WS_S5E);
    E[((size_t)(s * 16 + g) * 16 + ck) * 64 + lane] = (f32x2){hr, hi};
}

__device__ __forceinline__ void attn_prep_rows_wave(const Ctx& a, int wi, int lane) {
    OPAQUE(lane);
    const bf16* PROJ = (const bf16*)(a.ws + WS_PROJ);
    bf16* QB = (bf16*)(a.ws + WS_QB);
#pragma unroll
    for (int r = 0; r < 8; ++r) { const size_t m = (size_t)wi * 8 + r;
        const f32x4 q = ldp4(PROJ + m * DIN + OFF_AQ + 4 * lane);
        u32x2 qo; qo.x = pk2(q.x * QSCALE, q.y * QSCALE); qo.y = pk2(q.z * QSCALE, q.w * QSCALE);
        *(u32x2*)(QB + m * 256 + 4 * lane) = qo; }
}
__device__ __forceinline__ void attn_prep_kv_wave(const Ctx& a, int wi, int lane) {
    OPAQUE(lane);
    const bf16* PROJ = (const bf16*)(a.ws + WS_PROJ);
    bf16* KF = (bf16*)(a.ws + WS_KB); bf16* VF = (bf16*)(a.ws + WS_VT);
    const int kt = wi & 63, b = wi >> 6, r = lane & 31, hh = lane >> 5;
    const bf16* krow = PROJ + (size_t)(b * SEQ + kt * 32 + r) * DIN + OFF_AK + 8 * hh;
    const bf16* vcol = PROJ + (size_t)(b * SEQ + kt * 32 + 4 * hh) * DIN + OFF_AV + r;
#pragma unroll
    for (int h = 0; h < 4; ++h) {
#pragma unroll
        for (int cs = 0; cs < 4; ++cs) {
            const u32x4 ko = *(const u32x4*)(krow + h * 64 + cs * 16);
            const size_t frag = ((size_t)((b * 4 + h) * 64 + kt) * 4 + cs) * 512 + lane * 8;
            *(u32x4*)(KF + frag) = ko;
            const int tl = cs >> 1, s2 = cs & 1;
            const bf16* vp = vcol + (size_t)(16 * s2) * DIN + h * 64 + 32 * tl;
            unsigned v[8];
#pragma unroll
            for (int jj = 0; jj < 8; ++jj) v[jj] = (unsigned)vp[(size_t)(8 * (jj >> 2) + (jj & 3)) * DIN];
            u32x4 vo; vo.x = v[0] | (v[1] << 16); vo.y = v[2] | (v[3] << 16); vo.z = v[4] | (v[5] << 16); vo.w = v[6] | (v[7] << 16);
            *(u32x4*)(VF + frag) = vo;
        }
    }
}

#ifndef MP_MASK
#define MP_MASK 0x1f
#endif
#ifndef MM_MASK
#define MM_MASK 0x7f
#endif
#define MPE(j) ((MP_MASK >> (j)) & 1)
#define MME(j) ((MM_MASK >> (j)) & 1)
constexpr int MP_LRU = 256 + 32, MP_RW = MTOK / 32, MP_S5 = 256  , MP_AR = 256  , MP_VT = 64  ;
constexpr int MP_TOTAL = MP_LRU + MP_RW + MP_S5 + MP_AR + MP_VT;
#ifndef STREAM_DIV
#define STREAM_DIV 6
#endif
__device__ __forceinline__ void attn_sample_wave(const Ctx& a, int l, int wi, int lane);
__device__ __forceinline__ int grab_unit_until(unsigned* ctr, unsigned* stop, unsigned stopval, volatile LAS unsigned* MISC, int tid) {
    __syncthreads();
    if (tid == 0) MISC[4] = (__hip_atomic_load(stop, __ATOMIC_RELAXED, __HIP_MEMORY_SCOPE_AGENT) >= stopval) ? 0x7fffffffu : atomicAdd(ctr, 1u);
    __syncthreads();
    return (int)MISC[4];
}
__device__ __forceinline__ int grab_unit(unsigned* ctr, volatile LAS unsigned* MISC, int tid) {
    __syncthreads();
    if (tid == 0) MISC[4] = atomicAdd(ctr, 1u);
    __syncthreads();
    return (int)MISC[4];
}
__device__ __forceinline__ void ph_mixprep(const Ctx& a, int lq, int MMSK, LAS unsigned char* lds, volatile LAS unsigned* MISC, int tid, int lane, int wave) {
    const int l = lq & 1;
    unsigned* qctr = (unsigned*)(a.ws + WS_CTL) + CW_QUEUE + 4096 + 512 * lq;
    int u;
    if (((blockIdx.x >> 3) % STREAM_DIV) == 0 && lq < 2) {
        unsigned* asq = (unsigned*)(a.ws + WS_CTL) + CW_QUEUE + 1024 * lq + 2 * 64;
        while ((u = grab_unit_until(asq, qctr + 1 * 64, (unsigned)MP_RW, MISC, tid)) < (DB * NSPLIT * 4) / 8) attn_sample_wave(a, l, u * 8 + wave, lane);
    }
    if (MMSK & 1) while ((u = grab_unit(qctr + 0 * 64, MISC, tid)) < MP_LRU) lru_prep_item(a, l, u, lds, tid);
    if (MMSK & 2) while ((u = grab_unit(qctr + 1 * 64, MISC, tid)) < MP_RW) rwkv_prep_item(a, l, u, lds, tid);
    if (MMSK & 4) while ((u = grab_unit(qctr + 2 * 64, MISC, tid)) < MP_S5) s5_pass1_wave(a, l, u * 8 + wave, lds + wave * 17408, lane);
    if (MMSK & 8) while ((u = grab_unit(qctr + 3 * 64, MISC, tid)) < MP_AR) attn_prep_rows_wave(a, u * 8 + wave, lane);
    if (MMSK & 16) while ((u = grab_unit(qctr + 4 * 64, MISC, tid)) < MP_VT) attn_prep_kv_wave(a, u * 8 + wave, lane);
    {
        const bf16* PROJ = (const bf16*)(a.ws + WS_PROJ);
        const int gt = blockIdx.x * NTHREADS + tid, NGT = gridDim.x * NTHREADS;
        for (int idx = gt; idx < 136 * 1280; idx += NGT) {
            const int q = idx / 1280, c = idx % 1280;
            if (q < 8) a.out[OUT_SHIFT_P + (size_t)(l * 8 + q) * 1280 + c] = ldp1(PROJ + (size_t)(q * SEQ + SEQ - 1) * DIN + OFF_C + c);
            else a.out[OUT_SHIFT_S + (size_t)(l * DB + (q - 8)) * 1280 + c] = ldp1(PROJ + (size_t)(NP + (q - 8) * 8 + 7) * DIN + OFF_C + c);
        }
    }
}

struct RwOps { f32x2 w[4], k[4], a[4], b[4], r[4]; float vi; };
__device__ __forceinline__ void rw_ld4(f32x2 (&d)[4], const LAS float* p) { const f32x4 x = *(const LAS f32x4*)p, y = *(const LAS f32x4*)(p + 4);
    d[0] = (f32x2){x.x, x.y}; d[1] = (f32x2){x.z, x.w}; d[2] = (f32x2){y.x, y.y}; d[3] = (f32x2){y.z, y.w}; }
template <int MODE> __device__ __forceinline__ void rw_load_ops(RwOps& o, const LAS float* base, int i, int jq) {
    rw_ld4(o.w, base + 64 + 8 * jq); rw_ld4(o.k, base + 128 + 8 * jq);
    o.vi = base[192 + i];
    rw_ld4(o.a, base + 256 + 8 * jq); rw_ld4(o.b, base + 320 + 8 * jq);
    if (MODE == 0) rw_ld4(o.r, base + 8 * jq);
}
__device__ __forceinline__ float rw_dot(const f32x2 (&S)[4], const f32x2 (&v)[4]) {
    const f32x2 d0 = S[0] * v[0] + S[1] * v[1], d1 = S[2] * v[2] + S[3] * v[3];
    const f32x2 d = d0 + d1;
    return d.x + d.y;
}
template <int MODE> __device__ __forceinline__ void rw_step(const RwOps& o, f32x2 (&S)[4], f32x2 (&Pm)[4], LAS float* yslot, int jq) {
    const float sa = red8(rw_dot(S, o.a));
    const f32x2 sa2 = (f32x2){sa, sa}, vi2 = (f32x2){o.vi, o.vi};
#pragma unroll
    for (int k = 0; k < 4; ++k) S[k] = (S[k] * o.w[k] + vi2 * o.k[k]) + sa2 * o.b[k];
    if (MODE == 0) {
        const float y = red8(rw_dot(S, o.r));
        if (jq == 0) *yslot = y;
    } else {
        const float sp = red8(rw_dot(Pm, o.a));
        const f32x2 sp2 = (f32x2){sp, sp};
#pragma unroll
        for (int k = 0; k < 4; ++k) Pm[k] = Pm[k] * o.w[k] + sp2 * o.b[k];
    }
}
template <int MODE, int TT>
__device__ __forceinline__ void rwkv_core(const Ctx& a, int l, int h, int mbase, int T, float (&S8)[8], float (&P8)[8], LAS unsigned char* lds, int tid) {
    f32x2 S[4], Pm[4];
#pragma unroll
    for (int k = 0; k < 4; ++k) { S[k] = (f32x2){S8[2 * k], S8[2 * k + 1]}; Pm[k] = (f32x2){P8[2 * k], P8[2 * k + 1]}; }
    const float* RW = (const float*)(a.ws + WS_RW);
    const f32x4 rk4 = *(const f32x4*)(a.inp(I_RK) + l * 256 + h * 64 + 4 * (tid & 15));
    bf16* OB = (bf16*)(a.ws + WS_OB); const bf16* PROJ = (const bf16*)(a.ws + WS_PROJ);
    LAS float* RWT = (LAS float*)lds;
    LAS float* Y = (LAS float*)(lds + 49152);
    const int i = tid >> 3, jq = tid & 7;
    f32x4 pre[6];
#define RW_LOAD(tile) do { _Pragma("unroll") for (int k = 0; k < 6; ++k) { const int idx = tid + NTHREADS * k; \
        if (idx < TT * 96) { const int t = idx / 96, rem = idx % 96, sec = rem >> 4, c4 = rem & 15; \
            pre[k] = *(const f32x4*)(RW + (size_t)(mbase + (tile) * TT + t) * 1536 + sec * 256 + h * 64 + 4 * c4); } } } while (0)
#define RW_STORE() do { _Pragma("unroll") for (int k = 0; k < 6; ++k) { const int idx = tid + NTHREADS * k; \
        if (idx < TT * 96) *(LAS f32x4*)(RWT + idx * 4) = pre[k]; } } while (0)
    const int ntile = T / TT;
    const int gt_t = tid >> 4, gt_q = tid & 15;
    f32x4 gn_w = (f32x4){0.f, 0.f, 0.f, 0.f}, gn_b = gn_w, gpre = gn_w;
    if (MODE == 0) { gn_w = *(const f32x4*)(a.inp(I_GNW) + l * 256 + h * 64 + 4 * gt_q); gn_b = *(const f32x4*)(a.inp(I_GNB) + l * 256 + h * 64 + 4 * gt_q); }
    RW_LOAD(0);
    __syncthreads();
    RW_STORE();
    __syncthreads();
    for (int tile = 0; tile < ntile; ++tile) {
        if (tile + 1 < ntile) RW_LOAD(tile + 1);
        if (MODE == 0 && gt_t < TT) gpre = ldp4(PROJ + (size_t)(mbase + tile * TT + gt_t) * DIN + OFF_G + 512 + h * 64 + 4 * gt_q);
        {
            RwOps oa, ob;
            rw_load_ops<MODE>(oa, RWT, i, jq);
            for (int t = 0; t < TT; t += 2) {
                rw_load_ops<MODE>(ob, RWT + (t + 1) * 384, i, jq);
                rw_step<MODE>(oa, S, Pm, Y + t * 64 + i, jq);
                rw_load_ops<MODE>(oa, RWT + (t + 2) * 384, i, jq);
                rw_step<MODE>(ob, S, Pm, Y + (t + 1) * 64 + i, jq);
            }
        }
        __syncthreads();
        if (MODE == 0) {
            const int t = tid >> 4, q = tid & 15;
            if (t < TT) {
                const f32x4 yv = *(const LAS f32x4*)(Y + t * 64 + 4 * q);
                const float mean = red16((yv.x + yv.y) + (yv.z + yv.w)) * (1.f / 64.f);
                const f32x4 dv = yv - mean;
                const float rs = rsqrtf(red16((dv.x * dv.x + dv.y * dv.y) + (dv.z * dv.z + dv.w * dv.w)) * (1.f / 64.f) + 64.0f * 1e-5f);
                const int m = mbase + tile * TT + t;
                const f32x4 gw = gn_w, gb = gn_b;
                const f32x4 vv = *(const LAS f32x4*)(RWT + t * 384 + 192 + 4 * q);
                const f32x4 r4 = *(const LAS f32x4*)(RWT + t * 384 + 4 * q), k4 = *(const LAS f32x4*)(RWT + t * 384 + 128 + 4 * q);
                const float bon = red16((r4.x * k4.x * rk4.x + r4.y * k4.y * rk4.y) + (r4.z * k4.z * rk4.z + r4.w * k4.w * rk4.w));
                const f32x4 o = dv * rs * gw + gb + bon * vv;
                const f32x4 gt = gpre;
                u32x2 ow; ow.x = pk2(o.x * siluf_(gt.x), o.y * siluf_(gt.y)); ow.y = pk2(o.z * siluf_(gt.z), o.w * siluf_(gt.w));
                *(u32x2*)(OB + (size_t)m * DM + 512 + h * 64 + 4 * q) = ow;
            }
            __syncthreads();
        }
        if (tile + 1 < ntile) { RW_STORE(); }
        __syncthreads();
    }
#undef RW_LOAD
#undef RW_STORE
#pragma unroll
    for (int k = 0; k < 4; ++k) { S8[2 * k] = S[k].x; S8[2 * k + 1] = S[k].y; P8[2 * k] = Pm[k].x; P8[2 * k + 1] = Pm[k].y; }
}
__device__ __forceinline__ void st8(float* dst, const float (&S)[8]) { *(f32x4*)dst = (f32x4){S[0], S[1], S[2], S[3]}; *(f32x4*)(dst + 4) = (f32x4){S[4], S[5], S[6], S[7]}; }
__device__ __forceinline__ void ld8(const float* src, float (&S)[8]) { const f32x4 s0 = *(const f32x4*)src, s1 = *(const f32x4*)(src + 4);
    S[0] = s0.x; S[1] = s0.y; S[2] = s0.z; S[3] = s0.w; S[4] = s1.x; S[5] = s1.y; S[6] = s1.z; S[7] = s1.w; }
__device__ __forceinline__ void rwkv_sample_unit(const Ctx& a, int l, int b, int h, LAS unsigned char* lds, int tid) {
    OPAQUE(tid);
    const int i = tid >> 3, jq = tid & 7;
    float S[8], D[8];
    ld8(a.inp(I_SWKV) + (((size_t)(l * DB + b) * 4 + h) * 64 + i) * 64 + 8 * jq, S);
    rwkv_core<0, 8>(a, l, h, NP + b * DS, DS, S, D, lds, tid);
    st8(a.out + OUT_WKV_S + (((size_t)(l * DB + b) * 4 + h) * 64 + i) * 64 + 8 * jq, S);
}
__device__ __forceinline__ void rwkv_prompt_unitA(const Ctx& a, int l, int u, LAS unsigned char* lds, int tid) {
    OPAQUE(tid);
    const int c = u & 7, h = (u >> 3) & 3, s = u >> 5;
    if (c == 7) return;
    const int i = tid >> 3, jq = tid & 7;
    float* pz = (float*)(a.ws + WS_PZ) + ((size_t)((s * 4 + h) * 8 + c) * 2) * 4096 + i * 64 + 8 * jq;
    float S[8], Pm[8];
#pragma unroll
    for (int e = 0; e < 8; ++e) { S[e] = 0.f; Pm[e] = (8 * jq + e == i) ? 1.f : 0.f; }
    if (c == 0) { rwkv_core<0, 32>(a, l, h, s * SEQ, 256, S, Pm, lds, tid); st8(pz + 4096, S); }
    else { rwkv_core<1, 32>(a, l, h, s * SEQ + c * 256, 256, S, Pm, lds, tid); st8(pz, Pm); st8(pz + 4096, S); }
}
__device__ __forceinline__ void rwkv_prompt_unitB(const Ctx& a, int l, int u, LAS unsigned char* lds, int tid) {
    OPAQUE(tid);
    const int c = 7 - (u >> 5), sh = u & 31, s = sh >> 2, h = sh & 3;
    const int i = tid >> 3, jq = tid & 7;
    const float* pzb = (const float*)(a.ws + WS_PZ) + ((size_t)(sh * 8) * 2) * 4096;
    LAS float* SL = (LAS float*)lds;
    LAS float* PL = (LAS float*)(lds + 17408);
    LAS float* DL = (LAS float*)(lds + 17408 + 6 * 16384);
    const int fw = __builtin_amdgcn_readfirstlane(tid >> 6), ffr = tid & 15, ffq = (tid >> 4) & 3;
    float S[8], Z[8];
    ld8(pzb + 4096 + i * 64 + 8 * jq, S);
    {
        f32x4 pp[6][2]; float ZZ[6][8];
#pragma unroll
        for (int cp = 1; cp <= 6; ++cp) if (cp < c) { const float* pg = pzb + (size_t)cp * 8192;
            pp[cp - 1][0] = *(const f32x4*)(pg + tid * 4); pp[cp - 1][1] = *(const f32x4*)(pg + (tid + NTHREADS) * 4); ld8(pg + 4096 + i * 64 + 8 * jq, ZZ[cp - 1]); }
        __syncthreads();
#pragma unroll
        for (int cp = 1; cp <= 6; ++cp) if (cp < c) { *(LAS f32x4*)(PL + (cp - 1) * 4096 + tid * 4) = pp[cp - 1][0]; *(LAS f32x4*)(PL + (cp - 1) * 4096 + (tid + NTHREADS) * 4) = pp[cp - 1][1]; }
#pragma unroll
        for (int cp = 1; cp <= 6; ++cp) if (cp < c) {
            __syncthreads();
            *(LAS f32x4*)(SL + i * 68 + 8 * jq) = (f32x4){S[0], S[1], S[2], S[3]}; *(LAS f32x4*)(SL + i * 68 + 8 * jq + 4) = (f32x4){S[4], S[5], S[6], S[7]};
            __syncthreads();
            {
                const LAS float* ap = SL + (16 * (fw >> 1) + ffr) * 68 + ffq;
                const LAS float* bp = PL + (cp - 1) * 4096 + ffq * 64 + 32 * (fw & 1) + ffr;
                f32x4 d0 = (f32x4){0.f, 0.f, 0.f, 0.f}, d1 = d0;
#pragma unroll
                for (int ks = 0; ks < 16; ++ks) { const float av = ap[4 * ks], b0 = bp[256 * ks], b1 = bp[256 * ks + 16];
                    d0 = __builtin_amdgcn_mfma_f32_16x16x4f32(av, b0, d0, 0, 0, 0); d1 = __builtin_amdgcn_mfma_f32_16x16x4f32(av, b1, d1, 0, 0, 0); }
                LAS float* dp = DL + (16 * (fw >> 1) + 4 * ffq) * 68 + 32 * (fw & 1) + ffr;
#pragma unroll
                for (int e = 0; e < 4; ++e) { dp[e * 68] = d0[e]; dp[e * 68 + 16] = d1[e]; }
            }
            __syncthreads();
            { const f32x4 r0 = *(const LAS f32x4*)(DL + i * 68 + 8 * jq), r1 = *(const LAS f32x4*)(DL + i * 68 + 8 * jq + 4);
                S[0] = r0.x + ZZ[cp - 1][0]; S[1] = r0.y + ZZ[cp - 1][1]; S[2] = r0.z + ZZ[cp - 1][2]; S[3] = r0.w + ZZ[cp - 1][3];
                S[4] = r1.x + ZZ[cp - 1][4]; S[5] = r1.y + ZZ[cp - 1][5]; S[6] = r1.z + ZZ[cp - 1][6]; S[7] = r1.w + ZZ[cp - 1][7]; }
        }
    }
    rwkv_core<0, 32>(a, l, h, s * SEQ + c * 256, 256, S, Z, lds, tid);
    if (c == 7) st8(a.out + OUT_WKV_P + (((size_t)(l * 8 + s) * 4 + h) * 64 + i) * 64 + 8 * jq, S);
}

__device__ __forceinline__ void lru_pass2_wave(const Ctx& a, int l, int wi, int lane) {
    OPAQUE(lane);
    const int q = wi & 3, ch = (wi >> 2) & 31, s = wi >> 7;
    const int o = q * 64 + lane;
    const float* LA = (const float*)(a.ws + WS_LA); const float* LB = (const float*)(a.ws + WS_LB);
    const float* LP = (const float*)(a.ws + WS_LP); const float* LE = (const float*)(a.ws + WS_LE);
    bf16* OB = (bf16*)(a.ws + WS_OB); const bf16* PROJ = (const bf16*)(a.ws + WS_PROJ);
    float h = 0.f;
#pragma unroll 8
    for (int c = 0; c < ch; ++c) h = LP[(size_t)(s * 32 + c) * 256 + o] * h + LE[(size_t)(s * 32 + c) * 256 + o];
    const size_t m0 = (size_t)s * SEQ + ch * 64;
#pragma unroll
    for (int i0 = 0; i0 < 64; i0 += 32) {
        float av[32], bv[32], gv[32];
#pragma unroll
        for (int i = 0; i < 32; ++i) { av[i] = LA[(m0 + i0 + i) * 256 + o]; bv[i] = LB[(m0 + i0 + i) * 256 + o]; gv[i] = ldp1(PROJ + (m0 + i0 + i) * DIN + OFF_G + 256 + o); }
#pragma unroll
        for (int i = 0; i < 32; ++i) { h = av[i] * h + bv[i]; OB[(m0 + i0 + i) * DM + 256 + o] = (bf16)f2bf(h * siluf_(gv[i])); }
    }
    if (ch == 31) a.out[OUT_LRU_P + (size_t)(l * 8 + s) * 256 + o] = h;
}

__device__ __forceinline__ float gelu_tanh(float y) { return 0.5f * y * (1.0f + tanhf_(0.7978845608028654f * (y + 0.044715f * y * y * y))); }
__device__ __forceinline__ void s5_pass2_wave(const Ctx& a, int l, bool smp, int wi, LAS unsigned char* wlds, int lane) {
    OPAQUE(lane);
    const bf16* PROJ = (const bf16*)(a.ws + WS_PROJ);
    bf16* ZB = (bf16*)(a.ws + WS_ZB);
    LAS float* HR = (LAS float*)wlds;
    LAS float* HI = HR + 32 * 68;
    int g, mbase, T, ck = 0, sq;
    if (smp) { g = wi & 15; sq = wi >> 4; mbase = NP + sq * DS; T = DS; }
    else { ck = wi & 15; g = (wi >> 4) & 15; sq = wi >> 8; mbase = sq * SEQ + ck * 128; T = 128; }
    S5Par P; s5_params(a, l, g, lane, P);
    float hr, hi;
    if (smp) { const f32x2 v = *(const f32x2*)(a.inp(I_SSSM) + (((size_t)(l * DB + sq) * 16 + g) * 64 + lane) * 2); hr = v.x; hi = v.y; }
    else {
        float pr = P.ab_re, pi = P.ab_im;
#pragma unroll
        for (int k = 0; k < 7; ++k) { const float nr = pr * pr - pi * pi, ni = 2.0f * pr * pi; pr = nr; pi = ni; }
        hr = 0.f; hi = 0.f;
        const f32x2* E = (const f32x2*)(a.ws + WS_S5E) + ((size_t)(sq * 16 + g) * 16) * 64 + lane;
        for (int c = 0; c < ck; ++c) { const f32x2 e = E[(size_t)c * 64]; const float nr = pr * hr - pi * hi + e.x, ni = pr * hi + pi * hr + e.y; hr = nr; hi = ni; }
    }
    const int cc = lane & 15, kq = lane >> 4;
    bf16x8 cf[4];
    {
        const float* crp = a.inp(I_CRE) + ((size_t)(l * 16 + g) * 16 + cc) * 64 + 8 * kq; const float* cip = a.inp(I_CIM) + ((size_t)(l * 16 + g) * 16 + cc) * 64 + 8 * kq;
#pragma unroll
        for (int ks = 0; ks < 4; ++ks) { const float* p = (ks < 2 ? crp : cip) + 32 * (ks & 1); const float sg = ks < 2 ? 1.f : -1.f;
            const f32x4 x0 = *(const f32x4*)p, x1 = *(const f32x4*)(p + 4);
            u32x4 w; w.x = pk2(sg * x0.x, sg * x0.y); w.y = pk2(sg * x0.z, sg * x0.w); w.z = pk2(sg * x1.x, sg * x1.y); w.w = pk2(sg * x1.z, sg * x1.w); cf[ks] = __builtin_bit_cast(bf16x8, w); }
    }
    const f32x4 dd4 = *(const f32x4*)(a.inp(I_S5D) + l * 256 + g * 16 + 4 * kq);
    for (int t0 = 0; t0 < T; t0 += 32) {
        const int nt = (T - t0) < 32 ? (T - t0) : 32;
        s5_bu_block(P, PROJ, (size_t)(mbase + t0), nt, g, HR, HI, lane);
        for (int t = 0; t < nt; ++t) { const float br = HR[t * 68 + lane], bi = HI[t * 68 + lane];
            const float nr = P.ab_re * hr - P.ab_im * hi + br, ni = P.ab_re * hi + P.ab_im * hr + bi; hr = nr; hi = ni;
            HR[t * 68 + lane] = hr; HI[t * 68 + lane] = hi; }
        asm volatile("s_waitcnt lgkmcnt(0)" ::: "memory");
#pragma unroll
        for (int tt = 0; tt < 2; ++tt) {
            if (tt * 16 < nt) {
                f32x4 acc = (f32x4){0.f, 0.f, 0.f, 0.f};
#pragma unroll
                for (int ks = 0; ks < 4; ++ks) { const LAS float* hp = (ks < 2 ? HR : HI) + (tt * 16 + cc) * 68 + 32 * (ks & 1) + 8 * kq;
                    const f32x4 x0 = *(const LAS f32x4*)hp, x1 = *(const LAS f32x4*)(hp + 4);
                    u32x4 w; w.x = pk2(x0.x, x0.y); w.y = pk2(x0.z, x0.w); w.z = pk2(x1.x, x1.y); w.w = pk2(x1.z, x1.w);
                    acc = __builtin_amdgcn_mfma_f32_16x16x32_bf16(cf[ks], __builtin_bit_cast(bf16x8, w), acc, 0, 0, 0); }
                const int t = tt * 16 + cc;
                if (t < nt) { const size_t m = (size_t)(mbase + t0 + t);
                    const f32x4 u4 = ldp4(PROJ + m * DIN + OFF_D + g * 16 + 4 * kq);
                    u32x2 zz; zz.x = pk2(gelu_tanh(acc.x + dd4.x * u4.x), gelu_tanh(acc.y + dd4.y * u4.y)); zz.y = pk2(gelu_tanh(acc.z + dd4.z * u4.z), gelu_tanh(acc.w + dd4.w * u4.w));
                    *(u32x2*)(ZB + m * 256 + g * 16 + 4 * kq) = zz; }
            }
        }
        asm volatile("s_waitcnt lgkmcnt(0)" ::: "memory");
    }
    if (smp) *(f32x2*)(a.out + OUT_SSM_S + (((size_t)(l * DB + sq) * 16 + g) * 64 + lane) * 2) = (f32x2){hr, hi};
    else if (ck == 15) *(f32x2*)(a.out + OUT_SSM_P + (((size_t)(l * 8 + sq) * 16 + g) * 64 + lane) * 2) = (f32x2){hr, hi};
}

__device__ __forceinline__ bf16x8 pack8(const f32x16& p, int s) {
    u32x4 w; w.x = pk2(p[8 * s + 0], p[8 * s + 1]); w.y = pk2(p[8 * s + 2], p[8 * s + 3]); w.z = pk2(p[8 * s + 4], p[8 * s + 5]); w.w = pk2(p[8 * s + 6], p[8 * s + 7]);
    return __builtin_bit_cast(bf16x8, w);
}
__device__ __forceinline__ void attn_load4(const bf16* F, size_t fragbase, bf16x8 (&f)[4]) {
#pragma unroll
    for (int cs = 0; cs < 4; ++cs) f[cs] = *(const bf16x8*)(F + fragbase + cs * 512);
}
__device__ __forceinline__ void attn_tile(const bf16x8 (&qf)[2][2], const bf16x8 (&kf)[4], const bf16x8 (&vf)[4], f32x16 (&o)[2][2], float (&mrun)[2], float (&lrun)[2], bool diag, int r, int hh) {
    bf16x8 pf[2][2];
#pragma unroll
    for (int c = 0; c < 2; ++c) {
        f32x16 st;
#pragma unroll
        for (int e = 0; e < 16; ++e) st[e] = 0.f;
        st = __builtin_amdgcn_mfma_f32_32x32x16_bf16(kf[c * 2 + 0], qf[c][0], st, 0, 0, 0);
        st = __builtin_amdgcn_mfma_f32_32x32x16_bf16(kf[c * 2 + 1], qf[c][1], st, 0, 0, 0);
        if (diag) {
#pragma unroll
            for (int e = 0; e < 16; ++e) { const int key = (e & 3) + 8 * (e >> 2) + 4 * hh; if (key > r) st[e] = -1e30f; }
        }
        float mx = st[0];
#pragma unroll
        for (int e = 1; e < 16; ++e) mx = fmaxf(mx, st[e]);
        mx = fmaxf(mx, __shfl_xor(mx, 32));
        const bool upd = mx > mrun[c] + 8.0f;
        if (__any(upd)) {
            const float mnew = upd ? mx : mrun[c];
            const float corr = __builtin_amdgcn_exp2f(mrun[c] - mnew);
            lrun[c] *= corr; mrun[c] = mnew;
#pragma unroll
            for (int tl = 0; tl < 2; ++tl)
#pragma unroll
                for (int e = 0; e < 16; ++e) o[c][tl][e] *= corr;
        }
        float ps = 0.f;
        const float mcur = mrun[c];
#pragma unroll
        for (int e = 0; e < 16; ++e) { st[e] = __builtin_amdgcn_exp2f(st[e] - mcur); ps += st[e]; }
        lrun[c] += ps;
        pf[c][0] = pack8(st, 0); pf[c][1] = pack8(st, 1);
    }
#pragma unroll
    for (int c = 0; c < 2; ++c)
#pragma unroll
        for (int tl = 0; tl < 2; ++tl) {
            o[c][tl] = __builtin_amdgcn_mfma_f32_32x32x16_bf16(vf[tl * 2 + 0], pf[c][0], o[c][tl], 0, 0, 0);
            o[c][tl] = __builtin_amdgcn_mfma_f32_32x32x16_bf16(vf[tl * 2 + 1], pf[c][1], o[c][tl], 0, 0, 0);
        }
}
__device__ __forceinline__ void attn_prompt_wave(const Ctx& a, int l, int b, int h, int qt, float lam, int lane) {
    OPAQUE(lane);
    const bf16* QB = (const bf16*)(a.ws + WS_QB); const bf16* KF = (const bf16*)(a.ws + WS_KB); const bf16* VF = (const bf16*)(a.ws + WS_VT);
    bf16* OB = (bf16*)(a.ws + WS_OB); const bf16* PROJ = (const bf16*)(a.ws + WS_PROJ);
    const int r = lane & 31, hh = lane >> 5;
    const size_t mq = (size_t)b * SEQ + qt * 32 + r;
    bf16x8 qf[2][2];
#pragma unroll
    for (int c = 0; c < 2; ++c)
#pragma unroll
        for (int s = 0; s < 2; ++s) qf[c][s] = *(const bf16x8*)(QB + mq * 256 + h * 64 + c * 32 + 16 * s + 8 * hh);
    f32x16 o[2][2];
#pragma unroll
    for (int c = 0; c < 2; ++c)
#pragma unroll
        for (int tl = 0; tl < 2; ++tl)
#pragma unroll
            for (int e = 0; e < 16; ++e) o[c][tl][e] = 0.f;
    float mrun[2] = {-1e30f, -1e30f}, lrun[2] = {0.f, 0.f};
    const size_t fb0 = ((size_t)((b * 4 + h) * 64) * 4) * 512 + lane * 8;
    bf16x8 kA[4], kB[4], vv[4];
    attn_load4(KF, fb0, kA);
    int kt = 0;
    for (; kt + 1 <= qt; kt += 2) {
        attn_load4(VF, fb0 + (size_t)kt * 2048, vv);
        attn_load4(KF, fb0 + (size_t)(kt + 1) * 2048, kB);
        attn_tile(qf, kA, vv, o, mrun, lrun, false, r, hh);
        attn_load4(VF, fb0 + (size_t)(kt + 1) * 2048, vv);
        if (kt + 2 <= qt) attn_load4(KF, fb0 + (size_t)(kt + 2) * 2048, kA);
        attn_tile(qf, kB, vv, o, mrun, lrun, kt + 1 == qt, r, hh);
    }
    if (kt == qt) { attn_load4(VF, fb0 + (size_t)kt * 2048, vv); attn_tile(qf, kA, vv, o, mrun, lrun, true, r, hh); }
    const float l0 = lrun[0] + __shfl_xor(lrun[0], 32), l1 = lrun[1] + __shfl_xor(lrun[1], 32);
    const float i0 = 1.0f / l0, i1 = lam / l1;
    float ss = 0.f;
    f32x16 res[2];
#pragma unroll
    for (int tl = 0; tl < 2; ++tl)
#pragma unroll
        for (int e = 0; e < 16; ++e) { const float v = o[0][tl][e] * i0 - o[1][tl][e] * i1; res[tl][e] = v; ss += v * v; }
    ss += __shfl_xor(ss, 32);
    const float rs = rsqrtf(ss * (1.f / 64.f) + NORM_EPS) * (1.0f - lam_init_of(l));
    const float* sw = a.inp(I_SUBLN) + l * 64;
#pragma unroll
    for (int tl = 0; tl < 2; ++tl)
#pragma unroll
        for (int g4 = 0; g4 < 4; ++g4) { const int vd = 32 * tl + 8 * g4 + 4 * hh;
            const f32x4 w4 = *(const f32x4*)(sw + vd);
            f32x4 ov; ov.x = res[tl][4 * g4 + 0] * rs * w4.x; ov.y = res[tl][4 * g4 + 1] * rs * w4.y; ov.z = res[tl][4 * g4 + 2] * rs * w4.z; ov.w = res[tl][4 * g4 + 3] * rs * w4.w;
            const f32x4 gt = ldp4(PROJ + mq * DIN + OFF_G + h * 64 + vd);
            u32x2 ow; ow.x = pk2(ov.x * siluf_(gt.x), ov.y * siluf_(gt.y)); ow.y = pk2(ov.z * siluf_(gt.z), ov.w * siluf_(gt.w));
            *(u32x2*)(OB + mq * DM + h * 64 + vd) = ow; }
}

struct SmpK { f32x4 k[8]; };
__device__ __forceinline__ void smp_load(SmpK& d, const float* kp) {
#pragma unroll
    for (int t = 0; t < 8; ++t) d.k[t] = __builtin_nontemporal_load((const f32x4*)(kp + (size_t)t * 1024));
}
__device__ __forceinline__ void smp_group(const SmpK& d, const SmpK& dv, const f32x4 (&q)[8], f32x4 (&O)[4], float& M, float& Lsum, int nstep, bool isnew, int kk, int g, int lane) {
    float sc[8];
#pragma unroll
    for (int t = 0; t < 8; ++t) {
        float p[8];
#pragma unroll
        for (int i = 0; i < 8; ++i) p[i] = __builtin_fmaf(d.k[t].w, q[i].w, __builtin_fmaf(d.k[t].z, q[i].z, __builtin_fmaf(d.k[t].y, q[i].y, d.k[t].x * q[i].x)));
        float n4[4];
#pragma unroll
        for (int k = 0; k < 4; ++k) n4[k] = p[k] + dpp_mov<0x141>(p[4 + k]);
        float n2[2];
#pragma unroll
        for (int k = 0; k < 2; ++k) n2[k] = n4[k] + dpp_mov<0x4E>(n4[2 + k]);
        float sv = n2[0] + dpp_mov<0xB1>(n2[1]);
        if (t >= nstep || (isnew && (4 * t + kk) > g)) sv = -1e30f;
        sc[t] = sv;
    }
    float mx = fmaxf(fmaxf(fmaxf(sc[0], sc[1]), fmaxf(sc[2], sc[3])), fmaxf(fmaxf(sc[4], sc[5]), fmaxf(sc[6], sc[7])));
    mx = fmaxf(mx, __shfl_xor(mx, 16)); mx = fmaxf(mx, __shfl_xor(mx, 32));
    const float Mnew = fmaxf(M, mx);
    const float corr = __builtin_amdgcn_exp2f(M - Mnew);
    float ps = 0.f;
#pragma unroll
    for (int t = 0; t < 8; ++t) { sc[t] = __builtin_amdgcn_exp2f(sc[t] - Mnew); ps += sc[t]; }
    Lsum = Lsum * corr + ps; M = Mnew;
#pragma unroll
    for (int rg = 0; rg < 4; ++rg) { const float cr = __shfl(corr, (lane & 48) | (4 * kk + rg));
        O[0][rg] *= cr; O[1][rg] *= cr; O[2][rg] *= cr; O[3][rg] *= cr; }
    u32x4 pw; pw.x = pk2(sc[0], sc[1]); pw.y = pk2(sc[2], sc[3]); pw.z = pk2(sc[4], sc[5]); pw.w = pk2(sc[6], sc[7]);
    const bf16x8 pa = __builtin_bit_cast(bf16x8, pw);
#pragma unroll
    for (int e = 0; e < 4; ++e) {
        u32x4 vw; vw.x = pk2(dv.k[0][e], dv.k[1][e]); vw.y = pk2(dv.k[2][e], dv.k[3][e]); vw.z = pk2(dv.k[4][e], dv.k[5][e]); vw.w = pk2(dv.k[6][e], dv.k[7][e]);
        O[e] = __builtin_amdgcn_mfma_f32_16x16x32_bf16(pa, __builtin_bit_cast(bf16x8, vw), O[e], 0, 0, 0);
    }
}
__device__ __forceinline__ void attn_sample_wave(const Ctx& a, int l, int wi, int lane) {
    OPAQUE(lane);
    const int h = wi & 3, sp = (wi >> 2) % NSPLIT, b = (wi >> 2) / NSPLIT;
    const bf16* PROJ = (const bf16*)(a.ws + WS_PROJ);
    const int kk = lane >> 4, dq = lane & 15, g = (lane & 3) ^ ((lane & 4) ? 7 : 0);
    f32x4 q[8];
#pragma unroll
    for (int i = 0; i < 8; ++i) { q[i] = ldp4(PROJ + (size_t)(NP + b * 8 + (i ^ g)) * DIN + OFF_AQ + h * 64 + 4 * dq); q[i] *= QSCALE; }
    const bool isnew = (sp == NSPLIT - 1);
    float M = -1e30f, Lsum = 0.f;
    f32x4 O[4];
#pragma unroll
    for (int e = 0; e < 4; ++e) O[e] = (f32x4){0.f, 0.f, 0.f, 0.f};
    if (isnew) {
        SmpK d, dv;
        const bf16* kp = PROJ + (size_t)(NP + b * 8 + kk) * DIN + OFF_AK + h * 64 + 4 * dq;
#pragma unroll
        for (int t = 0; t < 8; ++t) { if (t < 2) { d.k[t] = ldp4(kp + (size_t)t * 4 * DIN); dv.k[t] = ldp4(kp + (size_t)t * 4 * DIN + (OFF_AV - OFF_AK)); }
            else { d.k[t] = (f32x4){0.f, 0.f, 0.f, 0.f}; dv.k[t] = (f32x4){0.f, 0.f, 0.f, 0.f}; } }
        smp_group(d, dv, q, O, M, Lsum, 2, true, kk, g, lane);
    } else {
        const int* pt = (const int*)a.inp(I_PT) + b * NPAGES + sp * 2;
        const int pg0 = pt[0], pg1 = pt[1];
        const size_t lo = (size_t)(kk * 4 + h) * 64 + 4 * dq;
        const float* kb0 = a.inp(I_CK) + ((size_t)l * NPOOL + pg0) * 32768 + lo; const float* kb1 = a.inp(I_CK) + ((size_t)l * NPOOL + pg1) * 32768 + lo;
        const float* vb0 = a.inp(I_CV) + ((size_t)l * NPOOL + pg0) * 32768 + lo; const float* vb1 = a.inp(I_CV) + ((size_t)l * NPOOL + pg1) * 32768 + lo;
        SmpK dA, dB, dV;
        smp_load(dA, kb0);
#pragma unroll
        for (int gi = 0; gi < 8; gi += 2) {
            smp_load(dV, ((gi >> 2) ? vb1 : vb0) + (size_t)(gi & 3) * 8192);
            { const int gn = gi + 1; smp_load(dB, ((gn >> 2) ? kb1 : kb0) + (size_t)(gn & 3) * 8192); }
            smp_group(dA, dV, q, O, M, Lsum, 8, false, kk, g, lane);
            { const int gn = gi + 1; smp_load(dV, ((gn >> 2) ? vb1 : vb0) + (size_t)(gn & 3) * 8192); }
            if (gi + 2 < 8) { const int gn = gi + 2; smp_load(dA, ((gn >> 2) ? kb1 : kb0) + (size_t)(gn & 3) * 8192); }
            smp_group(dB, dV, q, O, M, Lsum, 8, false, kk, g, lane);
        }
    }
    float Lall = Lsum + __shfl_xor(Lsum, 16); Lall += __shfl_xor(Lall, 32);
    float* part = (float*)(a.ws + WS_PART) + ((size_t)(b * 4 + h) * NSPLIT + sp) * PART_FLOATS;
    if (kk == 0) { const int pr = (dq & 8) | g; part[pr] = M; part[16 + pr] = Lall; }
#pragma unroll
    for (int rg = 0; rg < 4; ++rg) { const int r = 4 * kk + rg, pr = (r & 8) | ((r & 3) ^ ((r & 4) ? 7 : 0));
        *(f32x4*)(part + 32 + pr * 64 + 4 * dq) = (f32x4){O[0][rg], O[1][rg], O[2][rg], O[3][rg]}; }
}

__device__ __forceinline__ void attn_sample_merge_wave(const Ctx& a, int l, int wi, float lam, int lane) {
    OPAQUE(lane);
    const int h = wi & 3, q = wi >> 2, b = q >> 3, i = q & 7;
    const size_t m = (size_t)NP + q;
    const float* pb = (const float*)(a.ws + WS_PART) + ((size_t)(b * 4 + h) * NSPLIT) * PART_FLOATS;
    float oc[2];
#pragma unroll
    for (int c = 0; c < 2; ++c) { const int j = c * 8 + i;
        float ms[NSPLIT], M = -1e30f;
#pragma unroll
        for (int s = 0; s < NSPLIT; ++s) { ms[s] = pb[s * PART_FLOATS + j]; M = fmaxf(M, ms[s]); }
        float L = 0.f, O = 0.f;
#pragma unroll
        for (int s = 0; s < NSPLIT; ++s) { const float w = __builtin_amdgcn_exp2f(ms[s] - M); L += pb[s * PART_FLOATS + 16 + j] * w; O += pb[s * PART_FLOATS + 32 + j * 64 + lane] * w; }
        oc[c] = O / L; }
    const float v = oc[0] - lam * oc[1];
    const float ss = wave_sum(v * v);
    const float ov = v * rsqrtf(ss * (1.f / 64.f) + NORM_EPS) * a.inp(I_SUBLN)[l * 64 + lane] * (1.0f - lam_init_of(l));
    const float gt = ldp1((const bf16*)(a.ws + WS_PROJ) + m * DIN + OFF_G + h * 64 + lane);
    ((bf16*)(a.ws + WS_OB))[m * DM + h * 64 + lane] = (bf16)f2bf(ov * siluf_(gt));
}

__device__ __forceinline__ void glu_wave(const Ctx& a, int l, int unit, int wave, int lane) {
    OPAQUE(lane);
    const bf16* ZB = (const bf16*)(a.ws + WS_ZB); const bf16* WT = (const bf16*)(a.ws + WS_WGLU) + (size_t)l * 65536;
    const bf16* PROJ = (const bf16*)(a.ws + WS_PROJ); bf16* OB = (bf16*)(a.ws + WS_OB);
    const int r = lane & 31, hh = lane >> 5, n0 = wave * 32;
    const size_t m = (size_t)unit * 32 + r;
    const bf16* zp = ZB + m * 256 + 8 * hh; const bf16* wp = WT + (size_t)(n0 + r) * 256 + 8 * hh;
    f32x16 acc;
#pragma unroll
    for (int e = 0; e < 16; ++e) acc[e] = 0.f;
#pragma unroll
    for (int s0 = 0; s0 < 16; s0 += 8) {
        bf16x8 wa[8], zb[8];
#pragma unroll
        for (int s1 = 0; s1 < 8; ++s1) { wa[s1] = *(const bf16x8*)(wp + 16 * (s0 + s1)); zb[s1] = *(const bf16x8*)(zp + 16 * (s0 + s1)); }
#pragma unroll
        for (int s1 = 0; s1 < 8; ++s1) acc = __builtin_amdgcn_mfma_f32_32x32x16_bf16(wa[s1], zb[s1], acc, 0, 0, 0);
    }
    const float* bg = a.inp(I_BGLU) + l * 256;
#pragma unroll
    for (int g4 = 0; g4 < 4; ++g4) { const int n = n0 + 8 * g4 + 4 * hh;
        const f32x4 bb = *(const f32x4*)(bg + n), gt = ldp4(PROJ + m * DIN + OFF_G + 768 + n);
        const u32x2 zz = *(const u32x2*)(ZB + m * 256 + n);
        const float z0 = __builtin_bit_cast(float, zz.x << 16), z1 = __builtin_bit_cast(float, zz.x & 0xffff0000u), z2 = __builtin_bit_cast(float, zz.y << 16), z3 = __builtin_bit_cast(float, zz.y & 0xffff0000u);
        u32x2 o; o.x = pk2(z0 * sigmoidf_(acc[4 * g4 + 0] + bb.x) * siluf_(gt.x), z1 * sigmoidf_(acc[4 * g4 + 1] + bb.y) * siluf_(gt.y));
        o.y = pk2(z2 * sigmoidf_(acc[4 * g4 + 2] + bb.z) * siluf_(gt.z), z3 * sigmoidf_(acc[4 * g4 + 3] + bb.w) * siluf_(gt.w));
        *(u32x2*)(OB + m * DM + 768 + n) = o; }
}

constexpr int MM_RWA = 256;
constexpr int MM_RWB = 224;
constexpr int MM_AP = 256;
constexpr int MM_AS = (DB * NSPLIT * 4) / 8;
constexpr int MM_S5P = 256;
constexpr int MM_S5S = 256;
constexpr int MM_LRU = 128;
constexpr int MM_RWS = DB * 4;
constexpr int MM_MRG = 512;
constexpr int MM_GLU = MTOK / 32;
__device__ __forceinline__ void ph_mixA(const Ctx& a, int lq, int MMSK, LAS unsigned char* lds, volatile LAS unsigned* MISC, int tid, int lane, int wave) {
    const int l = lq & 1;
    unsigned* qctr = (unsigned*)(a.ws + WS_CTL) + CW_QUEUE + 1024 * lq;
    const float lam = compute_lam(a, l, lane);
    int u;
    const bool streamer = ((blockIdx.x >> 3) % STREAM_DIV) == 0;
#pragma unroll 1
    for (int pass = 0; pass < 2; ++pass) {
        if ((pass == 0) == streamer) { if ((MMSK >> 2) & 1) while ((u = grab_unit(qctr + 2 * 64, MISC, tid)) < MM_AS) attn_sample_wave(a, l, u * 8 + wave, lane); }
        if (pass == 0) {
            if ((MMSK >> 0) & 1) while ((u = grab_unit(qctr + 0 * 64, MISC, tid)) < MM_RWA) rwkv_prompt_unitA(a, l, u, lds, tid);
            if ((MMSK >> 1) & 1) while ((u = grab_unit(qctr + 1 * 64, MISC, tid)) < MM_AP) { const int bh = u & 31, qt = 8 * (7 - (u >> 5)) + wave; attn_prompt_wave(a, l, bh >> 2, bh & 3, qt, lam, lane); }
            if ((MMSK >> 3) & 1) while ((u = grab_unit(qctr + 3 * 64, MISC, tid)) < MM_S5P) s5_pass2_wave(a, l, false, u * 8 + wave, lds + wave * 17408, lane);
            if ((MMSK >> 4) & 1) while ((u = grab_unit(qctr + 4 * 64, MISC, tid)) < MM_S5S) s5_pass2_wave(a, l, true, u * 8 + wave, lds + wave * 17408, lane);
            if ((MMSK >> 5) & 1) while ((u = grab_unit(qctr + 5 * 64, MISC, tid)) < MM_LRU) lru_pass2_wave(a, l, u * 8 + wave, lane);
        }
    }
    __syncthreads();
}
__device__ __forceinline__ void ph_mixB(const Ctx& a, int lq, int MMSK, LAS unsigned char* lds, volatile LAS unsigned* MISC, int tid, int lane, int wave) {
    const int l = lq & 1;
    unsigned* qctr = (unsigned*)(a.ws + WS_CTL) + CW_QUEUE + 1024 * lq + 512;
    int u;
    if ((MMSK >> 0) & 1) while ((u = grab_unit(qctr + 0 * 64, MISC, tid)) < MM_RWB) rwkv_prompt_unitB(a, l, u, lds, tid);
    if ((MMSK >> 1) & 1) while ((u = grab_unit(qctr + 1 * 64, MISC, tid)) < MM_RWS / 2) {
#pragma unroll 1
        for (int k2 = 0; k2 < 2; ++k2) rwkv_sample_unit(a, l, u >> 1, 2 * (u & 1) + k2, lds, tid); }
    if ((MMSK >> 2) & 1) while ((u = grab_unit(qctr + 2 * 64, MISC, tid)) < MM_GLU) glu_wave(a, l, u, wave, lane);
    if ((MMSK >> 3) & 1) { const float lam = compute_lam(a, l, lane); while ((u = grab_unit(qctr + 3 * 64, MISC, tid)) < MM_MRG) attn_sample_merge_wave(a, l, u * 8 + wave, lam, lane); }
    __syncthreads();
}

__device__ __forceinline__ void ph_postnorm(const Ctx& a, int l, int lane, int wave) {
    OPAQUE(lane);
    const bf16* YP = (const bf16*)(a.ws + WS_YP);
    const float* xp = a.inp(I_XP);
    const float* xs = a.inp(I_XS) - (size_t)NP * DM;
    bf16* X1b = (bf16*)(a.ws + WS_X1);
    float* yp = a.out + OUT_Y_P;
    float* ys = a.out + OUT_Y_S - (size_t)NP * DM;
    bf16* H = (bf16*)(a.ws + WS_H);
    f32x4 gp[4], g2[4];
#pragma unroll
    for (int j = 0; j < 4; ++j) { gp[j] = ((const f32x4*)(a.inp(I_NPOST) + l * DM) + lane)[64 * j]; g2[j] = ((const f32x4*)(a.inp(I_NPRE) + DM) + lane)[64 * j]; }
    const int gw = blockIdx.x * NWAVES + wave, NGW = gridDim.x * NWAVES;
    for (int m0 = gw; m0 < MTOK; m0 += 2 * NGW) {
        const int m1 = m0 + NGW; const bool has1 = m1 < MTOK; const int mb = has1 ? m1 : m0;
        const bf16* ya = YP + (size_t)m0 * DM + 4 * lane; const bf16* yb = YP + (size_t)mb * DM + 4 * lane;
        const f32x4* xa = (const f32x4*)((m0 < NP ? xp : xs) + (size_t)m0 * DM) + lane; const f32x4* xb = (const f32x4*)((mb < NP ? xp : xs) + (size_t)mb * DM) + lane;
        f32x4 va[4], vb[4], wa[4], wb[4];
#pragma unroll
        for (int j = 0; j < 4; ++j) { va[j] = ldp4(ya + 256 * j); vb[j] = ldp4(yb + 256 * j);
            if (l == 0) { wa[j] = xa[64 * j]; wb[j] = xb[64 * j]; }
            else { wa[j] = ldp4(X1b + (size_t)m0 * DM + 4 * lane + 256 * j); wb[j] = ldp4(X1b + (size_t)mb * DM + 4 * lane + 256 * j); } }
        float sa = 0.f, sb = 0.f;
#pragma unroll
        for (int j = 0; j < 4; ++j) { sa += (va[j].x * va[j].x + va[j].y * va[j].y) + (va[j].z * va[j].z + va[j].w * va[j].w); sb += (vb[j].x * vb[j].x + vb[j].y * vb[j].y) + (vb[j].z * vb[j].z + vb[j].w * vb[j].w); }
        const float ra = rsqrtf(wave_sum_fast(sa) * (1.f / DM) + NORM_EPS), rb = rsqrtf(wave_sum_fast(sb) * (1.f / DM) + NORM_EPS);
        f32x4* oa = (f32x4*)((m0 < NP ? yp : ys) + (size_t)m0 * DM) + lane; f32x4* ob = (f32x4*)((mb < NP ? yp : ys) + (size_t)mb * DM) + lane;
        float ta = 0.f, tb = 0.f;
#pragma unroll
        for (int j = 0; j < 4; ++j) { va[j] = wa[j] + va[j] * ra * gp[j]; vb[j] = wb[j] + vb[j] * rb * gp[j];
            if (l == 0) { u32x2 o; o.x = pk2(va[j].x, va[j].y); o.y = pk2(va[j].z, va[j].w); *(u32x2*)(X1b + (size_t)m0 * DM + 4 * lane + 256 * j) = o;
                if (has1) { u32x2 p; p.x = pk2(vb[j].x, vb[j].y); p.y = pk2(vb[j].z, vb[j].w); *(u32x2*)(X1b + (size_t)mb * DM + 4 * lane + 256 * j) = p; } }
            else { __builtin_nontemporal_store(va[j], oa + 64 * j); if (has1) __builtin_nontemporal_store(vb[j], ob + 64 * j); }
            ta += (va[j].x * va[j].x + va[j].y * va[j].y) + (va[j].z * va[j].z + va[j].w * va[j].w); tb += (vb[j].x * vb[j].x + vb[j].y * vb[j].y) + (vb[j].z * vb[j].z + vb[j].w * vb[j].w); }
        if (l == 0) {
            const float qa = rsqrtf(wave_sum_fast(ta) * (1.f / DM) + NORM_EPS), qb = rsqrtf(wave_sum_fast(tb) * (1.f / DM) + NORM_EPS);
            u32x2* ha = (u32x2*)(H + (size_t)m0 * DM) + lane; u32x2* hb = (u32x2*)(H + (size_t)mb * DM) + lane;
#pragma unroll
            for (int j = 0; j < 4; ++j) { u32x2 o; o.x = pk2(va[j].x * qa * g2[j].x, va[j].y * qa * g2[j].y); o.y = pk2(va[j].z * qa * g2[j].z, va[j].w * qa * g2[j].w); ha[64 * j] = o;
                if (has1) { u32x2 p; p.x = pk2(vb[j].x * qb * g2[j].x, vb[j].y * qb * g2[j].y); p.y = pk2(vb[j].z * qb * g2[j].z, vb[j].w * qb * g2[j].w); hb[64 * j] = p; } }
        }
    }
}

constexpr int N_PHASES = 13;
#ifndef DUP_PHASE
#define DUP_PHASE -1
#endif
#ifndef DUP_MASK
#define DUP_MASK 0x7f
#endif
__global__ void __launch_bounds__(NTHREADS, 2) hymba_fwd(Args args) {
    extern __shared__ __attribute__((aligned(16))) unsigned char lds_raw[];
    LAS unsigned char* lds = (LAS unsigned char*)lds_raw;
    volatile LAS unsigned* MISC = (volatile LAS unsigned*)(lds + MISC_OFF);
    if (threadIdx.x < 64) MISC[threadIdx.x] = 0u;
    if (threadIdx.x < N_IN) *(LAS unsigned long long*)(lds + TAB_OFF + 8 * threadIdx.x) = (unsigned long long)args.in[threadIdx.x];
    Ctx ctx; ctx.out = args.out; ctx.ws = args.ws; ctx.tab = (const LAS unsigned*)(lds + TAB_OFF);
    const int wave_s = __builtin_amdgcn_readfirstlane(threadIdx.x >> 6);
#define TIDS() int tid = wave_s * 64 + lane_id_asm(); const int lane = tid & 63, wave = wave_s; (void)lane; (void)wave; Ctx cx = ctx; { GAS unsigned char* w_ = (GAS unsigned char*)ctx.ws; GAS float* o_ = (GAS float*)ctx.out; asm volatile("" : "+s"(w_), "+s"(o_)); cx.ws = (unsigned char*)w_; cx.out = (float*)o_; }
    __syncthreads();
    unsigned* ctl = (unsigned*)(args.ws + WS_CTL);
#if MK_PER_PHASE
#define GRID_BAR() do { } while (0)
#else
    XcdBarrier bar = xcd_barrier_post(ctl + CW_BAR, MISC);
#define GRID_BAR() xcd_barrier(bar, wave_s == 0 && lane_id_asm() == 0)
#endif
    const int lo = args.ph_lo, hi = args.ph_hi;
#define IN(k) (lo <= (k) && (k) < hi)
#define SEAM(k) do { if (IN(k) && IN((k) + 1)) GRID_BAR(); } while (0)
#define NREP(j) ((DUP_PHASE == (j)) ? 2 : 1)

    if (IN(0)) { TIDS(); ph_prologue(cx, lds, lane, wave); }
    SEAM(0);
    for (int l = 0; l < 2; ++l) {
        const int p0 = 1 + 6 * l;
        if (IN(p0))
#pragma unroll 1
          for (int rp = 0; rp < NREP(1); ++rp) {
            if (rp) GRID_BAR();
            TIDS();
            pg8::Gemm g{(const pg8::bf16_t*)(cx.ws + WS_H), (const pg8::bf16_t*)(cx.ws + WS_WIN) + (size_t)l * DIN * DM, MTOK, DIN, DM};
            pg8::StaticOrder S; S.init(MTOK, DIN, (int)gridDim.x, (int)blockIdx.x);
            EpiProj E{(bf16*)(cx.ws + WS_PROJ), cx.out, l};
            pg8::gemm_phase<EpiProj, pg8::StaticOrder, false>(lds, g, S, E, nullptr, tid);
        }
        SEAM(p0);
        if (IN(p0 + 1)) {
#pragma unroll 1
            for (int rp = 0; rp < NREP(2); ++rp) { if (rp) GRID_BAR(); TIDS(); ph_mixprep(cx, l + 2 * rp, rp ? (DUP_MASK) : 0x1f, lds, MISC, tid, lane, wave); } }
        SEAM(p0 + 1);
        if (IN(p0 + 2)) {
#pragma unroll 1
            for (int rp = 0; rp < NREP(3); ++rp) { if (rp) GRID_BAR(); TIDS(); ph_mixA(cx, l + 2 * rp, rp ? (DUP_MASK) : 0x3f, lds, MISC, tid, lane, wave); } }
        SEAM(p0 + 2);
        if (IN(p0 + 3)) {
#pragma unroll 1
            for (int rp = 0; rp < NREP(4); ++rp) { if (rp) GRID_BAR(); TIDS(); ph_mixB(cx, l + 2 * rp, rp ? (DUP_MASK) : 0xf, lds, MISC, tid, lane, wave); } }
        SEAM(p0 + 3);
        if (IN(p0 + 4))
#pragma unroll 1
          for (int rp = 0; rp < NREP(5); ++rp) {
            if (rp) GRID_BAR();
            TIDS();
            pg8::Gemm g{(const pg8::bf16_t*)(cx.ws + WS_OB), (const pg8::bf16_t*)(cx.ws + WS_WOUT) + (size_t)l * DM * DM, MTOK, DM, DM};
            FirstRoundOrder S; S.init(MTOK, DM, (int)gridDim.x, (int)blockIdx.x);
            EpiPlain E{(bf16*)(cx.ws + WS_YP), DM};
            pg8::gemm_phase<EpiPlain, FirstRoundOrder, false>(lds, g, S, E, nullptr, tid);
            g2_tail(cx, l, lds, tid);
        }
        SEAM(p0 + 4);
        if (IN(p0 + 5)) {
#pragma unroll 1
            for (int rp = 0; rp < NREP(6); ++rp) { if (rp) GRID_BAR(); TIDS(); ph_postnorm(cx, l, lane, wave); } }
        SEAM(p0 + 5);
    }
#undef IN
#undef SEAM
}

extern "C" void kernel_launch(void* const* d_in, const int* in_sizes, int n_in, void* d_out, int out_size, void* d_ws, size_t ws_size, hipStream_t stream) {
    static int grid = 0;
    if (grid == 0) {
        if (n_in != N_IN || out_size != (int)OUT_TOTAL || ws_size < WS_END) { fprintf(stderr, "kernel_launch: unexpected shapes: n_in %d out %d ws %zu (need %zu)\n", n_in, out_size, ws_size, (size_t)WS_END); grid = -1; return; }
        int dev = 0, cus = 0, per_cu = 0;
        if (hipGetDevice(&dev) != hipSuccess || hipDeviceGetAttribute(&cus, hipDeviceAttributeMultiprocessorCount, dev) != hipSuccess) { grid = -1; return; }
        if (hipFuncSetAttribute((const void*)hymba_fwd, hipFuncAttributeMaxDynamicSharedMemorySize, LDS_BYTES) != hipSuccess) { fprintf(stderr, "kernel_launch: hipFuncSetAttribute failed\n"); grid = -1; return; }
        if (hipOccupancyMaxActiveBlocksPerMultiprocessor(&per_cu, (const void*)hymba_fwd, NTHREADS, LDS_BYTES) != hipSuccess || per_cu < 1) { fprintf(stderr, "kernel_launch: occupancy query says %d\n", per_cu); }
        (void)hipGetLastError();
        grid = cus;
    }
    if (grid < 0) return;
    (void)hipMemsetAsync((char*)d_ws + WS_CTL, 0, CTL_ZERO_BYTES, stream);
    Args a{};
    for (int i = 0; i < N_IN; ++i) a.in[i] = (const float*)d_in[i];
    a.out = (float*)d_out; a.ws = (unsigned char*)d_ws;
#if MK_PER_PHASE
    for (int p = 0; p < N_PHASES; ++p) { a.ph_lo = p; a.ph_hi = p + 1; hipLaunchKernelGGL(hymba_fwd, dim3(grid), dim3(NTHREADS), LDS_BYTES, stream, a); }
#else
    a.ph_lo = 0; a.ph_hi = N_PHASES; hipLaunchKernelGGL(hymba_fwd, dim3(grid), dim3(NTHREADS), LDS_BYTES, stream, a);
#endif
}
```
